# Optimizing an MI355X kernel written in HIP

```python
import math
import jax, jax.numpy as jnp
from jax import lax
import numpy as np

D_MODEL = 4096
BATCH = 2
SEQ = 8192
DEPTH = 4

N_MIXERS = 3
MIX_WIDTH = D_MODEL
EPS = 1e-6
GRID_W = 64
NA_HEAD_DIM = 128
NA_HEADS = MIX_WIDTH // NA_HEAD_DIM
NA_ROWS_MAX = 8
NA_COLS = 16
S5_GROUP = 16
S5_GROUPS = MIX_WIDTH // S5_GROUP
S5_STATE = 64
S5_DT_MIN = 1e-3
S5_DT_MAX = 1e-1
GLA_DV = 512
GLA_HEADS = MIX_WIDTH // GLA_DV
GLA_KEY_WIDTH = MIX_WIDTH // 2
GLA_DK = GLA_KEY_WIDTH // GLA_HEADS
GLA_GATE_RANK = 16
GLA_GATE_NORM = 16.0
GLA_CHUNK = 64
N_NA_LAYERS = (DEPTH + 2) // 3
N_S5_LAYERS = (DEPTH + 1) // 3
N_GLA_LAYERS = DEPTH // 3

kernel_name = 'bidir_hybrid_na_s5_gla_adaln'


def _rmsnorm(x, w):
    xf = x.astype(jnp.float32)
    y = xf * lax.rsqrt(jnp.mean(xf * xf, axis=-1, keepdims=True) + EPS) * w.astype(jnp.float32)
    return y.astype(x.dtype)


def _na_mixer(h, w_in, rpb, w_out):
    bsz, seq, _ = h.shape
    q, k, v, g = jnp.split(h @ w_in, 4, axis=-1)
    rows = seq // GRID_W
    kr = min(NA_ROWS_MAX, rows)
    grid = lambda t: t.reshape(bsz, rows, GRID_W, NA_HEADS, NA_HEAD_DIM)
    qg, kg, vg = grid(q), grid(k), grid(v)
    col = jnp.arange(GRID_W)
    col_start = jnp.clip(col - NA_COLS // 2, 0, GRID_W - NA_COLS)
    col_idx = col_start[:, None] + jnp.arange(NA_COLS)[None, :]
    bias_cols = rpb.astype(jnp.float32)[:, :, col_idx - col[:, None] + NA_COLS - 1]
    scale = NA_HEAD_DIM ** -0.5

    def row_block(r):
        row_start = jnp.clip(r - kr // 2, 0, rows - kr)
        q_r = lax.dynamic_index_in_dim(qg, r, axis=1, keepdims=False)
        k_win = lax.dynamic_slice_in_dim(kg, row_start, kr, axis=1)[:, :, col_idx]
        v_win = lax.dynamic_slice_in_dim(vg, row_start, kr, axis=1)[:, :, col_idx]
        dr = row_start + jnp.arange(kr) - r + NA_ROWS_MAX - 1
        bias = jnp.take(bias_cols, dr, axis=1).transpose(0, 2, 1, 3)
        s = jnp.einsum('bqhd,bkqjhd->bhqkj', q_r, k_win).astype(jnp.float32) * scale + bias[None]
        p = jax.nn.softmax(s, axis=(-2, -1)).astype(v_win.dtype)
        return jnp.einsum('bhqkj,bkqjhd->bqhd', p, v_win)

    out = lax.map(row_block, jnp.arange(rows))
    out = out.transpose(1, 0, 2, 3, 4).reshape(bsz, seq, MIX_WIDTH)
    return (out * jax.nn.silu(g)) @ w_out


def _s5_states(u, a_re, a_im, log_step, b_re, b_im):
    dt = jnp.exp(log_step.astype(jnp.float32))
    a_re = a_re.astype(jnp.float32)
    a_im = a_im.astype(jnp.float32)
    mag = jnp.exp(a_re * dt)
    lam_re = mag * jnp.cos(a_im * dt)
    lam_im = mag * jnp.sin(a_im * dt)
    den = a_re * a_re + a_im * a_im
    nr = lam_re - 1.0
    r_re = ((nr * a_re + lam_im * a_im) / den)[..., None]
    r_im = ((lam_im * a_re - nr * a_im) / den)[..., None]
    b_re = b_re.astype(jnp.float32)
    b_im = b_im.astype(jnp.float32)
    bb_re = r_re * b_re - r_im * b_im
    bb_im = r_re * b_im + r_im * b_re
    bu_re = jnp.einsum('blgi,gpi->lbgp', u, bb_re)
    bu_im = jnp.einsum('blgi,gpi->lbgp', u, bb_im)
    seq = u.shape[1]
    lam_re_l = jnp.broadcast_to(lam_re[None, None], (seq, 1) + lam_re.shape)
    lam_im_l = jnp.broadcast_to(lam_im[None, None], (seq, 1) + lam_im.shape)

    def combine(e1, e2):
        a1r, a1i, b1r, b1i = e1
        a2r, a2i, b2r, b2i = e2
        return (a2r * a1r - a2i * a1i,
                a2r * a1i + a2i * a1r,
                a2r * b1r - a2i * b1i + b2r,
                a2r * b1i + a2i * b1r + b2i)

    _, _, x_re, x_im = lax.associative_scan(combine, (lam_re_l, lam_im_l, bu_re, bu_im), axis=0)
    return x_re, x_im


def _s5_mixer(h, w_in, b_re, b_im, c_re, c_im, d_skip, a_re_f, a_im_f, a_re_b, a_im_b,
              log_step_f, log_step_b, w_glu, b_glu, w_out):
    bsz, seq, _ = h.shape
    u, g = jnp.split(h @ w_in, 2, axis=-1)
    uf = u.reshape(bsz, seq, S5_GROUPS, S5_GROUP).astype(jnp.float32)
    xr_f, xi_f = _s5_states(uf, a_re_f, a_im_f, log_step_f, b_re, b_im)
    xr_b, xi_b = _s5_states(jnp.flip(uf, axis=1), a_re_b, a_im_b, log_step_b, b_re, b_im)
    x_re = xr_f + jnp.flip(xr_b, axis=0)
    x_im = xi_f + jnp.flip(xi_b, axis=0)
    y = (jnp.einsum('lbgp,gip->blgi', x_re, c_re.astype(jnp.float32))
         - jnp.einsum('lbgp,gip->blgi', x_im, c_im.astype(jnp.float32))
         + d_skip.astype(jnp.float32) * uf)
    y = jax.nn.gelu(y.reshape(bsz, seq, MIX_WIDTH).astype(h.dtype))
    y = y * jax.nn.sigmoid(y @ w_glu + b_glu)
    return (y * jax.nn.silu(g)) @ w_out


def _gla_chunked(q, k, v, gk, include_diag):
    bsz, seq, heads, dk = q.shape
    dv = v.shape[-1]
    n = seq // GLA_CHUNK
    chunks = lambda t: t.reshape(bsz, n, GLA_CHUNK, heads, t.shape[-1])
    q, k, v, gk = chunks(q), chunks(k), chunks(v), chunks(gk)
    b = jnp.cumsum(gk, axis=2)
    b_last = b[:, :, -1:]
    q_s = q * jnp.exp(b)
    k_s = k * jnp.exp(-b)
    idx = jnp.arange(GLA_CHUNK)
    mask = (idx[:, None] >= idx[None, :]) if include_diag else (idx[:, None] > idx[None, :])
    scores = jnp.einsum('bnihd,bnjhd->bnhij', q_s, k_s)
    scores = jnp.where(mask, scores, 0.0)
    o_intra = jnp.einsum('bnhij,bnjhv->bnihv', scores, v)
    k_end = k * jnp.exp(b_last - b)
    decay = jnp.exp(b_last[:, :, 0])

    def step(state, xs):
        q_n, k_n, v_n, d_n = xs
        o_n = jnp.einsum('bihd,bhdv->bihv', q_n, state)
        state = d_n[..., None] * state + jnp.einsum('bjhd,bjhv->bhdv', k_n, v_n)
        return state, o_n

    s0 = jnp.zeros((bsz, heads, dk, dv), jnp.float32)
    _, o_inter = lax.scan(step, s0, (q_s.swapaxes(0, 1), k_end.swapaxes(0, 1),
                                     v.swapaxes(0, 1), decay.swapaxes(0, 1)))
    o = o_intra + o_inter.swapaxes(0, 1)
    return o.reshape(bsz, seq, heads, dv)


def _gla_mixer(h, w_in, w1_f, w2_f, bg_f, w1_b, w2_b, bg_b, norm_w, w_out):
    bsz, seq, _ = h.shape
    q, k, v, g = jnp.split(h @ w_in, [GLA_KEY_WIDTH, 2 * GLA_KEY_WIDTH, 2 * GLA_KEY_WIDTH + MIX_WIDTH], axis=-1)
    heads = lambda t, d: t.reshape(bsz, seq, GLA_HEADS, d).astype(jnp.float32)
    q = heads(q, GLA_DK) * (GLA_DK ** -0.5)
    k = heads(k, GLA_DK)
    v = heads(v, GLA_DV)
    gate = lambda w1, w2, bg: heads(jax.nn.log_sigmoid(((h @ w1) @ w2 + bg).astype(jnp.float32)) / GLA_GATE_NORM, GLA_DK)
    gk_f = gate(w1_f, w2_f, bg_f)
    gk_b = gate(w1_b, w2_b, bg_b)
    flip = lambda t: jnp.flip(t, axis=1)
    o = (_gla_chunked(q, k, v, gk_f, True)
         + flip(_gla_chunked(flip(q), flip(k), flip(v), flip(gk_b), False)))
    o = o * lax.rsqrt(jnp.mean(o * o, axis=-1, keepdims=True) + EPS) * norm_w.astype(jnp.float32)
    o = o.reshape(bsz, seq, MIX_WIDTH).astype(h.dtype)
    return (o * jax.nn.silu(g)) @ w_out


def setup_inputs(seed: int = 0) -> dict:
    key = jax.random.key(seed)
    keys = iter(jax.random.split(key, 40))
    nrm = lambda shape, s: jax.random.normal(next(keys), shape, jnp.float32) * s
    E, D = MIX_WIDTH, D_MODEL
    G, P, I = S5_GROUPS, S5_STATE, S5_GROUP
    a_im_base = math.pi * jnp.arange(P, dtype=jnp.float32)
    log_step = lambda: jax.random.uniform(next(keys), (N_S5_LAYERS, G, P), jnp.float32,
                                          math.log(S5_DT_MIN), math.log(S5_DT_MAX))
    return {
        'x': nrm((BATCH, SEQ, D), 1.0),
        'c': nrm((BATCH, D), 1.0),
        'mod_w': nrm((DEPTH, D, 3 * D), 0.5 * D ** -0.5),
        'mod_b': nrm((DEPTH, 3 * D), 0.02),
        'norm_w': 1.0 + nrm((DEPTH, D), 0.02),
        'na_w_in': nrm((N_NA_LAYERS, D, 4 * E), D ** -0.5),
        'na_rpb': nrm((N_NA_LAYERS, NA_HEADS, 2 * NA_ROWS_MAX - 1, 2 * NA_COLS - 1), 0.1),
        'na_w_out': nrm((N_NA_LAYERS, E, D), E ** -0.5),
        's5_w_in': nrm((N_S5_LAYERS, D, 2 * E), D ** -0.5),
        's5_b_re': nrm((N_S5_LAYERS, G, P, I), (2 * I) ** -0.5),
        's5_b_im': nrm((N_S5_LAYERS, G, P, I), (2 * I) ** -0.5),
        's5_c_re': nrm((N_S5_LAYERS, G, I, P), (2 * P) ** -0.5),
        's5_c_im': nrm((N_S5_LAYERS, G, I, P), (2 * P) ** -0.5),
        's5_d': nrm((N_S5_LAYERS, G, I), 1.0),
        's5_a_re_fwd': -0.5 + nrm((N_S5_LAYERS, G, P), 0.01),
        's5_a_im_fwd': a_im_base + nrm((N_S5_LAYERS, G, P), 0.01),
        's5_a_re_bwd': -0.5 + nrm((N_S5_LAYERS, G, P), 0.01),
        's5_a_im_bwd': a_im_base + nrm((N_S5_LAYERS, G, P), 0.01),
        's5_log_step_fwd': log_step(),
        's5_log_step_bwd': log_step(),
        's5_w_glu': nrm((N_S5_LAYERS, E, E), E ** -0.5),
        's5_b_glu': nrm((N_S5_LAYERS, E), 0.02),
        's5_w_out': nrm((N_S5_LAYERS, E, D), E ** -0.5),
        'gla_w_in': nrm((N_GLA_LAYERS, D, 2 * GLA_KEY_WIDTH + 2 * E), D ** -0.5),
        'gla_gk_w1_fwd': nrm((N_GLA_LAYERS, D, GLA_GATE_RANK), D ** -0.5),
        'gla_gk_w2_fwd': nrm((N_GLA_LAYERS, GLA_GATE_RANK, GLA_KEY_WIDTH), GLA_GATE_RANK ** -0.5),
        'gla_gk_b_fwd': nrm((N_GLA_LAYERS, GLA_KEY_WIDTH), 0.1),
        'gla_gk_w1_bwd': nrm((N_GLA_LAYERS, D, GLA_GATE_RANK), D ** -0.5),
        'gla_gk_w2_bwd': nrm((N_GLA_LAYERS, GLA_GATE_RANK, GLA_KEY_WIDTH), GLA_GATE_RANK ** -0.5),
        'gla_gk_b_bwd': nrm((N_GLA_LAYERS, GLA_KEY_WIDTH), 0.1),
        'gla_norm_w': 1.0 + nrm((N_GLA_LAYERS, GLA_DV), 0.02),
        'gla_w_out': nrm((N_GLA_LAYERS, E, D), E ** -0.5),
        'final_norm_w': 1.0 + nrm((D,), 0.02),
    }


def reference(x, c, mod_w, mod_b, norm_w, na_w_in, na_rpb, na_w_out,
              s5_w_in, s5_b_re, s5_b_im, s5_c_re, s5_c_im, s5_d,
              s5_a_re_fwd, s5_a_im_fwd, s5_a_re_bwd, s5_a_im_bwd,
              s5_log_step_fwd, s5_log_step_bwd, s5_w_glu, s5_b_glu, s5_w_out,
              gla_w_in, gla_gk_w1_fwd, gla_gk_w2_fwd, gla_gk_b_fwd,
              gla_gk_w1_bwd, gla_gk_w2_bwd, gla_gk_b_bwd, gla_norm_w, gla_w_out,
              final_norm_w):
    c_act = jax.nn.silu(c)
    for i in range(DEPTH):
        kind, j = i % N_MIXERS, i // N_MIXERS
        mod = c_act @ mod_w[i] + mod_b[i]
        shift, scale, gate = [m[:, None, :] for m in jnp.split(mod, 3, axis=-1)]
        h = _rmsnorm(x, norm_w[i]) * (1.0 + scale) + shift
        if kind == 0:
            y = _na_mixer(h, na_w_in[j], na_rpb[j], na_w_out[j])
        elif kind == 1:
            y = _s5_mixer(h, s5_w_in[j], s5_b_re[j], s5_b_im[j], s5_c_re[j], s5_c_im[j], s5_d[j],
                          s5_a_re_fwd[j], s5_a_im_fwd[j], s5_a_re_bwd[j], s5_a_im_bwd[j],
                          s5_log_step_fwd[j], s5_log_step_bwd[j], s5_w_glu[j], s5_b_glu[j], s5_w_out[j])
        else:
            y = _gla_mixer(h, gla_w_in[j], gla_gk_w1_fwd[j], gla_gk_w2_fwd[j], gla_gk_b_fwd[j],
                           gla_gk_w1_bwd[j], gla_gk_w2_bwd[j], gla_gk_b_bwd[j], gla_norm_w[j], gla_w_out[j])
        x = x + gate * y
    return _rmsnorm(x, final_norm_w)
```

```cpp
#include <hip/hip_runtime.h>
#include <cstdio>
#include <cstdint>

#ifndef MK_ONE_LAUNCH
#define MK_ONE_LAUNCH 0
#endif
#ifndef MK_DIAG
#define MK_DIAG 0
#endif
#ifndef MK_NLAYERS
#define MK_NLAYERS 4
#endif

namespace pg8 {
#define PG8_LAS __attribute__((address_space(3)))
typedef unsigned short bf16_t;
typedef short bf16x8 __attribute__((ext_vector_type(8)));
typedef float f32x4 __attribute__((ext_vector_type(4)));
typedef unsigned u32x4 __attribute__((ext_vector_type(4)));
typedef unsigned u32x2 __attribute__((ext_vector_type(2)));
constexpr int BM = 256, BK = 64, HALF = 128, HTB = HALF * BK * 2  , STAGE_BYTES = 8 * HTB, NXCD = 8, WGM = 8;

__host__ __device__ __forceinline__ int lds_byte(int r, int c) { const int st = (r >> 4) * 2 + (c >> 5), rr = r & 15, cc = c & 31, ob = rr * 64 + cc * 2; return st * 1024 + (ob ^ (((ob >> 9) & 1) << 5)); }
__host__ __device__ __forceinline__ void stage_rc(int b, int& R, int& C) { const int st = b / 1024, sb = b % 1024, swz = sb ^ (((sb >> 9) & 1) << 5); R = (st >> 1) * 16 + swz / 64; C = (st & 1) * 32 + (swz % 64) / 2; }
__host__ __device__ __forceinline__ int perm32(int rho) { const int n = rho >> 4, i = rho & 15; return 8 * (i >> 2) + 4 * n + (i & 3); }

struct Unit { int pm, pn, pb, koff; };
struct Gemm { const bf16_t* A; const bf16_t* Bt; int K, lda, ldb; unsigned* dflag; unsigned dbit; };

struct StaticOrder {
    int nM, nN, nwg, G, c;
    __host__ __device__ void init(int M, int N, int G_, int c_) { nM = M / BM; nN = N / BM; nwg = nM * nN; G = G_; c = c_; }
    __host__ __device__ bool next(int i, Unit& u) const {
        const long L = (long)i * G + c; if (L >= nwg) return false;
        int wgid = (int)L; { const int q = nwg / NXCD, r = nwg % NXCD, xcd = wgid % NXCD, off = wgid / NXCD; wgid = (xcd < r ? xcd * (q + 1) : r * (q + 1) + (xcd - r) * q) + off; }
        const int nig = WGM * nN, gid = wgid / nig, fm = gid * WGM, gsz = (nM - fm) < WGM ? (nM - fm) : WGM;
        u.pm = fm + ((wgid % nig) % gsz); u.pn = (wgid % nig) / gsz; u.pb = u.pn; u.koff = 0; return true;
    }
    __device__ __forceinline__ void a_ready(const Unit&) const {}
    __device__ __forceinline__ void done(const Unit&) const {}
};
struct BatchedOrder {
    int nPm, nPn, total, G, c;
    __host__ __device__ void init(int ngroups, int nPm_, int nPn_, int G_, int c_) { nPm = nPm_; nPn = nPn_; total = ngroups * nPm * nPn; G = G_; c = c_; }
    __host__ __device__ bool next(int i, Unit& u) const {
        const long L = (long)i * G + c; if (L >= total) return false;
        const int upg = nPm * nPn, g = (int)L / upg, rem = (int)L % upg, pmi = rem / nPn, pni = rem % nPn;
        u.pm = g * nPm + pmi; u.pn = pni; u.pb = g * nPn + pni; u.koff = 0; return true;
    }
    __device__ __forceinline__ void a_ready(const Unit&) const {}
    __device__ __forceinline__ void done(const Unit&) const {}
};
struct SplitKOrder {
    int nM, nsplit, kslice, G, c;
    __host__ __device__ void init(int M, int nsplit_, int kslice_, int G_, int c_) { nM = M / BM; nsplit = nsplit_; kslice = kslice_; G = G_; c = c_; }
    __host__ __device__ bool next(int i, Unit& u) const {
        const long L = (long)i * G + c; if (L >= (long)nM * nsplit) return false;
        u.pm = (int)L / nsplit; u.pn = (int)L % nsplit; u.pb = 0; u.koff = u.pn * kslice; return true;
    }
    __device__ __forceinline__ void a_ready(const Unit&) const {}
    __device__ __forceinline__ void done(const Unit&) const {}
};

typedef float f32x2_t __attribute__((ext_vector_type(2))); typedef __bf16 bf16x2_t __attribute__((ext_vector_type(2)));
__device__ __forceinline__ unsigned cvt_pk_bf16(float lo, float hi) { f32x2_t v = {lo, hi}; bf16x2_t b = __builtin_convertvector(v, bf16x2_t); return __builtin_bit_cast(unsigned, b); }
__device__ __forceinline__ float bf_lo(unsigned w) { return __uint_as_float(w << 16); }
__device__ __forceinline__ float bf_hi(unsigned w) { return __uint_as_float(w & 0xffff0000u); }
__device__ __forceinline__ float sigmoidf_(float x) { return 1.0f / (1.0f + __expf(-x)); }
__device__ __forceinline__ float siluf_(float x) { return x / (1.0f + __expf(-x)); }
__device__ __forceinline__ float gelu_tanh(float x) { const float z = 0.7978845608028654f * (x + 0.044715f * x * x * x); return x / (1.0f + __expf(-2.0f * z)); }

struct EpiBf16 {
    static constexpr bool PERM = true, AFTER_DRAIN = false;
    bf16_t* O; int ldc;
    __device__ __forceinline__ void operator()(const f32x4 (&acc)[2][2][4][2], const Unit& u, int wr, int wc, int fr, int fq) const {
        const int row0 = u.pm * BM + wr * 64 + fr, col0 = u.pn * BM + wc * 32 + 8 * fq;
#pragma unroll
        for (int ai = 0; ai < 2; ++ai)
#pragma unroll
            for (int m = 0; m < 4; ++m) { bf16_t* rowp = O + (size_t)(row0 + ai * HALF + m * 16) * ldc + col0;
#pragma unroll
                for (int bj = 0; bj < 2; ++bj) { const f32x4 v0 = acc[ai][bj][m][0], v1 = acc[ai][bj][m][1];
                    u32x4 w; w.x = cvt_pk_bf16(v0[0], v0[1]); w.y = cvt_pk_bf16(v0[2], v0[3]); w.z = cvt_pk_bf16(v1[0], v1[1]); w.w = cvt_pk_bf16(v1[2], v1[3]);
                    *(u32x4*)(rowp + bj * HALF) = w; } }
    }
};
struct EpiResid {
    static constexpr bool PERM = false, AFTER_DRAIN = false;
    const float* base; float* out; int ldc; const float* gate0; int gate_stride; int rows_per_batch;
    __device__ __forceinline__ void operator()(const f32x4 (&acc)[2][2][4][2], const Unit& u, int wr, int wc, int fr, int fq) const {
        const int row0 = u.pm * BM + wr * 64 + fr, col0 = u.pn * BM + wc * 32 + 4 * fq;
        const float* gp = gate0 + (size_t)((u.pm * BM) / rows_per_batch) * gate_stride + col0;
        f32x4 gv[2][2];
#pragma unroll
        for (int bj = 0; bj < 2; ++bj)
#pragma unroll
            for (int n = 0; n < 2; ++n) gv[bj][n] = *(const f32x4*)(gp + bj * HALF + n * 16);
#pragma unroll
        for (int ai = 0; ai < 2; ++ai)
#pragma unroll
            for (int m = 0; m < 4; ++m) { const size_t off = (size_t)(row0 + ai * HALF + m * 16) * ldc + col0;
#pragma unroll
                for (int bj = 0; bj < 2; ++bj)
#pragma unroll
                    for (int n = 0; n < 2; ++n) { const f32x4 bs = *(const f32x4*)(base + off + bj * HALF + n * 16);
                        *(f32x4*)(out + off + bj * HALF + n * 16) = bs + gv[bj][n] * acc[ai][bj][m][n]; }
                asm volatile("" ::: "memory"); }
    }
};
struct EpiF32 {
    static constexpr bool PERM = false, AFTER_DRAIN = false;
    float* C; int ldc;
    __device__ __forceinline__ void operator()(const f32x4 (&acc)[2][2][4][2], const Unit& u, int wr, int wc, int fr, int fq) const {
        const int row0 = u.pm * BM + wr * 64 + fr, col0 = u.pn * BM + wc * 32 + 4 * fq;
#pragma unroll
        for (int ai = 0; ai < 2; ++ai)
#pragma unroll
            for (int m = 0; m < 4; ++m) { float* rowp = C + (size_t)(row0 + ai * HALF + m * 16) * ldc + col0;
#pragma unroll
                for (int bj = 0; bj < 2; ++bj)
#pragma unroll
                    for (int n = 0; n < 2; ++n) *(f32x4*)(rowp + bj * HALF + n * 16) = acc[ai][bj][m][n]; }
    }
};
struct EpiGate {
    static constexpr bool PERM = false, AFTER_DRAIN = false;
    float* P; int rows;
    __device__ __forceinline__ void operator()(const f32x4 (&acc)[2][2][4][2], const Unit& u, int wr, int wc, int fr, int fq) const {
        if (wc != 0) return;
        const int row0 = u.pm * BM + wr * 64 + fr;
#pragma unroll
        for (int ai = 0; ai < 2; ++ai)
#pragma unroll
            for (int m = 0; m < 4; ++m) { float* rowp = P + ((size_t)u.pn * rows + (row0 + ai * HALF + m * 16)) * 32 + 4 * fq;
#pragma unroll
                for (int n = 0; n < 2; ++n) *(f32x4*)(rowp + n * 16) = acc[ai][0][m][n]; }
    }
};
template <int T, int NCH, int KY> struct EpiS5In {
    static constexpr bool PERM = true, AFTER_DRAIN = false;
    bf16_t* Ug; bf16_t* Gs;
    __device__ __forceinline__ void operator()(const f32x4 (&acc)[2][2][4][2], const Unit& u, int wr, int wc, int fr, int fq) const {
        const int row0 = u.pm * BM + wr * 64 + fr, col0 = u.pn * BM + wc * 32 + 8 * fq;
#pragma unroll
        for (int ai = 0; ai < 2; ++ai)
#pragma unroll
            for (int m = 0; m < 4; ++m) { const int row = row0 + ai * HALF + m * 16;
#pragma unroll
                for (int bj = 0; bj < 2; ++bj) { const f32x4 v0 = acc[ai][bj][m][0], v1 = acc[ai][bj][m][1]; const int col = col0 + bj * HALF;
                    u32x4 w; w.x = cvt_pk_bf16(v0[0], v0[1]); w.y = cvt_pk_bf16(v0[2], v0[3]); w.z = cvt_pk_bf16(v1[0], v1[1]); w.w = cvt_pk_bf16(v1[2], v1[3]);
                    if (col < 4096) { const int g = col >> 4, i0 = col & 15, chunk = row / T, t = row % T;
                        *(u32x4*)(Ug + ((size_t)g * NCH + chunk) * KY + t * 16 + i0) = w; }
                    else *(u32x4*)(Gs + (size_t)row * 4096 + (col - 4096)) = w; } }
    }
};
template <int T, int NPM> struct EpiS5Y {
    static constexpr bool PERM = true, AFTER_DRAIN = false;
    bf16_t* Y;
    __device__ __forceinline__ void operator()(const f32x4 (&acc)[2][2][4][2], const Unit& u, int wr, int wc, int fr, int fq) const {
        const int g = u.pm / NPM, chunk0 = (u.pm % NPM) * BM + wr * 64 + fr, col0 = u.pn * BM + wc * 32 + 8 * fq;
#pragma unroll
        for (int ai = 0; ai < 2; ++ai)
#pragma unroll
            for (int m = 0; m < 4; ++m) { const int chunk = chunk0 + ai * HALF + m * 16;
#pragma unroll
                for (int bj = 0; bj < 2; ++bj) { f32x4 v0 = acc[ai][bj][m][0], v1 = acc[ai][bj][m][1]; const int n = col0 + bj * HALF, t = n >> 4, i0 = n & 15;
#pragma unroll
                    for (int j = 0; j < 4; ++j) { v0[j] = gelu_tanh(v0[j]); v1[j] = gelu_tanh(v1[j]); }
                    u32x4 w; w.x = cvt_pk_bf16(v0[0], v0[1]); w.y = cvt_pk_bf16(v0[2], v0[3]); w.z = cvt_pk_bf16(v1[0], v1[1]); w.w = cvt_pk_bf16(v1[2], v1[3]);
                    *(u32x4*)(Y + (size_t)(chunk * T + t) * 4096 + g * 16 + i0) = w; } }
    }
};
struct EpiGlu {
    static constexpr bool PERM = true, AFTER_DRAIN = false;
    const bf16_t* Y; const bf16_t* Gs; const float* bias; bf16_t* Z;
    __device__ __forceinline__ void operator()(const f32x4 (&acc)[2][2][4][2], const Unit& u, int wr, int wc, int fr, int fq) const {
        const int row0 = u.pm * BM + wr * 64 + fr, col0 = u.pn * BM + wc * 32 + 8 * fq;
        f32x4 bv[2][2];
#pragma unroll
        for (int bj = 0; bj < 2; ++bj)
#pragma unroll
            for (int n = 0; n < 2; ++n) bv[bj][n] = *(const f32x4*)(bias + col0 + bj * HALF + 4 * n);
#pragma unroll
        for (int ai = 0; ai < 2; ++ai)
#pragma unroll
            for (int m = 0; m < 4; ++m) { const size_t off = (size_t)(row0 + ai * HALF + m * 16) * 4096 + col0;
#pragma unroll
                for (int bj = 0; bj < 2; ++bj) { const u32x4 yw = *(const u32x4*)(Y + off + bj * HALF), gw = *(const u32x4*)(Gs + off + bj * HALF);
                    const f32x4 a0 = acc[ai][bj][m][0] + bv[bj][0], a1 = acc[ai][bj][m][1] + bv[bj][1];
                    float o[8];
#pragma unroll
                    for (int j = 0; j < 4; ++j) { const unsigned yj = yw[j], gj = gw[j];
                        const float aa = (j < 2) ? a0[2 * j] : a1[2 * j - 4], ab = (j < 2) ? a0[2 * j + 1] : a1[2 * j - 3];
                        o[2 * j] = bf_lo(yj) * sigmoidf_(aa) * siluf_(bf_lo(gj)); o[2 * j + 1] = bf_hi(yj) * sigmoidf_(ab) * siluf_(bf_hi(gj)); }
                    u32x4 w; w.x = cvt_pk_bf16(o[0], o[1]); w.y = cvt_pk_bf16(o[2], o[3]); w.z = cvt_pk_bf16(o[4], o[5]); w.w = cvt_pk_bf16(o[6], o[7]);
                    *(u32x4*)(Z + off + bj * HALF) = w; }
                asm volatile("" ::: "memory"); }
    }
};

template <class Epi, class Sched, bool ALIGN_EPI = false, bool SP2 = false>
__device__ __forceinline__ void gemm_phase(PG8_LAS unsigned char* lds, const Gemm g, const Sched& S, const Epi& E) {
    const int tid = threadIdx.x, wid = __builtin_amdgcn_readfirstlane(tid >> 6), lane = tid & 63, wr = wid >> 2, wc = wid & 3, fr = lane & 15, fq = lane >> 4;
    const int K = g.K, nt = K / BK, lda = g.lda, ldb = g.ldb;
    unsigned voffA[2], voffB[2];
#pragma unroll
    for (int i = 0; i < 2; ++i) { int R, C; stage_rc(tid * 16 + i * 8192, R, C); const int Rb = Epi::PERM ? ((R & ~31) + perm32(R & 31)) : R;
        voffA[i] = (unsigned)(R * lda + C) * 2u; voffB[i] = (unsigned)(Rb * ldb + C) * 2u; }
    const size_t kstep = (size_t)(BK * 2);
    const size_t hstepA = (size_t)HALF * lda * 2, hstepB = (size_t)HALF * ldb * 2;
    const size_t tstepA = 2 * hstepA, tstepB = 2 * hstepB;
    const unsigned ldsw = (unsigned)wid * 1024u;
    const int aoff = lds_byte(wr * 64 + fr, fq * 8), boff = lds_byte(wc * 32 + fr, fq * 8);
#define PG8_SA(b, h) (((b) * 2 + (h)) * HTB)
#define PG8_SB(b, h) ((4 + (b) * 2 + (h)) * HTB)
#define PG8_STAGE(bufoff, gbase, voff) do { _Pragma("unroll") for (int _i = 0; _i < 2; ++_i) \
        __builtin_amdgcn_global_load_lds((const unsigned*)((const char*)(gbase) + (voff)[_i]), (PG8_LAS unsigned*)(lds + (bufoff) + ldsw + _i * 8192), 16, 0, 0); } while (0)
#define PG8_LDA(dst, b, h) do { _Pragma("unroll") for (int m = 0; m < 4; ++m) _Pragma("unroll") for (int k = 0; k < 2; ++k) dst[m][k] = *(const PG8_LAS bf16x8*)(lds + PG8_SA(b, h) + aoff + m * 2048 + k * 1024); } while (0)
#define PG8_LDB(dst, b, h) do { _Pragma("unroll") for (int n = 0; n < 2; ++n) _Pragma("unroll") for (int k = 0; k < 2; ++k) dst[n][k] = *(const PG8_LAS bf16x8*)(lds + PG8_SB(b, h) + boff + n * 2048 + k * 1024); } while (0)
#define PG8_MMA(ai, bj, At, Bt) do { __builtin_amdgcn_s_setprio(1); _Pragma("unroll") for (int m = 0; m < 4; ++m) _Pragma("unroll") for (int n = 0; n < 2; ++n) _Pragma("unroll") for (int k = 0; k < 2; ++k) \
        acc[ai][bj][m][n] = __builtin_amdgcn_mfma_f32_16x16x32_bf16(Bt[n][k], At[m][k], acc[ai][bj][m][n], 0, 0, 0); __builtin_amdgcn_s_setprio(0); } while (0)
#define PG8_WAIT_V(n) asm volatile("s_waitcnt vmcnt(" #n ")" ::: "memory")
#define PG8_WAIT_L(n) asm volatile("s_waitcnt lgkmcnt(" #n ")" ::: "memory")
#define PG8_BAR __builtin_amdgcn_s_barrier()
#define PG8_SCHED __builtin_amdgcn_sched_barrier(0)
    Unit cur, nxt; int ui = 0;
    if (!S.next(0, cur)) return;
    f32x4 acc[2][2][4][2];
#pragma unroll
    for (int a = 0; a < 2; ++a)
#pragma unroll
        for (int b = 0; b < 2; ++b)
#pragma unroll
            for (int m = 0; m < 4; ++m)
#pragma unroll
                for (int n = 0; n < 2; ++n) acc[a][b][m][n] = (f32x4){0.f, 0.f, 0.f, 0.f};
    bf16x8 At[4][2], B0[2][2], B1[2][2];
    const char* cA = (const char*)g.A + (size_t)cur.pm * tstepA + (size_t)cur.koff * 2; const char* cB = (const char*)g.Bt + (size_t)cur.pb * tstepB + (size_t)cur.koff * 2;
    S.a_ready(cur);
    if constexpr (SP2) {
        PG8_STAGE(PG8_SB(0, 0), cB, voffB); PG8_STAGE(PG8_SB(0, 1), cB + hstepB, voffB); PG8_STAGE(PG8_SA(0, 0), cA, voffA); PG8_STAGE(PG8_SA(0, 1), cA + hstepA, voffA);
        if (wr == 1) PG8_BAR;
        PG8_WAIT_V(2); PG8_BAR;
        PG8_STAGE(PG8_SB(1, 0), cB + kstep, voffB); PG8_STAGE(PG8_SA(1, 0), cA + kstep, voffA); PG8_STAGE(PG8_SB(1, 1), cB + hstepB + kstep, voffB);
        PG8_WAIT_V(6); PG8_BAR;
    } else {
        PG8_STAGE(PG8_SB(0, 0), cB, voffB); PG8_STAGE(PG8_SA(0, 0), cA, voffA); PG8_STAGE(PG8_SB(0, 1), cB + hstepB, voffB); PG8_STAGE(PG8_SA(0, 1), cA + hstepA, voffA);
        if (wr == 1) PG8_BAR;
        PG8_WAIT_V(4); PG8_BAR;
        PG8_STAGE(PG8_SB(1, 0), cB + kstep, voffB); PG8_STAGE(PG8_SA(1, 0), cA + kstep, voffA); PG8_STAGE(PG8_SB(1, 1), cB + hstepB + kstep, voffB);
        PG8_WAIT_V(6); PG8_BAR;
    }
    for (;;) {
        const bool has_next = S.next(ui + 1, nxt);
        const char* nA = has_next ? (const char*)g.A + (size_t)nxt.pm * tstepA + (size_t)nxt.koff * 2 : cA; const char* nB = has_next ? (const char*)g.Bt + (size_t)nxt.pb * tstepB + (size_t)nxt.koff * 2 : cB;
        for (int t = 0; t < nt; t += 2) {
            const bool last = (t == nt - 2);
            const char* a1 = cA + (size_t)(t + 1) * kstep;
            const char* a2 = last ? nA : cA + (size_t)(t + 2) * kstep; const char* b2 = last ? nB : cB + (size_t)(t + 2) * kstep;
            const char* a3 = a2 + kstep; const char* b3 = b2 + kstep;
            if (last && has_next) S.a_ready(nxt);
            if constexpr (SP2) {
            PG8_LDB(B0, 0, 0); PG8_LDB(B1, 0, 1); PG8_SCHED; PG8_LDA(At, 0, 0); PG8_STAGE(PG8_SA(1, 1), a1 + hstepA, voffA);
            PG8_WAIT_V(8); PG8_WAIT_L(0); PG8_BAR; PG8_MMA(0, 0, At, B0); PG8_MMA(0, 1, At, B1); PG8_BAR; PG8_SCHED;
            PG8_LDA(At, 0, 1); PG8_STAGE(PG8_SB(0, 0), b2, voffB); PG8_STAGE(PG8_SB(0, 1), b2 + hstepB, voffB); PG8_STAGE(PG8_SA(0, 0), a2, voffA);
            PG8_WAIT_V(8); PG8_WAIT_L(0); PG8_BAR; PG8_MMA(1, 0, At, B0); PG8_MMA(1, 1, At, B1); PG8_BAR; PG8_SCHED;
            PG8_LDB(B0, 1, 0); PG8_LDB(B1, 1, 1); PG8_SCHED; PG8_LDA(At, 1, 0); PG8_STAGE(PG8_SA(0, 1), a2 + hstepA, voffA);
            PG8_WAIT_V(8); PG8_WAIT_L(0); PG8_BAR; PG8_MMA(0, 0, At, B0); PG8_MMA(0, 1, At, B1); PG8_BAR; PG8_SCHED;
            PG8_LDA(At, 1, 1); PG8_STAGE(PG8_SB(1, 0), b3, voffB); PG8_STAGE(PG8_SB(1, 1), b3 + hstepB, voffB); PG8_STAGE(PG8_SA(1, 0), a3, voffA);
            PG8_WAIT_V(8); PG8_WAIT_L(0); PG8_BAR; PG8_MMA(1, 0, At, B0); PG8_MMA(1, 1, At, B1); PG8_BAR; PG8_SCHED;
            } else {
            PG8_LDB(B0, 0, 0); PG8_SCHED; PG8_LDA(At, 0, 0); PG8_STAGE(PG8_SA(1, 1), a1 + hstepA, voffA);
            PG8_WAIT_L(8); PG8_BAR; PG8_WAIT_L(0); PG8_MMA(0, 0, At, B0); PG8_BAR; PG8_SCHED;
            PG8_LDB(B1, 0, 1); PG8_STAGE(PG8_SB(0, 0), b2, voffB);
            PG8_BAR; PG8_WAIT_L(0); PG8_MMA(0, 1, At, B1); PG8_BAR;
            PG8_LDA(At, 0, 1); PG8_STAGE(PG8_SA(0, 0), a2, voffA);
            PG8_BAR; PG8_WAIT_L(0); PG8_MMA(1, 0, At, B0); PG8_BAR; PG8_SCHED;
            PG8_STAGE(PG8_SB(0, 1), b2 + hstepB, voffB);
            PG8_WAIT_V(6); PG8_BAR; PG8_MMA(1, 1, At, B1); PG8_BAR;
            PG8_LDB(B0, 1, 0); PG8_SCHED; PG8_LDA(At, 1, 0); PG8_STAGE(PG8_SA(0, 1), a2 + hstepA, voffA);
            PG8_WAIT_L(8); PG8_BAR; PG8_WAIT_L(0); PG8_MMA(0, 0, At, B0); PG8_BAR; PG8_SCHED;
            PG8_LDB(B1, 1, 1); PG8_STAGE(PG8_SB(1, 0), b3, voffB);
            PG8_BAR; PG8_WAIT_L(0); PG8_MMA(0, 1, At, B1); PG8_BAR;
            PG8_LDA(At, 1, 1); PG8_STAGE(PG8_SA(1, 0), a3, voffA);
            PG8_BAR; PG8_WAIT_L(0); PG8_MMA(1, 0, At, B0); PG8_BAR; PG8_SCHED;
            PG8_STAGE(PG8_SB(1, 1), b3 + hstepB, voffB);
            PG8_WAIT_V(6); PG8_BAR; PG8_MMA(1, 1, At, B1); PG8_BAR;
            }
        }
        if constexpr (ALIGN_EPI) { if (wr == 0) PG8_BAR; }
#if MK_DIAG
        { bool bad = false;
#pragma unroll
          for (int a_ = 0; a_ < 2; ++a_)
#pragma unroll
            for (int b_ = 0; b_ < 2; ++b_)
#pragma unroll
              for (int m_ = 0; m_ < 4; ++m_)
#pragma unroll
                for (int n_ = 0; n_ < 2; ++n_)
#pragma unroll
                  for (int j_ = 0; j_ < 4; ++j_) bad |= !(__builtin_fabsf(acc[a_][b_][m_][n_][j_]) < 3.0e38f);
          if (bad && g.dflag) atomicOr(g.dflag, g.dbit); }
#endif
        if constexpr (!Epi::AFTER_DRAIN) { E(acc, cur, wr, wc, fr, fq); S.done(cur); }
        if (!has_next) break;
#pragma unroll
        for (int a = 0; a < 2; ++a)
#pragma unroll
            for (int b = 0; b < 2; ++b)
#pragma unroll
                for (int m = 0; m < 4; ++m)
#pragma unroll
                    for (int n = 0; n < 2; ++n) acc[a][b][m][n] = (f32x4){0.f, 0.f, 0.f, 0.f};
        cur = nxt; cA = nA; cB = nB; ++ui;
        if constexpr (ALIGN_EPI) { if (wr == 1) PG8_BAR; }
    }
    PG8_WAIT_V(0);
    if constexpr (!ALIGN_EPI) { if (wr == 0) PG8_BAR; }
    PG8_BAR;
    if constexpr (Epi::AFTER_DRAIN) { E.fused(acc, cur, wr, wc, fr, fq, lds, wid, lane); S.done(cur); }
#undef PG8_SA
#undef PG8_SB
#undef PG8_STAGE
#undef PG8_LDA
#undef PG8_LDB
#undef PG8_MMA
#undef PG8_WAIT_V
#undef PG8_WAIT_L
#undef PG8_BAR
#undef PG8_SCHED
}

}

constexpr int NWAVES = 8;
constexpr int BATCH = 2, SEQ = 8192, D = 4096, M = BATCH * SEQ;
constexpr int GRIDW = 64, GROWS = SEQ / GRIDW;
constexpr int NA_HEADS = 32, NA_HD = 128;
constexpr int S5_G = 256, S5_P = 64, S5_I = 16, S5_T = 32, S5_NCH = M / S5_T  , S5_NCHB = SEQ / S5_T  , S5_KS = S5_T * 16  , S5_KY = S5_KS + 256  ;
constexpr int GLA_H = 8, GLA_DK = 256, GLA_DV = 512, GLA_KW = 2048, GLA_C = 64, GLA_NCH = M / GLA_C  , GLA_NCHB = SEQ / GLA_C  , GLA_NIN = 12288;
constexpr float EPS = 1e-6f;

constexpr size_t MiB = 1u << 20;
constexpr size_t WS_CTL = 0, CTL_ZERO_BYTES = 64 * 1024;
constexpr size_t WS_MOD = 1 * MiB;
constexpr size_t WS_LAMT = 2 * MiB;
constexpr size_t WS_W_NAIN0 = 4 * MiB, WS_W_NAIN1 = WS_W_NAIN0 + 128 * MiB, WS_W_NAOUT0 = WS_W_NAIN1 + 128 * MiB, WS_W_NAOUT1 = WS_W_NAOUT0 + 32 * MiB;
constexpr size_t WS_W_S5IN = WS_W_NAOUT1 + 32 * MiB, WS_W_S5GLU = WS_W_S5IN + 64 * MiB, WS_W_S5OUT = WS_W_S5GLU + 32 * MiB;
constexpr size_t WS_W_GLAIN = WS_W_S5OUT + 32 * MiB, WS_W_GLAG1 = WS_W_GLAIN + 96 * MiB, WS_W_GLAOUT = WS_W_GLAG1 + 2 * MiB;
constexpr size_t WS_S5BS = WS_W_GLAOUT + 32 * MiB;
constexpr size_t WS_S5BY = WS_S5BS + 64 * MiB;
constexpr size_t WS_H = WS_S5BY + 192 * MiB;
constexpr size_t WS_ACT = WS_H + 128 * MiB;
constexpr size_t WS_NA_QKVG = WS_ACT;
constexpr size_t WS_S5_UG = WS_ACT;
constexpr size_t WS_S5_GS = WS_S5_UG + 192 * MiB;
constexpr size_t WS_S5_SLOC = WS_S5_GS + 128 * MiB;
constexpr size_t WS_S5_Y = WS_S5_SLOC + 128 * MiB;
constexpr size_t WS_S5_Z = WS_S5_Y + 128 * MiB;
constexpr size_t WS_GLA_IN = WS_ACT;
constexpr size_t WS_GLA_G1P = WS_GLA_IN + 384 * MiB;
constexpr size_t WS_GLA_PREP = WS_GLA_G1P + 8 * MiB;
constexpr size_t WS_GLA_DECAY = WS_GLA_PREP + 384 * MiB;
constexpr size_t WS_GLA_O = WS_GLA_DECAY + 4 * MiB;
constexpr size_t WS_GLA_Z = WS_GLA_O + 384 * MiB;
constexpr size_t WS_END = WS_GLA_Z + 128 * MiB;
static_assert(WS_S5_Z + 128 * MiB <= WS_END && WS_NA_QKVG + 512 * MiB <= WS_END, "ws map");
constexpr int CW_BAR = 1024;
static_assert((CW_BAR + 3456) * 4 <= (int)CTL_ZERO_BYTES, "CTL words inside the memset region");

constexpr int RING_OFF = 0, RING_BYTES = 131072;
constexpr int LDS_BYTES = 147456;
constexpr int MISC_OFF = LDS_BYTES - 256;

#define GAS __attribute__((address_space(1)))
#define LAS __attribute__((address_space(3)))
typedef unsigned short bf16;
typedef unsigned v4u __attribute__((ext_vector_type(4)));
typedef unsigned v2u __attribute__((ext_vector_type(2)));
typedef float f32x4 __attribute__((ext_vector_type(4)));
typedef float f32x2 __attribute__((ext_vector_type(2)));
typedef short bf16x8 __attribute__((ext_vector_type(8)));
typedef short s16x4 __attribute__((ext_vector_type(4)));
typedef GAS unsigned gu32;
#define LDS_WAIT() asm volatile("s_waitcnt lgkmcnt(0)" ::: "memory")
#define VM_WAIT() asm volatile("s_waitcnt vmcnt(0)" ::: "memory")
using pg8::cvt_pk_bf16; using pg8::bf_lo; using pg8::bf_hi; using pg8::siluf_; using pg8::sigmoidf_;

#define XB_TMO      128
#define XB_XCNT(j)  (256  + 64 * (j))
#define XB_XSUB(j)  (1280 + 64 * (j))
#define XB_XGEN(j)  (2304 + 64 * (j))
#define XB_TOP      3328
#define XB_TOPGEN   3392
#define XCD_BAR_WORDS 3456
#define XB_SPIN_CAP (1u << 18)
__device__ __forceinline__ unsigned xb_ld(unsigned* p)              { return __hip_atomic_load(p, __ATOMIC_RELAXED, __HIP_MEMORY_SCOPE_AGENT); }
__device__ __forceinline__ unsigned xb_add(unsigned* p, unsigned v) { return __hip_atomic_fetch_add(p, v, __ATOMIC_RELAXED, __HIP_MEMORY_SCOPE_AGENT); }
__device__ __forceinline__ unsigned xb_xcc_id() { return (unsigned)__builtin_amdgcn_s_getreg((3 << 11) | 20) & 0xFu; }
#define XB_SPIN(cond, bar) do { unsigned _sp = 0; while (cond) { __builtin_amdgcn_s_sleep(1); \
    if ((++_sp & 255u) == 0u) { if (xb_ld(&(bar)[XB_TMO])) break; if (_sp > XB_SPIN_CAP) { atomicAdd(&(bar)[XB_TMO], 1u); break; } } } } while (0)
struct XcdBarrier { unsigned* bar; unsigned x; volatile LAS unsigned* st; };
__device__ __forceinline__ XcdBarrier xcd_barrier_post(unsigned* bar, volatile LAS unsigned* st) {
    XcdBarrier b; b.bar = bar; b.x = xb_xcc_id(); b.st = st;
    if (threadIdx.x == 0) (void)xb_add(&bar[XB_XCNT(b.x)], 1u);
    return b;
}
__device__ __forceinline__ void xcd_barrier_complete(unsigned* bar, unsigned x, unsigned& nloc, unsigned& nx) {
    const unsigned G = gridDim.x * gridDim.y * gridDim.z;
    unsigned sum, cnt, mine, sp = 0u;
    for (;;) {
        sum = 0u; cnt = 0u; mine = 0u;
#pragma unroll
        for (unsigned j = 0; j < 16; ++j) { const unsigned c = xb_ld(&bar[XB_XCNT(j)]); sum += c; cnt += (c > 0u) ? 1u : 0u; mine = (j == x) ? c : mine; }
        if (sum == G) break;
        __builtin_amdgcn_s_sleep(1);
        if ((++sp & 255u) == 0u) { if (xb_ld(&bar[XB_TMO])) break; if (sp > XB_SPIN_CAP) { atomicAdd(&bar[XB_TMO], 1u); break; } }
    }
    nloc = mine > 0u ? mine : 1u; nx = cnt > 0u ? cnt : 1u;
}
__device__ __forceinline__ void xcd_barrier(const XcdBarrier& b) {
    asm volatile("s_waitcnt vmcnt(0)" ::: "memory");
    __syncthreads();
    if (threadIdx.x == 0) {
        unsigned* bar = b.bar;
        __builtin_amdgcn_s_waitcnt(0);
        unsigned nloc = b.st[0], nx = b.st[1];
        if (nloc == 0u) { xcd_barrier_complete(bar, b.x, nloc, nx); b.st[0] = nloc; b.st[1] = nx; }
        const unsigned old = xb_add(&bar[XB_XSUB(b.x)], 1u);
        const unsigned gen = old / nloc;
        if (old + 1u == (gen + 1u) * nloc) {
            __builtin_amdgcn_fence(__ATOMIC_RELEASE, "agent");
            asm volatile("s_waitcnt vmcnt(0)" ::: "memory");
            const unsigned og = xb_add(&bar[XB_TOP], 1u);
            const unsigned tg = og / nx;
            if (og + 1u == (tg + 1u) * nx) xb_add(&bar[XB_TOPGEN], 1u);
            else XB_SPIN(xb_ld(&bar[XB_TOPGEN]) == tg, bar);
            __builtin_amdgcn_fence(__ATOMIC_ACQUIRE, "agent");
            xb_add(&bar[XB_XGEN(b.x)], 1u);
            asm volatile("s_waitcnt vmcnt(0)" ::: "memory");
        } else {
            XB_SPIN(xb_ld(&bar[XB_XGEN(b.x)]) == gen, bar);
            __builtin_amdgcn_fence(__ATOMIC_ACQUIRE, "agent");
            asm volatile("s_waitcnt vmcnt(0)" ::: "memory");
        }
    }
    __syncthreads();
}

struct Args { const float* in[33]; float* out; unsigned char* ws; int ph_lo, ph_hi; };
struct Frame {
    LAS unsigned char* lds;
    int tid, lane, wave;
    int vcu, G;
};
__device__ __forceinline__ float wave_sum(float v) {
#pragma unroll
    for (int o = 1; o < 64; o <<= 1) v += __shfl_xor(v, o);
    return v;
}
__device__ __forceinline__ unsigned f2bf(float f) { unsigned u = __builtin_bit_cast(unsigned, f); return (u + 0x7fffu + ((u >> 16) & 1u)) >> 16; }
__device__ __forceinline__ unsigned pk2(float lo, float hi) { return f2bf(lo) | (f2bf(hi) << 16); }

__device__ __forceinline__ void p0_transpose_item(const float* W, int K, int N, bf16* WT, LAS float* scr, int item, int lane) {
    const int nblk = N / 32, kb = item / nblk, nb = item % nblk, k0 = 64 * kb, n0 = 32 * nb;
#pragma unroll 8
    for (int i = 0; i < 32; ++i) { const int kk = 2 * i + (lane >> 5); scr[kk * 33 + (lane & 31)] = W[(size_t)(k0 + kk) * N + n0 + (lane & 31)]; }
    LDS_WAIT(); asm volatile("" ::: "memory");
    const int c = lane & 7;
#pragma unroll
    for (int j = 0; j < 4; ++j) { const int n = (lane >> 3) + 8 * j; const LAS float* s = scr + (8 * c) * 33 + n;
        v4u o; o.x = pk2(s[0 * 33], s[1 * 33]); o.y = pk2(s[2 * 33], s[3 * 33]); o.z = pk2(s[4 * 33], s[5 * 33]); o.w = pk2(s[6 * 33], s[7 * 33]);
        *(GAS v4u*)(WT + (size_t)(n0 + n) * K + k0 + 8 * c) = o; }
    LDS_WAIT(); asm volatile("" ::: "memory");
}
__device__ __forceinline__ void p0_mod(Frame& F, const Args& a) {
    LAS float* cact = (LAS float*)(F.lds + RING_OFF);
    LAS float* red = cact + 2 * 4096;
    const float* c = a.in[1]; const float* mw = a.in[2]; const float* mb = a.in[3]; float* MOD = (float*)(a.ws + WS_MOD);
    for (int i = F.tid; i < 2 * 4096; i += NWAVES * 64) cact[i] = siluf_(c[i]);
    __syncthreads();
    const int rg = F.lane >> 4, cq = F.lane & 15;
    for (int it = F.vcu; it < 4 * 192; it += F.G) {
        const int layer = it / 192, cb = it % 192;
        const float* wp = mw + (size_t)layer * 4096 * 12288 + (size_t)(F.wave * 4 + rg) * 12288 + cb * 64 + cq * 4;
        f32x4 a0 = {0.f, 0.f, 0.f, 0.f}, a1 = {0.f, 0.f, 0.f, 0.f};
#pragma unroll 8
        for (int s = 0; s < 128; ++s) { const f32x4 w = *(const GAS f32x4*)(wp + (size_t)s * 32 * 12288); const int k = F.wave * 4 + rg + 32 * s;
            const float c0 = cact[k], c1 = cact[4096 + k]; a0 += w * c0; a1 += w * c1; }
#pragma unroll
        for (int j = 0; j < 4; ++j) { a0[j] += __shfl_xor(a0[j], 16); a0[j] += __shfl_xor(a0[j], 32); a1[j] += __shfl_xor(a1[j], 16); a1[j] += __shfl_xor(a1[j], 32); }
        if (F.lane < 16) { *(LAS f32x4*)(red + (F.wave * 2 + 0) * 64 + cq * 4) = a0; *(LAS f32x4*)(red + (F.wave * 2 + 1) * 64 + cq * 4) = a1; }
        __syncthreads();
        if (F.tid < 128) { const int b = F.tid >> 6, col = F.tid & 63; float s = mb[layer * 12288 + cb * 64 + col];
#pragma unroll
            for (int w = 0; w < 8; ++w) s += red[(w * 2 + b) * 64 + col];
            MOD[((size_t)layer * 2 + b) * 12288 + cb * 64 + col] = s; }
        __syncthreads();
    }
}
__device__ __forceinline__ void p0_s5_group(Frame& F, const Args& a, int g) {
    constexpr int T = S5_T;
    LAS f32x2* pw = (LAS f32x2*)(F.lds + RING_OFF);
    LAS f32x2* bbar = pw + 2 * (T + 1) * 64;
    LAS f32x2* cc = bbar + 2 * 64 * 16;
    LAS float* kf = (LAS float*)(cc + 16 * 64);
    static_assert((2 * (T + 1) * 64 + 2 * 64 * 16 + 16 * 64) * 8 + 2 * T * 256 * 4 <= RING_BYTES, "s5 gen LDS");
    const float *b_re = a.in[9], *b_im = a.in[10], *c_re = a.in[11], *c_im = a.in[12], *dsk = a.in[13];
    float* LAMT = (float*)(a.ws + WS_LAMT);
    if (F.tid < 128) {
        const int dir = F.tid >> 6, p = F.tid & 63, gp = g * 64 + p;
        const float are = (dir ? a.in[16] : a.in[14])[gp], aim = (dir ? a.in[17] : a.in[15])[gp], ls = (dir ? a.in[19] : a.in[18])[gp];
        const float dt = expf(ls), mag = expf(are * dt), lr = mag * cosf(aim * dt), li = mag * sinf(aim * dt);
        const float den = are * are + aim * aim, nr = lr - 1.0f, rre = (nr * are + li * aim) / den, rim = (li * are - nr * aim) / den;
#pragma unroll
        for (int j = 0; j < 16; ++j) { const float br = b_re[(size_t)gp * 16 + j], bi = b_im[(size_t)gp * 16 + j]; bbar[(dir * 64 + p) * 16 + j] = (f32x2){rre * br - rim * bi, rre * bi + rim * br}; }
        float wr_ = 1.0f, wi_ = 0.0f; pw[(dir * (T + 1) + 0) * 64 + p] = (f32x2){1.0f, 0.0f};
        for (int t = 1; t <= T; ++t) { const float nr2 = wr_ * lr - wi_ * li, ni2 = wr_ * li + wi_ * lr; wr_ = nr2; wi_ = ni2; pw[(dir * (T + 1) + t) * 64 + p] = (f32x2){wr_, wi_}; }
        LAMT[((size_t)(g * 2 + dir) * 64 + p) * 2 + 0] = wr_; LAMT[((size_t)(g * 2 + dir) * 64 + p) * 2 + 1] = wi_;
    }
    for (int e = F.tid; e < 16 * 64; e += NWAVES * 64) cc[e] = (f32x2){c_re[(size_t)g * 1024 + e], c_im[(size_t)g * 1024 + e]};
    __syncthreads();
    {
        const int dir = F.tid >> 8, i = (F.tid >> 4) & 15, j = F.tid & 15;
        float acc[T];
#pragma unroll
        for (int t = 0; t < T; ++t) acc[t] = 0.f;
        for (int p = 0; p < 64; ++p) { const f32x2 C = cc[i * 64 + p], Bb = bbar[(dir * 64 + p) * 16 + j]; const float e = C.x * Bb.x - C.y * Bb.y, f = C.x * Bb.y + C.y * Bb.x;
#pragma unroll
            for (int t = 0; t < T; ++t) { const f32x2 w = pw[(dir * (T + 1) + t) * 64 + p]; acc[t] += w.x * e - w.y * f; } }
#pragma unroll
        for (int t = 0; t < T; ++t) kf[((dir * T + t) * 16 + i) * 16 + j] = acc[t];
    }
    __syncthreads();
    bf16* BY = (bf16*)(a.ws + WS_S5BY) + (size_t)g * (S5_KS * S5_KY);
    for (int q = F.tid; q < S5_KS * (S5_KY / 8); q += NWAVES * 64) {
        const int n = q / (S5_KY / 8), pc = q % (S5_KY / 8), t = n >> 4, i = n & 15, k0 = pc * 8; float v[8];
        if (k0 < S5_KS) { const int s = k0 >> 4, j0 = k0 & 15;
#pragma unroll
            for (int e = 0; e < 8; ++e) { const int j = j0 + e; float x;
                if (t > s) x = kf[((0 * T + (t - s)) * 16 + i) * 16 + j];
                else if (t < s) x = kf[((1 * T + (s - t)) * 16 + i) * 16 + j];
                else x = kf[((0 * T + 0) * 16 + i) * 16 + j] + kf[((1 * T + 0) * 16 + i) * 16 + j] + ((i == j) ? dsk[g * 16 + i] : 0.f);
                v[e] = x; }
        } else { const int kk = k0 - S5_KS, seg = kk >> 6, p0 = kk & 63, dir = seg >> 1, tp = dir ? (T - t) : (t + 1);
#pragma unroll
            for (int e = 0; e < 8; ++e) { const int p = p0 + e; const f32x2 w = pw[(dir * (T + 1) + tp) * 64 + p], C = cc[i * 64 + p];
                v[e] = (seg & 1) ? -(C.x * w.y + C.y * w.x) : (C.x * w.x - C.y * w.y); }
        }
        v4u o; o.x = pk2(v[0], v[1]); o.y = pk2(v[2], v[3]); o.z = pk2(v[4], v[5]); o.w = pk2(v[6], v[7]);
        *(GAS v4u*)(BY + (size_t)n * S5_KY + k0) = o;
    }
    bf16* BS = (bf16*)(a.ws + WS_S5BS) + (size_t)g * (256 * S5_KS);
    for (int q = F.tid; q < 256 * (S5_KS / 8); q += NWAVES * 64) {
        const int n = q / (S5_KS / 8), pc = q % (S5_KS / 8), k0 = pc * 8, s = k0 >> 4, j0 = k0 & 15, seg = n >> 6, p = n & 63, dir = seg >> 1;
        const f32x2 w = pw[(dir * (T + 1) + (dir ? s : (T - 1 - s))) * 64 + p]; float v[8];
#pragma unroll
        for (int e = 0; e < 8; ++e) { const f32x2 Bb = bbar[(dir * 64 + p) * 16 + j0 + e]; v[e] = (seg & 1) ? (w.x * Bb.y + w.y * Bb.x) : (w.x * Bb.x - w.y * Bb.y); }
        v4u o; o.x = pk2(v[0], v[1]); o.y = pk2(v[2], v[3]); o.z = pk2(v[4], v[5]); o.w = pk2(v[6], v[7]);
        *(GAS v4u*)(BS + (size_t)n * S5_KS + k0) = o;
    }
    __syncthreads();
}
__device__ __forceinline__ void p0_prologue(Frame& F, const Args& a) {
    p0_mod(F, a);
    {
        LAS float* scr = (LAS float*)(F.lds + RING_OFF + F.wave * 16384);
        const int gw = F.vcu * NWAVES + F.wave, NGW = F.G * NWAVES;
        constexpr int I_NAIN = 64 * 512, I_SQ = 64 * 128, I_S5IN = 64 * 256, I_GLAIN = 64 * 384;
        constexpr int NITEMS = 2 * I_NAIN + 2 * I_SQ + I_S5IN + 2 * I_SQ + I_GLAIN + I_SQ;
        unsigned char* ws = a.ws;
        for (int it = gw; it < NITEMS; it += NGW) {
            int r = it;
            if (r < I_NAIN) { p0_transpose_item(a.in[5], 4096, 16384, (bf16*)(ws + WS_W_NAIN0), scr, r, F.lane); continue; } r -= I_NAIN;
            if (r < I_NAIN) { p0_transpose_item(a.in[5] + (size_t)4096 * 16384, 4096, 16384, (bf16*)(ws + WS_W_NAIN1), scr, r, F.lane); continue; } r -= I_NAIN;
            if (r < I_SQ) { p0_transpose_item(a.in[7], 4096, 4096, (bf16*)(ws + WS_W_NAOUT0), scr, r, F.lane); continue; } r -= I_SQ;
            if (r < I_SQ) { p0_transpose_item(a.in[7] + (size_t)4096 * 4096, 4096, 4096, (bf16*)(ws + WS_W_NAOUT1), scr, r, F.lane); continue; } r -= I_SQ;
            if (r < I_S5IN) { p0_transpose_item(a.in[8], 4096, 8192, (bf16*)(ws + WS_W_S5IN), scr, r, F.lane); continue; } r -= I_S5IN;
            if (r < I_SQ) { p0_transpose_item(a.in[20], 4096, 4096, (bf16*)(ws + WS_W_S5GLU), scr, r, F.lane); continue; } r -= I_SQ;
            if (r < I_SQ) { p0_transpose_item(a.in[22], 4096, 4096, (bf16*)(ws + WS_W_S5OUT), scr, r, F.lane); continue; } r -= I_SQ;
            if (r < I_GLAIN) { p0_transpose_item(a.in[23], 4096, 12288, (bf16*)(ws + WS_W_GLAIN), scr, r, F.lane); continue; } r -= I_GLAIN;
            p0_transpose_item(a.in[31], 4096, 4096, (bf16*)(ws + WS_W_GLAOUT), scr, r, F.lane);
        }
        bf16* G1T = (bf16*)(ws + WS_W_GLAG1);
        for (int e = (F.vcu * NWAVES * 64 + F.tid); e < 256 * 4096 / 2; e += F.G * NWAVES * 64) {
            const int n = e / 2048, k = (e % 2048) * 2; float v0 = 0.f, v1 = 0.f;
            if (n < 16) { v0 = a.in[24][(size_t)k * 16 + n]; v1 = a.in[24][(size_t)(k + 1) * 16 + n]; }
            else if (n < 32) { v0 = a.in[27][(size_t)k * 16 + (n - 16)]; v1 = a.in[27][(size_t)(k + 1) * 16 + (n - 16)]; }
            *(GAS unsigned*)(G1T + (size_t)n * 4096 + k) = pk2(v0, v1);
        }
    }
    __syncthreads();
    for (int g = F.vcu; g < S5_G; g += F.G) p0_s5_group(F, a, g);
}

template <bool FINAL>
__device__ __forceinline__ void norm_phase(Frame& F, const float* xin, const float* nw, const float* mod  , bf16* H, float* outf) {
    LAS f32x2* tab = (LAS f32x2*)(F.lds + RING_OFF);
    for (int i = F.tid; i < 2 * 4096; i += NWAVES * 64) { const int b = i >> 12, c = i & 4095;
        if (FINAL) tab[i] = (f32x2){nw[c], 0.f};
        else tab[i] = (f32x2){nw[c] * (1.0f + mod[b * 12288 + 4096 + c]), mod[b * 12288 + c]}; }
    __syncthreads();
    const int gw = F.vcu * NWAVES + F.wave, NGW = F.G * NWAVES;
    for (int m = gw; m < M; m += NGW) {
        const int b = m >> 13; const GAS f32x4* xr = (const GAS f32x4*)(xin + (size_t)m * D) + F.lane;
        f32x4 v[16]; float s = 0.f;
#pragma unroll
        for (int j = 0; j < 16; ++j) { v[j] = xr[64 * j]; s += (v[j].x * v[j].x + v[j].y * v[j].y) + (v[j].z * v[j].z + v[j].w * v[j].w); }
        const float rstd = rsqrtf(wave_sum(s) * (1.f / D) + EPS);
#pragma unroll
        for (int j = 0; j < 16; ++j) { const int c = 4 * F.lane + 256 * j; const LAS f32x2* tp = tab + b * 4096 + c;
            const f32x2 t0 = tp[0], t1 = tp[1], t2 = tp[2], t3 = tp[3];
            const float o0 = v[j].x * rstd * t0.x + t0.y, o1 = v[j].y * rstd * t1.x + t1.y, o2 = v[j].z * rstd * t2.x + t2.y, o3 = v[j].w * rstd * t3.x + t3.y;
            if (FINAL) *((GAS f32x4*)(outf + (size_t)m * D) + F.lane + 64 * j) = (f32x4){o0, o1, o2, o3};
            else *(GAS v2u*)(H + (size_t)m * D + c) = (v2u){cvt_pk_bf16(o0, o1), cvt_pk_bf16(o2, o3)}; }
    }
    __syncthreads();
}

typedef short v4i16_t __attribute__((ext_vector_type(4)));
__device__ __forceinline__ s16x4 tr4(const LAS unsigned char* p) { return __builtin_bit_cast(s16x4, __builtin_amdgcn_ds_read_tr16_b64_v4i16((LAS v4i16_t*)p)); }
__device__ __forceinline__ bf16x8 cat8(s16x4 a, s16x4 b) { return (bf16x8){a[0], a[1], a[2], a[3], b[0], b[1], b[2], b[3]}; }
__device__ __forceinline__ bf16x8 pack8(f32x4 a, f32x4 b) { v4u w; w.x = cvt_pk_bf16(a[0], a[1]); w.y = cvt_pk_bf16(a[2], a[3]); w.z = cvt_pk_bf16(b[0], b[1]); w.w = cvt_pk_bf16(b[2], b[3]); return __builtin_bit_cast(bf16x8, w); }
#define MFMA16(a, b, c) __builtin_amdgcn_mfma_f32_16x16x32_bf16((a), (b), (c), 0, 0, 0)

constexpr int NA_PITCH = 272, NA_TILE = 64 * NA_PITCH;
__device__ __forceinline__ void na_attn_phase(Frame& F, bf16* QKVG, const float* rpb) {
    const int grp = F.wave >> 2, ct = F.wave & 3, lane = F.lane, li = lane & 15, g = lane >> 4, q4 = li >> 2, p4 = li & 3;
    const int c0 = ct * 16, kc0 = min(max(c0 - 8, 0), 32);
    const int ipw = (4096 + F.G - 1) / F.G;
    LAS unsigned char* const lbase = F.lds + RING_OFF;
    LAS float* const rp = (LAS float*)(lbase + 4 * NA_TILE + grp * 2048);
    for (int k = 0; k < ipw; ++k) {
        const int it = F.vcu * ipw + k; if (it >= 4096) break;
        const int b = it >> 11, hp = (it >> 7) & 15, r = it & 127, h = hp * 2 + grp;
        const int rs = min(max(r - 4, 0), GROWS - 8);
        const size_t tok0 = (size_t)b * SEQ + (size_t)r * GRIDW;
        const bf16* qp = QKVG + (tok0 + c0 + li) * 16384 + h * 128 + 8 * g;
        bf16x8 qf[4];
#pragma unroll
        for (int ks = 0; ks < 4; ++ks) qf[ks] = *(const GAS bf16x8*)(qp + 32 * ks);
        for (int e = (F.tid & 255); e < 465; e += 256) rp[e] = rpb[h * 465 + e];
        v4u st[4];
        const bf16* kvbase = QKVG + ((size_t)b * SEQ + (size_t)rs * GRIDW + 16 * ct + g) * 16384 + h * 128 + li * 8;
#define NA_LOAD(t) do { _Pragma("unroll") for (int j = 0; j < 4; ++j) st[j] = *(const GAS v4u*)(kvbase + ((size_t)((t) & 7) * GRIDW + 4 * j) * 16384 + (((t) >> 3) ? 8192 : 4096)); } while (0)
#define NA_WRITE(buf) do { _Pragma("unroll") for (int j = 0; j < 4; ++j) *(LAS v4u*)(lbase + ((buf) * 2 + grp) * NA_TILE + (16 * ct + 4 * j + g) * NA_PITCH + li * 16) = st[j]; } while (0)
        NA_LOAD(0); NA_WRITE(0); __syncthreads();
        f32x4 S[8][2];
#pragma unroll
        for (int t = 0; t < 8; ++t) {
            NA_LOAD(t + 1);
            const LAS unsigned char* tb = lbase + ((t & 1) * 2 + grp) * NA_TILE;
            S[t][0] = (f32x4){0.f, 0.f, 0.f, 0.f}; S[t][1] = (f32x4){0.f, 0.f, 0.f, 0.f};
#pragma unroll
            for (int blk = 0; blk < 2; ++blk)
#pragma unroll
                for (int ks = 0; ks < 4; ++ks) { const bf16x8 A = *(const LAS bf16x8*)(tb + (kc0 + 16 * blk + li) * NA_PITCH + (32 * ks + 8 * g) * 2);
                    S[t][blk] = MFMA16(A, qf[ks], S[t][blk]); }
            NA_WRITE((t + 1) & 1);
            __syncthreads();
        }
        const int c = c0 + li, cs = min(max(c - 8, 0), GRIDW - 16);
        float mx = -1e30f;
#pragma unroll
        for (int t = 0; t < 8; ++t)
#pragma unroll
            for (int blk = 0; blk < 2; ++blk)
#pragma unroll
                for (int e = 0; e < 4; ++e) { const int kc = kc0 + 16 * blk + 4 * g + e; const bool valid = (kc >= cs) && (kc < cs + 16);
                    const int idx = valid ? ((rs + t - r + 7) * 31 + (kc - c + 15)) : 0;
                    const float s = valid ? (S[t][blk][e] * 0.08838834764831845f + rp[idx]) : -1e30f; S[t][blk][e] = s; mx = fmaxf(mx, s); }
        mx = fmaxf(mx, __shfl_xor(mx, 16)); mx = fmaxf(mx, __shfl_xor(mx, 32));
        float sum = 0.f;
#pragma unroll
        for (int t = 0; t < 8; ++t)
#pragma unroll
            for (int blk = 0; blk < 2; ++blk)
#pragma unroll
                for (int e = 0; e < 4; ++e) { const float p = __expf(S[t][blk][e] - mx); S[t][blk][e] = p; sum += p; }
        sum += __shfl_xor(sum, 16); sum += __shfl_xor(sum, 32);
        const float inv = 1.0f / sum;
        bf16x8 pb[8];
#pragma unroll
        for (int t = 0; t < 8; ++t) pb[t] = pack8(S[t][0], S[t][1]);
        f32x4 O[8];
#pragma unroll
        for (int db = 0; db < 8; ++db) O[db] = (f32x4){0.f, 0.f, 0.f, 0.f};
#pragma unroll
        for (int t = 8; t < 16; ++t) {
            if (t < 15) NA_LOAD(t + 1);
            const LAS unsigned char* tb = lbase + ((t & 1) * 2 + grp) * NA_TILE + (kc0 + 4 * g + q4) * NA_PITCH + 8 * p4;
#pragma unroll
            for (int db = 0; db < 8; ++db) { const s16x4 a0 = tr4(tb + 32 * db), a1 = tr4(tb + 16 * NA_PITCH + 32 * db);
                O[db] = MFMA16(cat8(a0, a1), pb[t - 8], O[db]); }
            if (t < 15) NA_WRITE((t + 1) & 1);
            __syncthreads();
        }
#undef NA_LOAD
#undef NA_WRITE
        bf16* zp = QKVG + (tok0 + c0 + li) * 16384 + h * 128 + 4 * g;
#pragma unroll
        for (int db = 0; db < 8; ++db) { const v2u gw = *(const GAS v2u*)(zp + 12288 + 16 * db);
            const float z0 = O[db][0] * inv * siluf_(bf_lo(gw.x)), z1 = O[db][1] * inv * siluf_(bf_hi(gw.x)), z2 = O[db][2] * inv * siluf_(bf_lo(gw.y)), z3 = O[db][3] * inv * siluf_(bf_hi(gw.y));
            *(GAS v2u*)(zp + 16 * db) = (v2u){cvt_pk_bf16(z0, z1), cvt_pk_bf16(z2, z3)}; }
    }
    __syncthreads();
}

__device__ __forceinline__ void s5_scan_phase(Frame& F, const Args& a) {
    const float* Sloc = (const float*)(a.ws + WS_S5_SLOC); bf16* Ug = (bf16*)(a.ws + WS_S5_UG); const float* LAMT = (const float*)(a.ws + WS_LAMT);
    const int t8 = F.tid & 255, b = t8 >> 7, dir = (t8 >> 6) & 1, p = t8 & 63;
    for (int gi = F.vcu * 2 + (F.tid >> 8); gi < S5_G; gi += F.G * 2) {
        const float lr = LAMT[((size_t)(gi * 2 + dir) * 64 + p) * 2 + 0], li = LAMT[((size_t)(gi * 2 + dir) * 64 + p) * 2 + 1];
        float xr = 0.f, xi = 0.f;
#pragma unroll 8
        for (int s = 0; s < S5_NCHB; ++s) { const int c = dir ? (S5_NCHB - 1 - s) : s; const size_t row = (size_t)gi * S5_NCH + b * S5_NCHB + c;
            bf16* up = Ug + row * S5_KY + S5_KS + dir * 128 + p;
            up[0] = (bf16)f2bf(xr); up[64] = (bf16)f2bf(xi);
            const float sr = Sloc[row * 256 + dir * 128 + p], si = Sloc[row * 256 + dir * 128 + 64 + p];
            const float nr = lr * xr - li * xi + sr, ni = lr * xi + li * xr + si; xr = nr; xi = ni; }
    }
}

__device__ __forceinline__ float log_sigmoidf_(float z) { return fminf(z, 0.f) - log1pf(expf(-fabsf(z))); }
__device__ __forceinline__ void gla_prep_phase(Frame& F, const Args& a) {
    const bf16* IN = (const bf16*)(a.ws + WS_GLA_IN); const float* G1P = (const float*)(a.ws + WS_GLA_G1P);
    bf16* PREP = (bf16*)(a.ws + WS_GLA_PREP); float* DECAY = (float*)(a.ws + WS_GLA_DECAY);
    LAS float* g1s = (LAS float*)(F.lds + RING_OFF);
    LAS float* Bc = g1s + 64 * 32;
    LAS float* bl = Bc + 2 * 64 * 128;
    const int ipw = (4096 + F.G - 1) / F.G;
    for (int k = 0; k < ipw; ++k) {
        const int it = F.vcu * ipw + k; if (it >= 4096) break;
        const int cidx = it >> 4, h = (it >> 1) & 7, hf = it & 1, m0 = cidx * GLA_C, dbase = h * 256 + hf * 128;
        { const int tok = F.tid >> 3, qd = F.tid & 7; f32x4 s = {0.f, 0.f, 0.f, 0.f};
#pragma unroll
          for (int ks = 0; ks < 4; ++ks) s += *(const GAS f32x4*)(G1P + ((size_t)ks * M + m0 + tok) * 32 + qd * 4);
          if (MK_DIAG && (!(fabsf(s[0]) < 20.f) || !(fabsf(s[1]) < 20.f) || !(fabsf(s[2]) < 20.f) || !(fabsf(s[3]) < 20.f))) atomicOr((unsigned*)(a.ws + WS_CTL) + 17, 1u << 0);
          *(LAS f32x4*)(g1s + tok * 32 + qd * 4) = s; }
        __syncthreads();
        if (F.tid < 256) {
            const int dir = F.tid >> 7, col = F.tid & 127, d = dbase + col;
            const float* w2 = dir ? a.in[28] : a.in[25]; const float bgd = (dir ? a.in[29] : a.in[26])[d];
            float w2r[16];
#pragma unroll
            for (int r = 0; r < 16; ++r) w2r[r] = w2[(size_t)r * GLA_KW + d];
            float run = 0.f;
            for (int s = 0; s < 64; ++s) { const int i = dir ? (63 - s) : s; const LAS float* gp = g1s + i * 32 + dir * 16; float z = bgd;
#pragma unroll
                for (int r = 0; r < 16; ++r) z += gp[r] * w2r[r];
                if (MK_DIAG && !(fabsf(z) < 12.f)) atomicOr((unsigned*)(a.ws + WS_CTL) + 17, 1u << 1);
                run += log_sigmoidf_(z) * (1.0f / 16.0f); Bc[(dir * 64 + i) * 128 + col] = run; }
            bl[dir * 128 + col] = run;
        }
        __syncthreads();
#pragma unroll
        for (int j = 0; j < 2; ++j) { const int e = F.tid + 512 * j, tok = e >> 4, c8 = (e & 15) * 8; const size_t m = (size_t)m0 + tok;
            const v4u q8 = *(const GAS v4u*)(IN + m * GLA_NIN + dbase + c8), k8 = *(const GAS v4u*)(IN + m * GLA_NIN + GLA_KW + dbase + c8);
            float qv[8], kv[8];
#pragma unroll
            for (int x = 0; x < 4; ++x) { qv[2 * x] = bf_lo(q8[x]) * 0.0625f; qv[2 * x + 1] = bf_hi(q8[x]) * 0.0625f; kv[2 * x] = bf_lo(k8[x]); kv[2 * x + 1] = bf_hi(k8[x]); }
#pragma unroll
            for (int dir = 0; dir < 2; ++dir) {
                f32x4 bbv[2], btv[2];
                bbv[0] = *(const LAS f32x4*)(Bc + (dir * 64 + tok) * 128 + c8); bbv[1] = *(const LAS f32x4*)(Bc + (dir * 64 + tok) * 128 + c8 + 4);
                btv[0] = *(const LAS f32x4*)(bl + dir * 128 + c8); btv[1] = *(const LAS f32x4*)(bl + dir * 128 + c8 + 4);
                float o0[8], o1[8], o2[8];
#pragma unroll
                for (int x = 0; x < 8; ++x) { const float bx = bbv[x >> 2][x & 3], tx = btv[x >> 2][x & 3]; o0[x] = qv[x] * __expf(bx); o1[x] = kv[x] * __expf(-bx); o2[x] = kv[x] * __expf(tx - bx); }
                if (MK_DIAG) { bool bad = false;
#pragma unroll
                    for (int x = 0; x < 8; ++x) bad |= !(fabsf(o0[x]) < 1e4f) || !(fabsf(o1[x]) < 1e4f) || !(fabsf(o2[x]) < 1e4f);
                    if (bad) atomicOr((unsigned*)(a.ws + WS_CTL) + 17, 1u << 2); }
                v4u w0, w1, w2;
#pragma unroll
                for (int x = 0; x < 4; ++x) { w0[x] = cvt_pk_bf16(o0[2 * x], o0[2 * x + 1]); w1[x] = cvt_pk_bf16(o1[2 * x], o1[2 * x + 1]); w2[x] = cvt_pk_bf16(o2[2 * x], o2[2 * x + 1]); }
                bf16* pp = PREP + (size_t)(dir * 3) * M * GLA_KW + m * GLA_KW + dbase + c8;
                *(GAS v4u*)(pp) = w0; *(GAS v4u*)(pp + (size_t)M * GLA_KW) = w1; *(GAS v4u*)(pp + (size_t)2 * M * GLA_KW) = w2;
                if (tok == 0) { float* dp = DECAY + ((size_t)dir * GLA_NCH + cidx) * GLA_KW + dbase + c8;
                    *(GAS f32x4*)(dp) = (f32x4){__expf(btv[0][0]), __expf(btv[0][1]), __expf(btv[0][2]), __expf(btv[0][3])}; *(GAS f32x4*)(dp + 4) = (f32x4){__expf(btv[1][0]), __expf(btv[1][1]), __expf(btv[1][2]), __expf(btv[1][3])}; }
            }
        }
        __syncthreads();
    }
}

constexpr int GLA_PQ = 528, GLA_PV = 272, GLA_PVI = 1040;
__device__ __forceinline__ void gla_chain_role(Frame& F, const Args& a, int ch) {
    const bf16* IN = (const bf16*)(a.ws + WS_GLA_IN); const bf16* PREP = (const bf16*)(a.ws + WS_GLA_PREP); const float* DECAY = (const float*)(a.ws + WS_GLA_DECAY);
    const int b = ch >> 6, h = (ch >> 3) & 7, dir = (ch >> 2) & 1, vq = ch & 3;
    bf16* OUT = (bf16*)(a.ws + WS_GLA_O) + (size_t)(1 + dir) * M * 4096;
    const bf16* QS = PREP + (size_t)(dir * 3 + 0) * M * GLA_KW; const bf16* KE = PREP + (size_t)(dir * 3 + 2) * M * GLA_KW;
    LAS unsigned char* const qsT = F.lds + RING_OFF; LAS unsigned char* const keT = qsT + 64 * GLA_PQ; LAS unsigned char* const vT = keT + 64 * GLA_PQ; LAS float* const decT = (LAS float*)(vT + 64 * GLA_PV);
    const int lane = F.lane, li = lane & 15, g = lane >> 4, q4 = li >> 2, p4 = li & 3, w = F.wave;
    f32x4 S[16];
#pragma unroll
    for (int dt = 0; dt < 16; ++dt) S[dt] = (f32x4){0.f, 0.f, 0.f, 0.f};
    v4u rq[4], rk[4], rv[2]; f32x4 rd = {0.f, 0.f, 0.f, 0.f};
#define GC_LOAD(sidx) do { const int cn_ = dir ? (GLA_NCHB - 1 - (sidx)) : (sidx); const size_t m0_ = ((size_t)b * GLA_NCHB + cn_) * GLA_C; \
        _Pragma("unroll") for (int j = 0; j < 4; ++j) { const int e = F.tid + 512 * j, tok = e >> 5, pc = e & 31; \
            rq[j] = *(const GAS v4u*)(QS + (m0_ + tok) * GLA_KW + h * 256 + pc * 8); rk[j] = *(const GAS v4u*)(KE + (m0_ + tok) * GLA_KW + h * 256 + pc * 8); } \
        _Pragma("unroll") for (int j = 0; j < 2; ++j) { const int e = F.tid + 512 * j, tok = e >> 4, pc = e & 15; \
            rv[j] = *(const GAS v4u*)(IN + (m0_ + tok) * GLA_NIN + 4096 + h * 512 + vq * 128 + pc * 8); } \
        if (F.tid < 64) rd = *(const GAS f32x4*)(DECAY + ((size_t)dir * GLA_NCH + b * GLA_NCHB + cn_) * GLA_KW + h * 256 + F.tid * 4); } while (0)
    GC_LOAD(0);
    for (int sidx = 0; sidx < GLA_NCHB; ++sidx) {
#pragma unroll
        for (int j = 0; j < 4; ++j) { const int e = F.tid + 512 * j, tok = e >> 5, pc = e & 31; *(LAS v4u*)(qsT + tok * GLA_PQ + pc * 16) = rq[j]; *(LAS v4u*)(keT + tok * GLA_PQ + pc * 16) = rk[j]; }
#pragma unroll
        for (int j = 0; j < 2; ++j) { const int e = F.tid + 512 * j, tok = e >> 4, pc = e & 15; *(LAS v4u*)(vT + tok * GLA_PV + pc * 16) = rv[j]; }
        if (F.tid < 64) *(LAS f32x4*)(decT + F.tid * 4) = rd;
        __syncthreads();
        const int cn = dir ? (GLA_NCHB - 1 - sidx) : sidx; const size_t m0 = ((size_t)b * GLA_NCHB + cn) * GLA_C;
        if (sidx + 1 < GLA_NCHB) GC_LOAD(sidx + 1);
        v2u Sb[16];
#pragma unroll
        for (int dt = 0; dt < 16; ++dt) Sb[dt] = (v2u){cvt_pk_bf16(S[dt][0], S[dt][1]), cvt_pk_bf16(S[dt][2], S[dt][3])};
#pragma unroll
        for (int ib = 0; ib < 4; ++ib) { f32x4 acc = {0.f, 0.f, 0.f, 0.f}; const LAS unsigned char* qrow = qsT + (16 * ib + li) * GLA_PQ + 8 * g;
#pragma unroll
            for (int ks = 0; ks < 8; ++ks) { const v2u b0 = *(const LAS v2u*)(qrow + 64 * ks), b1 = *(const LAS v2u*)(qrow + 64 * ks + 32);
                const bf16x8 A = __builtin_bit_cast(bf16x8, (v4u){Sb[2 * ks].x, Sb[2 * ks].y, Sb[2 * ks + 1].x, Sb[2 * ks + 1].y});
                const bf16x8 B = __builtin_bit_cast(bf16x8, (v4u){b0.x, b0.y, b1.x, b1.y});
                acc = MFMA16(A, B, acc); }
            if (MK_DIAG && (!(fabsf(acc[0]) < 1e30f) || !(fabsf(acc[1]) < 1e30f) || !(fabsf(acc[2]) < 1e30f) || !(fabsf(acc[3]) < 1e30f))) atomicOr((unsigned*)(a.ws + WS_CTL) + 17, 1u << 7);
            *(GAS v2u*)(OUT + (m0 + 16 * ib + li) * 4096 + h * 512 + vq * 128 + w * 16 + 4 * g) = (v2u){cvt_pk_bf16(acc[0], acc[1]), cvt_pk_bf16(acc[2], acc[3])}; }
#pragma unroll
        for (int dt = 0; dt < 16; ++dt) S[dt] *= *(const LAS f32x4*)(decT + 16 * dt + 4 * g);
#pragma unroll
        for (int k2 = 0; k2 < 2; ++k2) { const LAS unsigned char* vb = vT + (32 * k2 + 8 * g + q4) * GLA_PV + (w * 16 + 4 * p4) * 2;
            const bf16x8 Bv = cat8(tr4(vb), tr4(vb + 4 * GLA_PV));
            const LAS unsigned char* kb = keT + (32 * k2 + 8 * g + q4) * GLA_PQ + 8 * p4;
#pragma unroll
            for (int dt = 0; dt < 16; ++dt) { const bf16x8 A = cat8(tr4(kb + 32 * dt), tr4(kb + 4 * GLA_PQ + 32 * dt)); S[dt] = MFMA16(A, Bv, S[dt]); } }
        __syncthreads();
    }
#undef GC_LOAD
}
__device__ __forceinline__ void gla_intra_role(Frame& F, const Args& a, int it) {
    const bf16* IN = (const bf16*)(a.ws + WS_GLA_IN); const bf16* PREP = (const bf16*)(a.ws + WS_GLA_PREP);
    bf16* OUT = (bf16*)(a.ws + WS_GLA_O);
    const int b = it >> 10, h = (it >> 7) & 7, cn = it & 127; const size_t m0 = ((size_t)b * GLA_NCHB + cn) * GLA_C;
    LAS unsigned char* const kfT = F.lds + RING_OFF; LAS unsigned char* const kbT = kfT + 64 * GLA_PQ; LAS unsigned char* const vT = kbT + 64 * GLA_PQ;
    const int lane = F.lane, li = lane & 15, g = lane >> 4, q4 = li >> 2, p4 = li & 3, ib = F.wave & 3, vh = F.wave >> 2;
    const bf16* KSF = PREP + (size_t)1 * M * GLA_KW; const bf16* KSB = PREP + (size_t)4 * M * GLA_KW;
    const bf16* QSF = PREP; const bf16* QSB = PREP + (size_t)3 * M * GLA_KW;
    {
        v4u r0[4], r1[4], r2[8];
#pragma unroll
        for (int j = 0; j < 4; ++j) { const int e = F.tid + 512 * j, tok = e >> 5, pc = e & 31; r0[j] = *(const GAS v4u*)(KSF + (m0 + tok) * GLA_KW + h * 256 + pc * 8); r1[j] = *(const GAS v4u*)(KSB + (m0 + tok) * GLA_KW + h * 256 + pc * 8); }
#pragma unroll
        for (int j = 0; j < 8; ++j) { const int e = F.tid + 512 * j, tok = e >> 6, pc = e & 63; r2[j] = *(const GAS v4u*)(IN + (m0 + tok) * GLA_NIN + 4096 + h * 512 + pc * 8); }
#pragma unroll
        for (int j = 0; j < 4; ++j) { const int e = F.tid + 512 * j, tok = e >> 5, pc = e & 31; *(LAS v4u*)(kfT + tok * GLA_PQ + pc * 16) = r0[j]; *(LAS v4u*)(kbT + tok * GLA_PQ + pc * 16) = r1[j]; }
#pragma unroll
        for (int j = 0; j < 8; ++j) { const int e = F.tid + 512 * j, tok = e >> 6, pc = e & 63; *(LAS v4u*)(vT + tok * GLA_PVI + pc * 16) = r2[j]; }
    }
    bf16x8 qf[8], qb[8];
#pragma unroll
    for (int ks = 0; ks < 8; ++ks) { qf[ks] = *(const GAS bf16x8*)(QSF + (m0 + 16 * ib + li) * GLA_KW + h * 256 + 32 * ks + 8 * g); qb[ks] = *(const GAS bf16x8*)(QSB + (m0 + 16 * ib + li) * GLA_KW + h * 256 + 32 * ks + 8 * g); }
    __syncthreads();
    f32x4 P[4];
#pragma unroll
    for (int jb = 0; jb < 4; ++jb) { f32x4 sf = {0.f, 0.f, 0.f, 0.f}, sb = {0.f, 0.f, 0.f, 0.f};
        if (jb <= ib) {
#pragma unroll
            for (int ks = 0; ks < 8; ++ks) sf = MFMA16(*(const LAS bf16x8*)(kfT + (16 * jb + li) * GLA_PQ + (32 * ks + 8 * g) * 2), qf[ks], sf); }
        if (jb >= ib) {
#pragma unroll
            for (int ks = 0; ks < 8; ++ks) sb = MFMA16(*(const LAS bf16x8*)(kbT + (16 * jb + li) * GLA_PQ + (32 * ks + 8 * g) * 2), qb[ks], sb); }
#pragma unroll
        for (int e = 0; e < 4; ++e) { const int ii = 16 * ib + li, jj = 16 * jb + 4 * g + e; P[jb][e] = (ii >= jj) ? sf[e] : sb[e]; } }
    if (MK_DIAG) { bool bad = false;
#pragma unroll
        for (int jb = 0; jb < 4; ++jb)
#pragma unroll
            for (int e = 0; e < 4; ++e) bad |= !(fabsf(P[jb][e]) < 1e30f);
        if (bad) atomicOr((unsigned*)(a.ws + WS_CTL) + 17, 1u << 4); }
    const bf16x8 Pb0 = pack8(P[0], P[1]), Pb1 = pack8(P[2], P[3]);
    bf16* op = OUT + (m0 + 16 * ib + li) * 4096 + h * 512 + vh * 256 + 4 * g;
    const LAS unsigned char* vb = vT + (4 * g + q4) * GLA_PVI + (vh * 256 + 4 * p4) * 2;
#pragma unroll
    for (int vt = 0; vt < 16; ++vt) { f32x4 acc = {0.f, 0.f, 0.f, 0.f};
        acc = MFMA16(cat8(tr4(vb + 32 * vt), tr4(vb + 16 * GLA_PVI + 32 * vt)), Pb0, acc);
        acc = MFMA16(cat8(tr4(vb + 32 * GLA_PVI + 32 * vt), tr4(vb + 48 * GLA_PVI + 32 * vt)), Pb1, acc);
        if (MK_DIAG && (!(fabsf(acc[0]) < 1e30f) || !(fabsf(acc[1]) < 1e30f) || !(fabsf(acc[2]) < 1e30f) || !(fabsf(acc[3]) < 1e30f))) atomicOr((unsigned*)(a.ws + WS_CTL) + 17, 1u << 5);
        *(GAS v2u*)(op + 16 * vt) = (v2u){cvt_pk_bf16(acc[0], acc[1]), cvt_pk_bf16(acc[2], acc[3])}; }
    __syncthreads();
}
__device__ __forceinline__ void gla_main_phase(Frame& F, const Args& a) {
    if (F.vcu < 128) { for (int ch = F.vcu; ch < 128; ch += 128) gla_chain_role(F, a, ch); }
    else { for (int it = F.vcu - 128; it < 2048; it += F.G - 128) gla_intra_role(F, a, it); }
}
__device__ __forceinline__ void gla_combine_phase(Frame& F, const Args& a) {
    const bf16* IN = (const bf16*)(a.ws + WS_GLA_IN); const bf16* O = (const bf16*)(a.ws + WS_GLA_O); bf16* Z = (bf16*)(a.ws + WS_GLA_Z);
    const float* nw = a.in[30];
    float nwr[8];
#pragma unroll
    for (int x = 0; x < 8; ++x) nwr[x] = nw[F.lane * 8 + x];
    const int gw = F.vcu * NWAVES + F.wave, NGW = F.G * NWAVES;
    for (int m = gw; m < M; m += NGW) {
#pragma unroll 2
        for (int h = 0; h < 8; ++h) { const size_t off = (size_t)m * 4096 + h * 512 + F.lane * 8;
            const v4u x0 = *(const GAS v4u*)(O + off), x1 = *(const GAS v4u*)(O + (size_t)M * 4096 + off), x2 = *(const GAS v4u*)(O + (size_t)2 * M * 4096 + off);
            const v4u gg = *(const GAS v4u*)(IN + (size_t)m * GLA_NIN + 8192 + h * 512 + F.lane * 8);
            if (MK_DIAG) { bool b0 = false, b1 = false, b2 = false, b3 = false;
#pragma unroll
                for (int x = 0; x < 4; ++x) { b0 |= !(fabsf(bf_lo(x0[x])) < 1e30f) || !(fabsf(bf_hi(x0[x])) < 1e30f); b1 |= !(fabsf(bf_lo(x1[x])) < 1e30f) || !(fabsf(bf_hi(x1[x])) < 1e30f);
                    b2 |= !(fabsf(bf_lo(x2[x])) < 1e30f) || !(fabsf(bf_hi(x2[x])) < 1e30f); b3 |= !(fabsf(bf_lo(gg[x])) < 1e30f) || !(fabsf(bf_hi(gg[x])) < 1e30f); }
                const unsigned f = (b0 ? 1024u : 0u) | (b1 ? 2048u : 0u) | (b2 ? 4096u : 0u) | (b3 ? 8192u : 0u); if (f) atomicOr((unsigned*)(a.ws + WS_CTL) + 17, f); }
            float o[8]; float ss = 0.f;
#pragma unroll
            for (int x = 0; x < 4; ++x) { o[2 * x] = bf_lo(x0[x]) + bf_lo(x1[x]) + bf_lo(x2[x]); o[2 * x + 1] = bf_hi(x0[x]) + bf_hi(x1[x]) + bf_hi(x2[x]); ss += o[2 * x] * o[2 * x] + o[2 * x + 1] * o[2 * x + 1]; }
            const float rstd = rsqrtf(wave_sum(ss) * (1.0f / 512.0f) + EPS);
            v4u zw;
#pragma unroll
            for (int x = 0; x < 4; ++x) zw[x] = cvt_pk_bf16(o[2 * x] * rstd * nwr[2 * x] * siluf_(bf_lo(gg[x])), o[2 * x + 1] * rstd * nwr[2 * x + 1] * siluf_(bf_hi(gg[x])));
            *(GAS v4u*)(Z + off) = zw; }
    }
}

constexpr int NPH = 23;
__global__ void __launch_bounds__(NWAVES * 64, 2) fwd_kernel(Args args) {
    extern __shared__ __attribute__((aligned(16))) unsigned char lds[];
    Frame F;
    F.lds = (LAS unsigned char*)lds;
    F.tid = threadIdx.x; F.lane = F.tid & 63; F.wave = __builtin_amdgcn_readfirstlane(F.tid >> 6);
    F.G = gridDim.x; { const int bx = blockIdx.x; F.vcu = (F.G % 8 == 0) ? (bx % 8) * (F.G / 8) + bx / 8 : bx; }
    volatile LAS unsigned* MISC = (volatile LAS unsigned*)(F.lds + MISC_OFF);
    for (int u = F.tid; u < (LDS_BYTES - MISC_OFF) / 4; u += NWAVES * 64) MISC[u] = 0u;
    __syncthreads();
    unsigned char* ws = args.ws;
    const int lo = args.ph_lo, hi = args.ph_hi;
    XcdBarrier bar; bar.bar = (unsigned*)(ws + WS_CTL) + CW_BAR; bar.x = 0; bar.st = nullptr;
    if (hi - lo > 1) bar = xcd_barrier_post((unsigned*)(ws + WS_CTL) + CW_BAR, MISC + 8);
#define IN(k) (lo <= (k) && (k) < hi)
#define SEAM(k) do { if (IN(k) && IN((k) + 1)) xcd_barrier(bar); } while (0)
    const float* MOD = (const float*)(ws + WS_MOD);
    bf16* H = (bf16*)(ws + WS_H);
    float* XO = args.out;
    LAS unsigned char* ring = F.lds + RING_OFF;
    unsigned* const DFLAG = (unsigned*)(ws + WS_CTL) + 16;

    if (IN(0)) { p0_prologue(F, args); } SEAM(0);

#if MK_NLAYERS >= 1
    if (IN(1)) { norm_phase<false>(F, args.in[0], args.in[4] + 0 * D, MOD + 0 * 2 * 12288, H, nullptr); } SEAM(1);
    if (IN(2)) { pg8::Gemm g{H, (const bf16*)(ws + WS_W_NAIN0), 4096, 4096, 4096, DFLAG, 1u << 2}; pg8::StaticOrder S; S.init(M, 16384, F.G, (int)blockIdx.x);
        pg8::EpiBf16 E{(bf16*)(ws + WS_NA_QKVG), 16384};
        pg8::gemm_phase<pg8::EpiBf16, pg8::StaticOrder, true, true>(ring, g, S, E); } SEAM(2);
    if (IN(3)) { na_attn_phase(F, (bf16*)(ws + WS_NA_QKVG), args.in[6] + 0 * 32 * 465); } SEAM(3);
    if (IN(4)) { pg8::Gemm g{(const bf16*)(ws + WS_NA_QKVG), (const bf16*)(ws + WS_W_NAOUT0), 4096, 16384, 4096, DFLAG, 1u << 4}; pg8::StaticOrder S; S.init(M, 4096, F.G, (int)blockIdx.x);
        pg8::EpiResid E{args.in[0], XO, D, MOD + 0 * 2 * 12288 + 8192, 12288, SEQ};
        pg8::gemm_phase<pg8::EpiResid, pg8::StaticOrder, true, true>(ring, g, S, E); } SEAM(4);
#endif
#if MK_NLAYERS >= 2
    if (IN(5)) { norm_phase<false>(F, XO, args.in[4] + 1 * D, MOD + 1 * 2 * 12288, H, nullptr); } SEAM(5);
    if (IN(6)) { pg8::Gemm g{H, (const bf16*)(ws + WS_W_S5IN), 4096, 4096, 4096, DFLAG, 1u << 6}; pg8::StaticOrder S; S.init(M, 8192, F.G, (int)blockIdx.x);
        pg8::EpiS5In<S5_T, S5_NCH, S5_KY> E{(bf16*)(ws + WS_S5_UG), (bf16*)(ws + WS_S5_GS)};
        pg8::gemm_phase<pg8::EpiS5In<S5_T, S5_NCH, S5_KY>, pg8::StaticOrder, true, true>(ring, g, S, E); } SEAM(6);
    if (IN(7)) { pg8::Gemm g{(const bf16*)(ws + WS_S5_UG), (const bf16*)(ws + WS_S5BS), S5_KS, S5_KY, S5_KS, DFLAG, 1u << 7}; pg8::BatchedOrder S; S.init(S5_G, S5_NCH / 256, 1, F.G, (int)blockIdx.x);
        pg8::EpiF32 E{(float*)(ws + WS_S5_SLOC), 256};
        pg8::gemm_phase<pg8::EpiF32, pg8::BatchedOrder, true, true>(ring, g, S, E); } SEAM(7);
    if (IN(8)) { s5_scan_phase(F, args); } SEAM(8);
    if (IN(9)) { pg8::Gemm g{(const bf16*)(ws + WS_S5_UG), (const bf16*)(ws + WS_S5BY), S5_KY, S5_KY, S5_KY, DFLAG, 1u << 9}; pg8::BatchedOrder S; S.init(S5_G, S5_NCH / 256, S5_KS / 256, F.G, (int)blockIdx.x);
        pg8::EpiS5Y<S5_T, S5_NCH / 256> E{(bf16*)(ws + WS_S5_Y)};
        pg8::gemm_phase<pg8::EpiS5Y<S5_T, S5_NCH / 256>, pg8::BatchedOrder, true, true>(ring, g, S, E); } SEAM(9);
    if (IN(10)) { pg8::Gemm g{(const bf16*)(ws + WS_S5_Y), (const bf16*)(ws + WS_W_S5GLU), 4096, 4096, 4096, DFLAG, 1u << 10}; pg8::StaticOrder S; S.init(M, 4096, F.G, (int)blockIdx.x);
        pg8::EpiGlu E{(const bf16*)(ws + WS_S5_Y), (const bf16*)(ws + WS_S5_GS), args.in[21], (bf16*)(ws + WS_S5_Z)};
        pg8::gemm_phase<pg8::EpiGlu, pg8::StaticOrder, true, true>(ring, g, S, E); } SEAM(10);
    if (IN(11)) { pg8::Gemm g{(const bf16*)(ws + WS_S5_Z), (const bf16*)(ws + WS_W_S5OUT), 4096, 4096, 4096, DFLAG, 1u << 11}; pg8::StaticOrder S; S.init(M, 4096, F.G, (int)blockIdx.x);
        pg8::EpiResid E{XO, XO, D, MOD + 1 * 2 * 12288 + 8192, 12288, SEQ};
        pg8::gemm_phase<pg8::EpiResid, pg8::StaticOrder, true, true>(ring, g, S, E); } SEAM(11);
#endif
#if MK_NLAYERS >= 3
    if (IN(12)) { norm_phase<false>(F, XO, args.in[4] + 2 * D, MOD + 2 * 2 * 12288, H, nullptr); } SEAM(12);
    if (IN(13)) { { pg8::Gemm g{H, (const bf16*)(ws + WS_W_GLAIN), 4096, 4096, 4096, DFLAG, 1u << 13}; pg8::StaticOrder S; S.init(M, GLA_NIN, F.G, (int)blockIdx.x);
          pg8::EpiBf16 E{(bf16*)(ws + WS_GLA_IN), GLA_NIN};
          pg8::gemm_phase<pg8::EpiBf16, pg8::StaticOrder, true, true>(ring, g, S, E); }
        { pg8::Gemm g{H, (const bf16*)(ws + WS_W_GLAG1), 1024, 4096, 4096, DFLAG, 1u << 13}; pg8::SplitKOrder S; S.init(M, 4, 1024, F.G, (int)blockIdx.x);
          pg8::EpiGate E{(float*)(ws + WS_GLA_G1P), M};
          pg8::gemm_phase<pg8::EpiGate, pg8::SplitKOrder, true, true>(ring, g, S, E); } } SEAM(13);
    if (IN(14)) { gla_prep_phase(F, args); } SEAM(14);
    if (IN(15)) { gla_main_phase(F, args); } SEAM(15);
    if (IN(16)) { gla_combine_phase(F, args); } SEAM(16);
    if (IN(17)) { pg8::Gemm g{(const bf16*)(ws + WS_GLA_Z), (const bf16*)(ws + WS_W_GLAOUT), 4096, 4096, 4096, DFLAG, 1u << 17}; pg8::StaticOrder S; S.init(M, 4096, F.G, (int)blockIdx.x);
        pg8::EpiResid E{XO, XO, D, MOD + 2 * 2 * 12288 + 8192, 12288, SEQ};
        pg8::gemm_phase<pg8::EpiResid, pg8::StaticOrder, true, true>(ring, g, S, E); } SEAM(17);
#endif
#if MK_NLAYERS >= 4
    if (IN(18)) { norm_phase<false>(F, XO, args.in[4] + 3 * D, MOD + 3 * 2 * 12288, H, nullptr); } SEAM(18);
    if (IN(19)) { pg8::Gemm g{H, (const bf16*)(ws + WS_W_NAIN1), 4096, 4096, 4096, DFLAG, 1u << 19}; pg8::StaticOrder S; S.init(M, 16384, F.G, (int)blockIdx.x);
        pg8::EpiBf16 E{(bf16*)(ws + WS_NA_QKVG), 16384};
        pg8::gemm_phase<pg8::EpiBf16, pg8::StaticOrder, true, true>(ring, g, S, E); } SEAM(19);
    if (IN(20)) { na_attn_phase(F, (bf16*)(ws + WS_NA_QKVG), args.in[6] + 1 * 32 * 465); } SEAM(20);
    if (IN(21)) { pg8::Gemm g{(const bf16*)(ws + WS_NA_QKVG), (const bf16*)(ws + WS_W_NAOUT1), 4096, 16384, 4096, DFLAG, 1u << 21}; pg8::StaticOrder S; S.init(M, 4096, F.G, (int)blockIdx.x);
        pg8::EpiResid E{XO, XO, D, MOD + 3 * 2 * 12288 + 8192, 12288, SEQ};
        pg8::gemm_phase<pg8::EpiResid, pg8::StaticOrder, true, true>(ring, g, S, E); } SEAM(21);
#endif
    if (IN(22)) { norm_phase<true>(F, (MK_NLAYERS >= 1) ? (const float*)XO : args.in[0], args.in[32], nullptr, nullptr, XO); }
#if MK_DIAG
    if (IN(22)) { __syncthreads(); const unsigned f = __hip_atomic_load(DFLAG, __ATOMIC_RELAXED, __HIP_MEMORY_SCOPE_AGENT);
        const unsigned f2 = __hip_atomic_load(DFLAG + 1, __ATOMIC_RELAXED, __HIP_MEMORY_SCOPE_AGENT);
        if (f != 0u || f2 != 0u) { const int k = f2 ? (24 + __builtin_ctz(f2)) : __builtin_ctz(f); float mk = 10.f; for (int i = 0; i < k; ++i) mk *= 10.f;
            const int gw = F.vcu * NWAVES + F.wave, NGW = F.G * NWAVES;
            for (int m = gw; m < M; m += NGW) for (int j = 0; j < 16; ++j) *((GAS f32x4*)(XO + (size_t)m * D) + F.lane + 64 * j) = (f32x4){mk, mk, mk, mk}; }
        else { const int gw = F.vcu * NWAVES + F.wave, NGW = F.G * NWAVES;
            for (int m = gw; m < M; m += NGW) for (int j = 0; j < 16; ++j) { GAS f32x4* p = (GAS f32x4*)(XO + (size_t)m * D) + F.lane + 64 * j; f32x4 v = *p; bool ch = false;
                for (int e = 0; e < 4; ++e) if (!(__builtin_fabsf(v[e]) < 3.0e38f)) { v[e] = 3.0e30f; ch = true; } if (ch) *p = v; } } }
#endif
#undef IN
#undef SEAM
}

extern "C" void kernel_launch(void* const* d_in, const int* in_sizes, int n_in, void* d_out, int out_size, void* d_ws, size_t ws_size, hipStream_t stream) {
    static int grid = 0;
    if (grid == 0) {
        if (n_in != 33 || in_sizes[0] != M * D || out_size != M * D || ws_size < WS_END) {
            fprintf(stderr, "kernel_launch: built for 33 inputs, x/out of %d floats, >= %zu bytes of workspace; got n_in %d, in0 %d, out %d, ws %zu; nothing launched\n", M * D, (size_t)WS_END, n_in, n_in > 0 ? in_sizes[0] : -1, out_size, ws_size);
            grid = -1; return; }
        int dev = 0, cus = 0, per_cu = 0;
        if (hipGetDevice(&dev) != hipSuccess || hipDeviceGetAttribute(&cus, hipDeviceAttributeMultiprocessorCount, dev) != hipSuccess) { fprintf(stderr, "kernel_launch: device query failed\n"); grid = -1; return; }
        if (hipFuncSetAttribute((const void*)fwd_kernel, hipFuncAttributeMaxDynamicSharedMemorySize, LDS_BYTES) != hipSuccess) { fprintf(stderr, "kernel_launch: hipFuncSetAttribute failed\n"); grid = -1; return; }
        if (hipOccupancyMaxActiveBlocksPerMultiprocessor(&per_cu, (const void*)fwd_kernel, NWAVES * 64, LDS_BYTES) != hipSuccess || per_cu < 1)
            fprintf(stderr, "kernel_launch: note: occupancy query reports %d workgroups per CU\n", per_cu);
        (void)hipGetLastError();
        grid = cus;
        if (grid != 256) fprintf(stderr, "kernel_launch: note: %d CUs (tuned for 256)\n", grid);
        if (grid < 136) { fprintf(stderr, "kernel_launch: needs >= 136 CUs\n"); grid = -1; return; }
    }
    if (grid < 0) return;
    if (hipMemsetAsync((char*)d_ws + WS_CTL, 0, CTL_ZERO_BYTES, stream) != hipSuccess) { fprintf(stderr, "kernel_launch: memset failed\n"); return; }
    Args a{};
    for (int i = 0; i < 33; ++i) a.in[i] = (const float*)d_in[i];
    a.out = (float*)d_out; a.ws = (unsigned char*)d_ws;
#if MK_ONE_LAUNCH
    a.ph_lo = 0; a.ph_hi = NPH;
    hipLaunchKernelGGL(fwd_kernel, dim3(grid), dim3(NWAVES * 64), LDS_BYTES, stream, a);
#else
    for (int ph = 0; ph < NPH; ++ph) { a.ph_lo = ph; a.ph_hi = ph + 1;
        hipLaunchKernelGGL(fwd_kernel, dim3(grid), dim3(NWAVES * 64), LDS_BYTES, stream, a); }
#endif
    const hipError_t le = hipPeekAtLastError();
    if (le != hipSuccess) fprintf(stderr, "kernel_launch: launch failed: %s\n", hipGetErrorName(le));
}
```

```cpp
#include <hip/hip_runtime.h>
#include <cstdio>
#include <cstdint>

#ifndef MK_ONE_LAUNCH
#define MK_ONE_LAUNCH 1
#endif
#ifndef MK_DIAG
#define MK_DIAG 0
#endif
#ifndef MK_NLAYERS
#define MK_NLAYERS 4
#endif

namespace pg8 {
#define PG8_LAS __attribute__((address_space(3)))
typedef unsigned short bf16_t;
typedef short bf16x8 __attribute__((ext_vector_type(8)));
typedef float f32x4 __attribute__((ext_vector_type(4)));
typedef unsigned u32x4 __attribute__((ext_vector_type(4)));
typedef unsigned u32x2 __attribute__((ext_vector_type(2)));
constexpr int BM = 256, BK = 64, HALF = 128, HTB = HALF * BK * 2  , STAGE_BYTES = 8 * HTB, NXCD = 8, WGM = 8;

__host__ __device__ __forceinline__ int lds_byte(int r, int c) { const int st = (r >> 4) * 2 + (c >> 5), rr = r & 15, cc = c & 31, ob = rr * 64 + cc * 2; return st * 1024 + (ob ^ (((ob >> 9) & 1) << 5)); }
__host__ __device__ __forceinline__ void stage_rc(int b, int& R, int& C) { const int st = b / 1024, sb = b % 1024, swz = sb ^ (((sb >> 9) & 1) << 5); R = (st >> 1) * 16 + swz / 64; C = (st & 1) * 32 + (swz % 64) / 2; }
__host__ __device__ __forceinline__ int perm32(int rho) { const int n = rho >> 4, i = rho & 15; return 8 * (i >> 2) + 4 * n + (i & 3); }

struct Unit { int pm, pn, pb, koff; };
struct Gemm { const bf16_t* A; const bf16_t* Bt; int K, lda, ldb; unsigned* dflag; unsigned dbit; };

struct StaticOrder {
    int nM, nN, nwg, G, c;
    __host__ __device__ void init(int M, int N, int G_, int c_) { nM = M / BM; nN = N / BM; nwg = nM * nN; G = G_; c = c_; }
    __host__ __device__ bool next(int i, Unit& u) const {
        const long L = (long)i * G + c; if (L >= nwg) return false;
        int wgid = (int)L; { const int q = nwg / NXCD, r = nwg % NXCD, xcd = wgid % NXCD, off = wgid / NXCD; wgid = (xcd < r ? xcd * (q + 1) : r * (q + 1) + (xcd - r) * q) + off; }
        const int nig = WGM * nN, gid = wgid / nig, fm = gid * WGM, gsz = (nM - fm) < WGM ? (nM - fm) : WGM;
        u.pm = fm + ((wgid % nig) % gsz); u.pn = (wgid % nig) / gsz; u.pb = u.pn; u.koff = 0; return true;
    }
    __device__ __forceinline__ void a_ready(const Unit&) const {}
    __device__ __forceinline__ void done(const Unit&) const {}
};
struct BatchedOrder {
    int nPm, nPn, total, G, c;
    __host__ __device__ void init(int ngroups, int nPm_, int nPn_, int G_, int c_) { nPm = nPm_; nPn = nPn_; total = ngroups * nPm * nPn; G = G_; c = c_; }
    __host__ __device__ bool next(int i, Unit& u) const {
        const long L = (long)i * G + c; if (L >= total) return false;
        const int upg = nPm * nPn, g = (int)L / upg, rem = (int)L % upg, pmi = rem / nPn, pni = rem % nPn;
        u.pm = g * nPm + pmi; u.pn = pni; u.pb = g * nPn + pni; u.koff = 0; return true;
    }
    __device__ __forceinline__ void a_ready(const Unit&) const {}
    __device__ __forceinline__ void done(const Unit&) const {}
};
struct SplitKOrder {
    int nM, nsplit, kslice, G, c;
    __host__ __device__ void init(int M, int nsplit_, int kslice_, int G_, int c_) { nM = M / BM; nsplit = nsplit_; kslice = kslice_; G = G_; c = c_; }
    __host__ __device__ bool next(int i, Unit& u) const {
        const long L = (long)i * G + c; if (L >= (long)nM * nsplit) return false;
        u.pm = (int)L / nsplit; u.pn = (int)L % nsplit; u.pb = 0; u.koff = u.pn * kslice; return true;
    }
    __device__ __forceinline__ void a_ready(const Unit&) const {}
    __device__ __forceinline__ void done(const Unit&) const {}
};

typedef float f32x2_t __attribute__((ext_vector_type(2))); typedef __bf16 bf16x2_t __attribute__((ext_vector_type(2)));
__device__ __forceinline__ unsigned cvt_pk_bf16(float lo, float hi) { f32x2_t v = {lo, hi}; bf16x2_t b = __builtin_convertvector(v, bf16x2_t); return __builtin_bit_cast(unsigned, b); }
__device__ __forceinline__ float bf_lo(unsigned w) { return __uint_as_float(w << 16); }
__device__ __forceinline__ float bf_hi(unsigned w) { return __uint_as_float(w & 0xffff0000u); }
__device__ __forceinline__ float sigmoidf_(float x) { return 1.0f / (1.0f + __expf(-x)); }
__device__ __forceinline__ float siluf_(float x) { return x / (1.0f + __expf(-x)); }
__device__ __forceinline__ float gelu_tanh(float x) { const float z = 0.7978845608028654f * (x + 0.044715f * x * x * x); return x / (1.0f + __expf(-2.0f * z)); }

struct EpiBf16 {
    static constexpr bool PERM = true, AFTER_DRAIN = false;
    bf16_t* O; int ldc;
    __device__ __forceinline__ void operator()(const f32x4 (&acc)[2][2][4][2], const Unit& u, int wr, int wc, int fr, int fq) const {
        const int row0 = u.pm * BM + wr * 64 + fr, col0 = u.pn * BM + wc * 32 + 8 * fq;
#pragma unroll
        for (int ai = 0; ai < 2; ++ai)
#pragma unroll
            for (int m = 0; m < 4; ++m) { bf16_t* rowp = O + (size_t)(row0 + ai * HALF + m * 16) * ldc + col0;
#pragma unroll
                for (int bj = 0; bj < 2; ++bj) { const f32x4 v0 = acc[ai][bj][m][0], v1 = acc[ai][bj][m][1];
                    u32x4 w; w.x = cvt_pk_bf16(v0[0], v0[1]); w.y = cvt_pk_bf16(v0[2], v0[3]); w.z = cvt_pk_bf16(v1[0], v1[1]); w.w = cvt_pk_bf16(v1[2], v1[3]);
                    *(u32x4*)(rowp + bj * HALF) = w; } }
    }
};
struct EpiResid {
    static constexpr bool PERM = false, AFTER_DRAIN = false;
    const float* base; float* out; int ldc; const float* gate0; int gate_stride; int rows_per_batch;
    __device__ __forceinline__ void operator()(const f32x4 (&acc)[2][2][4][2], const Unit& u, int wr, int wc, int fr, int fq) const {
        const int row0 = u.pm * BM + wr * 64 + fr, col0 = u.pn * BM + wc * 32 + 4 * fq;
        const float* gp = gate0 + (size_t)((u.pm * BM) / rows_per_batch) * gate_stride + col0;
        f32x4 gv[2][2];
#pragma unroll
        for (int bj = 0; bj < 2; ++bj)
#pragma unroll
            for (int n = 0; n < 2; ++n) gv[bj][n] = *(const f32x4*)(gp + bj * HALF + n * 16);
#pragma unroll
        for (int ai = 0; ai < 2; ++ai)
#pragma unroll
            for (int m = 0; m < 4; ++m) { const size_t off = (size_t)(row0 + ai * HALF + m * 16) * ldc + col0;
#pragma unroll
                for (int bj = 0; bj < 2; ++bj)
#pragma unroll
                    for (int n = 0; n < 2; ++n) { const f32x4 bs = *(const f32x4*)(base + off + bj * HALF + n * 16);
                        *(f32x4*)(out + off + bj * HALF + n * 16) = bs + gv[bj][n] * acc[ai][bj][m][n]; }
                asm volatile("" ::: "memory"); }
    }
};
struct EpiF32 {
    static constexpr bool PERM = false, AFTER_DRAIN = false;
    float* C; int ldc;
    __device__ __forceinline__ void operator()(const f32x4 (&acc)[2][2][4][2], const Unit& u, int wr, int wc, int fr, int fq) const {
        const int row0 = u.pm * BM + wr * 64 + fr, col0 = u.pn * BM + wc * 32 + 4 * fq;
#pragma unroll
        for (int ai = 0; ai < 2; ++ai)
#pragma unroll
            for (int m = 0; m < 4; ++m) { float* rowp = C + (size_t)(row0 + ai * HALF + m * 16) * ldc + col0;
#pragma unroll
                for (int bj = 0; bj < 2; ++bj)
#pragma unroll
                    for (int n = 0; n < 2; ++n) *(f32x4*)(rowp + bj * HALF + n * 16) = acc[ai][bj][m][n]; }
    }
};
struct EpiGate {
    static constexpr bool PERM = false, AFTER_DRAIN = false;
    float* P; int rows;
    __device__ __forceinline__ void operator()(const f32x4 (&acc)[2][2][4][2], const Unit& u, int wr, int wc, int fr, int fq) const {
        if (wc != 0) return;
        const int row0 = u.pm * BM + wr * 64 + fr;
#pragma unroll
        for (int ai = 0; ai < 2; ++ai)
#pragma unroll
            for (int m = 0; m < 4; ++m) { float* rowp = P + ((size_t)u.pn * rows + (row0 + ai * HALF + m * 16)) * 32 + 4 * fq;
#pragma unroll
                for (int n = 0; n < 2; ++n) *(f32x4*)(rowp + n * 16) = acc[ai][0][m][n]; }
    }
};
template <int T, int NCH, int KY> struct EpiS5In {
    static constexpr bool PERM = true, AFTER_DRAIN = false;
    bf16_t* Ug; bf16_t* Gs;
    __device__ __forceinline__ void operator()(const f32x4 (&acc)[2][2][4][2], const Unit& u, int wr, int wc, int fr, int fq) const {
        const int row0 = u.pm * BM + wr * 64 + fr, col0 = u.pn * BM + wc * 32 + 8 * fq;
#pragma unroll
        for (int ai = 0; ai < 2; ++ai)
#pragma unroll
            for (int m = 0; m < 4; ++m) { const int row = row0 + ai * HALF + m * 16;
#pragma unroll
                for (int bj = 0; bj < 2; ++bj) { const f32x4 v0 = acc[ai][bj][m][0], v1 = acc[ai][bj][m][1]; const int col = col0 + bj * HALF;
                    u32x4 w; w.x = cvt_pk_bf16(v0[0], v0[1]); w.y = cvt_pk_bf16(v0[2], v0[3]); w.z = cvt_pk_bf16(v1[0], v1[1]); w.w = cvt_pk_bf16(v1[2], v1[3]);
                    if (col < 4096) { const int g = col >> 4, i0 = col & 15, chunk = row / T, t = row % T;
                        *(u32x4*)(Ug + ((size_t)g * NCH + chunk) * KY + t * 16 + i0) = w; }
                    else *(u32x4*)(Gs + (size_t)row * 4096 + (col - 4096)) = w; } }
    }
};
template <int T, int NPM> struct EpiS5Y {
    static constexpr bool PERM = true, AFTER_DRAIN = false;
    bf16_t* Y;
    __device__ __forceinline__ void operator()(const f32x4 (&acc)[2][2][4][2], const Unit& u, int wr, int wc, int fr, int fq) const {
        const int g = u.pm / NPM, chunk0 = (u.pm % NPM) * BM + wr * 64 + fr, col0 = u.pn * BM + wc * 32 + 8 * fq;
#pragma unroll
        for (int ai = 0; ai < 2; ++ai)
#pragma unroll
            for (int m = 0; m < 4; ++m) { const int chunk = chunk0 + ai * HALF + m * 16;
#pragma unroll
                for (int bj = 0; bj < 2; ++bj) { f32x4 v0 = acc[ai][bj][m][0], v1 = acc[ai][bj][m][1]; const int n = col0 + bj * HALF, t = n >> 4, i0 = n & 15;
#pragma unroll
                    for (int j = 0; j < 4; ++j) { v0[j] = gelu_tanh(v0[j]); v1[j] = gelu_tanh(v1[j]); }
                    u32x4 w; w.x = cvt_pk_bf16(v0[0], v0[1]); w.y = cvt_pk_bf16(v0[2], v0[3]); w.z = cvt_pk_bf16(v1[0], v1[1]); w.w = cvt_pk_bf16(v1[2], v1[3]);
                    *(u32x4*)(Y + (size_t)(chunk * T + t) * 4096 + g * 16 + i0) = w; } }
    }
};
struct EpiGlu {
    static constexpr bool PERM = true, AFTER_DRAIN = false;
    const bf16_t* Y; const bf16_t* Gs; const float* bias; bf16_t* Z;
    __device__ __forceinline__ void operator()(const f32x4 (&acc)[2][2][4][2], const Unit& u, int wr, int wc, int fr, int fq) const {
        const int row0 = u.pm * BM + wr * 64 + fr, col0 = u.pn * BM + wc * 32 + 8 * fq;
        f32x4 bv[2][2];
#pragma unroll
        for (int bj = 0; bj < 2; ++bj)
#pragma unroll
            for (int n = 0; n < 2; ++n) bv[bj][n] = *(const f32x4*)(bias + col0 + bj * HALF + 4 * n);
#pragma unroll
        for (int ai = 0; ai < 2; ++ai)
#pragma unroll
            for (int m = 0; m < 4; ++m) { const size_t off = (size_t)(row0 + ai * HALF + m * 16) * 4096 + col0;
#pragma unroll
                for (int bj = 0; bj < 2; ++bj) { const u32x4 yw = *(const u32x4*)(Y + off + bj * HALF), gw = *(const u32x4*)(Gs + off + bj * HALF);
                    const f32x4 a0 = acc[ai][bj][m][0] + bv[bj][0], a1 = acc[ai][bj][m][1] + bv[bj][1];
                    float o[8];
#pragma unroll
                    for (int j = 0; j < 4; ++j) { const unsigned yj = yw[j], gj = gw[j];
                        const float aa = (j < 2) ? a0[2 * j] : a1[2 * j - 4], ab = (j < 2) ? a0[2 * j + 1] : a1[2 * j - 3];
                        o[2 * j] = bf_lo(yj) * sigmoidf_(aa) * siluf_(bf_lo(gj)); o[2 * j + 1] = bf_hi(yj) * sigmoidf_(ab) * siluf_(bf_hi(gj)); }
                    u32x4 w; w.x = cvt_pk_bf16(o[0], o[1]); w.y = cvt_pk_bf16(o[2], o[3]); w.z = cvt_pk_bf16(o[4], o[5]); w.w = cvt_pk_bf16(o[6], o[7]);
                    *(u32x4*)(Z + off + bj * HALF) = w; }
                asm volatile("" ::: "memory"); }
    }
};

template <class Epi, class Sched, bool ALIGN_EPI = false, bool SP2 = false>
__device__ __forceinline__ void gemm_phase(PG8_LAS unsigned char* lds, const Gemm g, const Sched& S, const Epi& E) {
    const int tid = threadIdx.x, wid = __builtin_amdgcn_readfirstlane(tid >> 6), lane = tid & 63, wr = wid >> 2, wc = wid & 3, fr = lane & 15, fq = lane >> 4;
    const int K = g.K, nt = K / BK, lda = g.lda, ldb = g.ldb;
    unsigned voffA[2], voffB[2];
#pragma unroll
    for (int i = 0; i < 2; ++i) { int R, C; stage_rc(tid * 16 + i * 8192, R, C); const int Rb = Epi::PERM ? ((R & ~31) + perm32(R & 31)) : R;
        voffA[i] = (unsigned)(R * lda + C) * 2u; voffB[i] = (unsigned)(Rb * ldb + C) * 2u; }
    const size_t kstep = (size_t)(BK * 2);
    const size_t hstepA = (size_t)HALF * lda * 2, hstepB = (size_t)HALF * ldb * 2;
    const size_t tstepA = 2 * hstepA, tstepB = 2 * hstepB;
    const unsigned ldsw = (unsigned)wid * 1024u;
    const int aoff = lds_byte(wr * 64 + fr, fq * 8), boff = lds_byte(wc * 32 + fr, fq * 8);
#define PG8_SA(b, h) (((b) * 2 + (h)) * HTB)
#define PG8_SB(b, h) ((4 + (b) * 2 + (h)) * HTB)
#define PG8_STAGE(bufoff, gbase, voff) do { _Pragma("unroll") for (int _i = 0; _i < 2; ++_i) \
        __builtin_amdgcn_global_load_lds((const unsigned*)((const char*)(gbase) + (voff)[_i]), (PG8_LAS unsigned*)(lds + (bufoff) + ldsw + _i * 8192), 16, 0, 0); } while (0)
#define PG8_LDA(dst, b, h) do { _Pragma("unroll") for (int m = 0; m < 4; ++m) _Pragma("unroll") for (int k = 0; k < 2; ++k) dst[m][k] = *(const PG8_LAS bf16x8*)(lds + PG8_SA(b, h) + aoff + m * 2048 + k * 1024); } while (0)
#define PG8_LDB(dst, b, h) do { _Pragma("unroll") for (int n = 0; n < 2; ++n) _Pragma("unroll") for (int k = 0; k < 2; ++k) dst[n][k] = *(const PG8_LAS bf16x8*)(lds + PG8_SB(b, h) + boff + n * 2048 + k * 1024); } while (0)
#define PG8_MMA(ai, bj, At, Bt) do { __builtin_amdgcn_s_setprio(1); _Pragma("unroll") for (int m = 0; m < 4; ++m) _Pragma("unroll") for (int n = 0; n < 2; ++n) _Pragma("unroll") for (int k = 0; k < 2; ++k) \
        acc[ai][bj][m][n] = __builtin_amdgcn_mfma_f32_16x16x32_bf16(Bt[n][k], At[m][k], acc[ai][bj][m][n], 0, 0, 0); __builtin_amdgcn_s_setprio(0); } while (0)
#define PG8_WAIT_V(n) asm volatile("s_waitcnt vmcnt(" #n ")" ::: "memory")
#define PG8_WAIT_L(n) asm volatile("s_waitcnt lgkmcnt(" #n ")" ::: "memory")
#define PG8_BAR __builtin_amdgcn_s_barrier()
#define PG8_SCHED __builtin_amdgcn_sched_barrier(0)
    Unit cur, nxt; int ui = 0;
    if (!S.next(0, cur)) return;
    f32x4 acc[2][2][4][2];
#pragma unroll
    for (int a = 0; a < 2; ++a)
#pragma unroll
        for (int b = 0; b < 2; ++b)
#pragma unroll
            for (int m = 0; m < 4; ++m)
#pragma unroll
                for (int n = 0; n < 2; ++n) acc[a][b][m][n] = (f32x4){0.f, 0.f, 0.f, 0.f};
    bf16x8 At[4][2], B0[2][2], B1[2][2];
    const char* cA = (const char*)g.A + (size_t)cur.pm * tstepA + (size_t)cur.koff * 2; const char* cB = (const char*)g.Bt + (size_t)cur.pb * tstepB + (size_t)cur.koff * 2;
    S.a_ready(cur);
    if constexpr (SP2) {
        PG8_STAGE(PG8_SB(0, 0), cB, voffB); PG8_STAGE(PG8_SB(0, 1), cB + hstepB, voffB); PG8_STAGE(PG8_SA(0, 0), cA, voffA); PG8_STAGE(PG8_SA(0, 1), cA + hstepA, voffA);
        if (wr == 1) PG8_BAR;
        PG8_WAIT_V(2); PG8_BAR;
        PG8_STAGE(PG8_SB(1, 0), cB + kstep, voffB); PG8_STAGE(PG8_SA(1, 0), cA + kstep, voffA); PG8_STAGE(PG8_SB(1, 1), cB + hstepB + kstep, voffB);
        PG8_WAIT_V(6); PG8_BAR;
    } else {
        PG8_STAGE(PG8_SB(0, 0), cB, voffB); PG8_STAGE(PG8_SA(0, 0), cA, voffA); PG8_STAGE(PG8_SB(0, 1), cB + hstepB, voffB); PG8_STAGE(PG8_SA(0, 1), cA + hstepA, voffA);
        if (wr == 1) PG8_BAR;
        PG8_WAIT_V(4); PG8_BAR;
        PG8_STAGE(PG8_SB(1, 0), cB + kstep, voffB); PG8_STAGE(PG8_SA(1, 0), cA + kstep, voffA); PG8_STAGE(PG8_SB(1, 1), cB + hstepB + kstep, voffB);
        PG8_WAIT_V(6); PG8_BAR;
    }
    for (;;) {
        const bool has_next = S.next(ui + 1, nxt);
        const char* nA = has_next ? (const char*)g.A + (size_t)nxt.pm * tstepA + (size_t)nxt.koff * 2 : cA; const char* nB = has_next ? (const char*)g.Bt + (size_t)nxt.pb * tstepB + (size_t)nxt.koff * 2 : cB;
        for (int t = 0; t < nt; t += 2) {
            const bool last = (t == nt - 2);
            const char* a1 = cA + (size_t)(t + 1) * kstep;
            const char* a2 = last ? nA : cA + (size_t)(t + 2) * kstep; const char* b2 = last ? nB : cB + (size_t)(t + 2) * kstep;
            const char* a3 = a2 + kstep; const char* b3 = b2 + kstep;
            if (last && has_next) S.a_ready(nxt);
            if constexpr (SP2) {
            PG8_LDB(B0, 0, 0); PG8_LDB(B1, 0, 1); PG8_SCHED; PG8_LDA(At, 0, 0); PG8_STAGE(PG8_SA(1, 1), a1 + hstepA, voffA);
            PG8_WAIT_V(8); PG8_WAIT_L(0); PG8_BAR; PG8_MMA(0, 0, At, B0); PG8_MMA(0, 1, At, B1); PG8_BAR; PG8_SCHED;
            PG8_LDA(At, 0, 1); PG8_STAGE(PG8_SB(0, 0), b2, voffB); PG8_STAGE(PG8_SB(0, 1), b2 + hstepB, voffB); PG8_STAGE(PG8_SA(0, 0), a2, voffA);
            PG8_WAIT_V(8); PG8_WAIT_L(0); PG8_BAR; PG8_MMA(1, 0, At, B0); PG8_MMA(1, 1, At, B1); PG8_BAR; PG8_SCHED;
            PG8_LDB(B0, 1, 0); PG8_LDB(B1, 1, 1); PG8_SCHED; PG8_LDA(At, 1, 0); PG8_STAGE(PG8_SA(0, 1), a2 + hstepA, voffA);
            PG8_WAIT_V(8); PG8_WAIT_L(0); PG8_BAR; PG8_MMA(0, 0, At, B0); PG8_MMA(0, 1, At, B1); PG8_BAR; PG8_SCHED;
            PG8_LDA(At, 1, 1); PG8_STAGE(PG8_SB(1, 0), b3, voffB); PG8_STAGE(PG8_SB(1, 1), b3 + hstepB, voffB); PG8_STAGE(PG8_SA(1, 0), a3, voffA);
            PG8_WAIT_V(8); PG8_WAIT_L(0); PG8_BAR; PG8_MMA(1, 0, At, B0); PG8_MMA(1, 1, At, B1); PG8_BAR; PG8_SCHED;
            } else {
            PG8_LDB(B0, 0, 0); PG8_SCHED; PG8_LDA(At, 0, 0); PG8_STAGE(PG8_SA(1, 1), a1 + hstepA, voffA);
            PG8_WAIT_L(8); PG8_BAR; PG8_WAIT_L(0); PG8_MMA(0, 0, At, B0); PG8_BAR; PG8_SCHED;
            PG8_LDB(B1, 0, 1); PG8_STAGE(PG8_SB(0, 0), b2, voffB);
            PG8_BAR; PG8_WAIT_L(0); PG8_MMA(0, 1, At, B1); PG8_BAR;
            PG8_LDA(At, 0, 1); PG8_STAGE(PG8_SA(0, 0), a2, voffA);
            PG8_BAR; PG8_WAIT_L(0); PG8_MMA(1, 0, At, B0); PG8_BAR; PG8_SCHED;
            PG8_STAGE(PG8_SB(0, 1), b2 + hstepB, voffB);
            PG8_WAIT_V(6); PG8_BAR; PG8_MMA(1, 1, At, B1); PG8_BAR;
            PG8_LDB(B0, 1, 0); PG8_SCHED; PG8_LDA(At, 1, 0); PG8_STAGE(PG8_SA(0, 1), a2 + hstepA, voffA);
            PG8_WAIT_L(8); PG8_BAR; PG8_WAIT_L(0); PG8_MMA(0, 0, At, B0); PG8_BAR; PG8_SCHED;
            PG8_LDB(B1, 1, 1); PG8_STAGE(PG8_SB(1, 0), b3, voffB);
            PG8_BAR; PG8_WAIT_L(0); PG8_MMA(0, 1, At, B1); PG8_BAR;
            PG8_LDA(At, 1, 1); PG8_STAGE(PG8_SA(1, 0), a3, voffA);
            PG8_BAR; PG8_WAIT_L(0); PG8_MMA(1, 0, At, B0); PG8_BAR; PG8_SCHED;
            PG8_STAGE(PG8_SB(1, 1), b3 + hstepB, voffB);
            PG8_WAIT_V(6); PG8_BAR; PG8_MMA(1, 1, At, B1); PG8_BAR;
            }
        }
        if constexpr (ALIGN_EPI) { if (wr == 0) PG8_BAR; }
#if MK_DIAG
        { bool bad = false;
#pragma unroll
          for (int a_ = 0; a_ < 2; ++a_)
#pragma unroll
            for (int b_ = 0; b_ < 2; ++b_)
#pragma unroll
              for (int m_ = 0; m_ < 4; ++m_)
#pragma unroll
                for (int n_ = 0; n_ < 2; ++n_)
#pragma unroll
                  for (int j_ = 0; j_ < 4; ++j_) bad |= !(__builtin_fabsf(acc[a_][b_][m_][n_][j_]) < 3.0e38f);
          if (bad && g.dflag) atomicOr(g.dflag, g.dbit); }
#endif
        if constexpr (!Epi::AFTER_DRAIN) { E(acc, cur, wr, wc, fr, fq); S.done(cur); }
        if (!has_next) break;
#pragma unroll
        for (int a = 0; a < 2; ++a)
#pragma unroll
            for (int b = 0; b < 2; ++b)
#pragma unroll
                for (int m = 0; m < 4; ++m)
#pragma unroll
                    for (int n = 0; n < 2; ++n) acc[a][b][m][n] = (f32x4){0.f, 0.f, 0.f, 0.f};
        cur = nxt; cA = nA; cB = nB; ++ui;
        if constexpr (ALIGN_EPI) { if (wr == 1) PG8_BAR; }
    }
    PG8_WAIT_V(0);
    if constexpr (!ALIGN_EPI) { if (wr == 0) PG8_BAR; }
    PG8_BAR;
    if constexpr (Epi::AFTER_DRAIN) { E.fused(acc, cur, wr, wc, fr, fq, lds, wid, lane); S.done(cur); }
#undef PG8_SA
#undef PG8_SB
#undef PG8_STAGE
#undef PG8_LDA
#undef PG8_LDB
#undef PG8_MMA
#undef PG8_WAIT_V
#undef PG8_WAIT_L
#undef PG8_BAR
#undef PG8_SCHED
}

}

constexpr int NWAVES = 8;
constexpr int BATCH = 2, SEQ = 8192, D = 4096, M = BATCH * SEQ;
constexpr int GRIDW = 64, GROWS = SEQ / GRIDW;
constexpr int NA_HEADS = 32, NA_HD = 128;
constexpr int S5_G = 256, S5_P = 64, S5_I = 16, S5_T = 32, S5_NCH = M / S5_T  , S5_NCHB = SEQ / S5_T  , S5_KS = S5_T * 16  , S5_KY = S5_KS + 256  ;
constexpr int GLA_H = 8, GLA_DK = 256, GLA_DV = 512, GLA_KW = 2048, GLA_C = 64, GLA_NCH = M / GLA_C  , GLA_NCHB = SEQ / GLA_C  , GLA_NIN = 12288;
constexpr float EPS = 1e-6f;

constexpr size_t MiB = 1u << 20;
constexpr size_t WS_CTL = 0, CTL_ZERO_BYTES = 64 * 1024;
constexpr size_t WS_MOD = 1 * MiB;
constexpr size_t WS_LAMT = 2 * MiB;
constexpr size_t WS_W_NAIN0 = 4 * MiB, WS_W_NAIN1 = WS_W_NAIN0 + 128 * MiB, WS_W_NAOUT0 = WS_W_NAIN1 + 128 * MiB, WS_W_NAOUT1 = WS_W_NAOUT0 + 32 * MiB;
constexpr size_t WS_W_S5IN = WS_W_NAOUT1 + 32 * MiB, WS_W_S5GLU = WS_W_S5IN + 64 * MiB, WS_W_S5OUT = WS_W_S5GLU + 32 * MiB;
constexpr size_t WS_W_GLAIN = WS_W_S5OUT + 32 * MiB, WS_W_GLAG1 = WS_W_GLAIN + 96 * MiB, WS_W_GLAOUT = WS_W_GLAG1 + 2 * MiB;
constexpr size_t WS_S5BS = WS_W_GLAOUT + 32 * MiB;
constexpr size_t WS_S5BY = WS_S5BS + 64 * MiB;
constexpr size_t WS_H = WS_S5BY + 192 * MiB;
constexpr size_t WS_ACT = WS_H + 128 * MiB;
constexpr size_t WS_NA_QKVG = WS_ACT;
constexpr size_t WS_S5_UG = WS_ACT;
constexpr size_t WS_S5_GS = WS_S5_UG + 192 * MiB;
constexpr size_t WS_S5_SLOC = WS_S5_GS + 128 * MiB;
constexpr size_t WS_S5_Y = WS_S5_SLOC + 128 * MiB;
constexpr size_t WS_S5_Z = WS_S5_Y + 128 * MiB;
constexpr size_t WS_GLA_IN = WS_ACT;
constexpr size_t WS_GLA_G1P = WS_GLA_IN + 384 * MiB;
constexpr size_t WS_GLA_PREP = WS_GLA_G1P + 8 * MiB;
constexpr size_t WS_GLA_DECAY = WS_GLA_PREP + 384 * MiB;
constexpr size_t WS_GLA_O = WS_GLA_DECAY + 4 * MiB;
constexpr size_t WS_GLA_Z = WS_GLA_O + 384 * MiB;
constexpr size_t WS_END = WS_GLA_Z + 128 * MiB;
static_assert(WS_S5_Z + 128 * MiB <= WS_END && WS_NA_QKVG + 512 * MiB <= WS_END, "ws map");
constexpr int CW_BAR = 1024;
static_assert((CW_BAR + 3456) * 4 <= (int)CTL_ZERO_BYTES, "CTL words inside the memset region");

constexpr int RING_OFF = 0, RING_BYTES = 131072;
constexpr int LDS_BYTES = 147456;
constexpr int MISC_OFF = LDS_BYTES - 256;

#define GAS __attribute__((address_space(1)))
#define LAS __attribute__((address_space(3)))
typedef unsigned short bf16;
typedef unsigned v4u __attribute__((ext_vector_type(4)));
typedef unsigned v2u __attribute__((ext_vector_type(2)));
typedef float f32x4 __attribute__((ext_vector_type(4)));
typedef float f32x2 __attribute__((ext_vector_type(2)));
typedef short bf16x8 __attribute__((ext_vector_type(8)));
typedef short s16x4 __attribute__((ext_vector_type(4)));
typedef GAS unsigned gu32;
#define LDS_WAIT() asm volatile("s_waitcnt lgkmcnt(0)" ::: "memory")
#define VM_WAIT() asm volatile("s_waitcnt vmcnt(0)" ::: "memory")
using pg8::cvt_pk_bf16; using pg8::bf_lo; using pg8::bf_hi; using pg8::siluf_; using pg8::sigmoidf_;

#define XB_TMO      128
#define XB_XCNT(j)  (256  + 64 * (j))
#define XB_XSUB(j)  (1280 + 64 * (j))
#define XB_XGEN(j)  (2304 + 64 * (j))
#define XB_TOP      3328
#define XB_TOPGEN   3392
#define XCD_BAR_WORDS 3456
#define XB_SPIN_CAP (1u << 18)
__device__ __forceinline__ unsigned xb_ld(unsigned* p)              { return __hip_atomic_load(p, __ATOMIC_RELAXED, __HIP_MEMORY_SCOPE_AGENT); }
__device__ __forceinline__ unsigned xb_add(unsigned* p, unsigned v) { return __hip_atomic_fetch_add(p, v, __ATOMIC_RELAXED, __HIP_MEMORY_SCOPE_AGENT); }
__device__ __forceinline__ unsigned xb_xcc_id() { return (unsigned)__builtin_amdgcn_s_getreg((3 << 11) | 20) & 0xFu; }
#define XB_SPIN(cond, bar) do { unsigned _sp = 0; while (cond) { __builtin_amdgcn_s_sleep(1); \
    if ((++_sp & 255u) == 0u) { if (xb_ld(&(bar)[XB_TMO])) break; if (_sp > XB_SPIN_CAP) { atomicAdd(&(bar)[XB_TMO], 1u); break; } } } } while (0)
struct XcdBarrier { unsigned* bar; unsigned x; volatile LAS unsigned* st; };
__device__ __forceinline__ XcdBarrier xcd_barrier_post(unsigned* bar, volatile LAS unsigned* st) {
    XcdBarrier b; b.bar = bar; b.x = xb_xcc_id(); b.st = st;
    if (threadIdx.x == 0) (void)xb_add(&bar[XB_XCNT(b.x)], 1u);
    return b;
}
__device__ __forceinline__ void xcd_barrier_complete(unsigned* bar, unsigned x, unsigned& nloc, unsigned& nx) {
    const unsigned G = gridDim.x * gridDim.y * gridDim.z;
    unsigned sum, cnt, mine, sp = 0u;
    for (;;) {
        sum = 0u; cnt = 0u; mine = 0u;
#pragma unroll
        for (unsigned j = 0; j < 16; ++j) { const unsigned c = xb_ld(&bar[XB_XCNT(j)]); sum += c; cnt += (c > 0u) ? 1u : 0u; mine = (j == x) ? c : mine; }
        if (sum == G) break;
        __builtin_amdgcn_s_sleep(1);
        if ((++sp & 255u) == 0u) { if (xb_ld(&bar[XB_TMO])) break; if (sp > XB_SPIN_CAP) { atomicAdd(&bar[XB_TMO], 1u); break; } }
    }
    nloc = mine > 0u ? mine : 1u; nx = cnt > 0u ? cnt : 1u;
}
__device__ __forceinline__ void xcd_barrier(const XcdBarrier& b) {
    asm volatile("s_waitcnt vmcnt(0)" ::: "memory");
    __syncthreads();
    if (threadIdx.x == 0) {
        unsigned* bar = b.bar;
        __builtin_amdgcn_s_waitcnt(0);
        unsigned nloc = b.st[0], nx = b.st[1];
        if (nloc == 0u) { xcd_barrier_complete(bar, b.x, nloc, nx); b.st[0] = nloc; b.st[1] = nx; }
        const unsigned old = xb_add(&bar[XB_XSUB(b.x)], 1u);
        const unsigned gen = old / nloc;
        if (old + 1u == (gen + 1u) * nloc) {
            __builtin_amdgcn_fence(__ATOMIC_RELEASE, "agent");
            asm volatile("s_waitcnt vmcnt(0)" ::: "memory");
            const unsigned og = xb_add(&bar[XB_TOP], 1u);
            const unsigned tg = og / nx;
            if (og + 1u == (tg + 1u) * nx) xb_add(&bar[XB_TOPGEN], 1u);
            else XB_SPIN(xb_ld(&bar[XB_TOPGEN]) == tg, bar);
            __builtin_amdgcn_fence(__ATOMIC_ACQUIRE, "agent");
            xb_add(&bar[XB_XGEN(b.x)], 1u);
            asm volatile("s_waitcnt vmcnt(0)" ::: "memory");
        } else {
            XB_SPIN(xb_ld(&bar[XB_XGEN(b.x)]) == gen, bar);
            __builtin_amdgcn_fence(__ATOMIC_ACQUIRE, "agent");
            asm volatile("s_waitcnt vmcnt(0)" ::: "memory");
        }
    }
    __syncthreads();
}

struct Args { const float* in[33]; float* out; unsigned char* ws; int ph_lo, ph_hi; };
struct Frame {
    LAS unsigned char* lds;
    int tid, lane, wave;
    int vcu, G;
};
__device__ __forceinline__ float wave_sum(float v) {
#pragma unroll
    for (int o = 1; o < 64; o <<= 1) v += __shfl_xor(v, o);
    return v;
}
__device__ __forceinline__ unsigned f2bf(float f) { unsigned u = __builtin_bit_cast(unsigned, f); return (u + 0x7fffu + ((u >> 16) & 1u)) >> 16; }
__device__ __forceinline__ unsigned pk2(float lo, float hi) { return f2bf(lo) | (f2bf(hi) << 16); }

__device__ __forceinline__ void p0_transpose_item(const float* W, int K, int N, bf16* WT, LAS float* scr, int item, int lane) {
    const int nblk = N / 32, kb = item / nblk, nb = item % nblk, k0 = 64 * kb, n0 = 32 * nb;
#pragma unroll 8
    for (int i = 0; i < 32; ++i) { const int kk = 2 * i + (lane >> 5); scr[kk * 33 + (lane & 31)] = W[(size_t)(k0 + kk) * N + n0 + (lane & 31)]; }
    LDS_WAIT(); asm volatile("" ::: "memory");
    const int c = lane & 7;
#pragma unroll
    for (int j = 0; j < 4; ++j) { const int n = (lane >> 3) + 8 * j; const LAS float* s = scr + (8 * c) * 33 + n;
        v4u o; o.x = pk2(s[0 * 33], s[1 * 33]); o.y = pk2(s[2 * 33], s[3 * 33]); o.z = pk2(s[4 * 33], s[5 * 33]); o.w = pk2(s[6 * 33], s[7 * 33]);
        *(GAS v4u*)(WT + (size_t)(n0 + n) * K + k0 + 8 * c) = o; }
    LDS_WAIT(); asm volatile("" ::: "memory");
}
__device__ __forceinline__ void p0_mod(Frame& F, const Args& a) {
    LAS float* cact = (LAS float*)(F.lds + RING_OFF);
    LAS float* red = cact + 2 * 4096;
    const float* c = a.in[1]; const float* mw = a.in[2]; const float* mb = a.in[3]; float* MOD = (float*)(a.ws + WS_MOD);
    for (int i = F.tid; i < 2 * 4096; i += NWAVES * 64) cact[i] = siluf_(c[i]);
    __syncthreads();
    const int rg = F.lane >> 4, cq = F.lane & 15;
    for (int it = F.vcu; it < 4 * 192; it += F.G) {
        const int layer = it / 192, cb = it % 192;
        const float* wp = mw + (size_t)layer * 4096 * 12288 + (size_t)(F.wave * 4 + rg) * 12288 + cb * 64 + cq * 4;
        f32x4 a0 = {0.f, 0.f, 0.f, 0.f}, a1 = {0.f, 0.f, 0.f, 0.f};
#pragma unroll 8
        for (int s = 0; s < 128; ++s) { const f32x4 w = *(const GAS f32x4*)(wp + (size_t)s * 32 * 12288); const int k = F.wave * 4 + rg + 32 * s;
            const float c0 = cact[k], c1 = cact[4096 + k]; a0 += w * c0; a1 += w * c1; }
#pragma unroll
        for (int j = 0; j < 4; ++j) { a0[j] += __shfl_xor(a0[j], 16); a0[j] += __shfl_xor(a0[j], 32); a1[j] += __shfl_xor(a1[j], 16); a1[j] += __shfl_xor(a1[j], 32); }
        if (F.lane < 16) { *(LAS f32x4*)(red + (F.wave * 2 + 0) * 64 + cq * 4) = a0; *(LAS f32x4*)(red + (F.wave * 2 + 1) * 64 + cq * 4) = a1; }
        __syncthreads();
        if (F.tid < 128) { const int b = F.tid >> 6, col = F.tid & 63; float s = mb[layer * 12288 + cb * 64 + col];
#pragma unroll
            for (int w = 0; w < 8; ++w) s += red[(w * 2 + b) * 64 + col];
            MOD[((size_t)layer * 2 + b) * 12288 + cb * 64 + col] = s; }
        __syncthreads();
    }
}
__device__ __forceinline__ void p0_s5_group(Frame& F, const Args& a, int g) {
    constexpr int T = S5_T;
    LAS f32x2* pw = (LAS f32x2*)(F.lds + RING_OFF);
    LAS f32x2* bbar = pw + 2 * (T + 1) * 64;
    LAS f32x2* cc = bbar + 2 * 64 * 16;
    LAS float* kf = (LAS float*)(cc + 16 * 64);
    static_assert((2 * (T + 1) * 64 + 2 * 64 * 16 + 16 * 64) * 8 + 2 * T * 256 * 4 <= RING_BYTES, "s5 gen LDS");
    const float *b_re = a.in[9], *b_im = a.in[10], *c_re = a.in[11], *c_im = a.in[12], *dsk = a.in[13];
    float* LAMT = (float*)(a.ws + WS_LAMT);
    if (F.tid < 128) {
        const int dir = F.tid >> 6, p = F.tid & 63, gp = g * 64 + p;
        const float are = (dir ? a.in[16] : a.in[14])[gp], aim = (dir ? a.in[17] : a.in[15])[gp], ls = (dir ? a.in[19] : a.in[18])[gp];
        const float dt = expf(ls), mag = expf(are * dt), lr = mag * cosf(aim * dt), li = mag * sinf(aim * dt);
        const float den = are * are + aim * aim, nr = lr - 1.0f, rre = (nr * are + li * aim) / den, rim = (li * are - nr * aim) / den;
#pragma unroll
        for (int j = 0; j < 16; ++j) { const float br = b_re[(size_t)gp * 16 + j], bi = b_im[(size_t)gp * 16 + j]; bbar[(dir * 64 + p) * 16 + j] = (f32x2){rre * br - rim * bi, rre * bi + rim * br}; }
        float wr_ = 1.0f, wi_ = 0.0f; pw[(dir * (T + 1) + 0) * 64 + p] = (f32x2){1.0f, 0.0f};
        for (int t = 1; t <= T; ++t) { const float nr2 = wr_ * lr - wi_ * li, ni2 = wr_ * li + wi_ * lr; wr_ = nr2; wi_ = ni2; pw[(dir * (T + 1) + t) * 64 + p] = (f32x2){wr_, wi_}; }
        LAMT[((size_t)(g * 2 + dir) * 64 + p) * 2 + 0] = wr_; LAMT[((size_t)(g * 2 + dir) * 64 + p) * 2 + 1] = wi_;
    }
    for (int e = F.tid; e < 16 * 64; e += NWAVES * 64) cc[e] = (f32x2){c_re[(size_t)g * 1024 + e], c_im[(size_t)g * 1024 + e]};
    __syncthreads();
    {
        const int dir = F.tid >> 8, i = (F.tid >> 4) & 15, j = F.tid & 15;
        float acc[T];
#pragma unroll
        for (int t = 0; t < T; ++t) acc[t] = 0.f;
        for (int p = 0; p < 64; ++p) { const f32x2 C = cc[i * 64 + p], Bb = bbar[(dir * 64 + p) * 16 + j]; const float e = C.x * Bb.x - C.y * Bb.y, f = C.x * Bb.y + C.y * Bb.x;
#pragma unroll
            for (int t = 0; t < T; ++t) { const f32x2 w = pw[(dir * (T + 1) + t) * 64 + p]; acc[t] += w.x * e - w.y * f; } }
#pragma unroll
        for (int t = 0; t < T; ++t) kf[((dir * T + t) * 16 + i) * 16 + j] = acc[t];
    }
    __syncthreads();
    bf16* BY = (bf16*)(a.ws + WS_S5BY) + (size_t)g * (S5_KS * S5_KY);
    for (int q = F.tid; q < S5_KS * (S5_KY / 8); q += NWAVES * 64) {
        const int n = q / (S5_KY / 8), pc = q % (S5_KY / 8), t = n >> 4, i = n & 15, k0 = pc * 8; float v[8];
        if (k0 < S5_KS) { const int s = k0 >> 4, j0 = k0 & 15;
#pragma unroll
            for (int e = 0; e < 8; ++e) { const int j = j0 + e; float x;
                if (t > s) x = kf[((0 * T + (t - s)) * 16 + i) * 16 + j];
                else if (t < s) x = kf[((1 * T + (s - t)) * 16 + i) * 16 + j];
                else x = kf[((0 * T + 0) * 16 + i) * 16 + j] + kf[((1 * T + 0) * 16 + i) * 16 + j] + ((i == j) ? dsk[g * 16 + i] : 0.f);
                v[e] = x; }
        } else { const int kk = k0 - S5_KS, seg = kk >> 6, p0 = kk & 63, dir = seg >> 1, tp = dir ? (T - t) : (t + 1);
#pragma unroll
            for (int e = 0; e < 8; ++e) { const int p = p0 + e; const f32x2 w = pw[(dir * (T + 1) + tp) * 64 + p], C = cc[i * 64 + p];
                v[e] = (seg & 1) ? -(C.x * w.y + C.y * w.x) : (C.x * w.x - C.y * w.y); }
        }
        v4u o; o.x = pk2(v[0], v[1]); o.y = pk2(v[2], v[3]); o.z = pk2(v[4], v[5]); o.w = pk2(v[6], v[7]);
        *(GAS v4u*)(BY + (size_t)n * S5_KY + k0) = o;
    }
    bf16* BS = (bf16*)(a.ws + WS_S5BS) + (size_t)g * (256 * S5_KS);
    for (int q = F.tid; q < 256 * (S5_KS / 8); q += NWAVES * 64) {
        const int n = q / (S5_KS / 8), pc = q % (S5_KS / 8), k0 = pc * 8, s = k0 >> 4, j0 = k0 & 15, seg = n >> 6, p = n & 63, dir = seg >> 1;
        const f32x2 w = pw[(dir * (T + 1) + (dir ? s : (T - 1 - s))) * 64 + p]; float v[8];
#pragma unroll
        for (int e = 0; e < 8; ++e) { const f32x2 Bb = bbar[(dir * 64 + p) * 16 + j0 + e]; v[e] = (seg & 1) ? (w.x * Bb.y + w.y * Bb.x) : (w.x * Bb.x - w.y * Bb.y); }
        v4u o; o.x = pk2(v[0], v[1]); o.y = pk2(v[2], v[3]); o.z = pk2(v[4], v[5]); o.w = pk2(v[6], v[7]);
        *(GAS v4u*)(BS + (size_t)n * S5_KS + k0) = o;
    }
    __syncthreads();
}
__device__ __forceinline__ void p0_prologue(Frame& F, const Args& a) {
    p0_mod(F, a);
    {
        LAS float* scr = (LAS float*)(F.lds + RING_OFF + F.wave * 16384);
        const int gw = F.vcu * NWAVES + F.wave, NGW = F.G * NWAVES;
        constexpr int I_NAIN = 64 * 512, I_SQ = 64 * 128, I_S5IN = 64 * 256, I_GLAIN = 64 * 384;
        constexpr int NITEMS = 2 * I_NAIN + 2 * I_SQ + I_S5IN + 2 * I_SQ + I_GLAIN + I_SQ;
        unsigned char* ws = a.ws;
        for (int it = gw; it < NITEMS; it += NGW) {
            int r = it;
            if (r < I_NAIN) { p0_transpose_item(a.in[5], 4096, 16384, (bf16*)(ws + WS_W_NAIN0), scr, r, F.lane); continue; } r -= I_NAIN;
            if (r < I_NAIN) { p0_transpose_item(a.in[5] + (size_t)4096 * 16384, 4096, 16384, (bf16*)(ws + WS_W_NAIN1), scr, r, F.lane); continue; } r -= I_NAIN;
            if (r < I_SQ) { p0_transpose_item(a.in[7], 4096, 4096, (bf16*)(ws + WS_W_NAOUT0), scr, r, F.lane); continue; } r -= I_SQ;
            if (r < I_SQ) { p0_transpose_item(a.in[7] + (size_t)4096 * 4096, 4096, 4096, (bf16*)(ws + WS_W_NAOUT1), scr, r, F.lane); continue; } r -= I_SQ;
            if (r < I_S5IN) { p0_transpose_item(a.in[8], 4096, 8192, (bf16*)(ws + WS_W_S5IN), scr, r, F.lane); continue; } r -= I_S5IN;
            if (r < I_SQ) { p0_transpose_item(a.in[20], 4096, 4096, (bf16*)(ws + WS_W_S5GLU), scr, r, F.lane); continue; } r -= I_SQ;
            if (r < I_SQ) { p0_transpose_item(a.in[22], 4096, 4096, (bf16*)(ws + WS_W_S5OUT), scr, r, F.lane); continue; } r -= I_SQ;
            if (r < I_GLAIN) { p0_transpose_item(a.in[23], 4096, 12288, (bf16*)(ws + WS_W_GLAIN), scr, r, F.lane); continue; } r -= I_GLAIN;
            p0_transpose_item(a.in[31], 4096, 4096, (bf16*)(ws + WS_W_GLAOUT), scr, r, F.lane);
        }
        bf16* G1T = (bf16*)(ws + WS_W_GLAG1);
        for (int e = (F.vcu * NWAVES * 64 + F.tid); e < 256 * 4096 / 2; e += F.G * NWAVES * 64) {
            const int n = e / 2048, k = (e % 2048) * 2; float v0 = 0.f, v1 = 0.f;
            if (n < 16) { v0 = a.in[24][(size_t)k * 16 + n]; v1 = a.in[24][(size_t)(k + 1) * 16 + n]; }
            else if (n < 32) { v0 = a.in[27][(size_t)k * 16 + (n - 16)]; v1 = a.in[27][(size_t)(k + 1) * 16 + (n - 16)]; }
            *(GAS unsigned*)(G1T + (size_t)n * 4096 + k) = pk2(v0, v1);
        }
    }
    __syncthreads();
    for (int g = F.vcu; g < S5_G; g += F.G) p0_s5_group(F, a, g);
}

template <bool FINAL>
__device__ __forceinline__ void norm_phase(Frame& F, const float* xin, const float* nw, const float* mod  , bf16* H, float* outf) {
    LAS f32x2* tab = (LAS f32x2*)(F.lds + RING_OFF);
    for (int i = F.tid; i < 2 * 4096; i += NWAVES * 64) { const int b = i >> 12, c = i & 4095;
        if (FINAL) tab[i] = (f32x2){nw[c], 0.f};
        else tab[i] = (f32x2){nw[c] * (1.0f + mod[b * 12288 + 4096 + c]), mod[b * 12288 + c]}; }
    __syncthreads();
    const int gw = F.vcu * NWAVES + F.wave, NGW = F.G * NWAVES;
    for (int m = gw; m < M; m += NGW) {
        const int b = m >> 13; const GAS f32x4* xr = (const GAS f32x4*)(xin + (size_t)m * D) + F.lane;
        f32x4 v[16]; float s = 0.f;
#pragma unroll
        for (int j = 0; j < 16; ++j) { v[j] = xr[64 * j]; s += (v[j].x * v[j].x + v[j].y * v[j].y) + (v[j].z * v[j].z + v[j].w * v[j].w); }
        const float rstd = rsqrtf(wave_sum(s) * (1.f / D) + EPS);
#pragma unroll
        for (int j = 0; j < 16; ++j) { const int c = 4 * F.lane + 256 * j; const LAS f32x2* tp = tab + b * 4096 + c;
            const f32x2 t0 = tp[0], t1 = tp[1], t2 = tp[2], t3 = tp[3];
            const float o0 = v[j].x * rstd * t0.x + t0.y, o1 = v[j].y * rstd * t1.x + t1.y, o2 = v[j].z * rstd * t2.x + t2.y, o3 = v[j].w * rstd * t3.x + t3.y;
            if (FINAL) *((GAS f32x4*)(outf + (size_t)m * D) + F.lane + 64 * j) = (f32x4){o0, o1, o2, o3};
            else *(GAS v2u*)(H + (size_t)m * D + c) = (v2u){cvt_pk_bf16(o0, o1), cvt_pk_bf16(o2, o3)}; }
    }
    __syncthreads();
}

typedef short v4i16_t __attribute__((ext_vector_type(4)));
__device__ __forceinline__ s16x4 tr4(const LAS unsigned char* p) { return __builtin_bit_cast(s16x4, __builtin_amdgcn_ds_read_tr16_b64_v4i16((LAS v4i16_t*)p)); }
__device__ __forceinline__ bf16x8 cat8(s16x4 a, s16x4 b) { return (bf16x8){a[0], a[1], a[2], a[3], b[0], b[1], b[2], b[3]}; }
__device__ __forceinline__ bf16x8 pack8(f32x4 a, f32x4 b) { v4u w; w.x = cvt_pk_bf16(a[0], a[1]); w.y = cvt_pk_bf16(a[2], a[3]); w.z = cvt_pk_bf16(b[0], b[1]); w.w = cvt_pk_bf16(b[2], b[3]); return __builtin_bit_cast(bf16x8, w); }
#define MFMA16(a, b, c) __builtin_amdgcn_mfma_f32_16x16x32_bf16((a), (b), (c), 0, 0, 0)

constexpr int NA_PITCH = 272, NA_TILE = 64 * NA_PITCH;
__device__ __forceinline__ void na_attn_phase(Frame& F, bf16* QKVG, const float* rpb) {
    const int grp = F.wave >> 2, ct = F.wave & 3, lane = F.lane, li = lane & 15, g = lane >> 4, q4 = li >> 2, p4 = li & 3;
    const int c0 = ct * 16, kc0 = min(max(c0 - 8, 0), 32);
    const int ipw = (4096 + F.G - 1) / F.G;
    LAS unsigned char* const lbase = F.lds + RING_OFF;
    LAS float* const rp = (LAS float*)(lbase + 4 * NA_TILE + grp * 2048);
    for (int k = 0; k < ipw; ++k) {
        const int it = F.vcu * ipw + k; if (it >= 4096) break;
        const int b = it >> 11, hp = (it >> 7) & 15, r = it & 127, h = hp * 2 + grp;
        const int rs = min(max(r - 4, 0), GROWS - 8);
        const size_t tok0 = (size_t)b * SEQ + (size_t)r * GRIDW;
        const bf16* qp = QKVG + (tok0 + c0 + li) * 16384 + h * 128 + 8 * g;
        bf16x8 qf[4];
#pragma unroll
        for (int ks = 0; ks < 4; ++ks) qf[ks] = *(const GAS bf16x8*)(qp + 32 * ks);
        for (int e = (F.tid & 255); e < 465; e += 256) rp[e] = rpb[h * 465 + e];
        v4u st[4];
        const bf16* kvbase = QKVG + ((size_t)b * SEQ + (size_t)rs * GRIDW + 16 * ct + g) * 16384 + h * 128 + li * 8;
#define NA_LOAD(t) do { _Pragma("unroll") for (int j = 0; j < 4; ++j) st[j] = *(const GAS v4u*)(kvbase + ((size_t)((t) & 7) * GRIDW + 4 * j) * 16384 + (((t) >> 3) ? 8192 : 4096)); } while (0)
#define NA_WRITE(buf) do { _Pragma("unroll") for (int j = 0; j < 4; ++j) *(LAS v4u*)(lbase + ((buf) * 2 + grp) * NA_TILE + (16 * ct + 4 * j + g) * NA_PITCH + li * 16) = st[j]; } while (0)
        NA_LOAD(0); NA_WRITE(0); __syncthreads();
        f32x4 S[8][2];
#pragma unroll
        for (int t = 0; t < 8; ++t) {
            NA_LOAD(t + 1);
            const LAS unsigned char* tb = lbase + ((t & 1) * 2 + grp) * NA_TILE;
            S[t][0] = (f32x4){0.f, 0.f, 0.f, 0.f}; S[t][1] = (f32x4){0.f, 0.f, 0.f, 0.f};
#pragma unroll
            for (int blk = 0; blk < 2; ++blk)
#pragma unroll
                for (int ks = 0; ks < 4; ++ks) { const bf16x8 A = *(const LAS bf16x8*)(tb + (kc0 + 16 * blk + li) * NA_PITCH + (32 * ks + 8 * g) * 2);
                    S[t][blk] = MFMA16(A, qf[ks], S[t][blk]); }
            NA_WRITE((t + 1) & 1);
            __syncthreads();
        }
        const int c = c0 + li, cs = min(max(c - 8, 0), GRIDW - 16);
        float mx = -1e30f;
#pragma unroll
        for (int t = 0; t < 8; ++t)
#pragma unroll
            for (int blk = 0; blk < 2; ++blk)
#pragma unroll
                for (int e = 0; e < 4; ++e) { const int kc = kc0 + 16 * blk + 4 * g + e; const bool valid = (kc >= cs) && (kc < cs + 16);
                    const int idx = valid ? ((rs + t - r + 7) * 31 + (kc - c + 15)) : 0;
                    const float s = valid ? (S[t][blk][e] * 0.08838834764831845f + rp[idx]) : -1e30f; S[t][blk][e] = s; mx = fmaxf(mx, s); }
        mx = fmaxf(mx, __shfl_xor(mx, 16)); mx = fmaxf(mx, __shfl_xor(mx, 32));
        float sum = 0.f;
#pragma unroll
        for (int t = 0; t < 8; ++t)
#pragma unroll
            for (int blk = 0; blk < 2; ++blk)
#pragma unroll
                for (int e = 0; e < 4; ++e) { const float p = __expf(S[t][blk][e] - mx); S[t][blk][e] = p; sum += p; }
        sum += __shfl_xor(sum, 16); sum += __shfl_xor(sum, 32);
        const float inv = 1.0f / sum;
        bf16x8 pb[8];
#pragma unroll
        for (int t = 0; t < 8; ++t) pb[t] = pack8(S[t][0], S[t][1]);
        f32x4 O[8];
#pragma unroll
        for (int db = 0; db < 8; ++db) O[db] = (f32x4){0.f, 0.f, 0.f, 0.f};
#pragma unroll
        for (int t = 8; t < 16; ++t) {
            if (t < 15) NA_LOAD(t + 1);
            const LAS unsigned char* tb = lbase + ((t & 1) * 2 + grp) * NA_TILE + (kc0 + 4 * g + q4) * NA_PITCH + 8 * p4;
#pragma unroll
            for (int db = 0; db < 8; ++db) { const s16x4 a0 = tr4(tb + 32 * db), a1 = tr4(tb + 16 * NA_PITCH + 32 * db);
                O[db] = MFMA16(cat8(a0, a1), pb[t - 8], O[db]); }
            if (t < 15) NA_WRITE((t + 1) & 1);
            __syncthreads();
        }
#undef NA_LOAD
#undef NA_WRITE
        bf16* zp = QKVG + (tok0 + c0 + li) * 16384 + h * 128 + 4 * g;
#pragma unroll
        for (int db = 0; db < 8; ++db) { const v2u gw = *(const GAS v2u*)(zp + 12288 + 16 * db);
            const float z0 = O[db][0] * inv * siluf_(bf_lo(gw.x)), z1 = O[db][1] * inv * siluf_(bf_hi(gw.x)), z2 = O[db][2] * inv * siluf_(bf_lo(gw.y)), z3 = O[db][3] * inv * siluf_(bf_hi(gw.y));
            *(GAS v2u*)(zp + 16 * db) = (v2u){cvt_pk_bf16(z0, z1), cvt_pk_bf16(z2, z3)}; }
    }
    __syncthreads();
}

__device__ __forceinline__ void s5_scan_phase(Frame& F, const Args& a) {
    const float* Sloc = (const float*)(a.ws + WS_S5_SLOC); bf16* Ug = (bf16*)(a.ws + WS_S5_UG); const float* LAMT = (const float*)(a.ws + WS_LAMT);
    const int t8 = F.tid & 255, b = t8 >> 7, dir = (t8 >> 6) & 1, p = t8 & 63;
    for (int gi = F.vcu * 2 + (F.tid >> 8); gi < S5_G; gi += F.G * 2) {
        const float lr = LAMT[((size_t)(gi * 2 + dir) * 64 + p) * 2 + 0], li = LAMT[((size_t)(gi * 2 + dir) * 64 + p) * 2 + 1];
        float xr = 0.f, xi = 0.f;
#pragma unroll 8
        for (int s = 0; s < S5_NCHB; ++s) { const int c = dir ? (S5_NCHB - 1 - s) : s; const size_t row = (size_t)gi * S5_NCH + b * S5_NCHB + c;
            bf16* up = Ug + row * S5_KY + S5_KS + dir * 128 + p;
            up[0] = (bf16)f2bf(xr); up[64] = (bf16)f2bf(xi);
            const float sr = Sloc[row * 256 + dir * 128 + p], si = Sloc[row * 256 + dir * 128 + 64 + p];
            const float nr = lr * xr - li * xi + sr, ni = lr * xi + li * xr + si; xr = nr; xi = ni; }
    }
}

__device__ __forceinline__ float log_sigmoidf_(float z) { return fminf(z, 0.f) - log1pf(expf(-fabsf(z))); }
__device__ __forceinline__ void gla_prep_phase(Frame& F, const Args& a) {
    const bf16* IN = (const bf16*)(a.ws + WS_GLA_IN); const float* G1P = (const float*)(a.ws + WS_GLA_G1P);
    bf16* PREP = (bf16*)(a.ws + WS_GLA_PREP); float* DECAY = (float*)(a.ws + WS_GLA_DECAY);
    LAS float* g1s = (LAS float*)(F.lds + RING_OFF);
    LAS float* Bc = g1s + 64 * 32;
    LAS float* bl = Bc + 2 * 64 * 128;
    const int ipw = (4096 + F.G - 1) / F.G;
    for (int k = 0; k < ipw; ++k) {
        const int it = F.vcu * ipw + k; if (it >= 4096) break;
        const int cidx = it >> 4, h = (it >> 1) & 7, hf = it & 1, m0 = cidx * GLA_C, dbase = h * 256 + hf * 128;
        { const int tok = F.tid >> 3, qd = F.tid & 7; f32x4 s = {0.f, 0.f, 0.f, 0.f};
#pragma unroll
          for (int ks = 0; ks < 4; ++ks) s += *(const GAS f32x4*)(G1P + ((size_t)ks * M + m0 + tok) * 32 + qd * 4);
          if (MK_DIAG && (!(fabsf(s[0]) < 20.f) || !(fabsf(s[1]) < 20.f) || !(fabsf(s[2]) < 20.f) || !(fabsf(s[3]) < 20.f))) atomicOr((unsigned*)(a.ws + WS_CTL) + 17, 1u << 0);
          *(LAS f32x4*)(g1s + tok * 32 + qd * 4) = s; }
        __syncthreads();
        if (F.tid < 256) {
            const int dir = F.tid >> 7, col = F.tid & 127, d = dbase + col;
            const float* w2 = dir ? a.in[28] : a.in[25]; const float bgd = (dir ? a.in[29] : a.in[26])[d];
            float w2r[16];
#pragma unroll
            for (int r = 0; r < 16; ++r) w2r[r] = w2[(size_t)r * GLA_KW + d];
            float run = 0.f;
            for (int s = 0; s < 64; ++s) { const int i = dir ? (63 - s) : s; const LAS float* gp = g1s + i * 32 + dir * 16; float z = bgd;
#pragma unroll
                for (int r = 0; r < 16; ++r) z += gp[r] * w2r[r];
                if (MK_DIAG && !(fabsf(z) < 12.f)) atomicOr((unsigned*)(a.ws + WS_CTL) + 17, 1u << 1);
                run += log_sigmoidf_(z) * (1.0f / 16.0f); Bc[(dir * 64 + i) * 128 + col] = run; }
            bl[dir * 128 + col] = run;
        }
        __syncthreads();
#pragma unroll
        for (int j = 0; j < 2; ++j) { const int e = F.tid + 512 * j, tok = e >> 4, c8 = (e & 15) * 8; const size_t m = (size_t)m0 + tok;
            const v4u q8 = *(const GAS v4u*)(IN + m * GLA_NIN + dbase + c8), k8 = *(const GAS v4u*)(IN + m * GLA_NIN + GLA_KW + dbase + c8);
            float qv[8], kv[8];
#pragma unroll
            for (int x = 0; x < 4; ++x) { qv[2 * x] = bf_lo(q8[x]) * 0.0625f; qv[2 * x + 1] = bf_hi(q8[x]) * 0.0625f; kv[2 * x] = bf_lo(k8[x]); kv[2 * x + 1] = bf_hi(k8[x]); }
#pragma unroll
            for (int dir = 0; dir < 2; ++dir) {
                f32x4 bbv[2], btv[2];
                bbv[0] = *(const LAS f32x4*)(Bc + (dir * 64 + tok) * 128 + c8); bbv[1] = *(const LAS f32x4*)(Bc + (dir * 64 + tok) * 128 + c8 + 4);
                btv[0] = *(const LAS f32x4*)(bl + dir * 128 + c8); btv[1] = *(const LAS f32x4*)(bl + dir * 128 + c8 + 4);
                float o0[8], o1[8], o2[8];
#pragma unroll
                for (int x = 0; x < 8; ++x) { const float bx = bbv[x >> 2][x & 3], tx = btv[x >> 2][x & 3]; o0[x] = qv[x] * __expf(bx); o1[x] = kv[x] * __expf(-bx); o2[x] = kv[x] * __expf(tx - bx); }
                if (MK_DIAG) { bool bad = false;
#pragma unroll
                    for (int x = 0; x < 8; ++x) bad |= !(fabsf(o0[x]) < 1e4f) || !(fabsf(o1[x]) < 1e4f) || !(fabsf(o2[x]) < 1e4f);
                    if (bad) atomicOr((unsigned*)(a.ws + WS_CTL) + 17, 1u << 2); }
                v4u w0, w1, w2;
#pragma unroll
                for (int x = 0; x < 4; ++x) { w0[x] = cvt_pk_bf16(o0[2 * x], o0[2 * x + 1]); w1[x] = cvt_pk_bf16(o1[2 * x], o1[2 * x + 1]); w2[x] = cvt_pk_bf16(o2[2 * x], o2[2 * x + 1]); }
                bf16* pp = PREP + (size_t)(dir * 3) * M * GLA_KW + m * GLA_KW + dbase + c8;
                *(GAS v4u*)(pp) = w0; *(GAS v4u*)(pp + (size_t)M * GLA_KW) = w1; *(GAS v4u*)(pp + (size_t)2 * M * GLA_KW) = w2;
                if (tok == 0) { float* dp = DECAY + ((size_t)dir * GLA_NCH + cidx) * GLA_KW + dbase + c8;
                    *(GAS f32x4*)(dp) = (f32x4){__expf(btv[0][0]), __expf(btv[0][1]), __expf(btv[0][2]), __expf(btv[0][3])}; *(GAS f32x4*)(dp + 4) = (f32x4){__expf(btv[1][0]), __expf(btv[1][1]), __expf(btv[1][2]), __expf(btv[1][3])}; }
            }
        }
        __syncthreads();
    }
}

constexpr int GLA_PQ = 528, GLA_PV = 272, GLA_PVI = 1040;
__device__ __forceinline__ void gla_chain_role(Frame& F, const Args& a, int ch) {
    const bf16* IN = (const bf16*)(a.ws + WS_GLA_IN); const bf16* PREP = (const bf16*)(a.ws + WS_GLA_PREP); const float* DECAY = (const float*)(a.ws + WS_GLA_DECAY);
    const int b = ch >> 6, h = (ch >> 3) & 7, dir = (ch >> 2) & 1, vq = ch & 3;
    bf16* OUT = (bf16*)(a.ws + WS_GLA_O) + (size_t)(1 + dir) * M * 4096;
    const bf16* QS = PREP + (size_t)(dir * 3 + 0) * M * GLA_KW; const bf16* KE = PREP + (size_t)(dir * 3 + 2) * M * GLA_KW;
    LAS unsigned char* const qsT = F.lds + RING_OFF; LAS unsigned char* const keT = qsT + 64 * GLA_PQ; LAS unsigned char* const vT = keT + 64 * GLA_PQ; LAS float* const decT = (LAS float*)(vT + 64 * GLA_PV);
    const int lane = F.lane, li = lane & 15, g = lane >> 4, q4 = li >> 2, p4 = li & 3, w = F.wave;
    f32x4 S[16];
#pragma unroll
    for (int dt = 0; dt < 16; ++dt) S[dt] = (f32x4){0.f, 0.f, 0.f, 0.f};
    v4u rq[4], rk[4], rv[2]; f32x4 rd = {0.f, 0.f, 0.f, 0.f};
#define GC_LOAD(sidx) do { const int cn_ = dir ? (GLA_NCHB - 1 - (sidx)) : (sidx); const size_t m0_ = ((size_t)b * GLA_NCHB + cn_) * GLA_C; \
        _Pragma("unroll") for (int j = 0; j < 4; ++j) { const int e = F.tid + 512 * j, tok = e >> 5, pc = e & 31; \
            rq[j] = *(const GAS v4u*)(QS + (m0_ + tok) * GLA_KW + h * 256 + pc * 8); rk[j] = *(const GAS v4u*)(KE + (m0_ + tok) * GLA_KW + h * 256 + pc * 8); } \
        _Pragma("unroll") for (int j = 0; j < 2; ++j) { const int e = F.tid + 512 * j, tok = e >> 4, pc = e & 15; \
            rv[j] = *(const GAS v4u*)(IN + (m0_ + tok) * GLA_NIN + 4096 + h * 512 + vq * 128 + pc * 8); } \
        if (F.tid < 64) rd = *(const GAS f32x4*)(DECAY + ((size_t)dir * GLA_NCH + b * GLA_NCHB + cn_) * GLA_KW + h * 256 + F.tid * 4); } while (0)
    GC_LOAD(0);
    for (int sidx = 0; sidx < GLA_NCHB; ++sidx) {
#pragma unroll
        for (int j = 0; j < 4; ++j) { const int e = F.tid + 512 * j, tok = e >> 5, pc = e & 31; *(LAS v4u*)(qsT + tok * GLA_PQ + pc * 16) = rq[j]; *(LAS v4u*)(keT + tok * GLA_PQ + pc * 16) = rk[j]; }
#pragma unroll
        for (int j = 0; j < 2; ++j) { const int e = F.tid + 512 * j, tok = e >> 4, pc = e & 15; *(LAS v4u*)(vT + tok * GLA_PV + pc * 16) = rv[j]; }
        if (F.tid < 64) *(LAS f32x4*)(decT + F.tid * 4) = rd;
        __syncthreads();
        const int cn = dir ? (GLA_NCHB - 1 - sidx) : sidx; const size_t m0 = ((size_t)b * GLA_NCHB + cn) * GLA_C;
        if (sidx + 1 < GLA_NCHB) GC_LOAD(sidx + 1);
        v2u Sb[16];
#pragma unroll
        for (int dt = 0; dt < 16; ++dt) Sb[dt] = (v2u){cvt_pk_bf16(S[dt][0], S[dt][1]), cvt_pk_bf16(S[dt][2], S[dt][3])};
#pragma unroll
        for (int ib = 0; ib < 4; ++ib) { f32x4 acc = {0.f, 0.f, 0.f, 0.f}; const LAS unsigned char* qrow = qsT + (16 * ib + li) * GLA_PQ + 8 * g;
#pragma unroll
            for (int ks = 0; ks < 8; ++ks) { const v2u b0 = *(const LAS v2u*)(qrow + 64 * ks), b1 = *(const LAS v2u*)(qrow + 64 * ks + 32);
                const bf16x8 A = __builtin_bit_cast(bf16x8, (v4u){Sb[2 * ks].x, Sb[2 * ks].y, Sb[2 * ks + 1].x, Sb[2 * ks + 1].y});
                const bf16x8 B = __builtin_bit_cast(bf16x8, (v4u){b0.x, b0.y, b1.x, b1.y});
                acc = MFMA16(A, B, acc); }
            if (MK_DIAG && (!(fabsf(acc[0]) < 1e30f) || !(fabsf(acc[1]) < 1e30f) || !(fabsf(acc[2]) < 1e30f) || !(fabsf(acc[3]) < 1e30f))) atomicOr((unsigned*)(a.ws + WS_CTL) + 17, 1u << 7);
            *(GAS v2u*)(OUT + (m0 + 16 * ib + li) * 4096 + h * 512 + vq * 128 + w * 16 + 4 * g) = (v2u){cvt_pk_bf16(acc[0], acc[1]), cvt_pk_bf16(acc[2], acc[3])}; }
#pragma unroll
        for (int dt = 0; dt < 16; ++dt) S[dt] *= *(const LAS f32x4*)(decT + 16 * dt + 4 * g);
#pragma unroll
        for (int k2 = 0; k2 < 2; ++k2) { const LAS unsigned char* vb = vT + (32 * k2 + 8 * g + q4) * GLA_PV + (w * 16 + 4 * p4) * 2;
            const bf16x8 Bv = cat8(tr4(vb), tr4(vb + 4 * GLA_PV));
            const LAS unsigned char* kb = keT + (32 * k2 + 8 * g + q4) * GLA_PQ + 8 * p4;
#pragma unroll
            for (int dt = 0; dt < 16; ++dt) { const bf16x8 A = cat8(tr4(kb + 32 * dt), tr4(kb + 4 * GLA_PQ + 32 * dt)); S[dt] = MFMA16(A, Bv, S[dt]); } }
        __syncthreads();
    }
#undef GC_LOAD
}
__device__ __forceinline__ void gla_intra_role(Frame& F, const Args& a, int it) {
    const bf16* IN = (const bf16*)(a.ws + WS_GLA_IN); const bf16* PREP = (const bf16*)(a.ws + WS_GLA_PREP);
    bf16* OUT = (bf16*)(a.ws + WS_GLA_O);
    const int b = it >> 10, h = (it >> 7) & 7, cn = it & 127; const size_t m0 = ((size_t)b * GLA_NCHB + cn) * GLA_C;
    LAS unsigned char* const kfT = F.lds + RING_OFF; LAS unsigned char* const kbT = kfT + 64 * GLA_PQ; LAS unsigned char* const vT = kbT + 64 * GLA_PQ;
    const int lane = F.lane, li = lane & 15, g = lane >> 4, q4 = li >> 2, p4 = li & 3, ib = F.wave & 3, vh = F.wave >> 2;
    const bf16* KSF = PREP + (size_t)1 * M * GLA_KW; const bf16* KSB = PREP + (size_t)4 * M * GLA_KW;
    const bf16* QSF = PREP; const bf16* QSB = PREP + (size_t)3 * M * GLA_KW;
    {
        v4u r0[4], r1[4], r2[8];
#pragma unroll
        for (int j = 0; j < 4; ++j) { const int e = F.tid + 512 * j, tok = e >> 5, pc = e & 31; r0[j] = *(const GAS v4u*)(KSF + (m0 + tok) * GLA_KW + h * 256 + pc * 8); r1[j] = *(const GAS v4u*)(KSB + (m0 + tok) * GLA_KW + h * 256 + pc * 8); }
#pragma unroll
        for (int j = 0; j < 8; ++j) { const int e = F.tid + 512 * j, tok = e >> 6, pc = e & 63; r2[j] = *(const GAS v4u*)(IN + (m0 + tok) * GLA_NIN + 4096 + h * 512 + pc * 8); }
#pragma unroll
        for (int j = 0; j < 4; ++j) { const int e = F.tid + 512 * j, tok = e >> 5, pc = e & 31; *(LAS v4u*)(kfT + tok * GLA_PQ + pc * 16) = r0[j]; *(LAS v4u*)(kbT + tok * GLA_PQ + pc * 16) = r1[j]; }
#pragma unroll
        for (int j = 0; j < 8; ++j) { const int e = F.tid + 512 * j, tok = e >> 6, pc = e & 63; *(LAS v4u*)(vT + tok * GLA_PVI + pc * 16) = r2[j]; }
    }
    bf16x8 qf[8], qb[8];
#pragma unroll
    for (int ks = 0; ks < 8; ++ks) { qf[ks] = *(const GAS bf16x8*)(QSF + (m0 + 16 * ib + li) * GLA_KW + h * 256 + 32 * ks + 8 * g); qb[ks] = *(const GAS bf16x8*)(QSB + (m0 + 16 * ib + li) * GLA_KW + h * 256 + 32 * ks + 8 * g); }
    __syncthreads();
    f32x4 P[4];
#pragma unroll
    for (int jb = 0; jb < 4; ++jb) { f32x4 sf = {0.f, 0.f, 0.f, 0.f}, sb = {0.f, 0.f, 0.f, 0.f};
        if (jb <= ib) {
#pragma unroll
            for (int ks = 0; ks < 8; ++ks) sf = MFMA16(*(const LAS bf16x8*)(kfT + (16 * jb + li) * GLA_PQ + (32 * ks + 8 * g) * 2), qf[ks], sf); }
        if (jb >= ib) {
#pragma unroll
            for (int ks = 0; ks < 8; ++ks) sb = MFMA16(*(const LAS bf16x8*)(kbT + (16 * jb + li) * GLA_PQ + (32 * ks + 8 * g) * 2), qb[ks], sb); }
#pragma unroll
        for (int e = 0; e < 4; ++e) { const int ii = 16 * ib + li, jj = 16 * jb + 4 * g + e; P[jb][e] = (ii >= jj) ? sf[e] : sb[e]; } }
    if (MK_DIAG) { bool bad = false;
#pragma unroll
        for (int jb = 0; jb < 4; ++jb)
#pragma unroll
            for (int e = 0; e < 4; ++e) bad |= !(fabsf(P[jb][e]) < 1e30f);
        if (bad) atomicOr((unsigned*)(a.ws + WS_CTL) + 17, 1u << 4); }
    const bf16x8 Pb0 = pack8(P[0], P[1]), Pb1 = pack8(P[2], P[3]);
    bf16* op = OUT + (m0 + 16 * ib + li) * 4096 + h * 512 + vh * 256 + 4 * g;
    const LAS unsigned char* vb = vT + (4 * g + q4) * GLA_PVI + (vh * 256 + 4 * p4) * 2;
#pragma unroll
    for (int vt = 0; vt < 16; ++vt) { f32x4 acc = {0.f, 0.f, 0.f, 0.f};
        acc = MFMA16(cat8(tr4(vb + 32 * vt), tr4(vb + 16 * GLA_PVI + 32 * vt)), Pb0, acc);
        acc = MFMA16(cat8(tr4(vb + 32 * GLA_PVI + 32 * vt), tr4(vb + 48 * GLA_PVI + 32 * vt)), Pb1, acc);
        if (MK_DIAG && (!(fabsf(acc[0]) < 1e30f) || !(fabsf(acc[1]) < 1e30f) || !(fabsf(acc[2]) < 1e30f) || !(fabsf(acc[3]) < 1e30f))) atomicOr((unsigned*)(a.ws + WS_CTL) + 17, 1u << 5);
        *(GAS v2u*)(op + 16 * vt) = (v2u){cvt_pk_bf16(acc[0], acc[1]), cvt_pk_bf16(acc[2], acc[3])}; }
    __syncthreads();
}
__device__ __forceinline__ void gla_main_phase(Frame& F, const Args& a) {
    if (F.vcu < 128) { for (int ch = F.vcu; ch < 128; ch += 128) gla_chain_role(F, a, ch); }
    else { for (int it = F.vcu - 128; it < 2048; it += F.G - 128) gla_intra_role(F, a, it); }
}
__device__ __forceinline__ void gla_combine_phase(Frame& F, const Args& a) {
    const bf16* IN = (const bf16*)(a.ws + WS_GLA_IN); const bf16* O = (const bf16*)(a.ws + WS_GLA_O); bf16* Z = (bf16*)(a.ws + WS_GLA_Z);
    const float* nw = a.in[30];
    float nwr[8];
#pragma unroll
    for (int x = 0; x < 8; ++x) nwr[x] = nw[F.lane * 8 + x];
    const int gw = F.vcu * NWAVES + F.wave, NGW = F.G * NWAVES;
    for (int m = gw; m < M; m += NGW) {
#pragma unroll 2
        for (int h = 0; h < 8; ++h) { const size_t off = (size_t)m * 4096 + h * 512 + F.lane * 8;
            const v4u x0 = *(const GAS v4u*)(O + off), x1 = *(const GAS v4u*)(O + (size_t)M * 4096 + off), x2 = *(const GAS v4u*)(O + (size_t)2 * M * 4096 + off);
            const v4u gg = *(const GAS v4u*)(IN + (size_t)m * GLA_NIN + 8192 + h * 512 + F.lane * 8);
            if (MK_DIAG) { bool b0 = false, b1 = false, b2 = false, b3 = false;
#pragma unroll
                for (int x = 0; x < 4; ++x) { b0 |= !(fabsf(bf_lo(x0[x])) < 1e30f) || !(fabsf(bf_hi(x0[x])) < 1e30f); b1 |= !(fabsf(bf_lo(x1[x])) < 1e30f) || !(fabsf(bf_hi(x1[x])) < 1e30f);
                    b2 |= !(fabsf(bf_lo(x2[x])) < 1e30f) || !(fabsf(bf_hi(x2[x])) < 1e30f); b3 |= !(fabsf(bf_lo(gg[x])) < 1e30f) || !(fabsf(bf_hi(gg[x])) < 1e30f); }
                const unsigned f = (b0 ? 1024u : 0u) | (b1 ? 2048u : 0u) | (b2 ? 4096u : 0u) | (b3 ? 8192u : 0u); if (f) atomicOr((unsigned*)(a.ws + WS_CTL) + 17, f); }
            float o[8]; float ss = 0.f;
#pragma unroll
            for (int x = 0; x < 4; ++x) { o[2 * x] = bf_lo(x0[x]) + bf_lo(x1[x]) + bf_lo(x2[x]); o[2 * x + 1] = bf_hi(x0[x]) + bf_hi(x1[x]) + bf_hi(x2[x]); ss += o[2 * x] * o[2 * x] + o[2 * x + 1] * o[2 * x + 1]; }
            const float rstd = rsqrtf(wave_sum(ss) * (1.0f / 512.0f) + EPS);
            v4u zw;
#pragma unroll
            for (int x = 0; x < 4; ++x) zw[x] = cvt_pk_bf16(o[2 * x] * rstd * nwr[2 * x] * siluf_(bf_lo(gg[x])), o[2 * x + 1] * rstd * nwr[2 * x + 1] * siluf_(bf_hi(gg[x])));
            *(GAS v4u*)(Z + off) = zw; }
    }
}

constexpr int NPH = 23;
__global__ void __launch_bounds__(NWAVES * 64, 2) fwd_kernel(Args args) {
    extern __shared__ __attribute__((aligned(16))) unsigned char lds[];
    Frame F;
    F.lds = (LAS unsigned char*)lds;
    F.tid = threadIdx.x; F.lane = F.tid & 63; F.wave = __builtin_amdgcn_readfirstlane(F.tid >> 6);
    F.G = gridDim.x; { const int bx = blockIdx.x; F.vcu = (F.G % 8 == 0) ? (bx % 8) * (F.G / 8) + bx / 8 : bx; }
    volatile LAS unsigned* MISC = (volatile LAS unsigned*)(F.lds + MISC_OFF);
    for (int u = F.tid; u < (LDS_BYTES - MISC_OFF) / 4; u += NWAVES * 64) MISC[u] = 0u;
    __syncthreads();
    unsigned char* ws = args.ws;
    const int lo = args.ph_lo, hi = args.ph_hi;
    XcdBarrier bar; bar.bar = (unsigned*)(ws + WS_CTL) + CW_BAR; bar.x = 0; bar.st = nullptr;
    if (hi - lo > 1) bar = xcd_barrier_post((unsigned*)(ws + WS_CTL) + CW_BAR, MISC + 8);
#define IN(k) (lo <= (k) && (k) < hi)
#define SEAM(k) do { if (IN(k) && IN((k) + 1)) xcd_barrier(bar); } while (0)
    const float* MOD = (const float*)(ws + WS_MOD);
    bf16* H = (bf16*)(ws + WS_H);
    float* XO = args.out;
    LAS unsigned char* ring = F.lds + RING_OFF;
    unsigned* const DFLAG = (unsigned*)(ws + WS_CTL) + 16;

    if (IN(0)) { p0_prologue(F, args); } SEAM(0);

#if MK_NLAYERS >= 1
    if (IN(1)) { norm_phase<false>(F, args.in[0], args.in[4] + 0 * D, MOD + 0 * 2 * 12288, H, nullptr); } SEAM(1);
    if (IN(2)) { pg8::Gemm g{H, (const bf16*)(ws + WS_W_NAIN0), 4096, 4096, 4096, DFLAG, 1u << 2}; pg8::StaticOrder S; S.init(M, 16384, F.G, (int)blockIdx.x);
        pg8::EpiBf16 E{(bf16*)(ws + WS_NA_QKVG), 16384};
        pg8::gemm_phase<pg8::EpiBf16, pg8::StaticOrder, true, true>(ring, g, S, E); } SEAM(2);
    if (IN(3)) { na_attn_phase(F, (bf16*)(ws + WS_NA_QKVG), args.in[6] + 0 * 32 * 465); } SEAM(3);
    if (IN(4)) { pg8::Gemm g{(const bf16*)(ws + WS_NA_QKVG), (const bf16*)(ws + WS_W_NAOUT0), 4096, 16384, 4096, DFLAG, 1u << 4}; pg8::StaticOrder S; S.init(M, 4096, F.G, (int)blockIdx.x);
        pg8::EpiResid E{args.in[0], XO, D, MOD + 0 * 2 * 12288 + 8192, 12288, SEQ};
        pg8::gemm_phase<pg8::EpiResid, pg8::StaticOrder, true, true>(ring, g, S, E); } SEAM(4);
#endif
#if MK_NLAYERS >= 2
    if (IN(5)) { norm_phase<false>(F, XO, args.in[4] + 1 * D, MOD + 1 * 2 * 12288, H, nullptr); } SEAM(5);
    if (IN(6)) { pg8::Gemm g{H, (const bf16*)(ws + WS_W_S5IN), 4096, 4096, 4096, DFLAG, 1u << 6}; pg8::StaticOrder S; S.init(M, 8192, F.G, (int)blockIdx.x);
        pg8::EpiS5In<S5_T, S5_NCH, S5_KY> E{(bf16*)(ws + WS_S5_UG), (bf16*)(ws + WS_S5_GS)};
        pg8::gemm_phase<pg8::EpiS5In<S5_T, S5_NCH, S5_KY>, pg8::StaticOrder, true, true>(ring, g, S, E); } SEAM(6);
    if (IN(7)) { pg8::Gemm g{(const bf16*)(ws + WS_S5_UG), (const bf16*)(ws + WS_S5BS), S5_KS, S5_KY, S5_KS, DFLAG, 1u << 7}; pg8::BatchedOrder S; S.init(S5_G, S5_NCH / 256, 1, F.G, (int)blockIdx.x);
        pg8::EpiF32 E{(float*)(ws + WS_S5_SLOC), 256};
        pg8::gemm_phase<pg8::EpiF32, pg8::BatchedOrder, true, true>(ring, g, S, E); } SEAM(7);
    if (IN(8)) { s5_scan_phase(F, args); } SEAM(8);
    if (IN(9)) { pg8::Gemm g{(const bf16*)(ws + WS_S5_UG), (const bf16*)(ws + WS_S5BY), S5_KY, S5_KY, S5_KY, DFLAG, 1u << 9}; pg8::BatchedOrder S; S.init(S5_G, S5_NCH / 256, S5_KS / 256, F.G, (int)blockIdx.x);
        pg8::EpiS5Y<S5_T, S5_NCH / 256> E{(bf16*)(ws + WS_S5_Y)};
        pg8::gemm_phase<pg8::EpiS5Y<S5_T, S5_NCH / 256>, pg8::BatchedOrder, true, true>(ring, g, S, E); } SEAM(9);
    if (IN(10)) { pg8::Gemm g{(const bf16*)(ws + WS_S5_Y), (const bf16*)(ws + WS_W_S5GLU), 4096, 4096, 4096, DFLAG, 1u << 10}; pg8::StaticOrder S; S.init(M, 4096, F.G, (int)blockIdx.x);
        pg8::EpiGlu E{(const bf16*)(ws + WS_S5_Y), (const bf16*)(ws + WS_S5_GS), args.in[21], (bf16*)(ws + WS_S5_Z)};
        pg8::gemm_phase<pg8::EpiGlu, pg8::StaticOrder, true, true>(ring, g, S, E); } SEAM(10);
    if (IN(11)) { pg8::Gemm g{(const bf16*)(ws + WS_S5_Z), (const bf16*)(ws + WS_W_S5OUT), 4096, 4096, 4096, DFLAG, 1u << 11}; pg8::StaticOrder S; S.init(M, 4096, F.G, (int)blockIdx.x);
        pg8::EpiResid E{XO, XO, D, MOD + 1 * 2 * 12288 + 8192, 12288, SEQ};
        pg8::gemm_phase<pg8::EpiResid, pg8::StaticOrder, true, true>(ring, g, S, E); } SEAM(11);
#endif
#if MK_NLAYERS >= 3
    if (IN(12)) { norm_phase<false>(F, XO, args.in[4] + 2 * D, MOD + 2 * 2 * 12288, H, nullptr); } SEAM(12);
    if (IN(13)) { { pg8::Gemm g{H, (const bf16*)(ws + WS_W_GLAIN), 4096, 4096, 4096, DFLAG, 1u << 13}; pg8::StaticOrder S; S.init(M, GLA_NIN, F.G, (int)blockIdx.x);
          pg8::EpiBf16 E{(bf16*)(ws + WS_GLA_IN), GLA_NIN};
          pg8::gemm_phase<pg8::EpiBf16, pg8::StaticOrder, true, true>(ring, g, S, E); }
        { pg8::Gemm g{H, (const bf16*)(ws + WS_W_GLAG1), 1024, 4096, 4096, DFLAG, 1u << 13}; pg8::SplitKOrder S; S.init(M, 4, 1024, F.G, (int)blockIdx.x);
          pg8::EpiGate E{(float*)(ws + WS_GLA_G1P), M};
          pg8::gemm_phase<pg8::EpiGate, pg8::SplitKOrder, true, true>(ring, g, S, E); } } SEAM(13);
    if (IN(14)) { gla_prep_phase(F, args); } SEAM(14);
    if (IN(15)) { gla_main_phase(F, args); } SEAM(15);
    if (IN(16)) { gla_combine_phase(F, args); } SEAM(16);
    if (IN(17)) { pg8::Gemm g{(const bf16*)(ws + WS_GLA_Z), (const bf16*)(ws + WS_W_GLAOUT), 4096, 4096, 4096, DFLAG, 1u << 17}; pg8::StaticOrder S; S.init(M, 4096, F.G, (int)blockIdx.x);
        pg8::EpiResid E{XO, XO, D, MOD + 2 * 2 * 12288 + 8192, 12288, SEQ};
        pg8::gemm_phase<pg8::EpiResid, pg8::StaticOrder, true, true>(ring, g, S, E); } SEAM(17);
#endif
#if MK_NLAYERS >= 4
    if (IN(18)) { norm_phase<false>(F, XO, args.in[4] + 3 * D, MOD + 3 * 2 * 12288, H, nullptr); } SEAM(18);
    if (IN(19)) { pg8::Gemm g{H, (const bf16*)(ws + WS_W_NAIN1), 4096, 4096, 4096, DFLAG, 1u << 19}; pg8::StaticOrder S; S.init(M, 16384, F.G, (int)blockIdx.x);
        pg8::EpiBf16 E{(bf16*)(ws + WS_NA_QKVG), 16384};
        pg8::gemm_phase<pg8::EpiBf16, pg8::StaticOrder, true, true>(ring, g, S, E); } SEAM(19);
    if (IN(20)) { na_attn_phase(F, (bf16*)(ws + WS_NA_QKVG), args.in[6] + 1 * 32 * 465); } SEAM(20);
    if (IN(21)) { pg8::Gemm g{(const bf16*)(ws + WS_NA_QKVG), (const bf16*)(ws + WS_W_NAOUT1), 4096, 16384, 4096, DFLAG, 1u << 21}; pg8::StaticOrder S; S.init(M, 4096, F.G, (int)blockIdx.x);
        pg8::EpiResid E{XO, XO, D, MOD + 3 * 2 * 12288 + 8192, 12288, SEQ};
        pg8::gemm_phase<pg8::EpiResid, pg8::StaticOrder, true, true>(ring, g, S, E); } SEAM(21);
#endif
    if (IN(22)) { norm_phase<true>(F, (MK_NLAYERS >= 1) ? (const float*)XO : args.in[0], args.in[32], nullptr, nullptr, XO); }
#if MK_DIAG
    if (IN(22)) { __syncthreads(); const unsigned f = __hip_atomic_load(DFLAG, __ATOMIC_RELAXED, __HIP_MEMORY_SCOPE_AGENT);
        const unsigned f2 = __hip_atomic_load(DFLAG + 1, __ATOMIC_RELAXED, __HIP_MEMORY_SCOPE_AGENT);
        if (f != 0u || f2 != 0u) { const int k = f2 ? (24 + __builtin_ctz(f2)) : __builtin_ctz(f); float mk = 10.f; for (int i = 0; i < k; ++i) mk *= 10.f;
            const int gw = F.vcu * NWAVES + F.wave, NGW = F.G * NWAVES;
            for (int m = gw; m < M; m += NGW) for (int j = 0; j < 16; ++j) *((GAS f32x4*)(XO + (size_t)m * D) + F.lane + 64 * j) = (f32x4){mk, mk, mk, mk}; }
        else { const int gw = F.vcu * NWAVES + F.wave, NGW = F.G * NWAVES;
            for (int m = gw; m < M; m += NGW) for (int j = 0; j < 16; ++j) { GAS f32x4* p = (GAS f32x4*)(XO + (size_t)m * D) + F.lane + 64 * j; f32x4 v = *p; bool ch = false;
                for (int e = 0; e < 4; ++e) if (!(__builtin_fabsf(v[e]) < 3.0e38f)) { v[e] = 3.0e30f; ch = true; } if (ch) *p = v; } } }
#endif
#undef IN
#undef SEAM
}

extern "C" void kernel_launch(void* const* d_in, const int* in_sizes, int n_in, void* d_out, int out_size, void* d_ws, size_t ws_size, hipStream_t stream) {
    static int grid = 0;
    if (grid == 0) {
        if (n_in != 33 || in_sizes[0] != M * D || out_size != M * D || ws_size < WS_END) {
            fprintf(stderr, "kernel_launch: built for 33 inputs, x/out of %d floats, >= %zu bytes of workspace; got n_in %d, in0 %d, out %d, ws %zu; nothing launched\n", M * D, (size_t)WS_END, n_in, n_in > 0 ? in_sizes[0] : -1, out_size, ws_size);
            grid = -1; return; }
        int dev = 0, cus = 0, per_cu = 0;
        if (hipGetDevice(&dev) != hipSuccess || hipDeviceGetAttribute(&cus, hipDeviceAttributeMultiprocessorCount, dev) != hipSuccess) { fprintf(stderr, "kernel_launch: device query failed\n"); grid = -1; return; }
        if (hipFuncSetAttribute((const void*)fwd_kernel, hipFuncAttributeMaxDynamicSharedMemorySize, LDS_BYTES) != hipSuccess) { fprintf(stderr, "kernel_launch: hipFuncSetAttribute failed\n"); grid = -1; return; }
        if (hipOccupancyMaxActiveBlocksPerMultiprocessor(&per_cu, (const void*)fwd_kernel, NWAVES * 64, LDS_BYTES) != hipSuccess || per_cu < 1)
            fprintf(stderr, "kernel_launch: note: occupancy query reports %d workgroups per CU\n", per_cu);
        (void)hipGetLastError();
        grid = cus;
        if (grid != 256) fprintf(stderr, "kernel_launch: note: %d CUs (tuned for 256)\n", grid);
        if (grid < 136) { fprintf(stderr, "kernel_launch: needs >= 136 CUs\n"); grid = -1; return; }
    }
    if (grid < 0) return;
    if (hipMemsetAsync((char*)d_ws + WS_CTL, 0, CTL_ZERO_BYTES, stream) != hipSuccess) { fprintf(stderr, "kernel_launch: memset failed\n"); return; }
    Args a{};
    for (int i = 0; i < 33; ++i) a.in[i] = (const float*)d_in[i];
    a.out = (float*)d_out; a.ws = (unsigned char*)d_ws;
#if MK_ONE_LAUNCH
    a.ph_lo = 0; a.ph_hi = NPH;
    hipLaunchKernelGGL(fwd_kernel, dim3(grid), dim3(NWAVES * 64), LDS_BYTES, stream, a);
#else
    for (int ph = 0; ph < NPH; ++ph) { a.ph_lo = ph; a.ph_hi = ph + 1;
        hipLaunchKernelGGL(fwd_kernel, dim3(grid), dim3(NWAVES * 64), LDS_BYTES, stream, a); }
#endif
    const hipError_t le = hipPeekAtLastError();
    if (le != hipSuccess) fprintf(stderr, "kernel_launch: launch failed: %s\n", hipGetErrorName(le));
}
```

```cpp
#include <hip/hip_runtime.h>
#include <cstdio>
#include <cstdint>

#ifndef MK_ONE_LAUNCH
#define MK_ONE_LAUNCH 1
#endif
#ifndef MK_DIAG
#define MK_DIAG 0
#endif
#ifndef MK_PROF
#define MK_PROF 0
#endif
#define MK_PROF_A (d[2]+d[19]+d[4]+d[21]+d[6]+d[10]+d[11]+d[13]+d[17])
#define MK_PROF_B (d[0])
#ifndef MK_DUP
#define MK_DUP 0u
#endif
#ifndef MK_NLAYERS
#define MK_NLAYERS 4
#endif

namespace pg8 {
#define PG8_LAS __attribute__((address_space(3)))
typedef unsigned short bf16_t;
typedef short bf16x8 __attribute__((ext_vector_type(8)));
typedef float f32x4 __attribute__((ext_vector_type(4)));
typedef unsigned u32x4 __attribute__((ext_vector_type(4)));
typedef unsigned u32x2 __attribute__((ext_vector_type(2)));
constexpr int BM = 256, BK = 64, HALF = 128, HTB = HALF * BK * 2  , STAGE_BYTES = 8 * HTB, NXCD = 8, WGM = 8;

__host__ __device__ __forceinline__ int lds_byte(int r, int c) { const int st = (r >> 4) * 2 + (c >> 5), rr = r & 15, cc = c & 31, ob = rr * 64 + cc * 2; return st * 1024 + (ob ^ (((ob >> 9) & 1) << 5)); }
__host__ __device__ __forceinline__ void stage_rc(int b, int& R, int& C) { const int st = b / 1024, sb = b % 1024, swz = sb ^ (((sb >> 9) & 1) << 5); R = (st >> 1) * 16 + swz / 64; C = (st & 1) * 32 + (swz % 64) / 2; }
__host__ __device__ __forceinline__ int perm32(int rho) { const int n = rho >> 4, i = rho & 15; return 8 * (i >> 2) + 4 * n + (i & 3); }

struct Unit { int pm, pn, pb, koff; };
struct Gemm { const bf16_t* A; const bf16_t* Bt; int K, lda, ldb; unsigned* dflag; unsigned dbit; };

struct StaticOrder {
    int nM, nN, nwg, G, c;
    __host__ __device__ void init(int M, int N, int G_, int c_) { nM = M / BM; nN = N / BM; nwg = nM * nN; G = G_; c = c_; }
    __host__ __device__ bool next(int i, Unit& u) const {
        const long L = (long)i * G + c; if (L >= nwg) return false;
        int wgid = (int)L; { const int q = nwg / NXCD, r = nwg % NXCD, xcd = wgid % NXCD, off = wgid / NXCD; wgid = (xcd < r ? xcd * (q + 1) : r * (q + 1) + (xcd - r) * q) + off; }
        const int nig = WGM * nN, gid = wgid / nig, fm = gid * WGM, gsz = (nM - fm) < WGM ? (nM - fm) : WGM;
        u.pm = fm + ((wgid % nig) % gsz); u.pn = (wgid % nig) / gsz; u.pb = u.pn; u.koff = 0; return true;
    }
    __device__ __forceinline__ void a_ready(const Unit&) const {}
    __device__ __forceinline__ void done(const Unit&) const {}
};
struct BatchedOrder {
    int nPm, nPn, total, G, c;
    __host__ __device__ void init(int ngroups, int nPm_, int nPn_, int G_, int c_) { nPm = nPm_; nPn = nPn_; total = ngroups * nPm * nPn; G = G_; c = c_; }
    __host__ __device__ bool next(int i, Unit& u) const {
        const long L = (long)i * G + c; if (L >= total) return false;
        const int upg = nPm * nPn, g = (int)L / upg, rem = (int)L % upg, pmi = rem / nPn, pni = rem % nPn;
        u.pm = g * nPm + pmi; u.pn = pni; u.pb = g * nPn + pni; u.koff = 0; return true;
    }
    __device__ __forceinline__ void a_ready(const Unit&) const {}
    __device__ __forceinline__ void done(const Unit&) const {}
};
struct SplitKOrder {
    int nM, nsplit, kslice, G, c;
    __host__ __device__ void init(int M, int nsplit_, int kslice_, int G_, int c_) { nM = M / BM; nsplit = nsplit_; kslice = kslice_; G = G_; c = c_; }
    __host__ __device__ bool next(int i, Unit& u) const {
        const long L = (long)i * G + c; if (L >= (long)nM * nsplit) return false;
        u.pm = (int)L / nsplit; u.pn = (int)L % nsplit; u.pb = 0; u.koff = u.pn * kslice; return true;
    }
    __device__ __forceinline__ void a_ready(const Unit&) const {}
    __device__ __forceinline__ void done(const Unit&) const {}
};

typedef float f32x2_t __attribute__((ext_vector_type(2))); typedef __bf16 bf16x2_t __attribute__((ext_vector_type(2)));
__device__ __forceinline__ unsigned cvt_pk_bf16(float lo, float hi) { f32x2_t v = {lo, hi}; bf16x2_t b = __builtin_convertvector(v, bf16x2_t); return __builtin_bit_cast(unsigned, b); }
__device__ __forceinline__ float bf_lo(unsigned w) { return __uint_as_float(w << 16); }
__device__ __forceinline__ float bf_hi(unsigned w) { return __uint_as_float(w & 0xffff0000u); }
__device__ __forceinline__ float sigmoidf_(float x) { return 1.0f / (1.0f + __expf(-x)); }
__device__ __forceinline__ float siluf_(float x) { return x / (1.0f + __expf(-x)); }
__device__ __forceinline__ float gelu_tanh(float x) { const float z = 0.7978845608028654f * (x + 0.044715f * x * x * x); return x / (1.0f + __expf(-2.0f * z)); }

struct EpiBf16 {
    static constexpr bool PERM = true, AFTER_DRAIN = false;
    bf16_t* O; int ldc;
    __device__ __forceinline__ void operator()(const f32x4 (&acc)[2][2][4][2], const Unit& u, int wr, int wc, int fr, int fq) const {
        const int row0 = u.pm * BM + wr * 64 + fr, col0 = u.pn * BM + wc * 32 + 8 * fq;
#pragma unroll
        for (int ai = 0; ai < 2; ++ai)
#pragma unroll
            for (int m = 0; m < 4; ++m) { bf16_t* rowp = O + (size_t)(row0 + ai * HALF + m * 16) * ldc + col0;
#pragma unroll
                for (int bj = 0; bj < 2; ++bj) { const f32x4 v0 = acc[ai][bj][m][0], v1 = acc[ai][bj][m][1];
                    u32x4 w; w.x = cvt_pk_bf16(v0[0], v0[1]); w.y = cvt_pk_bf16(v0[2], v0[3]); w.z = cvt_pk_bf16(v1[0], v1[1]); w.w = cvt_pk_bf16(v1[2], v1[3]);
                    *(u32x4*)(rowp + bj * HALF) = w; } }
    }
};
struct EpiNaIn {
    static constexpr bool PERM = true, AFTER_DRAIN = false;
    bf16_t* O;
    __device__ __forceinline__ void operator()(const f32x4 (&acc)[2][2][4][2], const Unit& u, int wr, int wc, int fr, int fq) const {
        const int row0 = u.pm * BM + wr * 64 + fr, col0 = u.pn * BM + wc * 32 + 8 * fq;
#pragma unroll
        for (int ai = 0; ai < 2; ++ai)
#pragma unroll
            for (int m = 0; m < 4; ++m) { const int row = row0 + ai * HALF + m * 16, b = row >> 13, l = row & 8191;
#pragma unroll
                for (int bj = 0; bj < 2; ++bj) { const f32x4 v0 = acc[ai][bj][m][0], v1 = acc[ai][bj][m][1]; const int n = col0 + bj * HALF, sec = n >> 12, hd = (n >> 7) & 31, d = n & 127;
                    u32x4 w; w.x = cvt_pk_bf16(v0[0], v0[1]); w.y = cvt_pk_bf16(v0[2], v0[3]); w.z = cvt_pk_bf16(v1[0], v1[1]); w.w = cvt_pk_bf16(v1[2], v1[3]);
                    *(u32x4*)(O + ((size_t)((sec * 2 + b) * 32 + hd) * 8192 + l) * 128 + d) = w; } }
    }
};
struct EpiResid {
    static constexpr bool PERM = false, AFTER_DRAIN = false;
    const float* base; float* out; int ldc; const float* gate0; int gate_stride; int rows_per_batch;
    __device__ __forceinline__ void operator()(const f32x4 (&acc)[2][2][4][2], const Unit& u, int wr, int wc, int fr, int fq) const {
        const int row0 = u.pm * BM + wr * 64 + fr, col0 = u.pn * BM + wc * 32 + 4 * fq;
        const float* gp = gate0 + (size_t)((u.pm * BM) / rows_per_batch) * gate_stride + col0;
        f32x4 gv[2][2];
#pragma unroll
        for (int bj = 0; bj < 2; ++bj)
#pragma unroll
            for (int n = 0; n < 2; ++n) gv[bj][n] = *(const f32x4*)(gp + bj * HALF + n * 16);
#pragma unroll
        for (int ai = 0; ai < 2; ++ai)
#pragma unroll
            for (int m = 0; m < 4; ++m) { const size_t off = (size_t)(row0 + ai * HALF + m * 16) * ldc + col0;
#pragma unroll
                for (int bj = 0; bj < 2; ++bj)
#pragma unroll
                    for (int n = 0; n < 2; ++n) { const f32x4 bs = *(const f32x4*)(base + off + bj * HALF + n * 16);
                        *(f32x4*)(out + off + bj * HALF + n * 16) = bs + gv[bj][n] * acc[ai][bj][m][n]; }
                asm volatile("" ::: "memory"); }
    }
};
struct EpiF32 {
    static constexpr bool PERM = false, AFTER_DRAIN = false;
    float* C; int ldc;
    __device__ __forceinline__ void operator()(const f32x4 (&acc)[2][2][4][2], const Unit& u, int wr, int wc, int fr, int fq) const {
        const int row0 = u.pm * BM + wr * 64 + fr, col0 = u.pn * BM + wc * 32 + 4 * fq;
#pragma unroll
        for (int ai = 0; ai < 2; ++ai)
#pragma unroll
            for (int m = 0; m < 4; ++m) { float* rowp = C + (size_t)(row0 + ai * HALF + m * 16) * ldc + col0;
#pragma unroll
                for (int bj = 0; bj < 2; ++bj)
#pragma unroll
                    for (int n = 0; n < 2; ++n) *(f32x4*)(rowp + bj * HALF + n * 16) = acc[ai][bj][m][n]; }
    }
};
struct EpiGate {
    static constexpr bool PERM = false, AFTER_DRAIN = false;
    float* P; int rows;
    __device__ __forceinline__ void operator()(const f32x4 (&acc)[2][2][4][2], const Unit& u, int wr, int wc, int fr, int fq) const {
        if (wc != 0) return;
        const int row0 = u.pm * BM + wr * 64 + fr;
#pragma unroll
        for (int ai = 0; ai < 2; ++ai)
#pragma unroll
            for (int m = 0; m < 4; ++m) { float* rowp = P + ((size_t)u.pn * rows + (row0 + ai * HALF + m * 16)) * 32 + 4 * fq;
#pragma unroll
                for (int n = 0; n < 2; ++n) *(f32x4*)(rowp + n * 16) = acc[ai][0][m][n]; }
    }
};
template <int T, int NCH, int KY> struct EpiS5In {
    static constexpr bool PERM = true, AFTER_DRAIN = false;
    bf16_t* Ug; bf16_t* Gs;
    __device__ __forceinline__ void operator()(const f32x4 (&acc)[2][2][4][2], const Unit& u, int wr, int wc, int fr, int fq) const {
        const int row0 = u.pm * BM + wr * 64 + fr, col0 = u.pn * BM + wc * 32 + 8 * fq;
#pragma unroll
        for (int ai = 0; ai < 2; ++ai)
#pragma unroll
            for (int m = 0; m < 4; ++m) { const int row = row0 + ai * HALF + m * 16;
#pragma unroll
                for (int bj = 0; bj < 2; ++bj) { const f32x4 v0 = acc[ai][bj][m][0], v1 = acc[ai][bj][m][1]; const int col = col0 + bj * HALF;
                    u32x4 w; w.x = cvt_pk_bf16(v0[0], v0[1]); w.y = cvt_pk_bf16(v0[2], v0[3]); w.z = cvt_pk_bf16(v1[0], v1[1]); w.w = cvt_pk_bf16(v1[2], v1[3]);
                    if (col < 4096) { const int g = col >> 4, i0 = col & 15, chunk = row / T, t = row % T;
                        *(u32x4*)(Ug + ((size_t)g * NCH + chunk) * KY + t * 16 + i0) = w; }
                    else *(u32x4*)(Gs + (size_t)row * 4096 + (col - 4096)) = w; } }
    }
};
template <int T, int NPM> struct EpiS5Y {
    static constexpr bool PERM = true, AFTER_DRAIN = false;
    bf16_t* Y;
    __device__ __forceinline__ void operator()(const f32x4 (&acc)[2][2][4][2], const Unit& u, int wr, int wc, int fr, int fq) const {
        const int g = u.pm / NPM, chunk0 = (u.pm % NPM) * BM + wr * 64 + fr, col0 = u.pn * BM + wc * 32 + 8 * fq;
#pragma unroll
        for (int ai = 0; ai < 2; ++ai)
#pragma unroll
            for (int m = 0; m < 4; ++m) { const int chunk = chunk0 + ai * HALF + m * 16;
#pragma unroll
                for (int bj = 0; bj < 2; ++bj) { f32x4 v0 = acc[ai][bj][m][0], v1 = acc[ai][bj][m][1]; const int n = col0 + bj * HALF, t = n >> 4, i0 = n & 15;
#pragma unroll
                    for (int j = 0; j < 4; ++j) { v0[j] = gelu_tanh(v0[j]); v1[j] = gelu_tanh(v1[j]); }
                    u32x4 w; w.x = cvt_pk_bf16(v0[0], v0[1]); w.y = cvt_pk_bf16(v0[2], v0[3]); w.z = cvt_pk_bf16(v1[0], v1[1]); w.w = cvt_pk_bf16(v1[2], v1[3]);
                    *(u32x4*)(Y + (size_t)(chunk * T + t) * 4096 + g * 16 + i0) = w; } }
    }
};
struct EpiGlu {
    static constexpr bool PERM = true, AFTER_DRAIN = false;
    const bf16_t* Y; const bf16_t* Gs; const float* bias; bf16_t* Z;
    __device__ __forceinline__ void operator()(const f32x4 (&acc)[2][2][4][2], const Unit& u, int wr, int wc, int fr, int fq) const {
        const int row0 = u.pm * BM + wr * 64 + fr, col0 = u.pn * BM + wc * 32 + 8 * fq;
        f32x4 bv[2][2];
#pragma unroll
        for (int bj = 0; bj < 2; ++bj)
#pragma unroll
            for (int n = 0; n < 2; ++n) bv[bj][n] = *(const f32x4*)(bias + col0 + bj * HALF + 4 * n);
#pragma unroll
        for (int ai = 0; ai < 2; ++ai)
#pragma unroll
            for (int m = 0; m < 4; ++m) { const size_t off = (size_t)(row0 + ai * HALF + m * 16) * 4096 + col0;
#pragma unroll
                for (int bj = 0; bj < 2; ++bj) { const u32x4 yw = *(const u32x4*)(Y + off + bj * HALF), gw = *(const u32x4*)(Gs + off + bj * HALF);
                    const f32x4 a0 = acc[ai][bj][m][0] + bv[bj][0], a1 = acc[ai][bj][m][1] + bv[bj][1];
                    float o[8];
#pragma unroll
                    for (int j = 0; j < 4; ++j) { const unsigned yj = yw[j], gj = gw[j];
                        const float aa = (j < 2) ? a0[2 * j] : a1[2 * j - 4], ab = (j < 2) ? a0[2 * j + 1] : a1[2 * j - 3];
                        o[2 * j] = bf_lo(yj) * sigmoidf_(aa) * siluf_(bf_lo(gj)); o[2 * j + 1] = bf_hi(yj) * sigmoidf_(ab) * siluf_(bf_hi(gj)); }
                    u32x4 w; w.x = cvt_pk_bf16(o[0], o[1]); w.y = cvt_pk_bf16(o[2], o[3]); w.z = cvt_pk_bf16(o[4], o[5]); w.w = cvt_pk_bf16(o[6], o[7]);
                    *(u32x4*)(Z + off + bj * HALF) = w; }
                asm volatile("" ::: "memory"); }
    }
};

template <class Epi, class Sched, bool ALIGN_EPI = false, bool SP2 = false>
__device__ __forceinline__ void gemm_phase(PG8_LAS unsigned char* lds, const Gemm g, const Sched& S, const Epi& E) {
    const int tid = threadIdx.x, wid = __builtin_amdgcn_readfirstlane(tid >> 6), lane = tid & 63, wr = wid >> 2, wc = wid & 3, fr = lane & 15, fq = lane >> 4;
    const int K = g.K, nt = K / BK, lda = g.lda, ldb = g.ldb;
    unsigned voffA[2], voffB[2];
#pragma unroll
    for (int i = 0; i < 2; ++i) { int R, C; stage_rc(tid * 16 + i * 8192, R, C); const int Rb = Epi::PERM ? ((R & ~31) + perm32(R & 31)) : R;
        voffA[i] = (unsigned)(R * lda + C) * 2u; voffB[i] = (unsigned)(Rb * ldb + C) * 2u; }
    const size_t kstep = (size_t)(BK * 2);
    const size_t hstepA = (size_t)HALF * lda * 2, hstepB = (size_t)HALF * ldb * 2;
    const size_t tstepA = 2 * hstepA, tstepB = 2 * hstepB;
    const unsigned ldsw = (unsigned)wid * 1024u;
    const int aoff = lds_byte(wr * 64 + fr, fq * 8), boff = lds_byte(wc * 32 + fr, fq * 8);
#define PG8_SA(b, h) (((b) * 2 + (h)) * HTB)
#define PG8_SB(b, h) ((4 + (b) * 2 + (h)) * HTB)
#define PG8_STAGE(bufoff, gbase, voff) do { _Pragma("unroll") for (int _i = 0; _i < 2; ++_i) \
        __builtin_amdgcn_global_load_lds((const unsigned*)((const char*)(gbase) + (voff)[_i]), (PG8_LAS unsigned*)(lds + (bufoff) + ldsw + _i * 8192), 16, 0, 0); } while (0)
#define PG8_LDA(dst, b, h) do { _Pragma("unroll") for (int m = 0; m < 4; ++m) _Pragma("unroll") for (int k = 0; k < 2; ++k) dst[m][k] = *(const PG8_LAS bf16x8*)(lds + PG8_SA(b, h) + aoff + m * 2048 + k * 1024); } while (0)
#define PG8_LDB(dst, b, h) do { _Pragma("unroll") for (int n = 0; n < 2; ++n) _Pragma("unroll") for (int k = 0; k < 2; ++k) dst[n][k] = *(const PG8_LAS bf16x8*)(lds + PG8_SB(b, h) + boff + n * 2048 + k * 1024); } while (0)
#define PG8_MMA(ai, bj, At, Bt) do { __builtin_amdgcn_s_setprio(1); _Pragma("unroll") for (int m = 0; m < 4; ++m) _Pragma("unroll") for (int n = 0; n < 2; ++n) _Pragma("unroll") for (int k = 0; k < 2; ++k) \
        acc[ai][bj][m][n] = __builtin_amdgcn_mfma_f32_16x16x32_bf16(Bt[n][k], At[m][k], acc[ai][bj][m][n], 0, 0, 0); __builtin_amdgcn_s_setprio(0); } while (0)
#define PG8_WAIT_V(n) asm volatile("s_waitcnt vmcnt(" #n ")" ::: "memory")
#define PG8_WAIT_L(n) asm volatile("s_waitcnt lgkmcnt(" #n ")" ::: "memory")
#define PG8_BAR __builtin_amdgcn_s_barrier()
#define PG8_SCHED __builtin_amdgcn_sched_barrier(0)
    Unit cur, nxt; int ui = 0;
    if (!S.next(0, cur)) return;
    f32x4 acc[2][2][4][2];
#pragma unroll
    for (int a = 0; a < 2; ++a)
#pragma unroll
        for (int b = 0; b < 2; ++b)
#pragma unroll
            for (int m = 0; m < 4; ++m)
#pragma unroll
                for (int n = 0; n < 2; ++n) acc[a][b][m][n] = (f32x4){0.f, 0.f, 0.f, 0.f};
    bf16x8 At[4][2], B0[2][2], B1[2][2];
    const char* cA = (const char*)g.A + (size_t)cur.pm * tstepA + (size_t)cur.koff * 2; const char* cB = (const char*)g.Bt + (size_t)cur.pb * tstepB + (size_t)cur.koff * 2;
    S.a_ready(cur);
    if constexpr (SP2) {
        PG8_STAGE(PG8_SB(0, 0), cB, voffB); PG8_STAGE(PG8_SB(0, 1), cB + hstepB, voffB); PG8_STAGE(PG8_SA(0, 0), cA, voffA); PG8_STAGE(PG8_SA(0, 1), cA + hstepA, voffA);
        if (wr == 1) PG8_BAR;
        PG8_WAIT_V(2); PG8_BAR;
        PG8_STAGE(PG8_SB(1, 0), cB + kstep, voffB); PG8_STAGE(PG8_SA(1, 0), cA + kstep, voffA); PG8_STAGE(PG8_SB(1, 1), cB + hstepB + kstep, voffB);
        PG8_WAIT_V(6); PG8_BAR;
    } else {
        PG8_STAGE(PG8_SB(0, 0), cB, voffB); PG8_STAGE(PG8_SA(0, 0), cA, voffA); PG8_STAGE(PG8_SB(0, 1), cB + hstepB, voffB); PG8_STAGE(PG8_SA(0, 1), cA + hstepA, voffA);
        if (wr == 1) PG8_BAR;
        PG8_WAIT_V(4); PG8_BAR;
        PG8_STAGE(PG8_SB(1, 0), cB + kstep, voffB); PG8_STAGE(PG8_SA(1, 0), cA + kstep, voffA); PG8_STAGE(PG8_SB(1, 1), cB + hstepB + kstep, voffB);
        PG8_WAIT_V(6); PG8_BAR;
    }
    for (;;) {
        const bool has_next = S.next(ui + 1, nxt);
        const char* nA = has_next ? (const char*)g.A + (size_t)nxt.pm * tstepA + (size_t)nxt.koff * 2 : cA; const char* nB = has_next ? (const char*)g.Bt + (size_t)nxt.pb * tstepB + (size_t)nxt.koff * 2 : cB;
        for (int t = 0; t < nt; t += 2) {
            const bool last = (t == nt - 2);
            const char* a1 = cA + (size_t)(t + 1) * kstep;
            const char* a2 = last ? nA : cA + (size_t)(t + 2) * kstep; const char* b2 = last ? nB : cB + (size_t)(t + 2) * kstep;
            const char* a3 = a2 + kstep; const char* b3 = b2 + kstep;
            if (last && has_next) S.a_ready(nxt);
            if constexpr (SP2) {
            PG8_LDB(B0, 0, 0); PG8_LDB(B1, 0, 1); PG8_SCHED; PG8_LDA(At, 0, 0); PG8_STAGE(PG8_SA(1, 1), a1 + hstepA, voffA);
            PG8_WAIT_V(8); PG8_WAIT_L(0); PG8_BAR; PG8_MMA(0, 0, At, B0); PG8_MMA(0, 1, At, B1); PG8_BAR; PG8_SCHED;
            PG8_LDA(At, 0, 1); PG8_STAGE(PG8_SB(0, 0), b2, voffB); PG8_STAGE(PG8_SB(0, 1), b2 + hstepB, voffB); PG8_STAGE(PG8_SA(0, 0), a2, voffA);
            PG8_WAIT_V(8); PG8_WAIT_L(0); PG8_BAR; PG8_MMA(1, 0, At, B0); PG8_MMA(1, 1, At, B1); PG8_BAR; PG8_SCHED;
            PG8_LDB(B0, 1, 0); PG8_LDB(B1, 1, 1); PG8_SCHED; PG8_LDA(At, 1, 0); PG8_STAGE(PG8_SA(0, 1), a2 + hstepA, voffA);
            PG8_WAIT_V(8); PG8_WAIT_L(0); PG8_BAR; PG8_MMA(0, 0, At, B0); PG8_MMA(0, 1, At, B1); PG8_BAR; PG8_SCHED;
            PG8_LDA(At, 1, 1); PG8_STAGE(PG8_SB(1, 0), b3, voffB); PG8_STAGE(PG8_SB(1, 1), b3 + hstepB, voffB); PG8_STAGE(PG8_SA(1, 0), a3, voffA);
            PG8_WAIT_V(8); PG8_WAIT_L(0); PG8_BAR; PG8_MMA(1, 0, At, B0); PG8_MMA(1, 1, At, B1); PG8_BAR; PG8_SCHED;
            } else {
            PG8_LDB(B0, 0, 0); PG8_SCHED; PG8_LDA(At, 0, 0); PG8_STAGE(PG8_SA(1, 1), a1 + hstepA, voffA);
            PG8_WAIT_L(8); PG8_BAR; PG8_WAIT_L(0); PG8_MMA(0, 0, At, B0); PG8_BAR; PG8_SCHED;
            PG8_LDB(B1, 0, 1); PG8_STAGE(PG8_SB(0, 0), b2, voffB);
            PG8_BAR; PG8_WAIT_L(0); PG8_MMA(0, 1, At, B1); PG8_BAR;
            PG8_LDA(At, 0, 1); PG8_STAGE(PG8_SA(0, 0), a2, voffA);
            PG8_BAR; PG8_WAIT_L(0); PG8_MMA(1, 0, At, B0); PG8_BAR; PG8_SCHED;
            PG8_STAGE(PG8_SB(0, 1), b2 + hstepB, voffB);
            PG8_WAIT_V(6); PG8_BAR; PG8_MMA(1, 1, At, B1); PG8_BAR;
            PG8_LDB(B0, 1, 0); PG8_SCHED; PG8_LDA(At, 1, 0); PG8_STAGE(PG8_SA(0, 1), a2 + hstepA, voffA);
            PG8_WAIT_L(8); PG8_BAR; PG8_WAIT_L(0); PG8_MMA(0, 0, At, B0); PG8_BAR; PG8_SCHED;
            PG8_LDB(B1, 1, 1); PG8_STAGE(PG8_SB(1, 0), b3, voffB);
            PG8_BAR; PG8_WAIT_L(0); PG8_MMA(0, 1, At, B1); PG8_BAR;
            PG8_LDA(At, 1, 1); PG8_STAGE(PG8_SA(1, 0), a3, voffA);
            PG8_BAR; PG8_WAIT_L(0); PG8_MMA(1, 0, At, B0); PG8_BAR; PG8_SCHED;
            PG8_STAGE(PG8_SB(1, 1), b3 + hstepB, voffB);
            PG8_WAIT_V(6); PG8_BAR; PG8_MMA(1, 1, At, B1); PG8_BAR;
            }
        }
        if constexpr (ALIGN_EPI) { if (wr == 0) PG8_BAR; }
#if MK_DIAG
        { bool bad = false;
#pragma unroll
          for (int a_ = 0; a_ < 2; ++a_)
#pragma unroll
            for (int b_ = 0; b_ < 2; ++b_)
#pragma unroll
              for (int m_ = 0; m_ < 4; ++m_)
#pragma unroll
                for (int n_ = 0; n_ < 2; ++n_)
#pragma unroll
                  for (int j_ = 0; j_ < 4; ++j_) bad |= !(__builtin_fabsf(acc[a_][b_][m_][n_][j_]) < 3.0e38f);
          if (bad && g.dflag) atomicOr(g.dflag, g.dbit); }
#endif
        if constexpr (!Epi::AFTER_DRAIN) { E(acc, cur, wr, wc, fr, fq); S.done(cur); }
        if (!has_next) break;
#pragma unroll
        for (int a = 0; a < 2; ++a)
#pragma unroll
            for (int b = 0; b < 2; ++b)
#pragma unroll
                for (int m = 0; m < 4; ++m)
#pragma unroll
                    for (int n = 0; n < 2; ++n) acc[a][b][m][n] = (f32x4){0.f, 0.f, 0.f, 0.f};
        cur = nxt; cA = nA; cB = nB; ++ui;
        if constexpr (ALIGN_EPI) { if (wr == 1) PG8_BAR; }
    }
    PG8_WAIT_V(0);
    if constexpr (!ALIGN_EPI) { if (wr == 0) PG8_BAR; }
    PG8_BAR;
    if constexpr (Epi::AFTER_DRAIN) { E.fused(acc, cur, wr, wc, fr, fq, lds, wid, lane); S.done(cur); }
#undef PG8_SA
#undef PG8_SB
#undef PG8_STAGE
#undef PG8_LDA
#undef PG8_LDB
#undef PG8_MMA
#undef PG8_WAIT_V
#undef PG8_WAIT_L
#undef PG8_BAR
#undef PG8_SCHED
}

}

constexpr int NWAVES = 8;
constexpr int BATCH = 2, SEQ = 8192, D = 4096, M = BATCH * SEQ;
constexpr int GRIDW = 64, GROWS = SEQ / GRIDW;
constexpr int NA_HEADS = 32, NA_HD = 128;
constexpr int S5_G = 256, S5_P = 64, S5_I = 16, S5_T = 32, S5_NCH = M / S5_T  , S5_NCHB = SEQ / S5_T  , S5_KS = S5_T * 16  , S5_KY = S5_KS + 256  ;
constexpr int GLA_H = 8, GLA_DK = 256, GLA_DV = 512, GLA_KW = 2048, GLA_C = 64, GLA_NCH = M / GLA_C  , GLA_NCHB = SEQ / GLA_C  , GLA_NIN = 12288;
constexpr float EPS = 1e-6f;

constexpr size_t MiB = 1u << 20;
constexpr size_t WS_CTL = 0, CTL_ZERO_BYTES = 64 * 1024;
constexpr size_t WS_MOD = 1 * MiB;
constexpr size_t WS_LAMT = 2 * MiB;
constexpr size_t WS_W_NAIN0 = 4 * MiB, WS_W_NAIN1 = WS_W_NAIN0 + 128 * MiB, WS_W_NAOUT0 = WS_W_NAIN1 + 128 * MiB, WS_W_NAOUT1 = WS_W_NAOUT0 + 32 * MiB;
constexpr size_t WS_W_S5IN = WS_W_NAOUT1 + 32 * MiB, WS_W_S5GLU = WS_W_S5IN + 64 * MiB, WS_W_S5OUT = WS_W_S5GLU + 32 * MiB;
constexpr size_t WS_W_GLAIN = WS_W_S5OUT + 32 * MiB, WS_W_GLAG1 = WS_W_GLAIN + 96 * MiB, WS_W_GLAOUT = WS_W_GLAG1 + 2 * MiB;
constexpr size_t WS_S5BS = WS_W_GLAOUT + 32 * MiB;
constexpr size_t WS_S5BY = WS_S5BS + 64 * MiB;
constexpr size_t WS_H = WS_S5BY + 192 * MiB;
constexpr size_t WS_ACT = WS_H + 128 * MiB;
constexpr size_t WS_NA_QKVG = WS_ACT;
constexpr size_t WS_NA_Z = WS_ACT + 512 * MiB;
constexpr size_t WS_S5_UG = WS_ACT;
constexpr size_t WS_S5_GS = WS_S5_UG + 192 * MiB;
constexpr size_t WS_S5_SLOC = WS_S5_GS + 128 * MiB;
constexpr size_t WS_S5_Y = WS_S5_SLOC + 128 * MiB;
constexpr size_t WS_S5_Z = WS_S5_Y + 128 * MiB;
constexpr size_t WS_GLA_IN = WS_ACT;
constexpr size_t WS_GLA_G1P = WS_GLA_IN + 384 * MiB;
constexpr size_t WS_GLA_PREP = WS_GLA_G1P + 8 * MiB;
constexpr size_t WS_GLA_DECAY = WS_GLA_PREP + 384 * MiB;
constexpr size_t WS_GLA_O = WS_GLA_DECAY + 4 * MiB;
constexpr size_t WS_GLA_Z = WS_GLA_O + 384 * MiB;
constexpr size_t WS_SCR = WS_GLA_Z + 128 * MiB;
constexpr size_t WS_END = WS_SCR + 256 * MiB;
static_assert(WS_S5_Z + 128 * MiB <= WS_SCR && WS_NA_Z + 128 * MiB <= WS_SCR, "ws map");
constexpr int CW_BAR = 1024;
static_assert((CW_BAR + 3456) * 4 <= (int)CTL_ZERO_BYTES, "CTL words inside the memset region");

constexpr int RING_OFF = 0, RING_BYTES = 131072;
constexpr int LDS_BYTES = 147456;
constexpr int MISC_OFF = LDS_BYTES - 256;

#define GAS __attribute__((address_space(1)))
#define LAS __attribute__((address_space(3)))
typedef unsigned short bf16;
typedef unsigned v4u __attribute__((ext_vector_type(4)));
typedef unsigned v2u __attribute__((ext_vector_type(2)));
typedef float f32x4 __attribute__((ext_vector_type(4)));
typedef float f32x2 __attribute__((ext_vector_type(2)));
typedef short bf16x8 __attribute__((ext_vector_type(8)));
typedef short s16x4 __attribute__((ext_vector_type(4)));
typedef GAS unsigned gu32;
#define LDS_WAIT() asm volatile("s_waitcnt lgkmcnt(0)" ::: "memory")
#define VM_WAIT() asm volatile("s_waitcnt vmcnt(0)" ::: "memory")
using pg8::cvt_pk_bf16; using pg8::bf_lo; using pg8::bf_hi; using pg8::siluf_; using pg8::sigmoidf_;

#define XB_TMO      128
#define XB_XCNT(j)  (256  + 64 * (j))
#define XB_XSUB(j)  (1280 + 64 * (j))
#define XB_XGEN(j)  (2304 + 64 * (j))
#define XB_TOP      3328
#define XB_TOPGEN   3392
#define XCD_BAR_WORDS 3456
#define XB_SPIN_CAP (1u << 18)
__device__ __forceinline__ unsigned xb_ld(unsigned* p)              { return __hip_atomic_load(p, __ATOMIC_RELAXED, __HIP_MEMORY_SCOPE_AGENT); }
__device__ __forceinline__ unsigned xb_add(unsigned* p, unsigned v) { return __hip_atomic_fetch_add(p, v, __ATOMIC_RELAXED, __HIP_MEMORY_SCOPE_AGENT); }
__device__ __forceinline__ unsigned xb_xcc_id() { return (unsigned)__builtin_amdgcn_s_getreg((3 << 11) | 20) & 0xFu; }
#define XB_SPIN(cond, bar) do { unsigned _sp = 0; while (cond) { __builtin_amdgcn_s_sleep(1); \
    if ((++_sp & 255u) == 0u) { if (xb_ld(&(bar)[XB_TMO])) break; if (_sp > XB_SPIN_CAP) { atomicAdd(&(bar)[XB_TMO], 1u); break; } } } } while (0)
struct XcdBarrier { unsigned* bar; unsigned x; volatile LAS unsigned* st; };
__device__ __forceinline__ XcdBarrier xcd_barrier_post(unsigned* bar, volatile LAS unsigned* st) {
    XcdBarrier b; b.bar = bar; b.x = xb_xcc_id(); b.st = st;
    if (threadIdx.x == 0) (void)xb_add(&bar[XB_XCNT(b.x)], 1u);
    return b;
}
__device__ __forceinline__ void xcd_barrier_complete(unsigned* bar, unsigned x, unsigned& nloc, unsigned& nx) {
    const unsigned G = gridDim.x * gridDim.y * gridDim.z;
    unsigned sum, cnt, mine, sp = 0u;
    for (;;) {
        sum = 0u; cnt = 0u; mine = 0u;
#pragma unroll
        for (unsigned j = 0; j < 16; ++j) { const unsigned c = xb_ld(&bar[XB_XCNT(j)]); sum += c; cnt += (c > 0u) ? 1u : 0u; mine = (j == x) ? c : mine; }
        if (sum == G) break;
        __builtin_amdgcn_s_sleep(1);
        if ((++sp & 255u) == 0u) { if (xb_ld(&bar[XB_TMO])) break; if (sp > XB_SPIN_CAP) { atomicAdd(&bar[XB_TMO], 1u); break; } }
    }
    nloc = mine > 0u ? mine : 1u; nx = cnt > 0u ? cnt : 1u;
}
__device__ __forceinline__ void xcd_barrier(const XcdBarrier& b) {
    asm volatile("s_waitcnt vmcnt(0)" ::: "memory");
    __syncthreads();
    if (threadIdx.x == 0) {
        unsigned* bar = b.bar;
        __builtin_amdgcn_s_waitcnt(0);
        unsigned nloc = b.st[0], nx = b.st[1];
        if (nloc == 0u) { xcd_barrier_complete(bar, b.x, nloc, nx); b.st[0] = nloc; b.st[1] = nx; }
        const unsigned old = xb_add(&bar[XB_XSUB(b.x)], 1u);
        const unsigned gen = old / nloc;
        if (old + 1u == (gen + 1u) * nloc) {
            __builtin_amdgcn_fence(__ATOMIC_RELEASE, "agent");
            asm volatile("s_waitcnt vmcnt(0)" ::: "memory");
            const unsigned og = xb_add(&bar[XB_TOP], 1u);
            const unsigned tg = og / nx;
            if (og + 1u == (tg + 1u) * nx) xb_add(&bar[XB_TOPGEN], 1u);
            else XB_SPIN(xb_ld(&bar[XB_TOPGEN]) == tg, bar);
            __builtin_amdgcn_fence(__ATOMIC_ACQUIRE, "agent");
            xb_add(&bar[XB_XGEN(b.x)], 1u);
            asm volatile("s_waitcnt vmcnt(0)" ::: "memory");
        } else {
            XB_SPIN(xb_ld(&bar[XB_XGEN(b.x)]) == gen, bar);
            __builtin_amdgcn_fence(__ATOMIC_ACQUIRE, "agent");
            asm volatile("s_waitcnt vmcnt(0)" ::: "memory");
        }
    }
    __syncthreads();
}

struct Args { const float* in[33]; float* out; unsigned char* ws; int ph_lo, ph_hi, dup, pad; };
struct Frame {
    LAS unsigned char* lds;
    int tid, lane, wave;
    int vcu, G;
};
__device__ __forceinline__ float wave_sum(float v) {
#pragma unroll
    for (int o = 1; o < 64; o <<= 1) v += __shfl_xor(v, o);
    return v;
}
__device__ __forceinline__ unsigned f2bf(float f) { unsigned u = __builtin_bit_cast(unsigned, f); return (u + 0x7fffu + ((u >> 16) & 1u)) >> 16; }
__device__ __forceinline__ unsigned pk2(float lo, float hi) { return f2bf(lo) | (f2bf(hi) << 16); }

__device__ __forceinline__ void p0_transpose_item(const float* W, int K, int N, bf16* WT, LAS float* scr, int item, int lane) {
    const int nblk = N / 32, kb = item / nblk, nb = item % nblk, k0 = 64 * kb, n0 = 32 * nb;
#pragma unroll 8
    for (int i = 0; i < 32; ++i) { const int kk = 2 * i + (lane >> 5); scr[kk * 33 + (lane & 31)] = W[(size_t)(k0 + kk) * N + n0 + (lane & 31)]; }
    LDS_WAIT(); asm volatile("" ::: "memory");
    const int c = lane & 7;
#pragma unroll
    for (int j = 0; j < 4; ++j) { const int n = (lane >> 3) + 8 * j; const LAS float* s = scr + (8 * c) * 33 + n;
        v4u o; o.x = pk2(s[0 * 33], s[1 * 33]); o.y = pk2(s[2 * 33], s[3 * 33]); o.z = pk2(s[4 * 33], s[5 * 33]); o.w = pk2(s[6 * 33], s[7 * 33]);
        *(GAS v4u*)(WT + (size_t)(n0 + n) * K + k0 + 8 * c) = o; }
    LDS_WAIT(); asm volatile("" ::: "memory");
}
__device__ __forceinline__ void p0_mod(Frame& F, const Args& a) {
    LAS float* cact = (LAS float*)(F.lds + RING_OFF);
    LAS float* red = cact + 2 * 4096;
    const float* c = a.in[1]; const float* mw = a.in[2]; const float* mb = a.in[3]; float* MOD = (float*)(a.ws + WS_MOD);
    for (int i = F.tid; i < 2 * 4096; i += NWAVES * 64) cact[i] = siluf_(c[i]);
    __syncthreads();
    const int rg = F.lane >> 4, cq = F.lane & 15;
    for (int it = F.vcu; it < 4 * 192; it += F.G) {
        const int layer = it / 192, cb = it % 192;
        const float* wp = mw + (size_t)layer * 4096 * 12288 + (size_t)(F.wave * 4 + rg) * 12288 + cb * 64 + cq * 4;
        f32x4 a0 = {0.f, 0.f, 0.f, 0.f}, a1 = {0.f, 0.f, 0.f, 0.f};
#pragma unroll 8
        for (int s = 0; s < 128; ++s) { const f32x4 w = *(const GAS f32x4*)(wp + (size_t)s * 32 * 12288); const int k = F.wave * 4 + rg + 32 * s;
            const float c0 = cact[k], c1 = cact[4096 + k]; a0 += w * c0; a1 += w * c1; }
#pragma unroll
        for (int j = 0; j < 4; ++j) { a0[j] += __shfl_xor(a0[j], 16); a0[j] += __shfl_xor(a0[j], 32); a1[j] += __shfl_xor(a1[j], 16); a1[j] += __shfl_xor(a1[j], 32); }
        if (F.lane < 16) { *(LAS f32x4*)(red + (F.wave * 2 + 0) * 64 + cq * 4) = a0; *(LAS f32x4*)(red + (F.wave * 2 + 1) * 64 + cq * 4) = a1; }
        __syncthreads();
        if (F.tid < 128) { const int b = F.tid >> 6, col = F.tid & 63; float s = mb[layer * 12288 + cb * 64 + col];
#pragma unroll
            for (int w = 0; w < 8; ++w) s += red[(w * 2 + b) * 64 + col];
            MOD[((size_t)layer * 2 + b) * 12288 + cb * 64 + col] = s; }
        __syncthreads();
    }
}
__device__ __forceinline__ void p0_s5_group(Frame& F, const Args& a, int g) {
    constexpr int T = S5_T;
    LAS f32x2* pw = (LAS f32x2*)(F.lds + RING_OFF);
    LAS f32x2* bbar = pw + 2 * (T + 1) * 64;
    LAS f32x2* cc = bbar + 2 * 64 * 16;
    LAS float* kf = (LAS float*)(cc + 16 * 64);
    static_assert((2 * (T + 1) * 64 + 2 * 64 * 16 + 16 * 64) * 8 + 2 * T * 256 * 4 <= RING_BYTES, "s5 gen LDS");
    const float *b_re = a.in[9], *b_im = a.in[10], *c_re = a.in[11], *c_im = a.in[12], *dsk = a.in[13];
    float* LAMT = (float*)(a.ws + WS_LAMT);
    if (F.tid < 128) {
        const int dir = F.tid >> 6, p = F.tid & 63, gp = g * 64 + p;
        const float are = (dir ? a.in[16] : a.in[14])[gp], aim = (dir ? a.in[17] : a.in[15])[gp], ls = (dir ? a.in[19] : a.in[18])[gp];
        const float dt = expf(ls), mag = expf(are * dt), lr = mag * cosf(aim * dt), li = mag * sinf(aim * dt);
        const float den = are * are + aim * aim, nr = lr - 1.0f, rre = (nr * are + li * aim) / den, rim = (li * are - nr * aim) / den;
#pragma unroll
        for (int j = 0; j < 16; ++j) { const float br = b_re[(size_t)gp * 16 + j], bi = b_im[(size_t)gp * 16 + j]; bbar[(dir * 64 + p) * 16 + j] = (f32x2){rre * br - rim * bi, rre * bi + rim * br}; }
        float wr_ = 1.0f, wi_ = 0.0f; pw[(dir * (T + 1) + 0) * 64 + p] = (f32x2){1.0f, 0.0f};
        for (int t = 1; t <= T; ++t) { const float nr2 = wr_ * lr - wi_ * li, ni2 = wr_ * li + wi_ * lr; wr_ = nr2; wi_ = ni2; pw[(dir * (T + 1) + t) * 64 + p] = (f32x2){wr_, wi_}; }
        LAMT[((size_t)(g * 2 + dir) * 64 + p) * 2 + 0] = wr_; LAMT[((size_t)(g * 2 + dir) * 64 + p) * 2 + 1] = wi_;
    }
    for (int e = F.tid; e < 16 * 64; e += NWAVES * 64) cc[e] = (f32x2){c_re[(size_t)g * 1024 + e], c_im[(size_t)g * 1024 + e]};
    __syncthreads();
    {
        const int dir = F.tid >> 8, i = (F.tid >> 4) & 15, j = F.tid & 15;
        float acc[T];
#pragma unroll
        for (int t = 0; t < T; ++t) acc[t] = 0.f;
        for (int p = 0; p < 64; ++p) { const f32x2 C = cc[i * 64 + p], Bb = bbar[(dir * 64 + p) * 16 + j]; const float e = C.x * Bb.x - C.y * Bb.y, f = C.x * Bb.y + C.y * Bb.x;
#pragma unroll
            for (int t = 0; t < T; ++t) { const f32x2 w = pw[(dir * (T + 1) + t) * 64 + p]; acc[t] += w.x * e - w.y * f; } }
#pragma unroll
        for (int t = 0; t < T; ++t) kf[((dir * T + t) * 16 + i) * 16 + j] = acc[t];
    }
    __syncthreads();
    bf16* BY = (bf16*)(a.ws + WS_S5BY) + (size_t)g * (S5_KS * S5_KY);
    for (int q = F.tid; q < S5_KS * (S5_KY / 8); q += NWAVES * 64) {
        const int n = q / (S5_KY / 8), pc = q % (S5_KY / 8), t = n >> 4, i = n & 15, k0 = pc * 8; float v[8];
        if (k0 < S5_KS) { const int s = k0 >> 4, j0 = k0 & 15;
#pragma unroll
            for (int e = 0; e < 8; ++e) { const int j = j0 + e; float x;
                if (t > s) x = kf[((0 * T + (t - s)) * 16 + i) * 16 + j];
                else if (t < s) x = kf[((1 * T + (s - t)) * 16 + i) * 16 + j];
                else x = kf[((0 * T + 0) * 16 + i) * 16 + j] + kf[((1 * T + 0) * 16 + i) * 16 + j] + ((i == j) ? dsk[g * 16 + i] : 0.f);
                v[e] = x; }
        } else { const int kk = k0 - S5_KS, seg = kk >> 6, p0 = kk & 63, dir = seg >> 1, tp = dir ? (T - t) : (t + 1);
#pragma unroll
            for (int e = 0; e < 8; ++e) { const int p = p0 + e; const f32x2 w = pw[(dir * (T + 1) + tp) * 64 + p], C = cc[i * 64 + p];
                v[e] = (seg & 1) ? -(C.x * w.y + C.y * w.x) : (C.x * w.x - C.y * w.y); }
        }
        v4u o; o.x = pk2(v[0], v[1]); o.y = pk2(v[2], v[3]); o.z = pk2(v[4], v[5]); o.w = pk2(v[6], v[7]);
        *(GAS v4u*)(BY + (size_t)n * S5_KY + k0) = o;
    }
    bf16* BS = (bf16*)(a.ws + WS_S5BS) + (size_t)g * (256 * S5_KS);
    for (int q = F.tid; q < 256 * (S5_KS / 8); q += NWAVES * 64) {
        const int n = q / (S5_KS / 8), pc = q % (S5_KS / 8), k0 = pc * 8, s = k0 >> 4, j0 = k0 & 15, seg = n >> 6, p = n & 63, dir = seg >> 1;
        const f32x2 w = pw[(dir * (T + 1) + (dir ? s : (T - 1 - s))) * 64 + p]; float v[8];
#pragma unroll
        for (int e = 0; e < 8; ++e) { const f32x2 Bb = bbar[(dir * 64 + p) * 16 + j0 + e]; v[e] = (seg & 1) ? (w.x * Bb.y + w.y * Bb.x) : (w.x * Bb.x - w.y * Bb.y); }
        v4u o; o.x = pk2(v[0], v[1]); o.y = pk2(v[2], v[3]); o.z = pk2(v[4], v[5]); o.w = pk2(v[6], v[7]);
        *(GAS v4u*)(BS + (size_t)n * S5_KS + k0) = o;
    }
    __syncthreads();
}
__device__ __forceinline__ void p0_prologue(Frame& F, const Args& a) {
    p0_mod(F, a);
    {
        LAS float* scr = (LAS float*)(F.lds + RING_OFF + F.wave * 16384);
        const int gw = F.vcu * NWAVES + F.wave, NGW = F.G * NWAVES;
        constexpr int I_NAIN = 64 * 512, I_SQ = 64 * 128, I_S5IN = 64 * 256, I_GLAIN = 64 * 384;
        constexpr int NITEMS = 2 * I_NAIN + 2 * I_SQ + I_S5IN + 2 * I_SQ + I_GLAIN + I_SQ;
        unsigned char* ws = a.ws;
        for (int it = gw; it < NITEMS; it += NGW) {
            int r = it;
            if (r < I_NAIN) { p0_transpose_item(a.in[5], 4096, 16384, (bf16*)(ws + WS_W_NAIN0), scr, r, F.lane); continue; } r -= I_NAIN;
            if (r < I_NAIN) { p0_transpose_item(a.in[5] + (size_t)4096 * 16384, 4096, 16384, (bf16*)(ws + WS_W_NAIN1), scr, r, F.lane); continue; } r -= I_NAIN;
            if (r < I_SQ) { p0_transpose_item(a.in[7], 4096, 4096, (bf16*)(ws + WS_W_NAOUT0), scr, r, F.lane); continue; } r -= I_SQ;
            if (r < I_SQ) { p0_transpose_item(a.in[7] + (size_t)4096 * 4096, 4096, 4096, (bf16*)(ws + WS_W_NAOUT1), scr, r, F.lane); continue; } r -= I_SQ;
            if (r < I_S5IN) { p0_transpose_item(a.in[8], 4096, 8192, (bf16*)(ws + WS_W_S5IN), scr, r, F.lane); continue; } r -= I_S5IN;
            if (r < I_SQ) { p0_transpose_item(a.in[20], 4096, 4096, (bf16*)(ws + WS_W_S5GLU), scr, r, F.lane); continue; } r -= I_SQ;
            if (r < I_SQ) { p0_transpose_item(a.in[22], 4096, 4096, (bf16*)(ws + WS_W_S5OUT), scr, r, F.lane); continue; } r -= I_SQ;
            if (r < I_GLAIN) { p0_transpose_item(a.in[23], 4096, 12288, (bf16*)(ws + WS_W_GLAIN), scr, r, F.lane); continue; } r -= I_GLAIN;
            p0_transpose_item(a.in[31], 4096, 4096, (bf16*)(ws + WS_W_GLAOUT), scr, r, F.lane);
        }
        bf16* G1T = (bf16*)(ws + WS_W_GLAG1);
        for (int e = (F.vcu * NWAVES * 64 + F.tid); e < 256 * 4096 / 2; e += F.G * NWAVES * 64) {
            const int n = e / 2048, k = (e % 2048) * 2; float v0 = 0.f, v1 = 0.f;
            if (n < 16) { v0 = a.in[24][(size_t)k * 16 + n]; v1 = a.in[24][(size_t)(k + 1) * 16 + n]; }
            else if (n < 32) { v0 = a.in[27][(size_t)k * 16 + (n - 16)]; v1 = a.in[27][(size_t)(k + 1) * 16 + (n - 16)]; }
            *(GAS unsigned*)(G1T + (size_t)n * 4096 + k) = pk2(v0, v1);
        }
    }
    __syncthreads();
    for (int g = F.vcu; g < S5_G; g += F.G) p0_s5_group(F, a, g);
}

template <bool FINAL>
__device__ __forceinline__ void norm_phase(Frame& F, const float* xin, const float* nw, const float* mod  , bf16* H, float* outf) {
    LAS f32x2* tab = (LAS f32x2*)(F.lds + RING_OFF);
    for (int i = F.tid; i < 2 * 4096; i += NWAVES * 64) { const int b = i >> 12, c = i & 4095;
        if (FINAL) tab[i] = (f32x2){nw[c], 0.f};
        else tab[i] = (f32x2){nw[c] * (1.0f + mod[b * 12288 + 4096 + c]), mod[b * 12288 + c]}; }
    __syncthreads();
    const int gw = F.vcu * NWAVES + F.wave, NGW = F.G * NWAVES;
    for (int m = gw; m < M; m += NGW) {
        const int b = m >> 13; const GAS f32x4* xr = (const GAS f32x4*)(xin + (size_t)m * D) + F.lane;
        f32x4 v[16]; float s = 0.f;
#pragma unroll
        for (int j = 0; j < 16; ++j) { v[j] = xr[64 * j]; s += (v[j].x * v[j].x + v[j].y * v[j].y) + (v[j].z * v[j].z + v[j].w * v[j].w); }
        const float rstd = rsqrtf(wave_sum(s) * (1.f / D) + EPS);
#pragma unroll
        for (int j = 0; j < 16; ++j) { const int c = 4 * F.lane + 256 * j; const LAS f32x2* tp = tab + b * 4096 + c;
            const f32x2 t0 = tp[0], t1 = tp[1], t2 = tp[2], t3 = tp[3];
            const float o0 = v[j].x * rstd * t0.x + t0.y, o1 = v[j].y * rstd * t1.x + t1.y, o2 = v[j].z * rstd * t2.x + t2.y, o3 = v[j].w * rstd * t3.x + t3.y;
            if (FINAL) *((GAS f32x4*)(outf + (size_t)m * D) + F.lane + 64 * j) = (f32x4){o0, o1, o2, o3};
            else *(GAS v2u*)(H + (size_t)m * D + c) = (v2u){cvt_pk_bf16(o0, o1), cvt_pk_bf16(o2, o3)}; }
    }
    __syncthreads();
}

typedef short v4i16_t __attribute__((ext_vector_type(4)));
__device__ __forceinline__ s16x4 tr4(const LAS unsigned char* p) { return __builtin_bit_cast(s16x4, __builtin_amdgcn_ds_read_tr16_b64_v4i16((LAS v4i16_t*)p)); }
__device__ __forceinline__ bf16x8 cat8(s16x4 a, s16x4 b) { return (bf16x8){a[0], a[1], a[2], a[3], b[0], b[1], b[2], b[3]}; }
__device__ __forceinline__ bf16x8 pack8(f32x4 a, f32x4 b) { v4u w; w.x = cvt_pk_bf16(a[0], a[1]); w.y = cvt_pk_bf16(a[2], a[3]); w.z = cvt_pk_bf16(b[0], b[1]); w.w = cvt_pk_bf16(b[2], b[3]); return __builtin_bit_cast(bf16x8, w); }
#define MFMA16(a, b, c) __builtin_amdgcn_mfma_f32_16x16x32_bf16((a), (b), (c), 0, 0, 0)

constexpr int NA_PITCH = 272, NA_TILE = 64 * NA_PITCH;
__device__ __forceinline__ void na_attn_phase(Frame& F, const bf16* QKVG, bf16* Z, const float* rpb) {
    const int grp = F.wave >> 2, ct = F.wave & 3, lane = F.lane, li = lane & 15, g = lane >> 4, q4 = li >> 2, p4 = li & 3;
    const int c0 = ct * 16, kc0 = min(max(c0 - 8, 0), 32);
    const int ipw = (4096 + F.G - 1) / F.G;
    LAS unsigned char* const lbase = F.lds + RING_OFF;
    LAS float* const rp = (LAS float*)(lbase + 4 * NA_TILE + grp * 2048);
    for (int k = 0; k < ipw; ++k) {
        const int it = F.vcu * ipw + k; if (it >= 4096) break;
        const int b = it >> 11, hp = (it >> 7) & 15, r = ((it & 15) << 3) | ((it >> 4) & 7), h = hp * 2 + grp;
        const int rs = min(max(r - 4, 0), GROWS - 8);
        const size_t tok0 = (size_t)b * SEQ + (size_t)r * GRIDW;
        const bf16* qp = QKVG + (tok0 + c0 + li) * 16384 + h * 128 + 8 * g;
        bf16x8 qf[4];
#pragma unroll
        for (int ks = 0; ks < 4; ++ks) qf[ks] = *(const GAS bf16x8*)(qp + 32 * ks);
        for (int e = (F.tid & 255); e < 465; e += 256) rp[e] = rpb[h * 465 + e];
        v4u st[4];
        const bf16* kvbase = QKVG + ((size_t)b * SEQ + (size_t)rs * GRIDW + 16 * ct + g) * 16384 + h * 128 + li * 8;
#define NA_LOAD(t) do { _Pragma("unroll") for (int j = 0; j < 4; ++j) st[j] = *(const GAS v4u*)(kvbase + ((size_t)((t) & 7) * GRIDW + 4 * j) * 16384 + (((t) >> 3) ? 8192 : 4096)); } while (0)
#define NA_WRITE(buf) do { _Pragma("unroll") for (int j = 0; j < 4; ++j) *(LAS v4u*)(lbase + ((buf) * 2 + grp) * NA_TILE + (16 * ct + 4 * j + g) * NA_PITCH + li * 16) = st[j]; } while (0)
        NA_LOAD(0); NA_WRITE(0); __syncthreads();
        f32x4 S[8][2];
#pragma unroll
        for (int t = 0; t < 8; ++t) {
            NA_LOAD(t + 1);
            const LAS unsigned char* tb = lbase + ((t & 1) * 2 + grp) * NA_TILE;
            S[t][0] = (f32x4){0.f, 0.f, 0.f, 0.f}; S[t][1] = (f32x4){0.f, 0.f, 0.f, 0.f};
#pragma unroll
            for (int blk = 0; blk < 2; ++blk)
#pragma unroll
                for (int ks = 0; ks < 4; ++ks) { const bf16x8 A = *(const LAS bf16x8*)(tb + (kc0 + 16 * blk + li) * NA_PITCH + (32 * ks + 8 * g) * 2);
                    S[t][blk] = MFMA16(A, qf[ks], S[t][blk]); }
            NA_WRITE((t + 1) & 1);
            __syncthreads();
        }
        const int c = c0 + li, cs = min(max(c - 8, 0), GRIDW - 16);
        float mx = -1e30f;
#pragma unroll
        for (int t = 0; t < 8; ++t)
#pragma unroll
            for (int blk = 0; blk < 2; ++blk)
#pragma unroll
                for (int e = 0; e < 4; ++e) { const int kc = kc0 + 16 * blk + 4 * g + e; const bool valid = (kc >= cs) && (kc < cs + 16);
                    const int idx = valid ? ((rs + t - r + 7) * 31 + (kc - c + 15)) : 0;
                    const float s = valid ? (S[t][blk][e] * 0.08838834764831845f + rp[idx]) : -1e30f; S[t][blk][e] = s; mx = fmaxf(mx, s); }
        mx = fmaxf(mx, __shfl_xor(mx, 16)); mx = fmaxf(mx, __shfl_xor(mx, 32));
        float sum = 0.f;
#pragma unroll
        for (int t = 0; t < 8; ++t)
#pragma unroll
            for (int blk = 0; blk < 2; ++blk)
#pragma unroll
                for (int e = 0; e < 4; ++e) { const float p = __expf(S[t][blk][e] - mx); S[t][blk][e] = p; sum += p; }
        sum += __shfl_xor(sum, 16); sum += __shfl_xor(sum, 32);
        const float inv = 1.0f / sum;
        bf16x8 pb[8];
#pragma unroll
        for (int t = 0; t < 8; ++t) pb[t] = pack8(S[t][0], S[t][1]);
        f32x4 O[8];
#pragma unroll
        for (int db = 0; db < 8; ++db) O[db] = (f32x4){0.f, 0.f, 0.f, 0.f};
#pragma unroll
        for (int t = 8; t < 16; ++t) {
            if (t < 15) NA_LOAD(t + 1);
            const LAS unsigned char* tb = lbase + ((t & 1) * 2 + grp) * NA_TILE + (kc0 + 4 * g + q4) * NA_PITCH + 8 * p4;
#pragma unroll
            for (int db = 0; db < 8; ++db) { const s16x4 a0 = tr4(tb + 32 * db), a1 = tr4(tb + 16 * NA_PITCH + 32 * db);
                O[db] = MFMA16(cat8(a0, a1), pb[t - 8], O[db]); }
            if (t < 15) NA_WRITE((t + 1) & 1);
            __syncthreads();
        }
#undef NA_LOAD
#undef NA_WRITE
        bf16* zp = Z + (tok0 + c0 + li) * 4096 + h * 128 + 4 * g; const bf16* gp = QKVG + (tok0 + c0 + li) * 16384 + 12288 + h * 128 + 4 * g;
#pragma unroll
        for (int db = 0; db < 8; ++db) { const v2u gw = *(const GAS v2u*)(gp + 16 * db);
            const float z0 = O[db][0] * inv * siluf_(bf_lo(gw.x)), z1 = O[db][1] * inv * siluf_(bf_hi(gw.x)), z2 = O[db][2] * inv * siluf_(bf_lo(gw.y)), z3 = O[db][3] * inv * siluf_(bf_hi(gw.y));
            *(GAS v2u*)(zp + 16 * db) = (v2u){cvt_pk_bf16(z0, z1), cvt_pk_bf16(z2, z3)}; }
    }
    __syncthreads();
}

__device__ __forceinline__ void na_attn_phase2(Frame& F, const bf16* QKVG, bf16* Z, const float* rpb) {
    const int rq = F.wave >> 2, ct = F.wave & 3, lane = F.lane, li = lane & 15, g = lane >> 4, q4 = li >> 2, p4 = li & 3;
    const int c0 = ct * 16, kc0 = min(max(c0 - 8, 0), 32);
    LAS unsigned char* const lbase = F.lds + RING_OFF;
    LAS float* const rp = (LAS float*)(lbase + 6 * NA_TILE);
    const int ipw = (4096 + F.G - 1) / F.G, it0 = F.vcu * ipw;
    if (it0 >= 4096) return;
    const int nit = min(ipw, 4096 - it0);
    const bool xg = (F.G == 256);
#define NA2_ID(k_) (xg ? ((((F.vcu >> 5) * 8 + ((k_) >> 1)) << 6) | ((((k_) & 1) << 5) | (F.vcu & 31))) : (it0 + (k_)))
    const int id0 = NA2_ID(0);
    const int ptok = F.tid >> 4, pch = F.tid & 15;
    v4u R[1][3][2];
#define NA2_SEC (size_t)(2 * 32 * 8192) * 128
#define NA2_SRC(it_, ss_) (QKVG + (((ss_) >= 9) ? 2 : 1) * NA2_SEC + ((size_t)((it_) >> 6) * 8192 + (size_t)min(min(max(2 * ((it_) & 63) - 4, 0), GROWS - 8) + ((ss_) % 9), GROWS - 1) * GRIDW + ptok) * 128 + pch * 8)
#define NA2_LOADG(set_, it_, gq_) do { _Pragma("unroll") for (int jj_ = 0; jj_ < 3; ++jj_) { const bf16* s_ = NA2_SRC(it_, 3 * (gq_) + jj_); \
        R[set_][jj_][0] = *(const GAS v4u*)s_; R[set_][jj_][1] = *(const GAS v4u*)(s_ + 32 * 128); } } while (0)
#define NA2_WRITEG(set_, buf) do { _Pragma("unroll") for (int jj_ = 0; jj_ < 3; ++jj_) { LAS unsigned char* d_ = lbase + ((buf) * 3 + jj_) * NA_TILE + ptok * NA_PITCH + pch * 16; \
        *(LAS v4u*)d_ = R[set_][jj_][0]; *(LAS v4u*)(d_ + 32 * NA_PITCH) = R[set_][jj_][1]; } } while (0)
#define NA2_SCORE(kl, tb) do { S[kl][0] = (f32x4){0.f, 0.f, 0.f, 0.f}; S[kl][1] = (f32x4){0.f, 0.f, 0.f, 0.f}; \
        _Pragma("unroll") for (int blk = 0; blk < 2; ++blk) _Pragma("unroll") for (int ks = 0; ks < 4; ++ks) { \
            const bf16x8 A_ = *(const LAS bf16x8*)((tb) + (kc0 + 16 * blk + li) * NA_PITCH + (32 * ks + 8 * g) * 2); S[kl][blk] = MFMA16(A_, qf[ks], S[kl][blk]); } } while (0)
#define NA2_PV(kl, tb) do { const LAS unsigned char* t_ = (tb) + (kc0 + 4 * g + q4) * NA_PITCH + 8 * p4; \
        _Pragma("unroll") for (int db = 0; db < 8; ++db) O[db] = MFMA16(cat8(tr4(t_ + 32 * db), tr4(t_ + 16 * NA_PITCH + 32 * db)), pb[kl], O[db]); } while (0)
    NA2_LOADG(0, id0, 0);
    bf16x8 qf[4];
    { const int rp_ = id0 & 63, r_ = 2 * rp_ + rq;
      const bf16* qp = QKVG + ((size_t)(id0 >> 6) * 8192 + (size_t)r_ * GRIDW + c0 + li) * 128 + 8 * g;
#pragma unroll
      for (int ks = 0; ks < 4; ++ks) qf[ks] = *(const GAS bf16x8*)(qp + 32 * ks); }
    NA2_WRITEG(0, 0);
    __syncthreads();
    for (int k = 0; k < nit; ++k) {
        const int it = NA2_ID(k), itn = NA2_ID(k + 1), b = it >> 11, h = (it >> 6) & 31, rpi = it & 63;
        const int base = min(max(2 * rpi - 4, 0), GROWS - 8), r = 2 * rpi + rq, rsw = min(max(r - 4, 0), GROWS - 8), offw = rsw - base;
        const bool has_next = (k + 1 < nit);
        for (int e = F.tid; e < 465; e += NWAVES * 64) rp[e] = rpb[h * 465 + e];
        f32x4 S[8][2];
#pragma unroll
        for (int gi = 0; gi < 3; ++gi) {
            NA2_LOADG(0, it, gi + 1);
#pragma unroll
            for (int jj = 0; jj < 3; ++jj) { const int j = 3 * gi + jj; const LAS unsigned char* tb = lbase + ((gi & 1) * 3 + jj) * NA_TILE;
                if (offw == 0) { if (j < 8) NA2_SCORE((j < 8 ? j : 0), tb); } else { if (j >= 1) NA2_SCORE((j >= 1 ? j - 1 : 0), tb); }
                asm volatile("" ::: "memory"); }
            NA2_WRITEG(0, (gi + 1) & 1);
            __syncthreads();
        }
        int lz = F.lane; asm volatile("" : "+v"(lz)); const int liz = lz & 15, gz = lz >> 4, c = c0 + liz, cs = min(max(c - 8, 0), GRIDW - 16);
        float mx = -1e30f;
#pragma unroll
        for (int t = 0; t < 8; ++t) {
#pragma unroll
            for (int blk = 0; blk < 2; ++blk)
#pragma unroll
                for (int e = 0; e < 4; ++e) { const int kc = kc0 + 16 * blk + 4 * gz + e; const bool valid = (kc >= cs) && (kc < cs + 16);
                    const int idx = (rsw + t - r + 7) * 31 + min(max(kc - c + 15, 0), 30); const float bias = rp[idx];
                    const float sv = valid ? (S[t][blk][e] * 0.08838834764831845f + bias) : -1e30f; S[t][blk][e] = sv; mx = fmaxf(mx, sv); }
            asm volatile("" ::: "memory"); }
        mx = fmaxf(mx, __shfl_xor(mx, 16)); mx = fmaxf(mx, __shfl_xor(mx, 32));
        float sum = 0.f;
#pragma unroll
        for (int t = 0; t < 8; ++t)
#pragma unroll
            for (int blk = 0; blk < 2; ++blk)
#pragma unroll
                for (int e = 0; e < 4; ++e) { const float p = __expf(S[t][blk][e] - mx); S[t][blk][e] = p; sum += p; }
        sum += __shfl_xor(sum, 16); sum += __shfl_xor(sum, 32);
        const float inv = 1.0f / sum;
        bf16x8 pb[8];
#pragma unroll
        for (int t = 0; t < 8; ++t) pb[t] = pack8(S[t][0], S[t][1]);
        f32x4 O[8];
#pragma unroll
        for (int db = 0; db < 8; ++db) O[db] = (f32x4){0.f, 0.f, 0.f, 0.f};
        v2u gw[8];
        bf16x8 qn[4];
#pragma unroll
        for (int gi = 0; gi < 3; ++gi) {
            const int sg = 3 + gi;
            if (sg + 1 < 6) NA2_LOADG(0, it, sg + 1); else if (has_next) NA2_LOADG(0, itn, 0);
            if (gi == 2 && has_next) { const int rpn = itn & 63, rn = 2 * rpn + rq;
                const bf16* qp = QKVG + ((size_t)(itn >> 6) * 8192 + (size_t)rn * GRIDW + c0 + li) * 128 + 8 * g;
#pragma unroll
                for (int ks = 0; ks < 4; ++ks) qn[ks] = *(const GAS bf16x8*)(qp + 32 * ks); }
#pragma unroll
            for (int jj = 0; jj < 3; ++jj) { const int j = 3 * gi + jj; const LAS unsigned char* tb = lbase + ((sg & 1) * 3 + jj) * NA_TILE;
                if (offw == 0) { if (j < 8) NA2_PV((j < 8 ? j : 0), tb); } else { if (j >= 1) NA2_PV((j >= 1 ? j - 1 : 0), tb); }
                asm volatile("" ::: "memory"); }
            if (sg + 1 < 6 || has_next) NA2_WRITEG(0, (sg + 1) & 1);
            __syncthreads();
        }
        int lq = F.lane; asm volatile("" : "+v"(lq)); const int liq = lq & 15, gq = lq >> 4;
        const size_t mq = (size_t)b * SEQ + (size_t)r * GRIDW + c0 + liq;
        const bf16* gp = QKVG + 3 * NA2_SEC + ((size_t)(it >> 6) * 8192 + (size_t)r * GRIDW + c0 + liq) * 128 + 4 * gq;
        bf16* zp = Z + mq * 4096 + h * 128 + 4 * gq;
#pragma unroll
        for (int db = 0; db < 8; ++db) gw[db] = *(const GAS v2u*)(gp + 16 * db);
#pragma unroll
        for (int db = 0; db < 8; ++db) {
            const float z0 = O[db][0] * inv * siluf_(bf_lo(gw[db].x)), z1 = O[db][1] * inv * siluf_(bf_hi(gw[db].x)), z2 = O[db][2] * inv * siluf_(bf_lo(gw[db].y)), z3 = O[db][3] * inv * siluf_(bf_hi(gw[db].y));
            *(GAS v2u*)(zp + 16 * db) = (v2u){cvt_pk_bf16(z0, z1), cvt_pk_bf16(z2, z3)}; }
        if (has_next) {
#pragma unroll
            for (int ks = 0; ks < 4; ++ks) qf[ks] = qn[ks]; }
    }
#undef NA2_SRC
#undef NA2_SEC
#undef NA2_ID
#undef NA2_LOADG
#undef NA2_WRITEG
#undef NA2_SCORE
#undef NA2_PV
    __syncthreads();
}

__device__ __forceinline__ void s5_scan_phase(Frame& F, const Args& a) {
    const float* Sloc = (const float*)(a.ws + WS_S5_SLOC); bf16* Ug = (bf16*)(a.ws + WS_S5_UG); const float* LAMT = (const float*)(a.ws + WS_LAMT);
    const int t8 = F.tid & 255, b = t8 >> 7, dir = (t8 >> 6) & 1, p = t8 & 63;
    for (int gi = F.vcu * 2 + (F.tid >> 8); gi < S5_G; gi += F.G * 2) {
        const float lr = LAMT[((size_t)(gi * 2 + dir) * 64 + p) * 2 + 0], li = LAMT[((size_t)(gi * 2 + dir) * 64 + p) * 2 + 1];
        float xr = 0.f, xi = 0.f;
#pragma unroll 8
        for (int s = 0; s < S5_NCHB; ++s) { const int c = dir ? (S5_NCHB - 1 - s) : s; const size_t row = (size_t)gi * S5_NCH + b * S5_NCHB + c;
            bf16* up = Ug + row * S5_KY + S5_KS + dir * 128 + p;
            up[0] = (bf16)f2bf(xr); up[64] = (bf16)f2bf(xi);
            const float sr = Sloc[row * 256 + dir * 128 + p], si = Sloc[row * 256 + dir * 128 + 64 + p];
            const float nr = lr * xr - li * xi + sr, ni = lr * xi + li * xr + si; xr = nr; xi = ni; }
    }
}

__device__ __forceinline__ float log_sigmoidf_(float z) { return fminf(z, 0.f) - log1pf(expf(-fabsf(z))); }
__device__ __forceinline__ void gla_prep_phase(Frame& F, const Args& a) {
    const bf16* IN = (const bf16*)(a.ws + WS_GLA_IN); const float* G1P = (const float*)(a.ws + WS_GLA_G1P);
    bf16* PREP = (bf16*)(a.ws + WS_GLA_PREP); float* DECAY = (float*)(a.ws + WS_GLA_DECAY);
    LAS float* g1s = (LAS float*)(F.lds + RING_OFF);
    LAS float* Bc = g1s + 64 * 32;
    LAS float* bl = Bc + 2 * 64 * 256;
    static_assert((64 * 32 + 2 * 64 * 256 + 2 * 256) * 4 <= MISC_OFF, "gla prep LDS");
    const int ipw = (2048 + F.G - 1) / F.G; int cur_chunk = -1;
    for (int k = 0; k < ipw; ++k) {
        const int it = F.vcu * ipw + k; if (it >= 2048) break;
        const int cidx = it >> 3, h = it & 7, m0 = cidx * GLA_C, dbase = h * 256;
        if (cidx != cur_chunk) { cur_chunk = cidx;
            const int tok = F.tid >> 3, qd = F.tid & 7; f32x4 s4 = {0.f, 0.f, 0.f, 0.f};
#pragma unroll
            for (int ks = 0; ks < 4; ++ks) s4 += *(const GAS f32x4*)(G1P + ((size_t)ks * M + m0 + tok) * 32 + qd * 4);
            *(LAS f32x4*)(g1s + tok * 32 + qd * 4) = s4;
            __syncthreads(); }
        v4u q8[4], k8[4];
#pragma unroll
        for (int j = 0; j < 4; ++j) { const int e = F.tid + 512 * j, tok = e >> 5, c8 = (e & 31) * 8; const size_t m = (size_t)m0 + tok;
            q8[j] = *(const GAS v4u*)(IN + m * GLA_NIN + dbase + c8); k8[j] = *(const GAS v4u*)(IN + m * GLA_NIN + GLA_KW + dbase + c8); }
        {
            const int dir = F.tid >> 8, col = F.tid & 255, d = dbase + col;
            const float* w2 = dir ? a.in[28] : a.in[25]; const float bgd = (dir ? a.in[29] : a.in[26])[d];
            float w2r[16];
#pragma unroll
            for (int r = 0; r < 16; ++r) w2r[r] = w2[(size_t)r * GLA_KW + d];
            float run = 0.f;
#pragma unroll 4
            for (int s = 0; s < 64; ++s) { const int i = dir ? (63 - s) : s; const LAS f32x4* gp = (const LAS f32x4*)(g1s + i * 32 + dir * 16); float z = bgd;
                const f32x4 g0 = gp[0], g1 = gp[1], g2 = gp[2], g3 = gp[3];
                z += g0[0] * w2r[0] + g0[1] * w2r[1] + g0[2] * w2r[2] + g0[3] * w2r[3]; z += g1[0] * w2r[4] + g1[1] * w2r[5] + g1[2] * w2r[6] + g1[3] * w2r[7];
                z += g2[0] * w2r[8] + g2[1] * w2r[9] + g2[2] * w2r[10] + g2[3] * w2r[11]; z += g3[0] * w2r[12] + g3[1] * w2r[13] + g3[2] * w2r[14] + g3[3] * w2r[15];
                const float ls = fminf(z, 0.f) - __logf(1.0f + __expf(-fabsf(z)));
                run += ls * (1.0f / 16.0f); Bc[(dir * 64 + i) * 256 + col] = run; }
            bl[dir * 256 + col] = run;
        }
        __syncthreads();
#pragma unroll
        for (int j = 0; j < 4; ++j) { const int e = F.tid + 512 * j, tok = e >> 5, c8 = (e & 31) * 8; const size_t m = (size_t)m0 + tok;
            float qv[8], kv[8];
#pragma unroll
            for (int x = 0; x < 4; ++x) { qv[2 * x] = bf_lo(q8[j][x]) * 0.0625f; qv[2 * x + 1] = bf_hi(q8[j][x]) * 0.0625f; kv[2 * x] = bf_lo(k8[j][x]); kv[2 * x + 1] = bf_hi(k8[j][x]); }
#pragma unroll
            for (int dir = 0; dir < 2; ++dir) {
                f32x4 bbv[2], btv[2];
                bbv[0] = *(const LAS f32x4*)(Bc + (dir * 64 + tok) * 256 + c8); bbv[1] = *(const LAS f32x4*)(Bc + (dir * 64 + tok) * 256 + c8 + 4);
                btv[0] = *(const LAS f32x4*)(bl + dir * 256 + c8); btv[1] = *(const LAS f32x4*)(bl + dir * 256 + c8 + 4);
                float o0[8], o1[8], o2[8];
#pragma unroll
                for (int x = 0; x < 8; ++x) { const float bx = bbv[x >> 2][x & 3], tx = btv[x >> 2][x & 3]; o0[x] = qv[x] * __expf(bx); o1[x] = kv[x] * __expf(-bx); o2[x] = kv[x] * __expf(tx - bx); }
                v4u w0, w1, w2;
#pragma unroll
                for (int x = 0; x < 4; ++x) { w0[x] = cvt_pk_bf16(o0[2 * x], o0[2 * x + 1]); w1[x] = cvt_pk_bf16(o1[2 * x], o1[2 * x + 1]); w2[x] = cvt_pk_bf16(o2[2 * x], o2[2 * x + 1]); }
                bf16* pp = PREP + (size_t)(dir * 3) * M * GLA_KW + m * GLA_KW + dbase + c8;
                *(GAS v4u*)(pp) = w0; *(GAS v4u*)(pp + (size_t)M * GLA_KW) = w1; *(GAS v4u*)(pp + (size_t)2 * M * GLA_KW) = w2;
                if (tok == 0) { float* dp = DECAY + ((size_t)dir * GLA_NCH + cidx) * GLA_KW + dbase + c8;
                    *(GAS f32x4*)(dp) = (f32x4){__expf(btv[0][0]), __expf(btv[0][1]), __expf(btv[0][2]), __expf(btv[0][3])}; *(GAS f32x4*)(dp + 4) = (f32x4){__expf(btv[1][0]), __expf(btv[1][1]), __expf(btv[1][2]), __expf(btv[1][3])}; }
            }
        }
        __syncthreads();
    }
}

constexpr int GLA_PQ = 528, GLA_PV = 272, GLA_PVI = 1040;
__device__ __forceinline__ void gla_chain_role(Frame& F, const Args& a, int ch) {
    const bf16* IN = (const bf16*)(a.ws + WS_GLA_IN); const bf16* PREP = (const bf16*)(a.ws + WS_GLA_PREP); const float* DECAY = (const float*)(a.ws + WS_GLA_DECAY);
    const int b = ch >> 6, h = (ch >> 3) & 7, dir = (ch >> 2) & 1, vq = ch & 3;
    bf16* OUT = (bf16*)(a.ws + WS_GLA_O) + (size_t)(1 + dir) * M * 4096;
    const bf16* QS = PREP + (size_t)(dir * 3 + 0) * M * GLA_KW; const bf16* KE = PREP + (size_t)(dir * 3 + 2) * M * GLA_KW;
    LAS unsigned char* const qsT = F.lds + RING_OFF; LAS unsigned char* const keT = qsT + 64 * GLA_PQ; LAS unsigned char* const vT = keT + 64 * GLA_PQ; LAS float* const decT = (LAS float*)(vT + 64 * GLA_PV);
    const int lane = F.lane, li = lane & 15, g = lane >> 4, q4 = li >> 2, p4 = li & 3, w = F.wave;
    f32x4 S[16];
#pragma unroll
    for (int dt = 0; dt < 16; ++dt) S[dt] = (f32x4){0.f, 0.f, 0.f, 0.f};
    v4u rq[4], rk[4], rv[2]; f32x4 rd = {0.f, 0.f, 0.f, 0.f};
#define GC_LOAD(sidx) do { const int cn_ = dir ? (GLA_NCHB - 1 - (sidx)) : (sidx); const size_t m0_ = ((size_t)b * GLA_NCHB + cn_) * GLA_C; \
        _Pragma("unroll") for (int j = 0; j < 4; ++j) { const int e = F.tid + 512 * j, tok = e >> 5, pc = e & 31; \
            rq[j] = *(const GAS v4u*)(QS + (m0_ + tok) * GLA_KW + h * 256 + pc * 8); rk[j] = *(const GAS v4u*)(KE + (m0_ + tok) * GLA_KW + h * 256 + pc * 8); } \
        _Pragma("unroll") for (int j = 0; j < 2; ++j) { const int e = F.tid + 512 * j, tok = e >> 4, pc = e & 15; \
            rv[j] = *(const GAS v4u*)(IN + (m0_ + tok) * GLA_NIN + 4096 + h * 512 + vq * 128 + pc * 8); } \
        if (F.tid < 64) rd = *(const GAS f32x4*)(DECAY + ((size_t)dir * GLA_NCH + b * GLA_NCHB + cn_) * GLA_KW + h * 256 + F.tid * 4); } while (0)
    GC_LOAD(0);
    for (int sidx = 0; sidx < GLA_NCHB; ++sidx) {
#pragma unroll
        for (int j = 0; j < 4; ++j) { const int e = F.tid + 512 * j, tok = e >> 5, pc = e & 31; *(LAS v4u*)(qsT + tok * GLA_PQ + pc * 16) = rq[j]; *(LAS v4u*)(keT + tok * GLA_PQ + pc * 16) = rk[j]; }
#pragma unroll
        for (int j = 0; j < 2; ++j) { const int e = F.tid + 512 * j, tok = e >> 4, pc = e & 15; *(LAS v4u*)(vT + tok * GLA_PV + pc * 16) = rv[j]; }
        if (F.tid < 64) *(LAS f32x4*)(decT + F.tid * 4) = rd;
        __syncthreads();
        const int cn = dir ? (GLA_NCHB - 1 - sidx) : sidx; const size_t m0 = ((size_t)b * GLA_NCHB + cn) * GLA_C;
        if (sidx + 1 < GLA_NCHB) GC_LOAD(sidx + 1);
        v2u Sb[16];
#pragma unroll
        for (int dt = 0; dt < 16; ++dt) Sb[dt] = (v2u){cvt_pk_bf16(S[dt][0], S[dt][1]), cvt_pk_bf16(S[dt][2], S[dt][3])};
#pragma unroll
        for (int ib = 0; ib < 4; ++ib) { f32x4 acc = {0.f, 0.f, 0.f, 0.f}; const LAS unsigned char* qrow = qsT + (16 * ib + li) * GLA_PQ + 8 * g;
#pragma unroll
            for (int ks = 0; ks < 8; ++ks) { const v2u b0 = *(const LAS v2u*)(qrow + 64 * ks), b1 = *(const LAS v2u*)(qrow + 64 * ks + 32);
                const bf16x8 A = __builtin_bit_cast(bf16x8, (v4u){Sb[2 * ks].x, Sb[2 * ks].y, Sb[2 * ks + 1].x, Sb[2 * ks + 1].y});
                const bf16x8 B = __builtin_bit_cast(bf16x8, (v4u){b0.x, b0.y, b1.x, b1.y});
                acc = MFMA16(A, B, acc); }
            if (MK_DIAG && (!(fabsf(acc[0]) < 1e30f) || !(fabsf(acc[1]) < 1e30f) || !(fabsf(acc[2]) < 1e30f) || !(fabsf(acc[3]) < 1e30f))) atomicOr((unsigned*)(a.ws + WS_CTL) + 17, 1u << 7);
            *(GAS v2u*)(OUT + (m0 + 16 * ib + li) * 4096 + h * 512 + vq * 128 + w * 16 + 4 * g) = (v2u){cvt_pk_bf16(acc[0], acc[1]), cvt_pk_bf16(acc[2], acc[3])}; }
#pragma unroll
        for (int dt = 0; dt < 16; ++dt) S[dt] *= *(const LAS f32x4*)(decT + 16 * dt + 4 * g);
#pragma unroll
        for (int k2 = 0; k2 < 2; ++k2) { const LAS unsigned char* vb = vT + (32 * k2 + 8 * g + q4) * GLA_PV + (w * 16 + 4 * p4) * 2;
            const bf16x8 Bv = cat8(tr4(vb), tr4(vb + 4 * GLA_PV));
            const LAS unsigned char* kb = keT + (32 * k2 + 8 * g + q4) * GLA_PQ + 8 * p4;
#pragma unroll
            for (int dt = 0; dt < 16; ++dt) { const bf16x8 A = cat8(tr4(kb + 32 * dt), tr4(kb + 4 * GLA_PQ + 32 * dt)); S[dt] = MFMA16(A, Bv, S[dt]); } }
        __syncthreads();
    }
#undef GC_LOAD
}
__device__ __forceinline__ void gla_intra_role(Frame& F, const Args& a, int it) {
    const bf16* IN = (const bf16*)(a.ws + WS_GLA_IN); const bf16* PREP = (const bf16*)(a.ws + WS_GLA_PREP);
    bf16* OUT = (bf16*)(a.ws + WS_GLA_O);
    const int b = it >> 10, h = (it >> 7) & 7, cn = it & 127; const size_t m0 = ((size_t)b * GLA_NCHB + cn) * GLA_C;
    LAS unsigned char* const kfT = F.lds + RING_OFF; LAS unsigned char* const kbT = kfT + 64 * GLA_PQ; LAS unsigned char* const vT = kbT + 64 * GLA_PQ;
    const int lane = F.lane, li = lane & 15, g = lane >> 4, q4 = li >> 2, p4 = li & 3, ib = F.wave & 3, vh = F.wave >> 2;
    const bf16* KSF = PREP + (size_t)1 * M * GLA_KW; const bf16* KSB = PREP + (size_t)4 * M * GLA_KW;
    const bf16* QSF = PREP; const bf16* QSB = PREP + (size_t)3 * M * GLA_KW;
    {
        v4u r0[4], r1[4], r2[8];
#pragma unroll
        for (int j = 0; j < 4; ++j) { const int e = F.tid + 512 * j, tok = e >> 5, pc = e & 31; r0[j] = *(const GAS v4u*)(KSF + (m0 + tok) * GLA_KW + h * 256 + pc * 8); r1[j] = *(const GAS v4u*)(KSB + (m0 + tok) * GLA_KW + h * 256 + pc * 8); }
#pragma unroll
        for (int j = 0; j < 8; ++j) { const int e = F.tid + 512 * j, tok = e >> 6, pc = e & 63; r2[j] = *(const GAS v4u*)(IN + (m0 + tok) * GLA_NIN + 4096 + h * 512 + pc * 8); }
#pragma unroll
        for (int j = 0; j < 4; ++j) { const int e = F.tid + 512 * j, tok = e >> 5, pc = e & 31; *(LAS v4u*)(kfT + tok * GLA_PQ + pc * 16) = r0[j]; *(LAS v4u*)(kbT + tok * GLA_PQ + pc * 16) = r1[j]; }
#pragma unroll
        for (int j = 0; j < 8; ++j) { const int e = F.tid + 512 * j, tok = e >> 6, pc = e & 63; *(LAS v4u*)(vT + tok * GLA_PVI + pc * 16) = r2[j]; }
    }
    bf16x8 qf[8], qb[8];
#pragma unroll
    for (int ks = 0; ks < 8; ++ks) { qf[ks] = *(const GAS bf16x8*)(QSF + (m0 + 16 * ib + li) * GLA_KW + h * 256 + 32 * ks + 8 * g); qb[ks] = *(const GAS bf16x8*)(QSB + (m0 + 16 * ib + li) * GLA_KW + h * 256 + 32 * ks + 8 * g); }
    __syncthreads();
    f32x4 P[4];
#pragma unroll
    for (int jb = 0; jb < 4; ++jb) { f32x4 sf = {0.f, 0.f, 0.f, 0.f}, sb = {0.f, 0.f, 0.f, 0.f};
        if (jb <= ib) {
#pragma unroll
            for (int ks = 0; ks < 8; ++ks) sf = MFMA16(*(const LAS bf16x8*)(kfT + (16 * jb + li) * GLA_PQ + (32 * ks + 8 * g) * 2), qf[ks], sf); }
        if (jb >= ib) {
#pragma unroll
            for (int ks = 0; ks < 8; ++ks) sb = MFMA16(*(const LAS bf16x8*)(kbT + (16 * jb + li) * GLA_PQ + (32 * ks + 8 * g) * 2), qb[ks], sb); }
#pragma unroll
        for (int e = 0; e < 4; ++e) { const int ii = 16 * ib + li, jj = 16 * jb + 4 * g + e; P[jb][e] = (ii >= jj) ? sf[e] : sb[e]; } }
    if (MK_DIAG) { bool bad = false;
#pragma unroll
        for (int jb = 0; jb < 4; ++jb)
#pragma unroll
            for (int e = 0; e < 4; ++e) bad |= !(fabsf(P[jb][e]) < 1e30f);
        if (bad) atomicOr((unsigned*)(a.ws + WS_CTL) + 17, 1u << 4); }
    const bf16x8 Pb0 = pack8(P[0], P[1]), Pb1 = pack8(P[2], P[3]);
    bf16* op = OUT + (m0 + 16 * ib + li) * 4096 + h * 512 + vh * 256 + 4 * g;
    const LAS unsigned char* vb = vT + (4 * g + q4) * GLA_PVI + (vh * 256 + 4 * p4) * 2;
#pragma unroll
    for (int vt = 0; vt < 16; ++vt) { f32x4 acc = {0.f, 0.f, 0.f, 0.f};
        acc = MFMA16(cat8(tr4(vb + 32 * vt), tr4(vb + 16 * GLA_PVI + 32 * vt)), Pb0, acc);
        acc = MFMA16(cat8(tr4(vb + 32 * GLA_PVI + 32 * vt), tr4(vb + 48 * GLA_PVI + 32 * vt)), Pb1, acc);
        if (MK_DIAG && (!(fabsf(acc[0]) < 1e30f) || !(fabsf(acc[1]) < 1e30f) || !(fabsf(acc[2]) < 1e30f) || !(fabsf(acc[3]) < 1e30f))) atomicOr((unsigned*)(a.ws + WS_CTL) + 17, 1u << 5);
        *(GAS v2u*)(op + 16 * vt) = (v2u){cvt_pk_bf16(acc[0], acc[1]), cvt_pk_bf16(acc[2], acc[3])}; }
    __syncthreads();
}
__device__ __forceinline__ void gla_main_phase(Frame& F, const Args& a) {
    if (F.vcu < 128) { for (int ch = F.vcu; ch < 128; ch += 128) gla_chain_role(F, a, ch); }
    else { for (int it = F.vcu - 128; it < 2048; it += F.G - 128) gla_intra_role(F, a, it); }
}
__device__ __forceinline__ void gla_combine_phase(Frame& F, const Args& a) {
    const bf16* IN = (const bf16*)(a.ws + WS_GLA_IN); const bf16* O = (const bf16*)(a.ws + WS_GLA_O); bf16* Z = (bf16*)(a.ws + WS_GLA_Z);
    const float* nw = a.in[30];
    float nwr[8];
#pragma unroll
    for (int x = 0; x < 8; ++x) nwr[x] = nw[F.lane * 8 + x];
    const int gw = F.vcu * NWAVES + F.wave, NGW = F.G * NWAVES;
    for (int m = gw; m < M; m += NGW) {
#pragma unroll 2
        for (int h = 0; h < 8; ++h) { const size_t off = (size_t)m * 4096 + h * 512 + F.lane * 8;
            const v4u x0 = *(const GAS v4u*)(O + off), x1 = *(const GAS v4u*)(O + (size_t)M * 4096 + off), x2 = *(const GAS v4u*)(O + (size_t)2 * M * 4096 + off);
            const v4u gg = *(const GAS v4u*)(IN + (size_t)m * GLA_NIN + 8192 + h * 512 + F.lane * 8);
            if (MK_DIAG) { bool b0 = false, b1 = false, b2 = false, b3 = false;
#pragma unroll
                for (int x = 0; x < 4; ++x) { b0 |= !(fabsf(bf_lo(x0[x])) < 1e30f) || !(fabsf(bf_hi(x0[x])) < 1e30f); b1 |= !(fabsf(bf_lo(x1[x])) < 1e30f) || !(fabsf(bf_hi(x1[x])) < 1e30f);
                    b2 |= !(fabsf(bf_lo(x2[x])) < 1e30f) || !(fabsf(bf_hi(x2[x])) < 1e30f); b3 |= !(fabsf(bf_lo(gg[x])) < 1e30f) || !(fabsf(bf_hi(gg[x])) < 1e30f); }
                const unsigned f = (b0 ? 1024u : 0u) | (b1 ? 2048u : 0u) | (b2 ? 4096u : 0u) | (b3 ? 8192u : 0u); if (f) atomicOr((unsigned*)(a.ws + WS_CTL) + 17, f); }
            float o[8]; float ss = 0.f;
#pragma unroll
            for (int x = 0; x < 4; ++x) { o[2 * x] = bf_lo(x0[x]) + bf_lo(x1[x]) + bf_lo(x2[x]); o[2 * x + 1] = bf_hi(x0[x]) + bf_hi(x1[x]) + bf_hi(x2[x]); ss += o[2 * x] * o[2 * x] + o[2 * x + 1] * o[2 * x + 1]; }
            const float rstd = rsqrtf(wave_sum(ss) * (1.0f / 512.0f) + EPS);
            v4u zw;
#pragma unroll
            for (int x = 0; x < 4; ++x) zw[x] = cvt_pk_bf16(o[2 * x] * rstd * nwr[2 * x] * siluf_(bf_lo(gg[x])), o[2 * x + 1] * rstd * nwr[2 * x + 1] * siluf_(bf_hi(gg[x])));
            *(GAS v4u*)(Z + off) = zw; }
    }
}

constexpr int NPH = 23;
__global__ void __launch_bounds__(NWAVES * 64, 2) fwd_kernel(Args args) {
    extern __shared__ __attribute__((aligned(16))) unsigned char lds[];
    Frame F;
    F.lds = (LAS unsigned char*)lds;
    F.tid = threadIdx.x; F.lane = F.tid & 63; F.wave = __builtin_amdgcn_readfirstlane(F.tid >> 6);
    F.G = gridDim.x; { const int bx = blockIdx.x; F.vcu = (F.G % 8 == 0) ? (bx % 8) * (F.G / 8) + bx / 8 : bx; }
    volatile LAS unsigned* MISC = (volatile LAS unsigned*)(F.lds + MISC_OFF);
    for (int u = F.tid; u < (LDS_BYTES - MISC_OFF) / 4; u += NWAVES * 64) MISC[u] = 0u;
    __syncthreads();
    unsigned char* ws = args.ws;
    const int lo = args.ph_lo, hi = args.ph_hi, rep = args.dup;
    XcdBarrier bar; bar.bar = (unsigned*)(ws + WS_CTL) + CW_BAR; bar.x = 0; bar.st = nullptr;
    if (hi - lo > 1) bar = xcd_barrier_post((unsigned*)(ws + WS_CTL) + CW_BAR, MISC + 8);
#define IN(k) (lo <= (k) && (k) < hi)
#define REP(k)
#if MK_PROF
    volatile LAS unsigned long long* PROF = (volatile LAS unsigned long long*)(F.lds + 135168);
    if (F.tid == 0) PROF[0] = __builtin_amdgcn_s_memrealtime();
#define SEAM(k) do { if (IN(k) && IN((k) + 1)) { if (F.tid == 0) PROF[32 + (k)] = __builtin_amdgcn_s_memrealtime(); xcd_barrier(bar); if (F.tid == 0) PROF[1 + (k)] = __builtin_amdgcn_s_memrealtime(); } } while (0)
#else
#define SEAM(k) do { if (IN(k) && IN((k) + 1)) xcd_barrier(bar); } while (0)
#endif
    const float* MOD = (const float*)(ws + WS_MOD);
    bf16* H = (bf16*)(ws + WS_H);
    float* XO = args.out;
    LAS unsigned char* ring = F.lds + RING_OFF;
    unsigned* const DFLAG = (unsigned*)(ws + WS_CTL) + 16;

    if (IN(0)) { REP(0) { p0_prologue(F, args); } } SEAM(0);

#if MK_NLAYERS >= 1
    if (IN(1)) { REP(1) { norm_phase<false>(F, args.in[0], args.in[4] + 0 * D, MOD + 0 * 2 * 12288, H, nullptr); } } SEAM(1);
    if (IN(2)) { REP(2) { pg8::Gemm g{H, (const bf16*)(ws + WS_W_NAIN0), 4096, 4096, 4096, DFLAG, 1u << 2}; pg8::StaticOrder S; S.init(M, 16384, F.G, (int)blockIdx.x);
        pg8::EpiNaIn E{(bf16*)(ws + WS_NA_QKVG)};
        pg8::gemm_phase<pg8::EpiNaIn, pg8::StaticOrder, true, true>(ring, g, S, E); } } SEAM(2);
    if (IN(3)) { REP(3) na_attn_phase2(F, (const bf16*)(ws + WS_NA_QKVG), (bf16*)(ws + WS_NA_Z), args.in[6] + 0 * 32 * 465); } SEAM(3);
    if (IN(4)) { REP(4) { pg8::Gemm g{(const bf16*)(ws + WS_NA_Z), (const bf16*)(ws + WS_W_NAOUT0), 4096, 4096, 4096, DFLAG, 1u << 4}; pg8::StaticOrder S; S.init(M, 4096, F.G, (int)blockIdx.x);
        pg8::EpiResid E{args.in[0], rep ? (float*)(ws + WS_SCR) : XO, D, MOD + 0 * 2 * 12288 + 8192, 12288, SEQ};
        pg8::gemm_phase<pg8::EpiResid, pg8::StaticOrder, true, true>(ring, g, S, E); } } SEAM(4);
#endif
#if MK_NLAYERS >= 2
    if (IN(5)) { REP(5) { norm_phase<false>(F, XO, args.in[4] + 1 * D, MOD + 1 * 2 * 12288, H, nullptr); } } SEAM(5);
    if (IN(6)) { REP(6) { pg8::Gemm g{H, (const bf16*)(ws + WS_W_S5IN), 4096, 4096, 4096, DFLAG, 1u << 6}; pg8::StaticOrder S; S.init(M, 8192, F.G, (int)blockIdx.x);
        pg8::EpiS5In<S5_T, S5_NCH, S5_KY> E{(bf16*)(ws + WS_S5_UG), (bf16*)(ws + WS_S5_GS)};
        pg8::gemm_phase<pg8::EpiS5In<S5_T, S5_NCH, S5_KY>, pg8::StaticOrder, true, true>(ring, g, S, E); } } SEAM(6);
    if (IN(7)) { REP(7) { pg8::Gemm g{(const bf16*)(ws + WS_S5_UG), (const bf16*)(ws + WS_S5BS), S5_KS, S5_KY, S5_KS, DFLAG, 1u << 7}; pg8::BatchedOrder S; S.init(S5_G, S5_NCH / 256, 1, F.G, (int)blockIdx.x);
        pg8::EpiF32 E{(float*)(ws + WS_S5_SLOC), 256};
        pg8::gemm_phase<pg8::EpiF32, pg8::BatchedOrder, true, true>(ring, g, S, E); } } SEAM(7);
    if (IN(8)) { REP(8) { s5_scan_phase(F, args); } } SEAM(8);
    if (IN(9)) { REP(9) { pg8::Gemm g{(const bf16*)(ws + WS_S5_UG), (const bf16*)(ws + WS_S5BY), S5_KY, S5_KY, S5_KY, DFLAG, 1u << 9}; pg8::BatchedOrder S; S.init(S5_G, S5_NCH / 256, S5_KS / 256, F.G, (int)blockIdx.x);
        pg8::EpiS5Y<S5_T, S5_NCH / 256> E{(bf16*)(ws + WS_S5_Y)};
        pg8::gemm_phase<pg8::EpiS5Y<S5_T, S5_NCH / 256>, pg8::BatchedOrder, true, true>(ring, g, S, E); } } SEAM(9);
    if (IN(10)) { REP(10) { pg8::Gemm g{(const bf16*)(ws + WS_S5_Y), (const bf16*)(ws + WS_W_S5GLU), 4096, 4096, 4096, DFLAG, 1u << 10}; pg8::StaticOrder S; S.init(M, 4096, F.G, (int)blockIdx.x);
        pg8::EpiGlu E{(const bf16*)(ws + WS_S5_Y), (const bf16*)(ws + WS_S5_GS), args.in[21], (bf16*)(ws + WS_S5_Z)};
        pg8::gemm_phase<pg8::EpiGlu, pg8::StaticOrder, true, true>(ring, g, S, E); } } SEAM(10);
    if (IN(11)) { REP(11) { pg8::Gemm g{(const bf16*)(ws + WS_S5_Z), (const bf16*)(ws + WS_W_S5OUT), 4096, 4096, 4096, DFLAG, 1u << 11}; pg8::StaticOrder S; S.init(M, 4096, F.G, (int)blockIdx.x);
        pg8::EpiResid E{XO, rep ? (float*)(ws + WS_SCR) : XO, D, MOD + 1 * 2 * 12288 + 8192, 12288, SEQ};
        pg8::gemm_phase<pg8::EpiResid, pg8::StaticOrder, true, true>(ring, g, S, E); } } SEAM(11);
#endif
#if MK_NLAYERS >= 3
    if (IN(12)) { REP(12) { norm_phase<false>(F, XO, args.in[4] + 2 * D, MOD + 2 * 2 * 12288, H, nullptr); } } SEAM(12);
    if (IN(13)) { REP(13) { { pg8::Gemm g{H, (const bf16*)(ws + WS_W_GLAIN), 4096, 4096, 4096, DFLAG, 1u << 13}; pg8::StaticOrder S; S.init(M, GLA_NIN, F.G, (int)blockIdx.x);
          pg8::EpiBf16 E{(bf16*)(ws + WS_GLA_IN), GLA_NIN};
          pg8::gemm_phase<pg8::EpiBf16, pg8::StaticOrder, true, true>(ring, g, S, E); }
        { pg8::Gemm g{H, (const bf16*)(ws + WS_W_GLAG1), 1024, 4096, 4096, DFLAG, 1u << 13}; pg8::SplitKOrder S; S.init(M, 4, 1024, F.G, (int)blockIdx.x);
          pg8::EpiGate E{(float*)(ws + WS_GLA_G1P), M};
          pg8::gemm_phase<pg8::EpiGate, pg8::SplitKOrder, true, true>(ring, g, S, E); } } } SEAM(13);
    if (IN(14)) { REP(14) { gla_prep_phase(F, args); } } SEAM(14);
    if (IN(15)) { REP(15) { gla_main_phase(F, args); } } SEAM(15);
    if (IN(16)) { REP(16) { gla_combine_phase(F, args); } } SEAM(16);
    if (IN(17)) { REP(17) { pg8::Gemm g{(const bf16*)(ws + WS_GLA_Z), (const bf16*)(ws + WS_W_GLAOUT), 4096, 4096, 4096, DFLAG, 1u << 17}; pg8::StaticOrder S; S.init(M, 4096, F.G, (int)blockIdx.x);
        pg8::EpiResid E{XO, rep ? (float*)(ws + WS_SCR) : XO, D, MOD + 2 * 2 * 12288 + 8192, 12288, SEQ};
        pg8::gemm_phase<pg8::EpiResid, pg8::StaticOrder, true, true>(ring, g, S, E); } } SEAM(17);
#endif
#if MK_NLAYERS >= 4
    if (IN(18)) { REP(18) { norm_phase<false>(F, XO, args.in[4] + 3 * D, MOD + 3 * 2 * 12288, H, nullptr); } } SEAM(18);
    if (IN(19)) { REP(19) { pg8::Gemm g{H, (const bf16*)(ws + WS_W_NAIN1), 4096, 4096, 4096, DFLAG, 1u << 19}; pg8::StaticOrder S; S.init(M, 16384, F.G, (int)blockIdx.x);
        pg8::EpiNaIn E{(bf16*)(ws + WS_NA_QKVG)};
        pg8::gemm_phase<pg8::EpiNaIn, pg8::StaticOrder, true, true>(ring, g, S, E); } } SEAM(19);
    if (IN(20)) { REP(20) na_attn_phase2(F, (const bf16*)(ws + WS_NA_QKVG), (bf16*)(ws + WS_NA_Z), args.in[6] + 1 * 32 * 465); } SEAM(20);
    if (IN(21)) { REP(21) { pg8::Gemm g{(const bf16*)(ws + WS_NA_Z), (const bf16*)(ws + WS_W_NAOUT1), 4096, 4096, 4096, DFLAG, 1u << 21}; pg8::StaticOrder S; S.init(M, 4096, F.G, (int)blockIdx.x);
        pg8::EpiResid E{XO, rep ? (float*)(ws + WS_SCR) : XO, D, MOD + 3 * 2 * 12288 + 8192, 12288, SEQ};
        pg8::gemm_phase<pg8::EpiResid, pg8::StaticOrder, true, true>(ring, g, S, E); } } SEAM(21);
#endif
    if (IN(22)) { REP(22) norm_phase<true>(F, (MK_NLAYERS >= 1) ? (const float*)XO : args.in[0], args.in[32], nullptr, nullptr, XO); }
#if MK_DIAG
    if (IN(22)) { __syncthreads(); const unsigned f = __hip_atomic_load(DFLAG, __ATOMIC_RELAXED, __HIP_MEMORY_SCOPE_AGENT);
        const unsigned f2 = __hip_atomic_load(DFLAG + 1, __ATOMIC_RELAXED, __HIP_MEMORY_SCOPE_AGENT);
        if (f != 0u || f2 != 0u) { const int k = f2 ? (24 + __builtin_ctz(f2)) : __builtin_ctz(f); float mk = 10.f; for (int i = 0; i < k; ++i) mk *= 10.f;
            const int gw = F.vcu * NWAVES + F.wave, NGW = F.G * NWAVES;
            for (int m = gw; m < M; m += NGW) for (int j = 0; j < 16; ++j) *((GAS f32x4*)(XO + (size_t)m * D) + F.lane + 64 * j) = (f32x4){mk, mk, mk, mk}; }
        else { const int gw = F.vcu * NWAVES + F.wave, NGW = F.G * NWAVES;
            for (int m = gw; m < M; m += NGW) for (int j = 0; j < 16; ++j) { GAS f32x4* p = (GAS f32x4*)(XO + (size_t)m * D) + F.lane + 64 * j; f32x4 v = *p; bool ch = false;
                for (int e = 0; e < 4; ++e) if (!(__builtin_fabsf(v[e]) < 3.0e38f)) { v[e] = 3.0e30f; ch = true; } if (ch) *p = v; } } }
#endif
#if MK_PROF
    if (F.tid == 0) PROF[32 + 22] = __builtin_amdgcn_s_memrealtime();
    xcd_barrier(bar);
    if (F.tid == 0) PROF[1 + 22] = __builtin_amdgcn_s_memrealtime();
    __syncthreads();
    if (blockIdx.x == 0) {
        float d[23], w[23];
        for (int k = 0; k < 23; ++k) { d[k] = (float)(PROF[1 + k] - PROF[k]) * 0.01f; w[k] = (float)(PROF[1 + k] - PROF[32 + k]) * 0.01f; }
        (void)w;
        const float A = (float)(MK_PROF_A) * 1.0e4f, B = (float)(MK_PROF_B) * 1.0e3f;
        for (size_t i = F.tid; i < (size_t)M * D; i += NWAVES * 64) XO[i] = (i == 0) ? A : B;
    }
#endif
#undef IN
#undef REP
#undef SEAM
}

extern "C" void kernel_launch(void* const* d_in, const int* in_sizes, int n_in, void* d_out, int out_size, void* d_ws, size_t ws_size, hipStream_t stream) {
    static int grid = 0;
    if (grid == 0) {
        if (n_in != 33 || in_sizes[0] != M * D || out_size != M * D || ws_size < WS_END) {
            fprintf(stderr, "kernel_launch: built for 33 inputs, x/out of %d floats, >= %zu bytes of workspace; got n_in %d, in0 %d, out %d, ws %zu; nothing launched\n", M * D, (size_t)WS_END, n_in, n_in > 0 ? in_sizes[0] : -1, out_size, ws_size);
            grid = -1; return; }
        int dev = 0, cus = 0, per_cu = 0;
        if (hipGetDevice(&dev) != hipSuccess || hipDeviceGetAttribute(&cus, hipDeviceAttributeMultiprocessorCount, dev) != hipSuccess) { fprintf(stderr, "kernel_launch: device query failed\n"); grid = -1; return; }
        if (hipFuncSetAttribute((const void*)fwd_kernel, hipFuncAttributeMaxDynamicSharedMemorySize, LDS_BYTES) != hipSuccess) { fprintf(stderr, "kernel_launch: hipFuncSetAttribute failed\n"); grid = -1; return; }
        if (hipOccupancyMaxActiveBlocksPerMultiprocessor(&per_cu, (const void*)fwd_kernel, NWAVES * 64, LDS_BYTES) != hipSuccess || per_cu < 1)
            fprintf(stderr, "kernel_launch: note: occupancy query reports %d workgroups per CU\n", per_cu);
        (void)hipGetLastError();
        grid = cus;
        if (grid != 256) fprintf(stderr, "kernel_launch: note: %d CUs (tuned for 256)\n", grid);
        if (grid < 136) { fprintf(stderr, "kernel_launch: needs >= 136 CUs\n"); grid = -1; return; }
    }
    if (grid < 0) return;
    if (hipMemsetAsync((char*)d_ws + WS_CTL, 0, CTL_ZERO_BYTES, stream) != hipSuccess) { fprintf(stderr, "kernel_launch: memset failed\n"); return; }
    Args a{};
    for (int i = 0; i < 33; ++i) a.in[i] = (const float*)d_in[i];
    a.out = (float*)d_out; a.ws = (unsigned char*)d_ws;
#if MK_ONE_LAUNCH
    a.ph_lo = 0; a.ph_hi = NPH;
    hipLaunchKernelGGL(fwd_kernel, dim3(grid), dim3(NWAVES * 64), LDS_BYTES, stream, a);
#else
    for (int ph = 0; ph < NPH; ++ph) { a.ph_lo = ph; a.ph_hi = ph + 1; a.dup = 0;
        hipLaunchKernelGGL(fwd_kernel, dim3(grid), dim3(NWAVES * 64), LDS_BYTES, stream, a);
        if ((MK_DUP >> ph) & 1u) { a.dup = 1; hipLaunchKernelGGL(fwd_kernel, dim3(grid), dim3(NWAVES * 64), LDS_BYTES, stream, a); } }
#endif
    const hipError_t le = hipPeekAtLastError();
    if (le != hipSuccess) fprintf(stderr, "kernel_launch: launch failed: %s\n", hipGetErrorName(le));
}
```

```cpp
#include <hip/hip_runtime.h>
#include <cstdio>
#include <cstdint>

#ifndef MK_ONE_LAUNCH
#define MK_ONE_LAUNCH 1
#endif
#ifndef MK_DIAG
#define MK_DIAG 0
#endif
#ifndef MK_PROF
#define MK_PROF 0
#endif
#define MK_PROF_A (d[2]+d[19]+d[4]+d[21]+d[6]+d[10]+d[11]+d[13]+d[17])
#define MK_PROF_B (d[0])
#ifndef MK_DUP
#define MK_DUP 0u
#endif
#ifndef MK_NLAYERS
#define MK_NLAYERS 4
#endif

namespace pg8 {
#define PG8_LAS __attribute__((address_space(3)))
typedef unsigned short bf16_t;
typedef short bf16x8 __attribute__((ext_vector_type(8)));
typedef float f32x4 __attribute__((ext_vector_type(4)));
typedef unsigned u32x4 __attribute__((ext_vector_type(4)));
typedef unsigned u32x2 __attribute__((ext_vector_type(2)));
constexpr int BM = 256, BK = 64, HALF = 128, HTB = HALF * BK * 2  , STAGE_BYTES = 8 * HTB, NXCD = 8, WGM = 8;

__host__ __device__ __forceinline__ int lds_byte(int r, int c) { const int st = (r >> 4) * 2 + (c >> 5), rr = r & 15, cc = c & 31, ob = rr * 64 + cc * 2; return st * 1024 + (ob ^ (((ob >> 9) & 1) << 5)); }
__host__ __device__ __forceinline__ void stage_rc(int b, int& R, int& C) { const int st = b / 1024, sb = b % 1024, swz = sb ^ (((sb >> 9) & 1) << 5); R = (st >> 1) * 16 + swz / 64; C = (st & 1) * 32 + (swz % 64) / 2; }
__host__ __device__ __forceinline__ int perm32(int rho) { const int n = rho >> 4, i = rho & 15; return 8 * (i >> 2) + 4 * n + (i & 3); }

struct Unit { int pm, pn, pb, koff; };
struct Gemm { const bf16_t* A; const bf16_t* Bt; int K, lda, ldb; unsigned* dflag; unsigned dbit; };

struct StaticOrder {
    int nM, nN, nwg, G, c;
    __host__ __device__ void init(int M, int N, int G_, int c_) { nM = M / BM; nN = N / BM; nwg = nM * nN; G = G_; c = c_; }
    __host__ __device__ bool next(int i, Unit& u) const {
        const long L = (long)i * G + c; if (L >= nwg) return false;
        int wgid = (int)L; { const int q = nwg / NXCD, r = nwg % NXCD, xcd = wgid % NXCD, off = wgid / NXCD; wgid = (xcd < r ? xcd * (q + 1) : r * (q + 1) + (xcd - r) * q) + off; }
        const int nig = WGM * nN, gid = wgid / nig, fm = gid * WGM, gsz = (nM - fm) < WGM ? (nM - fm) : WGM;
        u.pm = fm + ((wgid % nig) % gsz); u.pn = (wgid % nig) / gsz; u.pb = u.pn; u.koff = 0; return true;
    }
    __device__ __forceinline__ void a_ready(const Unit&) const {}
    __device__ __forceinline__ void done(const Unit&) const {}
};
struct BatchedOrder {
    int nPm, nPn, total, G, c;
    __host__ __device__ void init(int ngroups, int nPm_, int nPn_, int G_, int c_) { nPm = nPm_; nPn = nPn_; total = ngroups * nPm * nPn; G = G_; c = c_; }
    __host__ __device__ bool next(int i, Unit& u) const {
        long L = (long)i * G + c; if (L >= total) return false;
        const int upg = nPm * nPn;
        if (G % 8 == 0 && (G / 8) % upg == 0 && total % G == 0) {
            const int x = c % 8, q = c / 8, gpx = (G / 8) / upg;
            L = ((long)(i * 8 + x) * gpx + q / upg) * upg + q % upg; }
        const int g = (int)L / upg, rem = (int)L % upg, pmi = rem / nPn, pni = rem % nPn;
        u.pm = g * nPm + pmi; u.pn = pni; u.pb = g * nPn + pni; u.koff = 0; return true;
    }
    __device__ __forceinline__ void a_ready(const Unit&) const {}
    __device__ __forceinline__ void done(const Unit&) const {}
};
struct SplitKOrder {
    int nM, nsplit, kslice, G, c;
    __host__ __device__ void init(int M, int nsplit_, int kslice_, int G_, int c_) { nM = M / BM; nsplit = nsplit_; kslice = kslice_; G = G_; c = c_; }
    __host__ __device__ bool next(int i, Unit& u) const {
        const long L = (long)i * G + c; if (L >= (long)nM * nsplit) return false;
        u.pm = (int)L / nsplit; u.pn = (int)L % nsplit; u.pb = 0; u.koff = u.pn * kslice; return true;
    }
    __device__ __forceinline__ void a_ready(const Unit&) const {}
    __device__ __forceinline__ void done(const Unit&) const {}
};

typedef float f32x2_t __attribute__((ext_vector_type(2))); typedef __bf16 bf16x2_t __attribute__((ext_vector_type(2)));
__device__ __forceinline__ unsigned cvt_pk_bf16(float lo, float hi) { f32x2_t v = {lo, hi}; bf16x2_t b = __builtin_convertvector(v, bf16x2_t); return __builtin_bit_cast(unsigned, b); }
__device__ __forceinline__ float bf_lo(unsigned w) { return __uint_as_float(w << 16); }
__device__ __forceinline__ float bf_hi(unsigned w) { return __uint_as_float(w & 0xffff0000u); }
__device__ __forceinline__ float sigmoidf_(float x) { return __builtin_amdgcn_rcpf(1.0f + __expf(-x)); }
__device__ __forceinline__ float siluf_(float x) { return x * __builtin_amdgcn_rcpf(1.0f + __expf(-x)); }
__device__ __forceinline__ float gelu_tanh(float x) { const float z = 0.7978845608028654f * (x + 0.044715f * x * x * x); return x * __builtin_amdgcn_rcpf(1.0f + __expf(-2.0f * z)); }

struct EpiBf16 {
    static constexpr bool PERM = true, AFTER_DRAIN = false;
    bf16_t* O; int ldc;
    __device__ __forceinline__ void operator()(const f32x4 (&acc)[2][2][4][2], const Unit& u, int wr, int wc, int fr, int fq) const {
        const int row0 = u.pm * BM + wr * 64 + fr, col0 = u.pn * BM + wc * 32 + 8 * fq;
#pragma unroll
        for (int ai = 0; ai < 2; ++ai)
#pragma unroll
            for (int m = 0; m < 4; ++m) { bf16_t* rowp = O + (size_t)(row0 + ai * HALF + m * 16) * ldc + col0;
#pragma unroll
                for (int bj = 0; bj < 2; ++bj) { const f32x4 v0 = acc[ai][bj][m][0], v1 = acc[ai][bj][m][1];
                    u32x4 w; w.x = cvt_pk_bf16(v0[0], v0[1]); w.y = cvt_pk_bf16(v0[2], v0[3]); w.z = cvt_pk_bf16(v1[0], v1[1]); w.w = cvt_pk_bf16(v1[2], v1[3]);
                    *(u32x4*)(rowp + bj * HALF) = w; } }
    }
};
struct EpiNaIn {
    static constexpr bool PERM = true, AFTER_DRAIN = false;
    bf16_t* O;
    __device__ __forceinline__ void operator()(const f32x4 (&acc)[2][2][4][2], const Unit& u, int wr, int wc, int fr, int fq) const {
        const int row0 = u.pm * BM + wr * 64 + fr, col0 = u.pn * BM + wc * 32 + 8 * fq;
#pragma unroll
        for (int ai = 0; ai < 2; ++ai)
#pragma unroll
            for (int m = 0; m < 4; ++m) { const int row = row0 + ai * HALF + m * 16, b = row >> 13, l = row & 8191;
#pragma unroll
                for (int bj = 0; bj < 2; ++bj) { const f32x4 v0 = acc[ai][bj][m][0], v1 = acc[ai][bj][m][1]; const int n = col0 + bj * HALF, sec = n >> 12, hd = (n >> 7) & 31, d = n & 127;
                    u32x4 w; w.x = cvt_pk_bf16(v0[0], v0[1]); w.y = cvt_pk_bf16(v0[2], v0[3]); w.z = cvt_pk_bf16(v1[0], v1[1]); w.w = cvt_pk_bf16(v1[2], v1[3]);
                    *(u32x4*)(O + ((size_t)((sec * 2 + b) * 32 + hd) * 8192 + l) * 128 + d) = w; } }
    }
};
struct EpiResid {
    static constexpr bool PERM = false, AFTER_DRAIN = false;
    const float* base; float* out; int ldc; const float* gate0; int gate_stride; int rows_per_batch;
    __device__ __forceinline__ void operator()(const f32x4 (&acc)[2][2][4][2], const Unit& u, int wr, int wc, int fr, int fq) const {
        const int row0 = u.pm * BM + wr * 64 + fr, col0 = u.pn * BM + wc * 32 + 4 * fq;
        const float* gp = gate0 + (size_t)((u.pm * BM) / rows_per_batch) * gate_stride + col0;
        f32x4 gv[2][2];
#pragma unroll
        for (int bj = 0; bj < 2; ++bj)
#pragma unroll
            for (int n = 0; n < 2; ++n) gv[bj][n] = *(const f32x4*)(gp + bj * HALF + n * 16);
#pragma unroll
        for (int ai = 0; ai < 2; ++ai)
#pragma unroll
            for (int m = 0; m < 4; ++m) { const size_t off = (size_t)(row0 + ai * HALF + m * 16) * ldc + col0;
#pragma unroll
                for (int bj = 0; bj < 2; ++bj)
#pragma unroll
                    for (int n = 0; n < 2; ++n) { const f32x4 bs = *(const f32x4*)(base + off + bj * HALF + n * 16);
                        *(f32x4*)(out + off + bj * HALF + n * 16) = bs + gv[bj][n] * acc[ai][bj][m][n]; }
                if (m & 1) asm volatile("" ::: "memory"); }
    }
};
struct EpiF32 {
    static constexpr bool PERM = false, AFTER_DRAIN = false;
    float* C; int ldc;
    __device__ __forceinline__ void operator()(const f32x4 (&acc)[2][2][4][2], const Unit& u, int wr, int wc, int fr, int fq) const {
        const int row0 = u.pm * BM + wr * 64 + fr, col0 = u.pn * BM + wc * 32 + 4 * fq;
#pragma unroll
        for (int ai = 0; ai < 2; ++ai)
#pragma unroll
            for (int m = 0; m < 4; ++m) { float* rowp = C + (size_t)(row0 + ai * HALF + m * 16) * ldc + col0;
#pragma unroll
                for (int bj = 0; bj < 2; ++bj)
#pragma unroll
                    for (int n = 0; n < 2; ++n) *(f32x4*)(rowp + bj * HALF + n * 16) = acc[ai][bj][m][n]; }
    }
};
struct EpiGate {
    static constexpr bool PERM = false, AFTER_DRAIN = false;
    float* P; int rows;
    __device__ __forceinline__ void operator()(const f32x4 (&acc)[2][2][4][2], const Unit& u, int wr, int wc, int fr, int fq) const {
        if (wc != 0) return;
        const int row0 = u.pm * BM + wr * 64 + fr;
#pragma unroll
        for (int ai = 0; ai < 2; ++ai)
#pragma unroll
            for (int m = 0; m < 4; ++m) { float* rowp = P + ((size_t)u.pn * rows + (row0 + ai * HALF + m * 16)) * 32 + 4 * fq;
#pragma unroll
                for (int n = 0; n < 2; ++n) *(f32x4*)(rowp + n * 16) = acc[ai][0][m][n]; }
    }
};
template <int T, int NCH, int KY> struct EpiS5In {
    static constexpr bool PERM = true, AFTER_DRAIN = false;
    bf16_t* Ug; bf16_t* Gs;
    __device__ __forceinline__ void operator()(const f32x4 (&acc)[2][2][4][2], const Unit& u, int wr, int wc, int fr, int fq) const {
        const int row0 = u.pm * BM + wr * 64 + fr, col0 = u.pn * BM + wc * 32 + 8 * fq;
#pragma unroll
        for (int ai = 0; ai < 2; ++ai)
#pragma unroll
            for (int m = 0; m < 4; ++m) { const int row = row0 + ai * HALF + m * 16;
#pragma unroll
                for (int bj = 0; bj < 2; ++bj) { const f32x4 v0 = acc[ai][bj][m][0], v1 = acc[ai][bj][m][1]; const int col = col0 + bj * HALF;
                    u32x4 w; w.x = cvt_pk_bf16(v0[0], v0[1]); w.y = cvt_pk_bf16(v0[2], v0[3]); w.z = cvt_pk_bf16(v1[0], v1[1]); w.w = cvt_pk_bf16(v1[2], v1[3]);
                    if (col < 4096) { const int g = col >> 4, i0 = col & 15, chunk = row / T, t = row % T;
                        *(u32x4*)(Ug + ((size_t)g * NCH + chunk) * KY + t * 16 + i0) = w; }
                    else *(u32x4*)(Gs + (size_t)row * 4096 + (col - 4096)) = w; } }
    }
};
template <int T, int NPM> struct EpiS5Y {
    static constexpr bool PERM = true, AFTER_DRAIN = false;
    bf16_t* Y;
    __device__ __forceinline__ void operator()(const f32x4 (&acc)[2][2][4][2], const Unit& u, int wr, int wc, int fr, int fq) const {
        const int g = u.pm / NPM, chunk0 = (u.pm % NPM) * BM + wr * 64 + fr, col0 = u.pn * BM + wc * 32 + 8 * fq;
#pragma unroll
        for (int ai = 0; ai < 2; ++ai)
#pragma unroll
            for (int m = 0; m < 4; ++m) { const int chunk = chunk0 + ai * HALF + m * 16;
#pragma unroll
                for (int bj = 0; bj < 2; ++bj) { f32x4 v0 = acc[ai][bj][m][0], v1 = acc[ai][bj][m][1]; const int n = col0 + bj * HALF, t = n >> 4, i0 = n & 15;
#pragma unroll
                    for (int j = 0; j < 4; ++j) { v0[j] = gelu_tanh(v0[j]); v1[j] = gelu_tanh(v1[j]); }
                    u32x4 w; w.x = cvt_pk_bf16(v0[0], v0[1]); w.y = cvt_pk_bf16(v0[2], v0[3]); w.z = cvt_pk_bf16(v1[0], v1[1]); w.w = cvt_pk_bf16(v1[2], v1[3]);
                    *(u32x4*)(Y + (size_t)(chunk * T + t) * 4096 + g * 16 + i0) = w; } }
    }
};
struct EpiGlu {
    static constexpr bool PERM = true, AFTER_DRAIN = false;
    const bf16_t* Y; const bf16_t* Gs; const float* bias; bf16_t* Z;
    __device__ __forceinline__ void operator()(const f32x4 (&acc)[2][2][4][2], const Unit& u, int wr, int wc, int fr, int fq) const {
        const int row0 = u.pm * BM + wr * 64 + fr, col0 = u.pn * BM + wc * 32 + 8 * fq;
        f32x4 bv[2][2];
#pragma unroll
        for (int bj = 0; bj < 2; ++bj)
#pragma unroll
            for (int n = 0; n < 2; ++n) bv[bj][n] = *(const f32x4*)(bias + col0 + bj * HALF + 4 * n);
#pragma unroll
        for (int ai = 0; ai < 2; ++ai)
#pragma unroll
            for (int m = 0; m < 4; ++m) { const size_t off = (size_t)(row0 + ai * HALF + m * 16) * 4096 + col0;
#pragma unroll
                for (int bj = 0; bj < 2; ++bj) { const u32x4 yw = *(const u32x4*)(Y + off + bj * HALF), gw = *(const u32x4*)(Gs + off + bj * HALF);
                    const f32x4 a0 = acc[ai][bj][m][0] + bv[bj][0], a1 = acc[ai][bj][m][1] + bv[bj][1];
                    float o[8];
#pragma unroll
                    for (int j = 0; j < 4; ++j) { const unsigned yj = yw[j], gj = gw[j];
                        const float aa = (j < 2) ? a0[2 * j] : a1[2 * j - 4], ab = (j < 2) ? a0[2 * j + 1] : a1[2 * j - 3];
                        o[2 * j] = bf_lo(yj) * sigmoidf_(aa) * siluf_(bf_lo(gj)); o[2 * j + 1] = bf_hi(yj) * sigmoidf_(ab) * siluf_(bf_hi(gj)); }
                    u32x4 w; w.x = cvt_pk_bf16(o[0], o[1]); w.y = cvt_pk_bf16(o[2], o[3]); w.z = cvt_pk_bf16(o[4], o[5]); w.w = cvt_pk_bf16(o[6], o[7]);
                    *(u32x4*)(Z + off + bj * HALF) = w; }
                asm volatile("" ::: "memory"); }
    }
};

template <class Epi, class Sched, bool ALIGN_EPI = false, bool SP2 = false>
__device__ __forceinline__ void gemm_phase(PG8_LAS unsigned char* lds, const Gemm g, const Sched& S, const Epi& E) {
    const int tid = threadIdx.x, wid = __builtin_amdgcn_readfirstlane(tid >> 6), lane = tid & 63, wr = wid >> 2, wc = wid & 3, fr = lane & 15, fq = lane >> 4;
    const int K = g.K, nt = K / BK, lda = g.lda, ldb = g.ldb;
    unsigned voffA[2], voffB[2];
#pragma unroll
    for (int i = 0; i < 2; ++i) { int R, C; stage_rc(tid * 16 + i * 8192, R, C); const int Rb = Epi::PERM ? ((R & ~31) + perm32(R & 31)) : R;
        voffA[i] = (unsigned)(R * lda + C) * 2u; voffB[i] = (unsigned)(Rb * ldb + C) * 2u; }
    const size_t kstep = (size_t)(BK * 2);
    const size_t hstepA = (size_t)HALF * lda * 2, hstepB = (size_t)HALF * ldb * 2;
    const size_t tstepA = 2 * hstepA, tstepB = 2 * hstepB;
    const unsigned ldsw = (unsigned)wid * 1024u;
    const int aoff = lds_byte(wr * 64 + fr, fq * 8), boff = lds_byte(wc * 32 + fr, fq * 8);
#define PG8_SA(b, h) (((b) * 2 + (h)) * HTB)
#define PG8_SB(b, h) ((4 + (b) * 2 + (h)) * HTB)
#define PG8_STAGE(bufoff, gbase, voff) do { _Pragma("unroll") for (int _i = 0; _i < 2; ++_i) \
        __builtin_amdgcn_global_load_lds((const unsigned*)((const char*)(gbase) + (voff)[_i]), (PG8_LAS unsigned*)(lds + (bufoff) + ldsw + _i * 8192), 16, 0, 0); } while (0)
#define PG8_LDA(dst, b, h) do { _Pragma("unroll") for (int m = 0; m < 4; ++m) _Pragma("unroll") for (int k = 0; k < 2; ++k) dst[m][k] = *(const PG8_LAS bf16x8*)(lds + PG8_SA(b, h) + aoff + m * 2048 + k * 1024); } while (0)
#define PG8_LDB(dst, b, h) do { _Pragma("unroll") for (int n = 0; n < 2; ++n) _Pragma("unroll") for (int k = 0; k < 2; ++k) dst[n][k] = *(const PG8_LAS bf16x8*)(lds + PG8_SB(b, h) + boff + n * 2048 + k * 1024); } while (0)
#define PG8_MMA(ai, bj, At, Bt) do { __builtin_amdgcn_s_setprio(1); _Pragma("unroll") for (int m = 0; m < 4; ++m) _Pragma("unroll") for (int n = 0; n < 2; ++n) _Pragma("unroll") for (int k = 0; k < 2; ++k) \
        acc[ai][bj][m][n] = __builtin_amdgcn_mfma_f32_16x16x32_bf16(Bt[n][k], At[m][k], acc[ai][bj][m][n], 0, 0, 0); __builtin_amdgcn_s_setprio(0); } while (0)
#define PG8_WAIT_V(n) asm volatile("s_waitcnt vmcnt(" #n ")" ::: "memory")
#define PG8_WAIT_L(n) asm volatile("s_waitcnt lgkmcnt(" #n ")" ::: "memory")
#define PG8_BAR __builtin_amdgcn_s_barrier()
#define PG8_SCHED __builtin_amdgcn_sched_barrier(0)
    Unit cur, nxt; int ui = 0;
    if (!S.next(0, cur)) return;
    f32x4 acc[2][2][4][2];
#pragma unroll
    for (int a = 0; a < 2; ++a)
#pragma unroll
        for (int b = 0; b < 2; ++b)
#pragma unroll
            for (int m = 0; m < 4; ++m)
#pragma unroll
                for (int n = 0; n < 2; ++n) acc[a][b][m][n] = (f32x4){0.f, 0.f, 0.f, 0.f};
    bf16x8 At[4][2], B0[2][2], B1[2][2];
    const char* cA = (const char*)g.A + (size_t)cur.pm * tstepA + (size_t)cur.koff * 2; const char* cB = (const char*)g.Bt + (size_t)cur.pb * tstepB + (size_t)cur.koff * 2;
    S.a_ready(cur);
    if constexpr (SP2) {
        PG8_STAGE(PG8_SB(0, 0), cB, voffB); PG8_STAGE(PG8_SB(0, 1), cB + hstepB, voffB); PG8_STAGE(PG8_SA(0, 0), cA, voffA); PG8_STAGE(PG8_SA(0, 1), cA + hstepA, voffA);
        if (wr == 1) PG8_BAR;
        PG8_WAIT_V(2); PG8_BAR;
        PG8_STAGE(PG8_SB(1, 0), cB + kstep, voffB); PG8_STAGE(PG8_SA(1, 0), cA + kstep, voffA); PG8_STAGE(PG8_SB(1, 1), cB + hstepB + kstep, voffB);
        PG8_WAIT_V(6); PG8_BAR;
    } else {
        PG8_STAGE(PG8_SB(0, 0), cB, voffB); PG8_STAGE(PG8_SA(0, 0), cA, voffA); PG8_STAGE(PG8_SB(0, 1), cB + hstepB, voffB); PG8_STAGE(PG8_SA(0, 1), cA + hstepA, voffA);
        if (wr == 1) PG8_BAR;
        PG8_WAIT_V(4); PG8_BAR;
        PG8_STAGE(PG8_SB(1, 0), cB + kstep, voffB); PG8_STAGE(PG8_SA(1, 0), cA + kstep, voffA); PG8_STAGE(PG8_SB(1, 1), cB + hstepB + kstep, voffB);
        PG8_WAIT_V(6); PG8_BAR;
    }
    for (;;) {
        const bool has_next = S.next(ui + 1, nxt);
        const char* nA = has_next ? (const char*)g.A + (size_t)nxt.pm * tstepA + (size_t)nxt.koff * 2 : cA; const char* nB = has_next ? (const char*)g.Bt + (size_t)nxt.pb * tstepB + (size_t)nxt.koff * 2 : cB;
        for (int t = 0; t < nt; t += 2) {
            const bool last = (t == nt - 2);
            const char* a1 = cA + (size_t)(t + 1) * kstep;
            const char* a2 = last ? nA : cA + (size_t)(t + 2) * kstep; const char* b2 = last ? nB : cB + (size_t)(t + 2) * kstep;
            const char* a3 = a2 + kstep; const char* b3 = b2 + kstep;
            if (last && has_next) S.a_ready(nxt);
            if constexpr (SP2) {
            PG8_LDB(B0, 0, 0); PG8_LDB(B1, 0, 1); PG8_SCHED; PG8_LDA(At, 0, 0); PG8_STAGE(PG8_SA(1, 1), a1 + hstepA, voffA);
            PG8_WAIT_V(8); PG8_WAIT_L(0); PG8_BAR; PG8_MMA(0, 0, At, B0); PG8_MMA(0, 1, At, B1); PG8_BAR; PG8_SCHED;
            PG8_LDA(At, 0, 1); PG8_STAGE(PG8_SB(0, 0), b2, voffB); PG8_STAGE(PG8_SB(0, 1), b2 + hstepB, voffB); PG8_STAGE(PG8_SA(0, 0), a2, voffA);
            PG8_WAIT_V(8); PG8_WAIT_L(0); PG8_BAR; PG8_MMA(1, 0, At, B0); PG8_MMA(1, 1, At, B1); PG8_BAR; PG8_SCHED;
            PG8_LDB(B0, 1, 0); PG8_LDB(B1, 1, 1); PG8_SCHED; PG8_LDA(At, 1, 0); PG8_STAGE(PG8_SA(0, 1), a2 + hstepA, voffA);
            PG8_WAIT_V(8); PG8_WAIT_L(0); PG8_BAR; PG8_MMA(0, 0, At, B0); PG8_MMA(0, 1, At, B1); PG8_BAR; PG8_SCHED;
            PG8_LDA(At, 1, 1); PG8_STAGE(PG8_SB(1, 0), b3, voffB); PG8_STAGE(PG8_SB(1, 1), b3 + hstepB, voffB); PG8_STAGE(PG8_SA(1, 0), a3, voffA);
            PG8_WAIT_V(8); PG8_WAIT_L(0); PG8_BAR; PG8_MMA(1, 0, At, B0); PG8_MMA(1, 1, At, B1); PG8_BAR; PG8_SCHED;
            } else {
            PG8_LDB(B0, 0, 0); PG8_SCHED; PG8_LDA(At, 0, 0); PG8_STAGE(PG8_SA(1, 1), a1 + hstepA, voffA);
            PG8_WAIT_L(8); PG8_BAR; PG8_WAIT_L(0); PG8_MMA(0, 0, At, B0); PG8_BAR; PG8_SCHED;
            PG8_LDB(B1, 0, 1); PG8_STAGE(PG8_SB(0, 0), b2, voffB);
            PG8_BAR; PG8_WAIT_L(0); PG8_MMA(0, 1, At, B1); PG8_BAR;
            PG8_LDA(At, 0, 1); PG8_STAGE(PG8_SA(0, 0), a2, voffA);
            PG8_BAR; PG8_WAIT_L(0); PG8_MMA(1, 0, At, B0); PG8_BAR; PG8_SCHED;
            PG8_STAGE(PG8_SB(0, 1), b2 + hstepB, voffB);
            PG8_WAIT_V(6); PG8_BAR; PG8_MMA(1, 1, At, B1); PG8_BAR;
            PG8_LDB(B0, 1, 0); PG8_SCHED; PG8_LDA(At, 1, 0); PG8_STAGE(PG8_SA(0, 1), a2 + hstepA, voffA);
            PG8_WAIT_L(8); PG8_BAR; PG8_WAIT_L(0); PG8_MMA(0, 0, At, B0); PG8_BAR; PG8_SCHED;
            PG8_LDB(B1, 1, 1); PG8_STAGE(PG8_SB(1, 0), b3, voffB);
            PG8_BAR; PG8_WAIT_L(0); PG8_MMA(0, 1, At, B1); PG8_BAR;
            PG8_LDA(At, 1, 1); PG8_STAGE(PG8_SA(1, 0), a3, voffA);
            PG8_BAR; PG8_WAIT_L(0); PG8_MMA(1, 0, At, B0); PG8_BAR; PG8_SCHED;
            PG8_STAGE(PG8_SB(1, 1), b3 + hstepB, voffB);
            PG8_WAIT_V(6); PG8_BAR; PG8_MMA(1, 1, At, B1); PG8_BAR;
            }
        }
        if constexpr (ALIGN_EPI) { if (wr == 0) PG8_BAR; }
#if MK_DIAG
        { bool bad = false;
#pragma unroll
          for (int a_ = 0; a_ < 2; ++a_)
#pragma unroll
            for (int b_ = 0; b_ < 2; ++b_)
#pragma unroll
              for (int m_ = 0; m_ < 4; ++m_)
#pragma unroll
                for (int n_ = 0; n_ < 2; ++n_)
#pragma unroll
                  for (int j_ = 0; j_ < 4; ++j_) bad |= !(__builtin_fabsf(acc[a_][b_][m_][n_][j_]) < 3.0e38f);
          if (bad && g.dflag) atomicOr(g.dflag, g.dbit); }
#endif
        if constexpr (!Epi::AFTER_DRAIN) { E(acc, cur, wr, wc, fr, fq); S.done(cur); }
        if (!has_next) break;
#pragma unroll
        for (int a = 0; a < 2; ++a)
#pragma unroll
            for (int b = 0; b < 2; ++b)
#pragma unroll
                for (int m = 0; m < 4; ++m)
#pragma unroll
                    for (int n = 0; n < 2; ++n) acc[a][b][m][n] = (f32x4){0.f, 0.f, 0.f, 0.f};
        cur = nxt; cA = nA; cB = nB; ++ui;
        if constexpr (ALIGN_EPI) { if (wr == 1) PG8_BAR; }
    }
    PG8_WAIT_V(0);
    if constexpr (!ALIGN_EPI) { if (wr == 0) PG8_BAR; }
    PG8_BAR;
    if constexpr (Epi::AFTER_DRAIN) { E.fused(acc, cur, wr, wc, fr, fq, lds, wid, lane); S.done(cur); }
#undef PG8_SA
#undef PG8_SB
#undef PG8_STAGE
#undef PG8_LDA
#undef PG8_LDB
#undef PG8_MMA
#undef PG8_WAIT_V
#undef PG8_WAIT_L
#undef PG8_BAR
#undef PG8_SCHED
}

}

constexpr int NWAVES = 8;
constexpr int BATCH = 2, SEQ = 8192, D = 4096, M = BATCH * SEQ;
constexpr int GRIDW = 64, GROWS = SEQ / GRIDW;
constexpr int NA_HEADS = 32, NA_HD = 128;
constexpr int S5_G = 256, S5_P = 64, S5_I = 16, S5_T = 32, S5_NCH = M / S5_T  , S5_NCHB = SEQ / S5_T  , S5_KS = S5_T * 16  , S5_KY = S5_KS + 256  ;
constexpr int GLA_H = 8, GLA_DK = 256, GLA_DV = 512, GLA_KW = 2048, GLA_C = 64, GLA_NCH = M / GLA_C  , GLA_NCHB = SEQ / GLA_C  , GLA_NIN = 12288;
constexpr float EPS = 1e-6f;

constexpr size_t MiB = 1u << 20;
constexpr size_t WS_CTL = 0, CTL_ZERO_BYTES = 64 * 1024;
constexpr size_t WS_MOD = 1 * MiB;
constexpr size_t WS_LAMT = 2 * MiB;
constexpr size_t WS_W_NAIN0 = 4 * MiB, WS_W_NAIN1 = WS_W_NAIN0 + 128 * MiB, WS_W_NAOUT0 = WS_W_NAIN1 + 128 * MiB, WS_W_NAOUT1 = WS_W_NAOUT0 + 32 * MiB;
constexpr size_t WS_W_S5IN = WS_W_NAOUT1 + 32 * MiB, WS_W_S5GLU = WS_W_S5IN + 64 * MiB, WS_W_S5OUT = WS_W_S5GLU + 32 * MiB;
constexpr size_t WS_W_GLAIN = WS_W_S5OUT + 32 * MiB, WS_W_GLAG1 = WS_W_GLAIN + 96 * MiB, WS_W_GLAOUT = WS_W_GLAG1 + 2 * MiB;
constexpr size_t WS_S5BS = WS_W_GLAOUT + 32 * MiB;
constexpr size_t WS_S5BY = WS_S5BS + 64 * MiB;
constexpr size_t WS_H = WS_S5BY + 192 * MiB;
constexpr size_t WS_ACT = WS_H + 128 * MiB;
constexpr size_t WS_NA_QKVG = WS_ACT;
constexpr size_t WS_NA_Z = WS_ACT + 512 * MiB;
constexpr size_t WS_S5_UG = WS_ACT;
constexpr size_t WS_S5_GS = WS_S5_UG + 192 * MiB;
constexpr size_t WS_S5_SLOC = WS_S5_GS + 128 * MiB;
constexpr size_t WS_S5_Y = WS_S5_SLOC + 128 * MiB;
constexpr size_t WS_S5_Z = WS_S5_Y + 128 * MiB;
constexpr size_t WS_GLA_IN = WS_ACT;
constexpr size_t WS_GLA_G1P = WS_GLA_IN + 384 * MiB;
constexpr size_t WS_GLA_PREP = WS_GLA_G1P + 8 * MiB;
constexpr size_t WS_GLA_DECAY = WS_GLA_PREP + 384 * MiB;
constexpr size_t WS_GLA_O = WS_GLA_DECAY + 4 * MiB;
constexpr size_t WS_GLA_Z = WS_GLA_O + 384 * MiB;
constexpr size_t WS_SCR = WS_GLA_Z + 128 * MiB;
constexpr size_t WS_END = WS_SCR + 256 * MiB;
static_assert(WS_S5_Z + 128 * MiB <= WS_SCR && WS_NA_Z + 128 * MiB <= WS_SCR, "ws map");
constexpr int CW_BAR = 1024;
static_assert((CW_BAR + 3456) * 4 <= (int)CTL_ZERO_BYTES, "CTL words inside the memset region");

constexpr int RING_OFF = 0, RING_BYTES = 131072;
constexpr int LDS_BYTES = 147456;
constexpr int MISC_OFF = LDS_BYTES - 256;

#define GAS __attribute__((address_space(1)))
#define LAS __attribute__((address_space(3)))
typedef unsigned short bf16;
typedef unsigned v4u __attribute__((ext_vector_type(4)));
typedef unsigned v2u __attribute__((ext_vector_type(2)));
typedef float f32x4 __attribute__((ext_vector_type(4)));
typedef float f32x2 __attribute__((ext_vector_type(2)));
typedef short bf16x8 __attribute__((ext_vector_type(8)));
typedef short s16x4 __attribute__((ext_vector_type(4)));
typedef GAS unsigned gu32;
#define LDS_WAIT() asm volatile("s_waitcnt lgkmcnt(0)" ::: "memory")
#define VM_WAIT() asm volatile("s_waitcnt vmcnt(0)" ::: "memory")
using pg8::cvt_pk_bf16; using pg8::bf_lo; using pg8::bf_hi; using pg8::siluf_; using pg8::sigmoidf_;

#define XB_TMO      128
#define XB_XCNT(j)  (256  + 64 * (j))
#define XB_XSUB(j)  (1280 + 64 * (j))
#define XB_XGEN(j)  (2304 + 64 * (j))
#define XB_TOP      3328
#define XB_TOPGEN   3392
#define XCD_BAR_WORDS 3456
#define XB_SPIN_CAP (1u << 18)
__device__ __forceinline__ unsigned xb_ld(unsigned* p)              { return __hip_atomic_load(p, __ATOMIC_RELAXED, __HIP_MEMORY_SCOPE_AGENT); }
__device__ __forceinline__ unsigned xb_add(unsigned* p, unsigned v) { return __hip_atomic_fetch_add(p, v, __ATOMIC_RELAXED, __HIP_MEMORY_SCOPE_AGENT); }
__device__ __forceinline__ unsigned xb_xcc_id() { return (unsigned)__builtin_amdgcn_s_getreg((3 << 11) | 20) & 0xFu; }
#define XB_SPIN(cond, bar) do { unsigned _sp = 0; while (cond) { __builtin_amdgcn_s_sleep(1); \
    if ((++_sp & 255u) == 0u) { if (xb_ld(&(bar)[XB_TMO])) break; if (_sp > XB_SPIN_CAP) { atomicAdd(&(bar)[XB_TMO], 1u); break; } } } } while (0)
struct XcdBarrier { unsigned* bar; unsigned x; volatile LAS unsigned* st; };
__device__ __forceinline__ XcdBarrier xcd_barrier_post(unsigned* bar, volatile LAS unsigned* st) {
    XcdBarrier b; b.bar = bar; b.x = xb_xcc_id(); b.st = st;
    if (threadIdx.x == 0) (void)xb_add(&bar[XB_XCNT(b.x)], 1u);
    return b;
}
__device__ __forceinline__ void xcd_barrier_complete(unsigned* bar, unsigned x, unsigned& nloc, unsigned& nx) {
    const unsigned G = gridDim.x * gridDim.y * gridDim.z;
    unsigned sum, cnt, mine, sp = 0u;
    for (;;) {
        sum = 0u; cnt = 0u; mine = 0u;
#pragma unroll
        for (unsigned j = 0; j < 16; ++j) { const unsigned c = xb_ld(&bar[XB_XCNT(j)]); sum += c; cnt += (c > 0u) ? 1u : 0u; mine = (j == x) ? c : mine; }
        if (sum == G) break;
        __builtin_amdgcn_s_sleep(1);
        if ((++sp & 255u) == 0u) { if (xb_ld(&bar[XB_TMO])) break; if (sp > XB_SPIN_CAP) { atomicAdd(&bar[XB_TMO], 1u); break; } }
    }
    nloc = mine > 0u ? mine : 1u; nx = cnt > 0u ? cnt : 1u;
}
__device__ __forceinline__ void xcd_barrier(const XcdBarrier& b) {
    asm volatile("s_waitcnt vmcnt(0)" ::: "memory");
    __syncthreads();
    if (threadIdx.x == 0) {
        unsigned* bar = b.bar;
        __builtin_amdgcn_s_waitcnt(0);
        unsigned nloc = b.st[0], nx = b.st[1];
        if (nloc == 0u) { xcd_barrier_complete(bar, b.x, nloc, nx); b.st[0] = nloc; b.st[1] = nx; }
        const unsigned old = xb_add(&bar[XB_XSUB(b.x)], 1u);
        const unsigned gen = old / nloc;
        if (old + 1u == (gen + 1u) * nloc) {
            __builtin_amdgcn_fence(__ATOMIC_RELEASE, "agent");
            asm volatile("s_waitcnt vmcnt(0)" ::: "memory");
            const unsigned og = xb_add(&bar[XB_TOP], 1u);
            const unsigned tg = og / nx;
            if (og + 1u == (tg + 1u) * nx) xb_add(&bar[XB_TOPGEN], 1u);
            else XB_SPIN(xb_ld(&bar[XB_TOPGEN]) == tg, bar);
            __builtin_amdgcn_fence(__ATOMIC_ACQUIRE, "agent");
            xb_add(&bar[XB_XGEN(b.x)], 1u);
            asm volatile("s_waitcnt vmcnt(0)" ::: "memory");
        } else {
            XB_SPIN(xb_ld(&bar[XB_XGEN(b.x)]) == gen, bar);
            __builtin_amdgcn_fence(__ATOMIC_ACQUIRE, "agent");
            asm volatile("s_waitcnt vmcnt(0)" ::: "memory");
        }
    }
    __syncthreads();
}

struct Args { const float* in[33]; float* out; unsigned char* ws; int ph_lo, ph_hi, dup, pad; };
struct Frame {
    LAS unsigned char* lds;
    int tid, lane, wave;
    int vcu, G;
};
__device__ __forceinline__ float wave_sum(float v) {
#pragma unroll
    for (int o = 1; o < 64; o <<= 1) v += __shfl_xor(v, o);
    return v;
}
__device__ __forceinline__ unsigned f2bf(float f) { unsigned u = __builtin_bit_cast(unsigned, f); return (u + 0x7fffu + ((u >> 16) & 1u)) >> 16; }
__device__ __forceinline__ unsigned pk2(float lo, float hi) { return f2bf(lo) | (f2bf(hi) << 16); }

__device__ __forceinline__ void p0_transpose_item(const float* W, int K, int N, bf16* WT, LAS float* scr, int item, int lane) {
    const int nblk = N / 32, kb = item / nblk, nb = item % nblk, k0 = 64 * kb, n0 = 32 * nb;
#pragma unroll 8
    for (int i = 0; i < 32; ++i) { const int kk = 2 * i + (lane >> 5); scr[kk * 33 + (lane & 31)] = W[(size_t)(k0 + kk) * N + n0 + (lane & 31)]; }
    LDS_WAIT(); asm volatile("" ::: "memory");
    const int c = lane & 7;
#pragma unroll
    for (int j = 0; j < 4; ++j) { const int n = (lane >> 3) + 8 * j; const LAS float* s = scr + (8 * c) * 33 + n;
        v4u o; o.x = pk2(s[0 * 33], s[1 * 33]); o.y = pk2(s[2 * 33], s[3 * 33]); o.z = pk2(s[4 * 33], s[5 * 33]); o.w = pk2(s[6 * 33], s[7 * 33]);
        *(GAS v4u*)(WT + (size_t)(n0 + n) * K + k0 + 8 * c) = o; }
    LDS_WAIT(); asm volatile("" ::: "memory");
}
__device__ __forceinline__ void p0_mod(Frame& F, const Args& a) {
    LAS float* cact = (LAS float*)(F.lds + RING_OFF);
    LAS float* red = cact + 2 * 4096;
    const float* c = a.in[1]; const float* mw = a.in[2]; const float* mb = a.in[3]; float* MOD = (float*)(a.ws + WS_MOD);
    for (int i = F.tid; i < 2 * 4096; i += NWAVES * 64) cact[i] = siluf_(c[i]);
    __syncthreads();
    const int rg = F.lane >> 4, cq = F.lane & 15;
    for (int it = F.vcu; it < 4 * 192; it += F.G) {
        const int layer = it / 192, cb = it % 192;
        const float* wp = mw + (size_t)layer * 4096 * 12288 + (size_t)(F.wave * 4 + rg) * 12288 + cb * 64 + cq * 4;
        f32x4 a0 = {0.f, 0.f, 0.f, 0.f}, a1 = {0.f, 0.f, 0.f, 0.f};
#pragma unroll 8
        for (int s = 0; s < 128; ++s) { const f32x4 w = *(const GAS f32x4*)(wp + (size_t)s * 32 * 12288); const int k = F.wave * 4 + rg + 32 * s;
            const float c0 = cact[k], c1 = cact[4096 + k]; a0 += w * c0; a1 += w * c1; }
#pragma unroll
        for (int j = 0; j < 4; ++j) { a0[j] += __shfl_xor(a0[j], 16); a0[j] += __shfl_xor(a0[j], 32); a1[j] += __shfl_xor(a1[j], 16); a1[j] += __shfl_xor(a1[j], 32); }
        if (F.lane < 16) { *(LAS f32x4*)(red + (F.wave * 2 + 0) * 64 + cq * 4) = a0; *(LAS f32x4*)(red + (F.wave * 2 + 1) * 64 + cq * 4) = a1; }
        __syncthreads();
        if (F.tid < 128) { const int b = F.tid >> 6, col = F.tid & 63; float s = mb[layer * 12288 + cb * 64 + col];
#pragma unroll
            for (int w = 0; w < 8; ++w) s += red[(w * 2 + b) * 64 + col];
            MOD[((size_t)layer * 2 + b) * 12288 + cb * 64 + col] = s; }
        __syncthreads();
    }
}
__device__ __forceinline__ void p0_s5_group(Frame& F, const Args& a, int g) {
    constexpr int T = S5_T;
    LAS f32x2* pw = (LAS f32x2*)(F.lds + RING_OFF);
    LAS f32x2* bbar = pw + 2 * (T + 1) * 64;
    LAS f32x2* cc = bbar + 2 * 64 * 16;
    LAS float* kf = (LAS float*)(cc + 16 * 64);
    static_assert((2 * (T + 1) * 64 + 2 * 64 * 16 + 16 * 64) * 8 + 2 * T * 256 * 4 <= RING_BYTES, "s5 gen LDS");
    const float *b_re = a.in[9], *b_im = a.in[10], *c_re = a.in[11], *c_im = a.in[12], *dsk = a.in[13];
    float* LAMT = (float*)(a.ws + WS_LAMT);
    if (F.tid < 128) {
        const int dir = F.tid >> 6, p = F.tid & 63, gp = g * 64 + p;
        const float are = (dir ? a.in[16] : a.in[14])[gp], aim = (dir ? a.in[17] : a.in[15])[gp], ls = (dir ? a.in[19] : a.in[18])[gp];
        const float dt = expf(ls), mag = expf(are * dt), lr = mag * cosf(aim * dt), li = mag * sinf(aim * dt);
        const float den = are * are + aim * aim, nr = lr - 1.0f, rre = (nr * are + li * aim) / den, rim = (li * are - nr * aim) / den;
#pragma unroll
        for (int j = 0; j < 16; ++j) { const float br = b_re[(size_t)gp * 16 + j], bi = b_im[(size_t)gp * 16 + j]; bbar[(dir * 64 + p) * 16 + j] = (f32x2){rre * br - rim * bi, rre * bi + rim * br}; }
        float wr_ = 1.0f, wi_ = 0.0f; pw[(dir * (T + 1) + 0) * 64 + p] = (f32x2){1.0f, 0.0f};
        for (int t = 1; t <= T; ++t) { const float nr2 = wr_ * lr - wi_ * li, ni2 = wr_ * li + wi_ * lr; wr_ = nr2; wi_ = ni2; pw[(dir * (T + 1) + t) * 64 + p] = (f32x2){wr_, wi_}; }
        LAMT[((size_t)(g * 2 + dir) * 64 + p) * 2 + 0] = wr_; LAMT[((size_t)(g * 2 + dir) * 64 + p) * 2 + 1] = wi_;
    }
    for (int e = F.tid; e < 16 * 64; e += NWAVES * 64) cc[e] = (f32x2){c_re[(size_t)g * 1024 + e], c_im[(size_t)g * 1024 + e]};
    __syncthreads();
    {
        const int dir = F.tid >> 8, i = (F.tid >> 4) & 15, j = F.tid & 15;
        float acc[T];
#pragma unroll
        for (int t = 0; t < T; ++t) acc[t] = 0.f;
        for (int p = 0; p < 64; ++p) { const f32x2 C = cc[i * 64 + p], Bb = bbar[(dir * 64 + p) * 16 + j]; const float e = C.x * Bb.x - C.y * Bb.y, f = C.x * Bb.y + C.y * Bb.x;
#pragma unroll
            for (int t = 0; t < T; ++t) { const f32x2 w = pw[(dir * (T + 1) + t) * 64 + p]; acc[t] += w.x * e - w.y * f; } }
#pragma unroll
        for (int t = 0; t < T; ++t) kf[((dir * T + t) * 16 + i) * 16 + j] = acc[t];
    }
    __syncthreads();
    bf16* BY = (bf16*)(a.ws + WS_S5BY) + (size_t)g * (S5_KS * S5_KY);
    for (int q = F.tid; q < S5_KS * (S5_KY / 8); q += NWAVES * 64) {
        const int n = q / (S5_KY / 8), pc = q % (S5_KY / 8), t = n >> 4, i = n & 15, k0 = pc * 8; float v[8];
        if (k0 < S5_KS) { const int s = k0 >> 4, j0 = k0 & 15;
#pragma unroll
            for (int e = 0; e < 8; ++e) { const int j = j0 + e; float x;
                if (t > s) x = kf[((0 * T + (t - s)) * 16 + i) * 16 + j];
                else if (t < s) x = kf[((1 * T + (s - t)) * 16 + i) * 16 + j];
                else x = kf[((0 * T + 0) * 16 + i) * 16 + j] + kf[((1 * T + 0) * 16 + i) * 16 + j] + ((i == j) ? dsk[g * 16 + i] : 0.f);
                v[e] = x; }
        } else { const int kk = k0 - S5_KS, seg = kk >> 6, p0 = kk & 63, dir = seg >> 1, tp = dir ? (T - t) : (t + 1);
#pragma unroll
            for (int e = 0; e < 8; ++e) { const int p = p0 + e; const f32x2 w = pw[(dir * (T + 1) + tp) * 64 + p], C = cc[i * 64 + p];
                v[e] = (seg & 1) ? -(C.x * w.y + C.y * w.x) : (C.x * w.x - C.y * w.y); }
        }
        v4u o; o.x = pk2(v[0], v[1]); o.y = pk2(v[2], v[3]); o.z = pk2(v[4], v[5]); o.w = pk2(v[6], v[7]);
        *(GAS v4u*)(BY + (size_t)n * S5_KY + k0) = o;
    }
    bf16* BS = (bf16*)(a.ws + WS_S5BS) + (size_t)g * (256 * S5_KS);
    for (int q = F.tid; q < 256 * (S5_KS / 8); q += NWAVES * 64) {
        const int n = q / (S5_KS / 8), pc = q % (S5_KS / 8), k0 = pc * 8, s = k0 >> 4, j0 = k0 & 15, seg = n >> 6, p = n & 63, dir = seg >> 1;
        const f32x2 w = pw[(dir * (T + 1) + (dir ? s : (T - 1 - s))) * 64 + p]; float v[8];
#pragma unroll
        for (int e = 0; e < 8; ++e) { const f32x2 Bb = bbar[(dir * 64 + p) * 16 + j0 + e]; v[e] = (seg & 1) ? (w.x * Bb.y + w.y * Bb.x) : (w.x * Bb.x - w.y * Bb.y); }
        v4u o; o.x = pk2(v[0], v[1]); o.y = pk2(v[2], v[3]); o.z = pk2(v[4], v[5]); o.w = pk2(v[6], v[7]);
        *(GAS v4u*)(BS + (size_t)n * S5_KS + k0) = o;
    }
    __syncthreads();
}
__device__ __forceinline__ void p0_prologue(Frame& F, const Args& a) {
    p0_mod(F, a);
    {
        LAS float* scr = (LAS float*)(F.lds + RING_OFF + F.wave * 16384);
        const int gw = F.vcu * NWAVES + F.wave, NGW = F.G * NWAVES;
        constexpr int I_NAIN = 64 * 512, I_SQ = 64 * 128, I_S5IN = 64 * 256, I_GLAIN = 64 * 384;
        constexpr int NITEMS = 2 * I_NAIN + 2 * I_SQ + I_S5IN + 2 * I_SQ + I_GLAIN + I_SQ;
        unsigned char* ws = a.ws;
        for (int it = gw; it < NITEMS; it += NGW) {
            int r = it;
            if (r < I_NAIN) { p0_transpose_item(a.in[5], 4096, 16384, (bf16*)(ws + WS_W_NAIN0), scr, r, F.lane); continue; } r -= I_NAIN;
            if (r < I_NAIN) { p0_transpose_item(a.in[5] + (size_t)4096 * 16384, 4096, 16384, (bf16*)(ws + WS_W_NAIN1), scr, r, F.lane); continue; } r -= I_NAIN;
            if (r < I_SQ) { p0_transpose_item(a.in[7], 4096, 4096, (bf16*)(ws + WS_W_NAOUT0), scr, r, F.lane); continue; } r -= I_SQ;
            if (r < I_SQ) { p0_transpose_item(a.in[7] + (size_t)4096 * 4096, 4096, 4096, (bf16*)(ws + WS_W_NAOUT1), scr, r, F.lane); continue; } r -= I_SQ;
            if (r < I_S5IN) { p0_transpose_item(a.in[8], 4096, 8192, (bf16*)(ws + WS_W_S5IN), scr, r, F.lane); continue; } r -= I_S5IN;
            if (r < I_SQ) { p0_transpose_item(a.in[20], 4096, 4096, (bf16*)(ws + WS_W_S5GLU), scr, r, F.lane); continue; } r -= I_SQ;
            if (r < I_SQ) { p0_transpose_item(a.in[22], 4096, 4096, (bf16*)(ws + WS_W_S5OUT), scr, r, F.lane); continue; } r -= I_SQ;
            if (r < I_GLAIN) { p0_transpose_item(a.in[23], 4096, 12288, (bf16*)(ws + WS_W_GLAIN), scr, r, F.lane); continue; } r -= I_GLAIN;
            p0_transpose_item(a.in[31], 4096, 4096, (bf16*)(ws + WS_W_GLAOUT), scr, r, F.lane);
        }
        bf16* G1T = (bf16*)(ws + WS_W_GLAG1);
        for (int e = (F.vcu * NWAVES * 64 + F.tid); e < 256 * 4096 / 2; e += F.G * NWAVES * 64) {
            const int n = e / 2048, k = (e % 2048) * 2; float v0 = 0.f, v1 = 0.f;
            if (n < 16) { v0 = a.in[24][(size_t)k * 16 + n]; v1 = a.in[24][(size_t)(k + 1) * 16 + n]; }
            else if (n < 32) { v0 = a.in[27][(size_t)k * 16 + (n - 16)]; v1 = a.in[27][(size_t)(k + 1) * 16 + (n - 16)]; }
            *(GAS unsigned*)(G1T + (size_t)n * 4096 + k) = pk2(v0, v1);
        }
    }
    __syncthreads();
    for (int g = F.vcu; g < S5_G; g += F.G) p0_s5_group(F, a, g);
}

template <bool FINAL>
__device__ __forceinline__ void norm_phase(Frame& F, const float* xin, const float* nw, const float* mod  , bf16* H, float* outf) {
    LAS f32x2* tab = (LAS f32x2*)(F.lds + RING_OFF);
    for (int i = F.tid; i < 2 * 4096; i += NWAVES * 64) { const int b = i >> 12, c = i & 4095;
        if (FINAL) tab[i] = (f32x2){nw[c], 0.f};
        else tab[i] = (f32x2){nw[c] * (1.0f + mod[b * 12288 + 4096 + c]), mod[b * 12288 + c]}; }
    __syncthreads();
    const int gw = F.vcu * NWAVES + F.wave, NGW = F.G * NWAVES;
    for (int m = gw; m < M; m += NGW) {
        const int b = m >> 13; const GAS f32x4* xr = (const GAS f32x4*)(xin + (size_t)m * D) + F.lane;
        f32x4 v[16]; float s = 0.f;
#pragma unroll
        for (int j = 0; j < 16; ++j) { v[j] = xr[64 * j]; s += (v[j].x * v[j].x + v[j].y * v[j].y) + (v[j].z * v[j].z + v[j].w * v[j].w); }
        const float rstd = rsqrtf(wave_sum(s) * (1.f / D) + EPS);
#pragma unroll
        for (int j = 0; j < 16; ++j) { const int c = 4 * F.lane + 256 * j; const LAS f32x2* tp = tab + b * 4096 + c;
            const f32x2 t0 = tp[0], t1 = tp[1], t2 = tp[2], t3 = tp[3];
            const float o0 = v[j].x * rstd * t0.x + t0.y, o1 = v[j].y * rstd * t1.x + t1.y, o2 = v[j].z * rstd * t2.x + t2.y, o3 = v[j].w * rstd * t3.x + t3.y;
            if (FINAL) *((GAS f32x4*)(outf + (size_t)m * D) + F.lane + 64 * j) = (f32x4){o0, o1, o2, o3};
            else *(GAS v2u*)(H + (size_t)m * D + c) = (v2u){cvt_pk_bf16(o0, o1), cvt_pk_bf16(o2, o3)}; }
    }
    __syncthreads();
}

typedef short v4i16_t __attribute__((ext_vector_type(4)));
__device__ __forceinline__ s16x4 tr4(const LAS unsigned char* p) { return __builtin_bit_cast(s16x4, __builtin_amdgcn_ds_read_tr16_b64_v4i16((LAS v4i16_t*)p)); }
__device__ __forceinline__ bf16x8 cat8(s16x4 a, s16x4 b) { return (bf16x8){a[0], a[1], a[2], a[3], b[0], b[1], b[2], b[3]}; }
__device__ __forceinline__ bf16x8 pack8(f32x4 a, f32x4 b) { v4u w; w.x = cvt_pk_bf16(a[0], a[1]); w.y = cvt_pk_bf16(a[2], a[3]); w.z = cvt_pk_bf16(b[0], b[1]); w.w = cvt_pk_bf16(b[2], b[3]); return __builtin_bit_cast(bf16x8, w); }
#define MFMA16(a, b, c) __builtin_amdgcn_mfma_f32_16x16x32_bf16((a), (b), (c), 0, 0, 0)

constexpr int NA_PITCH = 272, NA_TILE = 64 * NA_PITCH;
__device__ __forceinline__ void na_attn_phase(Frame& F, const bf16* QKVG, bf16* Z, const float* rpb) {
    const int grp = F.wave >> 2, ct = F.wave & 3, lane = F.lane, li = lane & 15, g = lane >> 4, q4 = li >> 2, p4 = li & 3;
    const int c0 = ct * 16, kc0 = min(max(c0 - 8, 0), 32);
    const int ipw = (4096 + F.G - 1) / F.G;
    LAS unsigned char* const lbase = F.lds + RING_OFF;
    LAS float* const rp = (LAS float*)(lbase + 4 * NA_TILE + grp * 2048);
    for (int k = 0; k < ipw; ++k) {
        const int it = F.vcu * ipw + k; if (it >= 4096) break;
        const int b = it >> 11, hp = (it >> 7) & 15, r = ((it & 15) << 3) | ((it >> 4) & 7), h = hp * 2 + grp;
        const int rs = min(max(r - 4, 0), GROWS - 8);
        const size_t tok0 = (size_t)b * SEQ + (size_t)r * GRIDW;
        const bf16* qp = QKVG + (tok0 + c0 + li) * 16384 + h * 128 + 8 * g;
        bf16x8 qf[4];
#pragma unroll
        for (int ks = 0; ks < 4; ++ks) qf[ks] = *(const GAS bf16x8*)(qp + 32 * ks);
        for (int e = (F.tid & 255); e < 465; e += 256) rp[e] = rpb[h * 465 + e];
        v4u st[4];
        const bf16* kvbase = QKVG + ((size_t)b * SEQ + (size_t)rs * GRIDW + 16 * ct + g) * 16384 + h * 128 + li * 8;
#define NA_LOAD(t) do { _Pragma("unroll") for (int j = 0; j < 4; ++j) st[j] = *(const GAS v4u*)(kvbase + ((size_t)((t) & 7) * GRIDW + 4 * j) * 16384 + (((t) >> 3) ? 8192 : 4096)); } while (0)
#define NA_WRITE(buf) do { _Pragma("unroll") for (int j = 0; j < 4; ++j) *(LAS v4u*)(lbase + ((buf) * 2 + grp) * NA_TILE + (16 * ct + 4 * j + g) * NA_PITCH + li * 16) = st[j]; } while (0)
        NA_LOAD(0); NA_WRITE(0); __syncthreads();
        f32x4 S[8][2];
#pragma unroll
        for (int t = 0; t < 8; ++t) {
            NA_LOAD(t + 1);
            const LAS unsigned char* tb = lbase + ((t & 1) * 2 + grp) * NA_TILE;
            S[t][0] = (f32x4){0.f, 0.f, 0.f, 0.f}; S[t][1] = (f32x4){0.f, 0.f, 0.f, 0.f};
#pragma unroll
            for (int blk = 0; blk < 2; ++blk)
#pragma unroll
                for (int ks = 0; ks < 4; ++ks) { const bf16x8 A = *(const LAS bf16x8*)(tb + (kc0 + 16 * blk + li) * NA_PITCH + (32 * ks + 8 * g) * 2);
                    S[t][blk] = MFMA16(A, qf[ks], S[t][blk]); }
            NA_WRITE((t + 1) & 1);
            __syncthreads();
        }
        const int c = c0 + li, cs = min(max(c - 8, 0), GRIDW - 16);
        float mx = -1e30f;
#pragma unroll
        for (int t = 0; t < 8; ++t)
#pragma unroll
            for (int blk = 0; blk < 2; ++blk)
#pragma unroll
                for (int e = 0; e < 4; ++e) { const int kc = kc0 + 16 * blk + 4 * g + e; const bool valid = (kc >= cs) && (kc < cs + 16);
                    const int idx = valid ? ((rs + t - r + 7) * 31 + (kc - c + 15)) : 0;
                    const float s = valid ? (S[t][blk][e] * 0.08838834764831845f + rp[idx]) : -1e30f; S[t][blk][e] = s; mx = fmaxf(mx, s); }
        mx = fmaxf(mx, __shfl_xor(mx, 16)); mx = fmaxf(mx, __shfl_xor(mx, 32));
        float sum = 0.f;
#pragma unroll
        for (int t = 0; t < 8; ++t)
#pragma unroll
            for (int blk = 0; blk < 2; ++blk)
#pragma unroll
                for (int e = 0; e < 4; ++e) { const float p = __expf(S[t][blk][e] - mx); S[t][blk][e] = p; sum += p; }
        sum += __shfl_xor(sum, 16); sum += __shfl_xor(sum, 32);
        const float inv = 1.0f / sum;
        bf16x8 pb[8];
#pragma unroll
        for (int t = 0; t < 8; ++t) pb[t] = pack8(S[t][0], S[t][1]);
        f32x4 O[8];
#pragma unroll
        for (int db = 0; db < 8; ++db) O[db] = (f32x4){0.f, 0.f, 0.f, 0.f};
#pragma unroll
        for (int t = 8; t < 16; ++t) {
            if (t < 15) NA_LOAD(t + 1);
            const LAS unsigned char* tb = lbase + ((t & 1) * 2 + grp) * NA_TILE + (kc0 + 4 * g + q4) * NA_PITCH + 8 * p4;
#pragma unroll
            for (int db = 0; db < 8; ++db) { const s16x4 a0 = tr4(tb + 32 * db), a1 = tr4(tb + 16 * NA_PITCH + 32 * db);
                O[db] = MFMA16(cat8(a0, a1), pb[t - 8], O[db]); }
            if (t < 15) NA_WRITE((t + 1) & 1);
            __syncthreads();
        }
#undef NA_LOAD
#undef NA_WRITE
        bf16* zp = Z + (tok0 + c0 + li) * 4096 + h * 128 + 4 * g; const bf16* gp = QKVG + (tok0 + c0 + li) * 16384 + 12288 + h * 128 + 4 * g;
#pragma unroll
        for (int db = 0; db < 8; ++db) { const v2u gw = *(const GAS v2u*)(gp + 16 * db);
            const float z0 = O[db][0] * inv * siluf_(bf_lo(gw.x)), z1 = O[db][1] * inv * siluf_(bf_hi(gw.x)), z2 = O[db][2] * inv * siluf_(bf_lo(gw.y)), z3 = O[db][3] * inv * siluf_(bf_hi(gw.y));
            *(GAS v2u*)(zp + 16 * db) = (v2u){cvt_pk_bf16(z0, z1), cvt_pk_bf16(z2, z3)}; }
    }
    __syncthreads();
}

__device__ __forceinline__ void na_attn_phase2(Frame& F, const bf16* QKVG, bf16* Z, const float* rpb) {
    const int rq = F.wave >> 2, ct = F.wave & 3, lane = F.lane, li = lane & 15, g = lane >> 4, q4 = li >> 2, p4 = li & 3;
    const int c0 = ct * 16, kc0 = min(max(c0 - 8, 0), 32);
    LAS unsigned char* const lbase = F.lds + RING_OFF;
    LAS float* const rp = (LAS float*)(lbase + 6 * NA_TILE);
    const int ipw = (4096 + F.G - 1) / F.G, it0 = F.vcu * ipw;
    if (it0 >= 4096) return;
    const int nit = min(ipw, 4096 - it0);
    const bool xg = (F.G == 256);
#define NA2_ID(k_) (xg ? ((((F.vcu >> 5) * 8 + ((k_) >> 1)) << 6) | ((((k_) & 1) << 5) | (F.vcu & 31))) : (it0 + (k_)))
    const int id0 = NA2_ID(0);
    const int ptok = F.tid >> 4, pch = F.tid & 15;
    v4u R[1][3][2];
#define NA2_SEC (size_t)(2 * 32 * 8192) * 128
#define NA2_SRC(it_, ss_) (QKVG + (((ss_) >= 9) ? 2 : 1) * NA2_SEC + ((size_t)((it_) >> 6) * 8192 + (size_t)min(min(max(2 * ((it_) & 63) - 4, 0), GROWS - 8) + ((ss_) % 9), GROWS - 1) * GRIDW + ptok) * 128 + pch * 8)
#define NA2_LOADG(set_, it_, gq_) do { _Pragma("unroll") for (int jj_ = 0; jj_ < 3; ++jj_) { const bf16* s_ = NA2_SRC(it_, 3 * (gq_) + jj_); \
        R[set_][jj_][0] = *(const GAS v4u*)s_; R[set_][jj_][1] = *(const GAS v4u*)(s_ + 32 * 128); } } while (0)
#define NA2_WRITEG(set_, buf) do { _Pragma("unroll") for (int jj_ = 0; jj_ < 3; ++jj_) { LAS unsigned char* d_ = lbase + ((buf) * 3 + jj_) * NA_TILE + ptok * NA_PITCH + pch * 16; \
        *(LAS v4u*)d_ = R[set_][jj_][0]; *(LAS v4u*)(d_ + 32 * NA_PITCH) = R[set_][jj_][1]; } } while (0)
#define NA2_SCORE(kl, tb) do { S[kl][0] = (f32x4){0.f, 0.f, 0.f, 0.f}; S[kl][1] = (f32x4){0.f, 0.f, 0.f, 0.f}; \
        _Pragma("unroll") for (int blk = 0; blk < 2; ++blk) _Pragma("unroll") for (int ks = 0; ks < 4; ++ks) { \
            const bf16x8 A_ = *(const LAS bf16x8*)((tb) + (kc0 + 16 * blk + li) * NA_PITCH + (32 * ks + 8 * g) * 2); S[kl][blk] = MFMA16(A_, qf[ks], S[kl][blk]); } \
        _Pragma("unroll") for (int blk = 0; blk < 2; ++blk) _Pragma("unroll") for (int e = 0; e < 4; ++e) { const bool valid = ((blk ? vm1 : vm0) + (unsigned)e) < 16u; const float bias = bp[(kl) * 31 + blk * 16 + e]; \
            const float sv = valid ? (S[kl][blk][e] * 0.08838834764831845f + bias) : -1e30f; S[kl][blk][e] = sv; mx = fmaxf(mx, sv); } } while (0)
#define NA2_PV(kl, tb) do { const LAS unsigned char* t_ = (tb) + (kc0 + 4 * g + q4) * NA_PITCH + 8 * p4; \
        _Pragma("unroll") for (int blk = 0; blk < 2; ++blk) _Pragma("unroll") for (int e = 0; e < 4; ++e) { const float p_ = __expf(S[kl][blk][e] - mx); S[kl][blk][e] = p_; sum += p_; } \
        const bf16x8 pb_ = pack8(S[kl][0], S[kl][1]); \
        _Pragma("unroll") for (int db = 0; db < 8; ++db) O[db] = MFMA16(cat8(tr4(t_ + 32 * db), tr4(t_ + 16 * NA_PITCH + 32 * db)), pb_, O[db]); } while (0)
    NA2_LOADG(0, id0, 0);
    bf16x8 qf[4];
    { const int rp_ = id0 & 63, r_ = 2 * rp_ + rq;
      const bf16* qp = QKVG + ((size_t)(id0 >> 6) * 8192 + (size_t)r_ * GRIDW + c0 + li) * 128 + 8 * g;
#pragma unroll
      for (int ks = 0; ks < 4; ++ks) qf[ks] = *(const GAS bf16x8*)(qp + 32 * ks); }
    NA2_WRITEG(0, 0);
    for (int e = F.tid; e < 465; e += NWAVES * 64) rp[e] = rpb[((id0 >> 6) & 31) * 465 + e];
    __syncthreads();
    for (int k = 0; k < nit; ++k) {
        const int it = NA2_ID(k), itn = NA2_ID(k + 1), b = it >> 11, h = (it >> 6) & 31, rpi = it & 63;
        const int base = min(max(2 * rpi - 4, 0), GROWS - 8), r = 2 * rpi + rq, rsw = min(max(r - 4, 0), GROWS - 8), offw = rsw - base;
        const bool has_next = (k + 1 < nit);
        f32x4 S[8][2];
        int lz = F.lane; asm volatile("" : "+v"(lz)); const int liz = lz & 15, gz = lz >> 4, c = c0 + liz, cs = min(max(c - 8, 0), GRIDW - 16);
        const LAS float* bp = rp + (rsw - r + 7) * 31 + (kc0 + 4 * gz - c + 15);
        const unsigned vm0 = (unsigned)(kc0 + 4 * gz - cs), vm1 = vm0 + 16u;
        float mx = -1e30f, sum = 0.f;
#pragma unroll
        for (int gi = 0; gi < 3; ++gi) {
            NA2_LOADG(0, it, gi + 1);
#pragma unroll
            for (int jj = 0; jj < 3; ++jj) { const int j = 3 * gi + jj; const LAS unsigned char* tb = lbase + ((gi & 1) * 3 + jj) * NA_TILE;
                if (offw == 0) { if (j < 8) NA2_SCORE((j < 8 ? j : 0), tb); } else { if (j >= 1) NA2_SCORE((j >= 1 ? j - 1 : 0), tb); }
                asm volatile("" ::: "memory"); }
            NA2_WRITEG(0, (gi + 1) & 1);
            __syncthreads();
        }
        mx = fmaxf(mx, __shfl_xor(mx, 16)); mx = fmaxf(mx, __shfl_xor(mx, 32));
        f32x4 O[8];
#pragma unroll
        for (int db = 0; db < 8; ++db) O[db] = (f32x4){0.f, 0.f, 0.f, 0.f};
        v2u gw[8];
        bf16x8 qn[4];
#pragma unroll
        for (int gi = 0; gi < 3; ++gi) {
            const int sg = 3 + gi;
            if (sg + 1 < 6) NA2_LOADG(0, it, sg + 1); else if (has_next) NA2_LOADG(0, itn, 0);
            if (gi == 1 && has_next) { for (int e = F.tid; e < 465; e += NWAVES * 64) rp[e] = rpb[((itn >> 6) & 31) * 465 + e]; }
            if (gi == 2 && has_next) { const int rpn = itn & 63, rn = 2 * rpn + rq;
                const bf16* qp = QKVG + ((size_t)(itn >> 6) * 8192 + (size_t)rn * GRIDW + c0 + li) * 128 + 8 * g;
#pragma unroll
                for (int ks = 0; ks < 4; ++ks) qn[ks] = *(const GAS bf16x8*)(qp + 32 * ks); }
#pragma unroll
            for (int jj = 0; jj < 3; ++jj) { const int j = 3 * gi + jj; const LAS unsigned char* tb = lbase + ((sg & 1) * 3 + jj) * NA_TILE;
                if (offw == 0) { if (j < 8) NA2_PV((j < 8 ? j : 0), tb); } else { if (j >= 1) NA2_PV((j >= 1 ? j - 1 : 0), tb); }
                asm volatile("" ::: "memory"); }
            if (sg + 1 < 6 || has_next) NA2_WRITEG(0, (sg + 1) & 1);
            __syncthreads();
        }
        sum += __shfl_xor(sum, 16); sum += __shfl_xor(sum, 32);
        const float inv = __builtin_amdgcn_rcpf(sum);
        int lq = F.lane; asm volatile("" : "+v"(lq)); const int liq = lq & 15, gq = lq >> 4;
        const size_t mq = (size_t)b * SEQ + (size_t)r * GRIDW + c0 + liq;
        const bf16* gp = QKVG + 3 * NA2_SEC + ((size_t)(it >> 6) * 8192 + (size_t)r * GRIDW + c0 + liq) * 128 + 4 * gq;
        bf16* zp = Z + mq * 4096 + h * 128 + 4 * gq;
#pragma unroll
        for (int db = 0; db < 8; ++db) gw[db] = *(const GAS v2u*)(gp + 16 * db);
#pragma unroll
        for (int db = 0; db < 8; ++db) {
            const float z0 = O[db][0] * inv * siluf_(bf_lo(gw[db].x)), z1 = O[db][1] * inv * siluf_(bf_hi(gw[db].x)), z2 = O[db][2] * inv * siluf_(bf_lo(gw[db].y)), z3 = O[db][3] * inv * siluf_(bf_hi(gw[db].y));
            *(GAS v2u*)(zp + 16 * db) = (v2u){cvt_pk_bf16(z0, z1), cvt_pk_bf16(z2, z3)}; }
        if (has_next) {
#pragma unroll
            for (int ks = 0; ks < 4; ++ks) qf[ks] = qn[ks]; }
    }
#undef NA2_SRC
#undef NA2_SEC
#undef NA2_ID
#undef NA2_LOADG
#undef NA2_WRITEG
#undef NA2_SCORE
#undef NA2_PV
    __syncthreads();
}

__device__ __forceinline__ void s5_scan_phase(Frame& F, const Args& a) {
    const float* Sloc = (const float*)(a.ws + WS_S5_SLOC); bf16* Ug = (bf16*)(a.ws + WS_S5_UG); const float* LAMT = (const float*)(a.ws + WS_LAMT);
    const int t8 = F.tid & 255, b = t8 >> 7, dir = (t8 >> 6) & 1, p = t8 & 63;
    for (int gi = F.vcu * 2 + (F.tid >> 8); gi < S5_G; gi += F.G * 2) {
        const float lr = LAMT[((size_t)(gi * 2 + dir) * 64 + p) * 2 + 0], li = LAMT[((size_t)(gi * 2 + dir) * 64 + p) * 2 + 1];
        float xr = 0.f, xi = 0.f;
#pragma unroll 8
        for (int s = 0; s < S5_NCHB; ++s) { const int c = dir ? (S5_NCHB - 1 - s) : s; const size_t row = (size_t)gi * S5_NCH + b * S5_NCHB + c;
            bf16* up = Ug + row * S5_KY + S5_KS + dir * 128 + p;
            up[0] = (bf16)f2bf(xr); up[64] = (bf16)f2bf(xi);
            const float sr = Sloc[row * 256 + dir * 128 + p], si = Sloc[row * 256 + dir * 128 + 64 + p];
            const float nr = lr * xr - li * xi + sr, ni = lr * xi + li * xr + si; xr = nr; xi = ni; }
    }
}

__device__ __forceinline__ float log_sigmoidf_(float z) { return fminf(z, 0.f) - log1pf(expf(-fabsf(z))); }
__device__ __forceinline__ void gla_prep_phase(Frame& F, const Args& a) {
    const bf16* IN = (const bf16*)(a.ws + WS_GLA_IN); const float* G1P = (const float*)(a.ws + WS_GLA_G1P);
    bf16* PREP = (bf16*)(a.ws + WS_GLA_PREP); float* DECAY = (float*)(a.ws + WS_GLA_DECAY);
    LAS float* g1s = (LAS float*)(F.lds + RING_OFF);
    LAS float* Bc = g1s + 64 * 32;
    LAS float* bl = Bc + 2 * 64 * 256;
    static_assert((64 * 32 + 2 * 64 * 256 + 2 * 256) * 4 <= MISC_OFF, "gla prep LDS");
    const int ipw = (2048 + F.G - 1) / F.G; int cur_chunk = -1;
    for (int k = 0; k < ipw; ++k) {
        const int it = F.vcu * ipw + k; if (it >= 2048) break;
        const int cidx = it >> 3, h = it & 7, m0 = cidx * GLA_C, dbase = h * 256;
        if (cidx != cur_chunk) { cur_chunk = cidx;
            const int tok = F.tid >> 3, qd = F.tid & 7; f32x4 s4 = {0.f, 0.f, 0.f, 0.f};
#pragma unroll
            for (int ks = 0; ks < 4; ++ks) s4 += *(const GAS f32x4*)(G1P + ((size_t)ks * M + m0 + tok) * 32 + qd * 4);
            *(LAS f32x4*)(g1s + tok * 32 + qd * 4) = s4;
            __syncthreads(); }
        v4u q8[4], k8[4];
#pragma unroll
        for (int j = 0; j < 4; ++j) { const int e = F.tid + 512 * j, tok = e >> 5, c8 = (e & 31) * 8; const size_t m = (size_t)m0 + tok;
            q8[j] = *(const GAS v4u*)(IN + m * GLA_NIN + dbase + c8); k8[j] = *(const GAS v4u*)(IN + m * GLA_NIN + GLA_KW + dbase + c8); }
        {
            const int dir = F.tid >> 8, col = F.tid & 255, d = dbase + col;
            const float* w2 = dir ? a.in[28] : a.in[25]; const float bgd = (dir ? a.in[29] : a.in[26])[d];
            float w2r[16];
#pragma unroll
            for (int r = 0; r < 16; ++r) w2r[r] = w2[(size_t)r * GLA_KW + d];
            float run = 0.f;
#pragma unroll 4
            for (int s = 0; s < 64; ++s) { const int i = dir ? (63 - s) : s; const LAS f32x4* gp = (const LAS f32x4*)(g1s + i * 32 + dir * 16); float z = bgd;
                const f32x4 g0 = gp[0], g1 = gp[1], g2 = gp[2], g3 = gp[3];
                z += g0[0] * w2r[0] + g0[1] * w2r[1] + g0[2] * w2r[2] + g0[3] * w2r[3]; z += g1[0] * w2r[4] + g1[1] * w2r[5] + g1[2] * w2r[6] + g1[3] * w2r[7];
                z += g2[0] * w2r[8] + g2[1] * w2r[9] + g2[2] * w2r[10] + g2[3] * w2r[11]; z += g3[0] * w2r[12] + g3[1] * w2r[13] + g3[2] * w2r[14] + g3[3] * w2r[15];
                const float ls = fminf(z, 0.f) - __logf(1.0f + __expf(-fabsf(z)));
                run += ls * (1.0f / 16.0f); Bc[(dir * 64 + i) * 256 + col] = run; }
            bl[dir * 256 + col] = run;
        }
        __syncthreads();
#pragma unroll
        for (int j = 0; j < 4; ++j) { const int e = F.tid + 512 * j, tok = e >> 5, c8 = (e & 31) * 8; const size_t m = (size_t)m0 + tok;
            float qv[8], kv[8];
#pragma unroll
            for (int x = 0; x < 4; ++x) { qv[2 * x] = bf_lo(q8[j][x]) * 0.0625f; qv[2 * x + 1] = bf_hi(q8[j][x]) * 0.0625f; kv[2 * x] = bf_lo(k8[j][x]); kv[2 * x + 1] = bf_hi(k8[j][x]); }
#pragma unroll
            for (int dir = 0; dir < 2; ++dir) {
                f32x4 bbv[2], btv[2];
                bbv[0] = *(const LAS f32x4*)(Bc + (dir * 64 + tok) * 256 + c8); bbv[1] = *(const LAS f32x4*)(Bc + (dir * 64 + tok) * 256 + c8 + 4);
                btv[0] = *(const LAS f32x4*)(bl + dir * 256 + c8); btv[1] = *(const LAS f32x4*)(bl + dir * 256 + c8 + 4);
                float o0[8], o1[8], o2[8];
#pragma unroll
                for (int x = 0; x < 8; ++x) { const float bx = bbv[x >> 2][x & 3], tx = btv[x >> 2][x & 3]; o0[x] = qv[x] * __expf(bx); o1[x] = kv[x] * __expf(-bx); o2[x] = kv[x] * __expf(tx - bx); }
                v4u w0, w1, w2;
#pragma unroll
                for (int x = 0; x < 4; ++x) { w0[x] = cvt_pk_bf16(o0[2 * x], o0[2 * x + 1]); w1[x] = cvt_pk_bf16(o1[2 * x], o1[2 * x + 1]); w2[x] = cvt_pk_bf16(o2[2 * x], o2[2 * x + 1]); }
                bf16* pp = PREP + (size_t)(dir * 3) * M * GLA_KW + m * GLA_KW + dbase + c8;
                *(GAS v4u*)(pp) = w0; *(GAS v4u*)(pp + (size_t)M * GLA_KW) = w1; *(GAS v4u*)(pp + (size_t)2 * M * GLA_KW) = w2;
                if (tok == 0) { float* dp = DECAY + ((size_t)dir * GLA_NCH + cidx) * GLA_KW + dbase + c8;
                    *(GAS f32x4*)(dp) = (f32x4){__expf(btv[0][0]), __expf(btv[0][1]), __expf(btv[0][2]), __expf(btv[0][3])}; *(GAS f32x4*)(dp + 4) = (f32x4){__expf(btv[1][0]), __expf(btv[1][1]), __expf(btv[1][2]), __expf(btv[1][3])}; }
            }
        }
        __syncthreads();
    }
}

constexpr int GLA_PQ = 528, GLA_PV = 272, GLA_PVI = 1040;
__device__ __forceinline__ void gla_chain_role(Frame& F, const Args& a, int ch) {
    const bf16* IN = (const bf16*)(a.ws + WS_GLA_IN); const bf16* PREP = (const bf16*)(a.ws + WS_GLA_PREP); const float* DECAY = (const float*)(a.ws + WS_GLA_DECAY);
    const int b = ch >> 6, h = (ch >> 3) & 7, dir = (ch >> 2) & 1, vq = ch & 3;
    bf16* OUT = (bf16*)(a.ws + WS_GLA_O) + (size_t)(1 + dir) * M * 4096;
    const bf16* QS = PREP + (size_t)(dir * 3 + 0) * M * GLA_KW; const bf16* KE = PREP + (size_t)(dir * 3 + 2) * M * GLA_KW;
    LAS unsigned char* const qsT = F.lds + RING_OFF; LAS unsigned char* const keT = qsT + 64 * GLA_PQ; LAS unsigned char* const vT = keT + 64 * GLA_PQ; LAS float* const decT = (LAS float*)(vT + 64 * GLA_PV);
    const int lane = F.lane, li = lane & 15, g = lane >> 4, q4 = li >> 2, p4 = li & 3, w = F.wave;
    f32x4 S[16];
#pragma unroll
    for (int dt = 0; dt < 16; ++dt) S[dt] = (f32x4){0.f, 0.f, 0.f, 0.f};
    v4u rq[4], rk[4], rv[2]; f32x4 rd = {0.f, 0.f, 0.f, 0.f};
#define GC_LOAD(sidx) do { const int cn_ = dir ? (GLA_NCHB - 1 - (sidx)) : (sidx); const size_t m0_ = ((size_t)b * GLA_NCHB + cn_) * GLA_C; \
        _Pragma("unroll") for (int j = 0; j < 4; ++j) { const int e = F.tid + 512 * j, tok = e >> 5, pc = e & 31; \
            rq[j] = *(const GAS v4u*)(QS + (m0_ + tok) * GLA_KW + h * 256 + pc * 8); rk[j] = *(const GAS v4u*)(KE + (m0_ + tok) * GLA_KW + h * 256 + pc * 8); } \
        _Pragma("unroll") for (int j = 0; j < 2; ++j) { const int e = F.tid + 512 * j, tok = e >> 4, pc = e & 15; \
            rv[j] = *(const GAS v4u*)(IN + (m0_ + tok) * GLA_NIN + 4096 + h * 512 + vq * 128 + pc * 8); } \
        if (F.tid < 64) rd = *(const GAS f32x4*)(DECAY + ((size_t)dir * GLA_NCH + b * GLA_NCHB + cn_) * GLA_KW + h * 256 + F.tid * 4); } while (0)
    GC_LOAD(0);
    for (int sidx = 0; sidx < GLA_NCHB; ++sidx) {
#pragma unroll
        for (int j = 0; j < 4; ++j) { const int e = F.tid + 512 * j, tok = e >> 5, pc = e & 31; *(LAS v4u*)(qsT + tok * GLA_PQ + pc * 16) = rq[j]; *(LAS v4u*)(keT + tok * GLA_PQ + pc * 16) = rk[j]; }
#pragma unroll
        for (int j = 0; j < 2; ++j) { const int e = F.tid + 512 * j, tok = e >> 4, pc = e & 15; *(LAS v4u*)(vT + tok * GLA_PV + pc * 16) = rv[j]; }
        if (F.tid < 64) *(LAS f32x4*)(decT + F.tid * 4) = rd;
        __syncthreads();
        const int cn = dir ? (GLA_NCHB - 1 - sidx) : sidx; const size_t m0 = ((size_t)b * GLA_NCHB + cn) * GLA_C;
        if (sidx + 1 < GLA_NCHB) GC_LOAD(sidx + 1);
        v2u Sb[16];
#pragma unroll
        for (int dt = 0; dt < 16; ++dt) Sb[dt] = (v2u){cvt_pk_bf16(S[dt][0], S[dt][1]), cvt_pk_bf16(S[dt][2], S[dt][3])};
        {
            f32x4 acc[4];
#pragma unroll
            for (int ib = 0; ib < 4; ++ib) acc[ib] = (f32x4){0.f, 0.f, 0.f, 0.f};
            const LAS unsigned char* qrow = qsT + li * GLA_PQ + 8 * g;
#pragma unroll
            for (int ks = 0; ks < 8; ++ks) { const bf16x8 A = __builtin_bit_cast(bf16x8, (v4u){Sb[2 * ks].x, Sb[2 * ks].y, Sb[2 * ks + 1].x, Sb[2 * ks + 1].y});
#pragma unroll
                for (int ib = 0; ib < 4; ++ib) { const v2u b0 = *(const LAS v2u*)(qrow + 16 * ib * GLA_PQ + 64 * ks), b1 = *(const LAS v2u*)(qrow + 16 * ib * GLA_PQ + 64 * ks + 32);
                    acc[ib] = MFMA16(A, __builtin_bit_cast(bf16x8, (v4u){b0.x, b0.y, b1.x, b1.y}), acc[ib]); } }
#pragma unroll
            for (int ib = 0; ib < 4; ++ib)
                *(GAS v2u*)(OUT + (m0 + 16 * ib + li) * 4096 + h * 512 + vq * 128 + w * 16 + 4 * g) = (v2u){cvt_pk_bf16(acc[ib][0], acc[ib][1]), cvt_pk_bf16(acc[ib][2], acc[ib][3])};
        }
#pragma unroll
        for (int dt = 0; dt < 16; ++dt) S[dt] *= *(const LAS f32x4*)(decT + 16 * dt + 4 * g);
#pragma unroll
        for (int k2 = 0; k2 < 2; ++k2) { const LAS unsigned char* vb = vT + (32 * k2 + 8 * g + q4) * GLA_PV + (w * 16 + 4 * p4) * 2;
            const bf16x8 Bv = cat8(tr4(vb), tr4(vb + 4 * GLA_PV));
            const LAS unsigned char* kb = keT + (32 * k2 + 8 * g + q4) * GLA_PQ + 8 * p4;
#pragma unroll
            for (int dt = 0; dt < 16; ++dt) { const bf16x8 A = cat8(tr4(kb + 32 * dt), tr4(kb + 4 * GLA_PQ + 32 * dt)); S[dt] = MFMA16(A, Bv, S[dt]); } }
        __syncthreads();
    }
#undef GC_LOAD
}
__device__ __forceinline__ void gla_intra_role(Frame& F, const Args& a, int it) {
    const bf16* IN = (const bf16*)(a.ws + WS_GLA_IN); const bf16* PREP = (const bf16*)(a.ws + WS_GLA_PREP);
    bf16* OUT = (bf16*)(a.ws + WS_GLA_O);
    const int b = it >> 10, h = (it >> 7) & 7, cn = it & 127; const size_t m0 = ((size_t)b * GLA_NCHB + cn) * GLA_C;
    LAS unsigned char* const kfT = F.lds + RING_OFF; LAS unsigned char* const kbT = kfT + 64 * GLA_PQ; LAS unsigned char* const vT = kbT + 64 * GLA_PQ;
    const int lane = F.lane, li = lane & 15, g = lane >> 4, q4 = li >> 2, p4 = li & 3, ib = F.wave & 3, vh = F.wave >> 2;
    const bf16* KSF = PREP + (size_t)1 * M * GLA_KW; const bf16* KSB = PREP + (size_t)4 * M * GLA_KW;
    const bf16* QSF = PREP; const bf16* QSB = PREP + (size_t)3 * M * GLA_KW;
    {
        v4u r0[4], r1[4], r2[8];
#pragma unroll
        for (int j = 0; j < 4; ++j) { const int e = F.tid + 512 * j, tok = e >> 5, pc = e & 31; r0[j] = *(const GAS v4u*)(KSF + (m0 + tok) * GLA_KW + h * 256 + pc * 8); r1[j] = *(const GAS v4u*)(KSB + (m0 + tok) * GLA_KW + h * 256 + pc * 8); }
#pragma unroll
        for (int j = 0; j < 8; ++j) { const int e = F.tid + 512 * j, tok = e >> 6, pc = e & 63; r2[j] = *(const GAS v4u*)(IN + (m0 + tok) * GLA_NIN + 4096 + h * 512 + pc * 8); }
#pragma unroll
        for (int j = 0; j < 4; ++j) { const int e = F.tid + 512 * j, tok = e >> 5, pc = e & 31; *(LAS v4u*)(kfT + tok * GLA_PQ + pc * 16) = r0[j]; *(LAS v4u*)(kbT + tok * GLA_PQ + pc * 16) = r1[j]; }
#pragma unroll
        for (int j = 0; j < 8; ++j) { const int e = F.tid + 512 * j, tok = e >> 6, pc = e & 63; *(LAS v4u*)(vT + tok * GLA_PVI + pc * 16) = r2[j]; }
    }
    bf16x8 qf[8], qb[8];
#pragma unroll
    for (int ks = 0; ks < 8; ++ks) { qf[ks] = *(const GAS bf16x8*)(QSF + (m0 + 16 * ib + li) * GLA_KW + h * 256 + 32 * ks + 8 * g); qb[ks] = *(const GAS bf16x8*)(QSB + (m0 + 16 * ib + li) * GLA_KW + h * 256 + 32 * ks + 8 * g); }
    __syncthreads();
    f32x4 P[4];
#pragma unroll
    for (int jb = 0; jb < 4; ++jb) { f32x4 sf = {0.f, 0.f, 0.f, 0.f}, sb = {0.f, 0.f, 0.f, 0.f};
        if (jb <= ib) {
#pragma unroll
            for (int ks = 0; ks < 8; ++ks) sf = MFMA16(*(const LAS bf16x8*)(kfT + (16 * jb + li) * GLA_PQ + (32 * ks + 8 * g) * 2), qf[ks], sf); }
        if (jb >= ib) {
#pragma unroll
            for (int ks = 0; ks < 8; ++ks) sb = MFMA16(*(const LAS bf16x8*)(kbT + (16 * jb + li) * GLA_PQ + (32 * ks + 8 * g) * 2), qb[ks], sb); }
#pragma unroll
        for (int e = 0; e < 4; ++e) { const int ii = 16 * ib + li, jj = 16 * jb + 4 * g + e; P[jb][e] = (ii >= jj) ? sf[e] : sb[e]; } }
    if (MK_DIAG) { bool bad = false;
#pragma unroll
        for (int jb = 0; jb < 4; ++jb)
#pragma unroll
            for (int e = 0; e < 4; ++e) bad |= !(fabsf(P[jb][e]) < 1e30f);
        if (bad) atomicOr((unsigned*)(a.ws + WS_CTL) + 17, 1u << 4); }
    const bf16x8 Pb0 = pack8(P[0], P[1]), Pb1 = pack8(P[2], P[3]);
    bf16* op = OUT + (m0 + 16 * ib + li) * 4096 + h * 512 + vh * 256 + 4 * g;
    const LAS unsigned char* vb = vT + (4 * g + q4) * GLA_PVI + (vh * 256 + 4 * p4) * 2;
#pragma unroll
    for (int vt = 0; vt < 16; ++vt) { f32x4 acc = {0.f, 0.f, 0.f, 0.f};
        acc = MFMA16(cat8(tr4(vb + 32 * vt), tr4(vb + 16 * GLA_PVI + 32 * vt)), Pb0, acc);
        acc = MFMA16(cat8(tr4(vb + 32 * GLA_PVI + 32 * vt), tr4(vb + 48 * GLA_PVI + 32 * vt)), Pb1, acc);
        if (MK_DIAG && (!(fabsf(acc[0]) < 1e30f) || !(fabsf(acc[1]) < 1e30f) || !(fabsf(acc[2]) < 1e30f) || !(fabsf(acc[3]) < 1e30f))) atomicOr((unsigned*)(a.ws + WS_CTL) + 17, 1u << 5);
        *(GAS v2u*)(op + 16 * vt) = (v2u){cvt_pk_bf16(acc[0], acc[1]), cvt_pk_bf16(acc[2], acc[3])}; }
    __syncthreads();
}
__device__ __forceinline__ void gla_main_phase(Frame& F, const Args& a) {
    if (F.vcu < 128) { for (int ch = F.vcu; ch < 128; ch += 128) gla_chain_role(F, a, ch); }
    else { for (int it = F.vcu - 128; it < 2048; it += F.G - 128) gla_intra_role(F, a, it); }
}
__device__ __forceinline__ void gla_combine_phase(Frame& F, const Args& a) {
    const bf16* IN = (const bf16*)(a.ws + WS_GLA_IN); const bf16* O = (const bf16*)(a.ws + WS_GLA_O); bf16* Z = (bf16*)(a.ws + WS_GLA_Z);
    const float* nw = a.in[30];
    float nwr[8];
#pragma unroll
    for (int x = 0; x < 8; ++x) nwr[x] = nw[F.lane * 8 + x];
    const int gw = F.vcu * NWAVES + F.wave, NGW = F.G * NWAVES;
    for (int m = gw; m < M; m += NGW) {
#pragma unroll 2
        for (int h = 0; h < 8; ++h) { const size_t off = (size_t)m * 4096 + h * 512 + F.lane * 8;
            const v4u x0 = *(const GAS v4u*)(O + off), x1 = *(const GAS v4u*)(O + (size_t)M * 4096 + off), x2 = *(const GAS v4u*)(O + (size_t)2 * M * 4096 + off);
            const v4u gg = *(const GAS v4u*)(IN + (size_t)m * GLA_NIN + 8192 + h * 512 + F.lane * 8);
            if (MK_DIAG) { bool b0 = false, b1 = false, b2 = false, b3 = false;
#pragma unroll
                for (int x = 0; x < 4; ++x) { b0 |= !(fabsf(bf_lo(x0[x])) < 1e30f) || !(fabsf(bf_hi(x0[x])) < 1e30f); b1 |= !(fabsf(bf_lo(x1[x])) < 1e30f) || !(fabsf(bf_hi(x1[x])) < 1e30f);
                    b2 |= !(fabsf(bf_lo(x2[x])) < 1e30f) || !(fabsf(bf_hi(x2[x])) < 1e30f); b3 |= !(fabsf(bf_lo(gg[x])) < 1e30f) || !(fabsf(bf_hi(gg[x])) < 1e30f); }
                const unsigned f = (b0 ? 1024u : 0u) | (b1 ? 2048u : 0u) | (b2 ? 4096u : 0u) | (b3 ? 8192u : 0u); if (f) atomicOr((unsigned*)(a.ws + WS_CTL) + 17, f); }
            float o[8]; float ss = 0.f;
#pragma unroll
            for (int x = 0; x < 4; ++x) { o[2 * x] = bf_lo(x0[x]) + bf_lo(x1[x]) + bf_lo(x2[x]); o[2 * x + 1] = bf_hi(x0[x]) + bf_hi(x1[x]) + bf_hi(x2[x]); ss += o[2 * x] * o[2 * x] + o[2 * x + 1] * o[2 * x + 1]; }
            const float rstd = rsqrtf(wave_sum(ss) * (1.0f / 512.0f) + EPS);
            v4u zw;
#pragma unroll
            for (int x = 0; x < 4; ++x) zw[x] = cvt_pk_bf16(o[2 * x] * rstd * nwr[2 * x] * siluf_(bf_lo(gg[x])), o[2 * x + 1] * rstd * nwr[2 * x + 1] * siluf_(bf_hi(gg[x])));
            *(GAS v4u*)(Z + off) = zw; }
    }
}

constexpr int NPH = 23;
__global__ void __launch_bounds__(NWAVES * 64, 2) fwd_kernel(Args args) {
    extern __shared__ __attribute__((aligned(16))) unsigned char lds[];
    Frame F;
    F.lds = (LAS unsigned char*)lds;
    F.tid = threadIdx.x; F.lane = F.tid & 63; F.wave = __builtin_amdgcn_readfirstlane(F.tid >> 6);
    F.G = gridDim.x; { const int bx = blockIdx.x; F.vcu = (F.G % 8 == 0) ? (bx % 8) * (F.G / 8) + bx / 8 : bx; }
    volatile LAS unsigned* MISC = (volatile LAS unsigned*)(F.lds + MISC_OFF);
    for (int u = F.tid; u < (LDS_BYTES - MISC_OFF) / 4; u += NWAVES * 64) MISC[u] = 0u;
    __syncthreads();
    unsigned char* ws = args.ws;
    const int lo = args.ph_lo, hi = args.ph_hi, rep = args.dup;
    XcdBarrier bar; bar.bar = (unsigned*)(ws + WS_CTL) + CW_BAR; bar.x = 0; bar.st = nullptr;
    if (hi - lo > 1) bar = xcd_barrier_post((unsigned*)(ws + WS_CTL) + CW_BAR, MISC + 8);
#define IN(k) (lo <= (k) && (k) < hi)
#define REP(k)
#if MK_PROF
    volatile LAS unsigned long long* PROF = (volatile LAS unsigned long long*)(F.lds + 135168);
    if (F.tid == 0) PROF[0] = __builtin_amdgcn_s_memrealtime();
#define SEAM(k) do { if (IN(k) && IN((k) + 1)) { if (F.tid == 0) PROF[32 + (k)] = __builtin_amdgcn_s_memrealtime(); xcd_barrier(bar); if (F.tid == 0) PROF[1 + (k)] = __builtin_amdgcn_s_memrealtime(); } } while (0)
#else
#define SEAM(k) do { if (IN(k) && IN((k) + 1)) xcd_barrier(bar); } while (0)
#endif
    const float* MOD = (const float*)(ws + WS_MOD);
    bf16* H = (bf16*)(ws + WS_H);
    float* XO = args.out;
    LAS unsigned char* ring = F.lds + RING_OFF;
    unsigned* const DFLAG = (unsigned*)(ws + WS_CTL) + 16;

    if (IN(0)) { REP(0) { p0_prologue(F, args); } } SEAM(0);

#if MK_NLAYERS >= 1
    if (IN(1)) { REP(1) { norm_phase<false>(F, args.in[0], args.in[4] + 0 * D, MOD + 0 * 2 * 12288, H, nullptr); } } SEAM(1);
    if (IN(2)) { REP(2) { pg8::Gemm g{H, (const bf16*)(ws + WS_W_NAIN0), 4096, 4096, 4096, DFLAG, 1u << 2}; pg8::StaticOrder S; S.init(M, 16384, F.G, (int)blockIdx.x);
        pg8::EpiNaIn E{(bf16*)(ws + WS_NA_QKVG)};
        pg8::gemm_phase<pg8::EpiNaIn, pg8::StaticOrder, false, true>(ring, g, S, E); } } SEAM(2);
    if (IN(3)) { REP(3) na_attn_phase2(F, (const bf16*)(ws + WS_NA_QKVG), (bf16*)(ws + WS_NA_Z), args.in[6] + 0 * 32 * 465); } SEAM(3);
    if (IN(4)) { REP(4) { pg8::Gemm g{(const bf16*)(ws + WS_NA_Z), (const bf16*)(ws + WS_W_NAOUT0), 4096, 4096, 4096, DFLAG, 1u << 4}; pg8::StaticOrder S; S.init(M, 4096, F.G, (int)blockIdx.x);
        pg8::EpiResid E{args.in[0], rep ? (float*)(ws + WS_SCR) : XO, D, MOD + 0 * 2 * 12288 + 8192, 12288, SEQ};
        pg8::gemm_phase<pg8::EpiResid, pg8::StaticOrder, true, true>(ring, g, S, E); } } SEAM(4);
#endif
#if MK_NLAYERS >= 2
    if (IN(5)) { REP(5) { norm_phase<false>(F, XO, args.in[4] + 1 * D, MOD + 1 * 2 * 12288, H, nullptr); } } SEAM(5);
    if (IN(6)) { REP(6) { pg8::Gemm g{H, (const bf16*)(ws + WS_W_S5IN), 4096, 4096, 4096, DFLAG, 1u << 6}; pg8::StaticOrder S; S.init(M, 8192, F.G, (int)blockIdx.x);
        pg8::EpiS5In<S5_T, S5_NCH, S5_KY> E{(bf16*)(ws + WS_S5_UG), (bf16*)(ws + WS_S5_GS)};
        pg8::gemm_phase<pg8::EpiS5In<S5_T, S5_NCH, S5_KY>, pg8::StaticOrder, true, true>(ring, g, S, E); } } SEAM(6);
    if (IN(7)) { REP(7) { pg8::Gemm g{(const bf16*)(ws + WS_S5_UG), (const bf16*)(ws + WS_S5BS), S5_KS, S5_KY, S5_KS, DFLAG, 1u << 7}; pg8::BatchedOrder S; S.init(S5_G, S5_NCH / 256, 1, F.G, (int)blockIdx.x);
        pg8::EpiF32 E{(float*)(ws + WS_S5_SLOC), 256};
        pg8::gemm_phase<pg8::EpiF32, pg8::BatchedOrder, true, true>(ring, g, S, E); } } SEAM(7);
    if (IN(8)) { REP(8) { s5_scan_phase(F, args); } } SEAM(8);
    if (IN(9)) { REP(9) { pg8::Gemm g{(const bf16*)(ws + WS_S5_UG), (const bf16*)(ws + WS_S5BY), S5_KY, S5_KY, S5_KY, DFLAG, 1u << 9}; pg8::BatchedOrder S; S.init(S5_G, S5_NCH / 256, S5_KS / 256, F.G, (int)blockIdx.x);
        pg8::EpiS5Y<S5_T, S5_NCH / 256> E{(bf16*)(ws + WS_S5_Y)};
        pg8::gemm_phase<pg8::EpiS5Y<S5_T, S5_NCH / 256>, pg8::BatchedOrder, true, true>(ring, g, S, E); } } SEAM(9);
    if (IN(10)) { REP(10) { pg8::Gemm g{(const bf16*)(ws + WS_S5_Y), (const bf16*)(ws + WS_W_S5GLU), 4096, 4096, 4096, DFLAG, 1u << 10}; pg8::StaticOrder S; S.init(M, 4096, F.G, (int)blockIdx.x);
        pg8::EpiGlu E{(const bf16*)(ws + WS_S5_Y), (const bf16*)(ws + WS_S5_GS), args.in[21], (bf16*)(ws + WS_S5_Z)};
        pg8::gemm_phase<pg8::EpiGlu, pg8::StaticOrder, true, true>(ring, g, S, E); } } SEAM(10);
    if (IN(11)) { REP(11) { pg8::Gemm g{(const bf16*)(ws + WS_S5_Z), (const bf16*)(ws + WS_W_S5OUT), 4096, 4096, 4096, DFLAG, 1u << 11}; pg8::StaticOrder S; S.init(M, 4096, F.G, (int)blockIdx.x);
        pg8::EpiResid E{XO, rep ? (float*)(ws + WS_SCR) : XO, D, MOD + 1 * 2 * 12288 + 8192, 12288, SEQ};
        pg8::gemm_phase<pg8::EpiResid, pg8::StaticOrder, true, true>(ring, g, S, E); } } SEAM(11);
#endif
#if MK_NLAYERS >= 3
    if (IN(12)) { REP(12) { norm_phase<false>(F, XO, args.in[4] + 2 * D, MOD + 2 * 2 * 12288, H, nullptr); } } SEAM(12);
    if (IN(13)) { REP(13) { { pg8::Gemm g{H, (const bf16*)(ws + WS_W_GLAIN), 4096, 4096, 4096, DFLAG, 1u << 13}; pg8::StaticOrder S; S.init(M, GLA_NIN, F.G, (int)blockIdx.x);
          pg8::EpiBf16 E{(bf16*)(ws + WS_GLA_IN), GLA_NIN};
          pg8::gemm_phase<pg8::EpiBf16, pg8::StaticOrder, true, true>(ring, g, S, E); }
        { pg8::Gemm g{H, (const bf16*)(ws + WS_W_GLAG1), 1024, 4096, 4096, DFLAG, 1u << 13}; pg8::SplitKOrder S; S.init(M, 4, 1024, F.G, (int)blockIdx.x);
          pg8::EpiGate E{(float*)(ws + WS_GLA_G1P), M};
          pg8::gemm_phase<pg8::EpiGate, pg8::SplitKOrder, true, true>(ring, g, S, E); } } } SEAM(13);
    if (IN(14)) { REP(14) { gla_prep_phase(F, args); } } SEAM(14);
    if (IN(15)) { REP(15) { gla_main_phase(F, args); } } SEAM(15);
    if (IN(16)) { REP(16) { gla_combine_phase(F, args); } } SEAM(16);
    if (IN(17)) { REP(17) { pg8::Gemm g{(const bf16*)(ws + WS_GLA_Z), (const bf16*)(ws + WS_W_GLAOUT), 4096, 4096, 4096, DFLAG, 1u << 17}; pg8::StaticOrder S; S.init(M, 4096, F.G, (int)blockIdx.x);
        pg8::EpiResid E{XO, rep ? (float*)(ws + WS_SCR) : XO, D, MOD + 2 * 2 * 12288 + 8192, 12288, SEQ};
        pg8::gemm_phase<pg8::EpiResid, pg8::StaticOrder, true, true>(ring, g, S, E); } } SEAM(17);
#endif
#if MK_NLAYERS >= 4
    if (IN(18)) { REP(18) { norm_phase<false>(F, XO, args.in[4] + 3 * D, MOD + 3 * 2 * 12288, H, nullptr); } } SEAM(18);
    if (IN(19)) { REP(19) { pg8::Gemm g{H, (const bf16*)(ws + WS_W_NAIN1), 4096, 4096, 4096, DFLAG, 1u << 19}; pg8::StaticOrder S; S.init(M, 16384, F.G, (int)blockIdx.x);
        pg8::EpiNaIn E{(bf16*)(ws + WS_NA_QKVG)};
        pg8::gemm_phase<pg8::EpiNaIn, pg8::StaticOrder, false, true>(ring, g, S, E); } } SEAM(19);
    if (IN(20)) { REP(20) na_attn_phase2(F, (const bf16*)(ws + WS_NA_QKVG), (bf16*)(ws + WS_NA_Z), args.in[6] + 1 * 32 * 465); } SEAM(20);
    if (IN(21)) { REP(21) { pg8::Gemm g{(const bf16*)(ws + WS_NA_Z), (const bf16*)(ws + WS_W_NAOUT1), 4096, 4096, 4096, DFLAG, 1u << 21}; pg8::StaticOrder S; S.init(M, 4096, F.G, (int)blockIdx.x);
        pg8::EpiResid E{XO, rep ? (float*)(ws + WS_SCR) : XO, D, MOD + 3 * 2 * 12288 + 8192, 12288, SEQ};
        pg8::gemm_phase<pg8::EpiResid, pg8::StaticOrder, true, true>(ring, g, S, E); } } SEAM(21);
#endif
    if (IN(22)) { REP(22) norm_phase<true>(F, (MK_NLAYERS >= 1) ? (const float*)XO : args.in[0], args.in[32], nullptr, nullptr, XO); }
#if MK_DIAG
    if (IN(22)) { __syncthreads(); const unsigned f = __hip_atomic_load(DFLAG, __ATOMIC_RELAXED, __HIP_MEMORY_SCOPE_AGENT);
        const unsigned f2 = __hip_atomic_load(DFLAG + 1, __ATOMIC_RELAXED, __HIP_MEMORY_SCOPE_AGENT);
        if (f != 0u || f2 != 0u) { const int k = f2 ? (24 + __builtin_ctz(f2)) : __builtin_ctz(f); float mk = 10.f; for (int i = 0; i < k; ++i) mk *= 10.f;
            const int gw = F.vcu * NWAVES + F.wave, NGW = F.G * NWAVES;
            for (int m = gw; m < M; m += NGW) for (int j = 0; j < 16; ++j) *((GAS f32x4*)(XO + (size_t)m * D) + F.lane + 64 * j) = (f32x4){mk, mk, mk, mk}; }
        else { const int gw = F.vcu * NWAVES + F.wave, NGW = F.G * NWAVES;
            for (int m = gw; m < M; m += NGW) for (int j = 0; j < 16; ++j) { GAS f32x4* p = (GAS f32x4*)(XO + (size_t)m * D) + F.lane + 64 * j; f32x4 v = *p; bool ch = false;
                for (int e = 0; e < 4; ++e) if (!(__builtin_fabsf(v[e]) < 3.0e38f)) { v[e] = 3.0e30f; ch = true; } if (ch) *p = v; } } }
#endif
#if MK_PROF
    if (F.tid == 0) PROF[32 + 22] = __builtin_amdgcn_s_memrealtime();
    xcd_barrier(bar);
    if (F.tid == 0) PROF[1 + 22] = __builtin_amdgcn_s_memrealtime();
    __syncthreads();
    if (blockIdx.x == 0) {
        float d[23], w[23];
        for (int k = 0; k < 23; ++k) { d[k] = (float)(PROF[1 + k] - PROF[k]) * 0.01f; w[k] = (float)(PROF[1 + k] - PROF[32 + k]) * 0.01f; }
        (void)w;
        const float A = (float)(MK_PROF_A) * 1.0e4f, B = (float)(MK_PROF_B) * 1.0e3f;
        for (size_t i = F.tid; i < (size_t)M * D; i += NWAVES * 64) XO[i] = (i == 0) ? A : B;
    }
#endif
#undef IN
#undef REP
#undef SEAM
}

extern "C" void kernel_launch(void* const* d_in, const int* in_sizes, int n_in, void* d_out, int out_size, void* d_ws, size_t ws_size, hipStream_t stream) {
    static int grid = 0;
    if (grid == 0) {
        if (n_in != 33 || in_sizes[0] != M * D || out_size != M * D || ws_size < WS_END) {
            fprintf(stderr, "kernel_launch: built for 33 inputs, x/out of %d floats, >= %zu bytes of workspace; got n_in %d, in0 %d, out %d, ws %zu; nothing launched\n", M * D, (size_t)WS_END, n_in, n_in > 0 ? in_sizes[0] : -1, out_size, ws_size);
            grid = -1; return; }
        int dev = 0, cus = 0, per_cu = 0;
        if (hipGetDevice(&dev) != hipSuccess || hipDeviceGetAttribute(&cus, hipDeviceAttributeMultiprocessorCount, dev) != hipSuccess) { fprintf(stderr, "kernel_launch: device query failed\n"); grid = -1; return; }
        if (hipFuncSetAttribute((const void*)fwd_kernel, hipFuncAttributeMaxDynamicSharedMemorySize, LDS_BYTES) != hipSuccess) { fprintf(stderr, "kernel_launch: hipFuncSetAttribute failed\n"); grid = -1; return; }
        if (hipOccupancyMaxActiveBlocksPerMultiprocessor(&per_cu, (const void*)fwd_kernel, NWAVES * 64, LDS_BYTES) != hipSuccess || per_cu < 1)
            fprintf(stderr, "kernel_launch: note: occupancy query reports %d workgroups per CU\n", per_cu);
        (void)hipGetLastError();
        grid = cus;
        if (grid != 256) fprintf(stderr, "kernel_launch: note: %d CUs (tuned for 256)\n", grid);
        if (grid < 136) { fprintf(stderr, "kernel_launch: needs >= 136 CUs\n"); grid = -1; return; }
    }
    if (grid < 0) return;
    if (hipMemsetAsync((char*)d_ws + WS_CTL, 0, CTL_ZERO_BYTES, stream) != hipSuccess) { fprintf(stderr, "kernel_launch: memset failed\n"); return; }
    Args a{};
    for (int i = 0; i < 33; ++i) a.in[i] = (const float*)d_in[i];
    a.out = (float*)d_out; a.ws = (unsigned char*)d_ws;
#if MK_ONE_LAUNCH
    a.ph_lo = 0; a.ph_hi = NPH;
    hipLaunchKernelGGL(fwd_kernel, dim3(grid), dim3(NWAVES * 64), LDS_BYTES, stream, a);
#else
    for (int ph = 0; ph < NPH; ++ph) { a.ph_lo = ph; a.ph_hi = ph + 1; a.dup = 0;
        hipLaunchKernelGGL(fwd_kernel, dim3(grid), dim3(NWAVES * 64), LDS_BYTES, stream, a);
        if ((MK_DUP >> ph) & 1u) { a.dup = 1; hipLaunchKernelGGL(fwd_kernel, dim3(grid), dim3(NWAVES * 64), LDS_BYTES, stream, a); } }
#endif
    const hipError_t le = hipPeekAtLastError();
    if (le != hipSuccess) fprintf(stderr, "kernel_launch: launch failed: %s\n", hipGetErrorName(le));
}
```

```cpp
#include <hip/hip_runtime.h>
#include <cstdio>
#include <cstdint>

#ifndef MK_ONE_LAUNCH
#define MK_ONE_LAUNCH 1
#endif
#ifndef MK_DIAG
#define MK_DIAG 0
#endif
#ifndef MK_PROF
#define MK_PROF 0
#endif
#define MK_PROF_A (d[2]+d[19]+d[4]+d[21]+d[6]+d[10]+d[11]+d[13]+d[17])
#define MK_PROF_B (d[0])
#ifndef MK_DUP
#define MK_DUP 0u
#endif
#ifndef MK_NLAYERS
#define MK_NLAYERS 4
#endif

namespace pg8 {
#define PG8_LAS __attribute__((address_space(3)))
typedef unsigned short bf16_t;
typedef short bf16x8 __attribute__((ext_vector_type(8)));
typedef float f32x4 __attribute__((ext_vector_type(4)));
typedef unsigned u32x4 __attribute__((ext_vector_type(4)));
typedef unsigned u32x2 __attribute__((ext_vector_type(2)));
constexpr int BM = 256, BK = 64, HALF = 128, HTB = HALF * BK * 2  , STAGE_BYTES = 8 * HTB, NXCD = 8, WGM = 8;

__host__ __device__ __forceinline__ int lds_byte(int r, int c) { const int st = (r >> 4) * 2 + (c >> 5), rr = r & 15, cc = c & 31, ob = rr * 64 + cc * 2; return st * 1024 + (ob ^ (((ob >> 9) & 1) << 5)); }
__host__ __device__ __forceinline__ void stage_rc(int b, int& R, int& C) { const int st = b / 1024, sb = b % 1024, swz = sb ^ (((sb >> 9) & 1) << 5); R = (st >> 1) * 16 + swz / 64; C = (st & 1) * 32 + (swz % 64) / 2; }
__host__ __device__ __forceinline__ int perm32(int rho) { const int n = rho >> 4, i = rho & 15; return 8 * (i >> 2) + 4 * n + (i & 3); }

struct Unit { int pm, pn, pb, koff; };
struct Gemm { const bf16_t* A; const bf16_t* Bt; int K, lda, ldb; unsigned* dflag; unsigned dbit; };

struct StaticOrder {
    int nM, nN, nwg, G, c;
    __host__ __device__ void init(int M, int N, int G_, int c_) { nM = M / BM; nN = N / BM; nwg = nM * nN; G = G_; c = c_; }
    __host__ __device__ bool next(int i, Unit& u) const {
        const long L = (long)i * G + c; if (L >= nwg) return false;
        int wgid = (int)L; { const int q = nwg / NXCD, r = nwg % NXCD, xcd = wgid % NXCD, off = wgid / NXCD; wgid = (xcd < r ? xcd * (q + 1) : r * (q + 1) + (xcd - r) * q) + off; }
        const int nig = WGM * nN, gid = wgid / nig, fm = gid * WGM, gsz = (nM - fm) < WGM ? (nM - fm) : WGM;
        u.pm = fm + ((wgid % nig) % gsz); u.pn = (wgid % nig) / gsz; u.pb = u.pn; u.koff = 0; return true;
    }
    __device__ __forceinline__ void a_ready(const Unit&) const {}
    __device__ __forceinline__ void done(const Unit&) const {}
};
struct BatchedOrder {
    int nPm, nPn, total, G, c;
    __host__ __device__ void init(int ngroups, int nPm_, int nPn_, int G_, int c_) { nPm = nPm_; nPn = nPn_; total = ngroups * nPm * nPn; G = G_; c = c_; }
    __host__ __device__ bool next(int i, Unit& u) const {
        long L = (long)i * G + c; if (L >= total) return false;
        const int upg = nPm * nPn;
        if (G % 8 == 0 && (G / 8) % upg == 0 && total % G == 0) {
            const int x = c % 8, q = c / 8, gpx = (G / 8) / upg;
            L = ((long)(i * 8 + x) * gpx + q / upg) * upg + q % upg; }
        const int g = (int)L / upg, rem = (int)L % upg, pmi = rem / nPn, pni = rem % nPn;
        u.pm = g * nPm + pmi; u.pn = pni; u.pb = g * nPn + pni; u.koff = 0; return true;
    }
    __device__ __forceinline__ void a_ready(const Unit&) const {}
    __device__ __forceinline__ void done(const Unit&) const {}
};
struct SplitKOrder {
    int nM, nsplit, kslice, G, c;
    __host__ __device__ void init(int M, int nsplit_, int kslice_, int G_, int c_) { nM = M / BM; nsplit = nsplit_; kslice = kslice_; G = G_; c = c_; }
    __host__ __device__ bool next(int i, Unit& u) const {
        const long L = (long)i * G + c; if (L >= (long)nM * nsplit) return false;
        u.pm = (int)L / nsplit; u.pn = (int)L % nsplit; u.pb = 0; u.koff = u.pn * kslice; return true;
    }
    __device__ __forceinline__ void a_ready(const Unit&) const {}
    __device__ __forceinline__ void done(const Unit&) const {}
};

typedef float f32x2_t __attribute__((ext_vector_type(2))); typedef __bf16 bf16x2_t __attribute__((ext_vector_type(2)));
__device__ __forceinline__ unsigned cvt_pk_bf16(float lo, float hi) { f32x2_t v = {lo, hi}; bf16x2_t b = __builtin_convertvector(v, bf16x2_t); return __builtin_bit_cast(unsigned, b); }
__device__ __forceinline__ float bf_lo(unsigned w) { return __uint_as_float(w << 16); }
__device__ __forceinline__ float bf_hi(unsigned w) { return __uint_as_float(w & 0xffff0000u); }
__device__ __forceinline__ float sigmoidf_(float x) { return __builtin_amdgcn_rcpf(1.0f + __expf(-x)); }
__device__ __forceinline__ float siluf_(float x) { return x * __builtin_amdgcn_rcpf(1.0f + __expf(-x)); }
__device__ __forceinline__ float gelu_tanh(float x) { const float z = 0.7978845608028654f * (x + 0.044715f * x * x * x); return x * __builtin_amdgcn_rcpf(1.0f + __expf(-2.0f * z)); }

struct EpiBf16 {
    static constexpr bool PERM = true, AFTER_DRAIN = false;
    bf16_t* O; int ldc;
    __device__ __forceinline__ void operator()(const f32x4 (&acc)[2][2][4][2], const Unit& u, int wr, int wc, int fr, int fq) const {
        const int row0 = u.pm * BM + wr * 64 + fr, col0 = u.pn * BM + wc * 32 + 8 * fq;
#pragma unroll
        for (int ai = 0; ai < 2; ++ai)
#pragma unroll
            for (int m = 0; m < 4; ++m) { bf16_t* rowp = O + (size_t)(row0 + ai * HALF + m * 16) * ldc + col0;
#pragma unroll
                for (int bj = 0; bj < 2; ++bj) { const f32x4 v0 = acc[ai][bj][m][0], v1 = acc[ai][bj][m][1];
                    u32x4 w; w.x = cvt_pk_bf16(v0[0], v0[1]); w.y = cvt_pk_bf16(v0[2], v0[3]); w.z = cvt_pk_bf16(v1[0], v1[1]); w.w = cvt_pk_bf16(v1[2], v1[3]);
                    *(u32x4*)(rowp + bj * HALF) = w; } }
    }
};
struct EpiNaIn {
    static constexpr bool PERM = true, AFTER_DRAIN = false;
    bf16_t* O;
    __device__ __forceinline__ void operator()(const f32x4 (&acc)[2][2][4][2], const Unit& u, int wr, int wc, int fr, int fq) const {
        const int row0 = u.pm * BM + wr * 64 + fr, col0 = u.pn * BM + wc * 32 + 8 * fq;
#pragma unroll
        for (int ai = 0; ai < 2; ++ai)
#pragma unroll
            for (int m = 0; m < 4; ++m) { const int row = row0 + ai * HALF + m * 16, b = row >> 13, l = row & 8191;
#pragma unroll
                for (int bj = 0; bj < 2; ++bj) { const f32x4 v0 = acc[ai][bj][m][0], v1 = acc[ai][bj][m][1]; const int n = col0 + bj * HALF, sec = n >> 12, hd = (n >> 7) & 31, d = n & 127;
                    u32x4 w; w.x = cvt_pk_bf16(v0[0], v0[1]); w.y = cvt_pk_bf16(v0[2], v0[3]); w.z = cvt_pk_bf16(v1[0], v1[1]); w.w = cvt_pk_bf16(v1[2], v1[3]);
                    *(u32x4*)(O + ((size_t)((sec * 2 + b) * 32 + hd) * 8192 + l) * 128 + d) = w; } }
    }
};
struct EpiResid {
    static constexpr bool PERM = false, AFTER_DRAIN = false;
    const float* base; float* out; int ldc; const float* gate0; int gate_stride; int rows_per_batch;
    __device__ __forceinline__ void operator()(const f32x4 (&acc)[2][2][4][2], const Unit& u, int wr, int wc, int fr, int fq) const {
        const int row0 = u.pm * BM + wr * 64 + fr, col0 = u.pn * BM + wc * 32 + 4 * fq;
        const float* gp = gate0 + (size_t)((u.pm * BM) / rows_per_batch) * gate_stride + col0;
        f32x4 gv[2][2];
#pragma unroll
        for (int bj = 0; bj < 2; ++bj)
#pragma unroll
            for (int n = 0; n < 2; ++n) gv[bj][n] = *(const f32x4*)(gp + bj * HALF + n * 16);
#pragma unroll
        for (int ai = 0; ai < 2; ++ai)
#pragma unroll
            for (int m = 0; m < 4; ++m) { const size_t off = (size_t)(row0 + ai * HALF + m * 16) * ldc + col0;
#pragma unroll
                for (int bj = 0; bj < 2; ++bj)
#pragma unroll
                    for (int n = 0; n < 2; ++n) { const f32x4 bs = *(const f32x4*)(base + off + bj * HALF + n * 16);
                        *(f32x4*)(out + off + bj * HALF + n * 16) = bs + gv[bj][n] * acc[ai][bj][m][n]; }
                if (m & 1) asm volatile("" ::: "memory"); }
    }
};
struct EpiF32 {
    static constexpr bool PERM = false, AFTER_DRAIN = false;
    float* C; int ldc;
    __device__ __forceinline__ void operator()(const f32x4 (&acc)[2][2][4][2], const Unit& u, int wr, int wc, int fr, int fq) const {
        const int row0 = u.pm * BM + wr * 64 + fr, col0 = u.pn * BM + wc * 32 + 4 * fq;
#pragma unroll
        for (int ai = 0; ai < 2; ++ai)
#pragma unroll
            for (int m = 0; m < 4; ++m) { float* rowp = C + (size_t)(row0 + ai * HALF + m * 16) * ldc + col0;
#pragma unroll
                for (int bj = 0; bj < 2; ++bj)
#pragma unroll
                    for (int n = 0; n < 2; ++n) *(f32x4*)(rowp + bj * HALF + n * 16) = acc[ai][bj][m][n]; }
    }
};
struct EpiGate {
    static constexpr bool PERM = false, AFTER_DRAIN = false;
    float* P; int rows;
    __device__ __forceinline__ void operator()(const f32x4 (&acc)[2][2][4][2], const Unit& u, int wr, int wc, int fr, int fq) const {
        if (wc != 0) return;
        const int row0 = u.pm * BM + wr * 64 + fr;
#pragma unroll
        for (int ai = 0; ai < 2; ++ai)
#pragma unroll
            for (int m = 0; m < 4; ++m) { float* rowp = P + ((size_t)u.pn * rows + (row0 + ai * HALF + m * 16)) * 32 + 4 * fq;
#pragma unroll
                for (int n = 0; n < 2; ++n) *(f32x4*)(rowp + n * 16) = acc[ai][0][m][n]; }
    }
};
template <int T, int NCH, int KY> struct EpiS5In {
    static constexpr bool PERM = true, AFTER_DRAIN = false;
    bf16_t* Ug; bf16_t* Gs;
    __device__ __forceinline__ void operator()(const f32x4 (&acc)[2][2][4][2], const Unit& u, int wr, int wc, int fr, int fq) const {
        const int row0 = u.pm * BM + wr * 64 + fr, col0 = u.pn * BM + wc * 32 + 8 * fq;
#pragma unroll
        for (int ai = 0; ai < 2; ++ai)
#pragma unroll
            for (int m = 0; m < 4; ++m) { const int row = row0 + ai * HALF + m * 16;
#pragma unroll
                for (int bj = 0; bj < 2; ++bj) { const f32x4 v0 = acc[ai][bj][m][0], v1 = acc[ai][bj][m][1]; const int col = col0 + bj * HALF;
                    u32x4 w; w.x = cvt_pk_bf16(v0[0], v0[1]); w.y = cvt_pk_bf16(v0[2], v0[3]); w.z = cvt_pk_bf16(v1[0], v1[1]); w.w = cvt_pk_bf16(v1[2], v1[3]);
                    if (col < 4096) { const int g = col >> 4, i0 = col & 15, chunk = row / T, t = row % T;
                        *(u32x4*)(Ug + ((size_t)g * NCH + chunk) * KY + t * 16 + i0) = w; }
                    else *(u32x4*)(Gs + (size_t)row * 4096 + (col - 4096)) = w; } }
    }
};
template <int T, int NPM> struct EpiS5Y {
    static constexpr bool PERM = true, AFTER_DRAIN = false;
    bf16_t* Y;
    __device__ __forceinline__ void operator()(const f32x4 (&acc)[2][2][4][2], const Unit& u, int wr, int wc, int fr, int fq) const {
        const int g = u.pm / NPM, chunk0 = (u.pm % NPM) * BM + wr * 64 + fr, col0 = u.pn * BM + wc * 32 + 8 * fq;
#pragma unroll
        for (int ai = 0; ai < 2; ++ai)
#pragma unroll
            for (int m = 0; m < 4; ++m) { const int chunk = chunk0 + ai * HALF + m * 16;
#pragma unroll
                for (int bj = 0; bj < 2; ++bj) { f32x4 v0 = acc[ai][bj][m][0], v1 = acc[ai][bj][m][1]; const int n = col0 + bj * HALF, t = n >> 4, i0 = n & 15;
#pragma unroll
                    for (int j = 0; j < 4; ++j) { v0[j] = gelu_tanh(v0[j]); v1[j] = gelu_tanh(v1[j]); }
                    u32x4 w; w.x = cvt_pk_bf16(v0[0], v0[1]); w.y = cvt_pk_bf16(v0[2], v0[3]); w.z = cvt_pk_bf16(v1[0], v1[1]); w.w = cvt_pk_bf16(v1[2], v1[3]);
                    *(u32x4*)(Y + (size_t)(chunk * T + t) * 4096 + g * 16 + i0) = w; } }
    }
};
struct EpiGlu {
    static constexpr bool PERM = true, AFTER_DRAIN = false;
    const bf16_t* Y; const bf16_t* Gs; const float* bias; bf16_t* Z;
    __device__ __forceinline__ void operator()(const f32x4 (&acc)[2][2][4][2], const Unit& u, int wr, int wc, int fr, int fq) const {
        const int row0 = u.pm * BM + wr * 64 + fr, col0 = u.pn * BM + wc * 32 + 8 * fq;
        f32x4 bv[2][2];
#pragma unroll
        for (int bj = 0; bj < 2; ++bj)
#pragma unroll
            for (int n = 0; n < 2; ++n) bv[bj][n] = *(const f32x4*)(bias + col0 + bj * HALF + 4 * n);
#pragma unroll
        for (int ai = 0; ai < 2; ++ai)
#pragma unroll
            for (int m = 0; m < 4; ++m) { const size_t off = (size_t)(row0 + ai * HALF + m * 16) * 4096 + col0;
#pragma unroll
                for (int bj = 0; bj < 2; ++bj) { const u32x4 yw = *(const u32x4*)(Y + off + bj * HALF), gw = *(const u32x4*)(Gs + off + bj * HALF);
                    const f32x4 a0 = acc[ai][bj][m][0] + bv[bj][0], a1 = acc[ai][bj][m][1] + bv[bj][1];
                    float o[8];
#pragma unroll
                    for (int j = 0; j < 4; ++j) { const unsigned yj = yw[j], gj = gw[j];
                        const float aa = (j < 2) ? a0[2 * j] : a1[2 * j - 4], ab = (j < 2) ? a0[2 * j + 1] : a1[2 * j - 3];
                        o[2 * j] = bf_lo(yj) * sigmoidf_(aa) * siluf_(bf_lo(gj)); o[2 * j + 1] = bf_hi(yj) * sigmoidf_(ab) * siluf_(bf_hi(gj)); }
                    u32x4 w; w.x = cvt_pk_bf16(o[0], o[1]); w.y = cvt_pk_bf16(o[2], o[3]); w.z = cvt_pk_bf16(o[4], o[5]); w.w = cvt_pk_bf16(o[6], o[7]);
                    *(u32x4*)(Z + off + bj * HALF) = w; }
                asm volatile("" ::: "memory"); }
    }
};

template <class Epi, class Sched, bool ALIGN_EPI = false, bool SP2 = false>
__device__ __forceinline__ void gemm_phase(PG8_LAS unsigned char* lds, const Gemm g, const Sched& S, const Epi& E) {
    const int tid = threadIdx.x, wid = __builtin_amdgcn_readfirstlane(tid >> 6), lane = tid & 63, wr = wid >> 2, wc = wid & 3, fr = lane & 15, fq = lane >> 4;
    const int K = g.K, nt = K / BK, lda = g.lda, ldb = g.ldb;
    unsigned voffA[2], voffB[2];
#pragma unroll
    for (int i = 0; i < 2; ++i) { int R, C; stage_rc(tid * 16 + i * 8192, R, C); const int Rb = Epi::PERM ? ((R & ~31) + perm32(R & 31)) : R;
        voffA[i] = (unsigned)(R * lda + C) * 2u; voffB[i] = (unsigned)(Rb * ldb + C) * 2u; }
    const size_t kstep = (size_t)(BK * 2);
    const size_t hstepA = (size_t)HALF * lda * 2, hstepB = (size_t)HALF * ldb * 2;
    const size_t tstepA = 2 * hstepA, tstepB = 2 * hstepB;
    const unsigned ldsw = (unsigned)wid * 1024u;
    const int aoff = lds_byte(wr * 64 + fr, fq * 8), boff = lds_byte(wc * 32 + fr, fq * 8);
#define PG8_SA(b, h) (((b) * 2 + (h)) * HTB)
#define PG8_SB(b, h) ((4 + (b) * 2 + (h)) * HTB)
#define PG8_STAGE(bufoff, gbase, voff) do { _Pragma("unroll") for (int _i = 0; _i < 2; ++_i) \
        __builtin_amdgcn_global_load_lds((const unsigned*)((const char*)(gbase) + (voff)[_i]), (PG8_LAS unsigned*)(lds + (bufoff) + ldsw + _i * 8192), 16, 0, 0); } while (0)
#define PG8_LDA(dst, b, h) do { _Pragma("unroll") for (int m = 0; m < 4; ++m) _Pragma("unroll") for (int k = 0; k < 2; ++k) dst[m][k] = *(const PG8_LAS bf16x8*)(lds + PG8_SA(b, h) + aoff + m * 2048 + k * 1024); } while (0)
#define PG8_LDB(dst, b, h) do { _Pragma("unroll") for (int n = 0; n < 2; ++n) _Pragma("unroll") for (int k = 0; k < 2; ++k) dst[n][k] = *(const PG8_LAS bf16x8*)(lds + PG8_SB(b, h) + boff + n * 2048 + k * 1024); } while (0)
#define PG8_MMA(ai, bj, At, Bt) do { __builtin_amdgcn_s_setprio(1); _Pragma("unroll") for (int m = 0; m < 4; ++m) _Pragma("unroll") for (int n = 0; n < 2; ++n) _Pragma("unroll") for (int k = 0; k < 2; ++k) \
        acc[ai][bj][m][n] = __builtin_amdgcn_mfma_f32_16x16x32_bf16(Bt[n][k], At[m][k], acc[ai][bj][m][n], 0, 0, 0); __builtin_amdgcn_s_setprio(0); } while (0)
#define PG8_WAIT_V(n) asm volatile("s_waitcnt vmcnt(" #n ")" ::: "memory")
#define PG8_WAIT_L(n) asm volatile("s_waitcnt lgkmcnt(" #n ")" ::: "memory")
#define PG8_BAR __builtin_amdgcn_s_barrier()
#define PG8_SCHED __builtin_amdgcn_sched_barrier(0)
    Unit cur, nxt; int ui = 0;
    if (!S.next(0, cur)) return;
    f32x4 acc[2][2][4][2];
#pragma unroll
    for (int a = 0; a < 2; ++a)
#pragma unroll
        for (int b = 0; b < 2; ++b)
#pragma unroll
            for (int m = 0; m < 4; ++m)
#pragma unroll
                for (int n = 0; n < 2; ++n) acc[a][b][m][n] = (f32x4){0.f, 0.f, 0.f, 0.f};
    bf16x8 At[4][2], B0[2][2], B1[2][2];
    const char* cA = (const char*)g.A + (size_t)cur.pm * tstepA + (size_t)cur.koff * 2; const char* cB = (const char*)g.Bt + (size_t)cur.pb * tstepB + (size_t)cur.koff * 2;
    S.a_ready(cur);
    if constexpr (SP2) {
        PG8_STAGE(PG8_SB(0, 0), cB, voffB); PG8_STAGE(PG8_SB(0, 1), cB + hstepB, voffB); PG8_STAGE(PG8_SA(0, 0), cA, voffA); PG8_STAGE(PG8_SA(0, 1), cA + hstepA, voffA);
        if (wr == 1) PG8_BAR;
        PG8_WAIT_V(2); PG8_BAR;
        PG8_STAGE(PG8_SB(1, 0), cB + kstep, voffB); PG8_STAGE(PG8_SA(1, 0), cA + kstep, voffA); PG8_STAGE(PG8_SB(1, 1), cB + hstepB + kstep, voffB);
        PG8_WAIT_V(6); PG8_BAR;
    } else {
        PG8_STAGE(PG8_SB(0, 0), cB, voffB); PG8_STAGE(PG8_SA(0, 0), cA, voffA); PG8_STAGE(PG8_SB(0, 1), cB + hstepB, voffB); PG8_STAGE(PG8_SA(0, 1), cA + hstepA, voffA);
        if (wr == 1) PG8_BAR;
        PG8_WAIT_V(4); PG8_BAR;
        PG8_STAGE(PG8_SB(1, 0), cB + kstep, voffB); PG8_STAGE(PG8_SA(1, 0), cA + kstep, voffA); PG8_STAGE(PG8_SB(1, 1), cB + hstepB + kstep, voffB);
        PG8_WAIT_V(6); PG8_BAR;
    }
    for (;;) {
        const bool has_next = S.next(ui + 1, nxt);
        const char* nA = has_next ? (const char*)g.A + (size_t)nxt.pm * tstepA + (size_t)nxt.koff * 2 : cA; const char* nB = has_next ? (const char*)g.Bt + (size_t)nxt.pb * tstepB + (size_t)nxt.koff * 2 : cB;
        for (int t = 0; t < nt; t += 2) {
            const bool last = (t == nt - 2);
            const char* a1 = cA + (size_t)(t + 1) * kstep;
            const char* a2 = last ? nA : cA + (size_t)(t + 2) * kstep; const char* b2 = last ? nB : cB + (size_t)(t + 2) * kstep;
            const char* a3 = a2 + kstep; const char* b3 = b2 + kstep;
            if (last && has_next) S.a_ready(nxt);
            if constexpr (SP2) {
            PG8_LDB(B0, 0, 0); PG8_LDB(B1, 0, 1); PG8_SCHED; PG8_LDA(At, 0, 0); PG8_STAGE(PG8_SA(1, 1), a1 + hstepA, voffA);
            PG8_WAIT_V(8); PG8_WAIT_L(0); PG8_BAR; PG8_MMA(0, 0, At, B0); PG8_MMA(0, 1, At, B1); PG8_BAR; PG8_SCHED;
            PG8_LDA(At, 0, 1); PG8_STAGE(PG8_SB(0, 0), b2, voffB); PG8_STAGE(PG8_SB(0, 1), b2 + hstepB, voffB); PG8_STAGE(PG8_SA(0, 0), a2, voffA);
            PG8_WAIT_V(8); PG8_WAIT_L(0); PG8_BAR; PG8_MMA(1, 0, At, B0); PG8_MMA(1, 1, At, B1); PG8_BAR; PG8_SCHED;
            PG8_LDB(B0, 1, 0); PG8_LDB(B1, 1, 1); PG8_SCHED; PG8_LDA(At, 1, 0); PG8_STAGE(PG8_SA(0, 1), a2 + hstepA, voffA);
            PG8_WAIT_V(8); PG8_WAIT_L(0); PG8_BAR; PG8_MMA(0, 0, At, B0); PG8_MMA(0, 1, At, B1); PG8_BAR; PG8_SCHED;
            PG8_LDA(At, 1, 1); PG8_STAGE(PG8_SB(1, 0), b3, voffB); PG8_STAGE(PG8_SB(1, 1), b3 + hstepB, voffB); PG8_STAGE(PG8_SA(1, 0), a3, voffA);
            PG8_WAIT_V(8); PG8_WAIT_L(0); PG8_BAR; PG8_MMA(1, 0, At, B0); PG8_MMA(1, 1, At, B1); PG8_BAR; PG8_SCHED;
            } else {
            PG8_LDB(B0, 0, 0); PG8_SCHED; PG8_LDA(At, 0, 0); PG8_STAGE(PG8_SA(1, 1), a1 + hstepA, voffA);
            PG8_WAIT_L(8); PG8_BAR; PG8_WAIT_L(0); PG8_MMA(0, 0, At, B0); PG8_BAR; PG8_SCHED;
            PG8_LDB(B1, 0, 1); PG8_STAGE(PG8_SB(0, 0), b2, voffB);
            PG8_BAR; PG8_WAIT_L(0); PG8_MMA(0, 1, At, B1); PG8_BAR;
            PG8_LDA(At, 0, 1); PG8_STAGE(PG8_SA(0, 0), a2, voffA);
            PG8_BAR; PG8_WAIT_L(0); PG8_MMA(1, 0, At, B0); PG8_BAR; PG8_SCHED;
            PG8_STAGE(PG8_SB(0, 1), b2 + hstepB, voffB);
            PG8_WAIT_V(6); PG8_BAR; PG8_MMA(1, 1, At, B1); PG8_BAR;
            PG8_LDB(B0, 1, 0); PG8_SCHED; PG8_LDA(At, 1, 0); PG8_STAGE(PG8_SA(0, 1), a2 + hstepA, voffA);
            PG8_WAIT_L(8); PG8_BAR; PG8_WAIT_L(0); PG8_MMA(0, 0, At, B0); PG8_BAR; PG8_SCHED;
            PG8_LDB(B1, 1, 1); PG8_STAGE(PG8_SB(1, 0), b3, voffB);
            PG8_BAR; PG8_WAIT_L(0); PG8_MMA(0, 1, At, B1); PG8_BAR;
            PG8_LDA(At, 1, 1); PG8_STAGE(PG8_SA(1, 0), a3, voffA);
            PG8_BAR; PG8_WAIT_L(0); PG8_MMA(1, 0, At, B0); PG8_BAR; PG8_SCHED;
            PG8_STAGE(PG8_SB(1, 1), b3 + hstepB, voffB);
            PG8_WAIT_V(6); PG8_BAR; PG8_MMA(1, 1, At, B1); PG8_BAR;
            }
        }
        if constexpr (ALIGN_EPI) { if (wr == 0) PG8_BAR; }
#if MK_DIAG
        { bool bad = false;
#pragma unroll
          for (int a_ = 0; a_ < 2; ++a_)
#pragma unroll
            for (int b_ = 0; b_ < 2; ++b_)
#pragma unroll
              for (int m_ = 0; m_ < 4; ++m_)
#pragma unroll
                for (int n_ = 0; n_ < 2; ++n_)
#pragma unroll
                  for (int j_ = 0; j_ < 4; ++j_) bad |= !(__builtin_fabsf(acc[a_][b_][m_][n_][j_]) < 3.0e38f);
          if (bad && g.dflag) atomicOr(g.dflag, g.dbit); }
#endif
        if constexpr (!Epi::AFTER_DRAIN) { E(acc, cur, wr, wc, fr, fq); S.done(cur); }
        if (!has_next) break;
#pragma unroll
        for (int a = 0; a < 2; ++a)
#pragma unroll
            for (int b = 0; b < 2; ++b)
#pragma unroll
                for (int m = 0; m < 4; ++m)
#pragma unroll
                    for (int n = 0; n < 2; ++n) acc[a][b][m][n] = (f32x4){0.f, 0.f, 0.f, 0.f};
        cur = nxt; cA = nA; cB = nB; ++ui;
        if constexpr (ALIGN_EPI) { if (wr == 1) PG8_BAR; }
    }
    PG8_WAIT_V(0);
    if constexpr (!ALIGN_EPI) { if (wr == 0) PG8_BAR; }
    PG8_BAR;
    if constexpr (Epi::AFTER_DRAIN) { E.fused(acc, cur, wr, wc, fr, fq, lds, wid, lane); S.done(cur); }
#undef PG8_SA
#undef PG8_SB
#undef PG8_STAGE
#undef PG8_LDA
#undef PG8_LDB
#undef PG8_MMA
#undef PG8_WAIT_V
#undef PG8_WAIT_L
#undef PG8_BAR
#undef PG8_SCHED
}

}

constexpr int NWAVES = 8;
constexpr int BATCH = 2, SEQ = 8192, D = 4096, M = BATCH * SEQ;
constexpr int GRIDW = 64, GROWS = SEQ / GRIDW;
constexpr int NA_HEADS = 32, NA_HD = 128;
constexpr int S5_G = 256, S5_P = 64, S5_I = 16, S5_T = 32, S5_NCH = M / S5_T  , S5_NCHB = SEQ / S5_T  , S5_KS = S5_T * 16  , S5_KY = S5_KS + 256  ;
constexpr int GLA_H = 8, GLA_DK = 256, GLA_DV = 512, GLA_KW = 2048, GLA_C = 64, GLA_NCH = M / GLA_C  , GLA_NCHB = SEQ / GLA_C  , GLA_NIN = 12288;
constexpr float EPS = 1e-6f;

constexpr size_t MiB = 1u << 20;
constexpr size_t WS_CTL = 0, CTL_ZERO_BYTES = 64 * 1024;
constexpr size_t WS_MOD = 1 * MiB;
constexpr size_t WS_LAMT = 2 * MiB;
constexpr size_t WS_W_NAIN0 = 4 * MiB, WS_W_NAIN1 = WS_W_NAIN0 + 128 * MiB, WS_W_NAOUT0 = WS_W_NAIN1 + 128 * MiB, WS_W_NAOUT1 = WS_W_NAOUT0 + 32 * MiB;
constexpr size_t WS_W_S5IN = WS_W_NAOUT1 + 32 * MiB, WS_W_S5GLU = WS_W_S5IN + 64 * MiB, WS_W_S5OUT = WS_W_S5GLU + 32 * MiB;
constexpr size_t WS_W_GLAIN = WS_W_S5OUT + 32 * MiB, WS_W_GLAG1 = WS_W_GLAIN + 96 * MiB, WS_W_GLAOUT = WS_W_GLAG1 + 2 * MiB;
constexpr size_t WS_S5BS = WS_W_GLAOUT + 32 * MiB;
constexpr size_t WS_S5BY = WS_S5BS + 64 * MiB;
constexpr size_t WS_H = WS_S5BY + 192 * MiB;
constexpr size_t WS_ACT = WS_H + 128 * MiB;
constexpr size_t WS_NA_QKVG = WS_ACT;
constexpr size_t WS_NA_Z = WS_ACT + 512 * MiB;
constexpr size_t WS_S5_UG = WS_ACT;
constexpr size_t WS_S5_GS = WS_S5_UG + 192 * MiB;
constexpr size_t WS_S5_SLOC = WS_S5_GS + 128 * MiB;
constexpr size_t WS_S5_Y = WS_S5_SLOC + 128 * MiB;
constexpr size_t WS_S5_Z = WS_S5_Y + 128 * MiB;
constexpr size_t WS_GLA_IN = WS_ACT;
constexpr size_t WS_GLA_G1P = WS_GLA_IN + 384 * MiB;
constexpr size_t WS_GLA_PREP = WS_GLA_G1P + 8 * MiB;
constexpr size_t WS_GLA_DECAY = WS_GLA_PREP + 384 * MiB;
constexpr size_t WS_GLA_O = WS_GLA_DECAY + 4 * MiB;
constexpr size_t WS_GLA_Z = WS_GLA_O + 384 * MiB;
constexpr size_t WS_SCR = WS_GLA_Z + 128 * MiB;
constexpr size_t WS_END = WS_SCR + 256 * MiB;
static_assert(WS_S5_Z + 128 * MiB <= WS_SCR && WS_NA_Z + 128 * MiB <= WS_SCR, "ws map");
constexpr int CW_BAR = 1024;
static_assert((CW_BAR + 3456) * 4 <= (int)CTL_ZERO_BYTES, "CTL words inside the memset region");

constexpr int RING_OFF = 0, RING_BYTES = 131072;
constexpr int LDS_BYTES = 147456;
constexpr int MISC_OFF = LDS_BYTES - 256;

#define GAS __attribute__((address_space(1)))
#define LAS __attribute__((address_space(3)))
typedef unsigned short bf16;
typedef unsigned v4u __attribute__((ext_vector_type(4)));
typedef unsigned v2u __attribute__((ext_vector_type(2)));
typedef float f32x4 __attribute__((ext_vector_type(4)));
typedef float f32x2 __attribute__((ext_vector_type(2)));
typedef short bf16x8 __attribute__((ext_vector_type(8)));
typedef short s16x4 __attribute__((ext_vector_type(4)));
typedef GAS unsigned gu32;
#define LDS_WAIT() asm volatile("s_waitcnt lgkmcnt(0)" ::: "memory")
#define VM_WAIT() asm volatile("s_waitcnt vmcnt(0)" ::: "memory")
using pg8::cvt_pk_bf16; using pg8::bf_lo; using pg8::bf_hi; using pg8::siluf_; using pg8::sigmoidf_;

#define XB_TMO      128
#define XB_XCNT(j)  (256  + 64 * (j))
#define XB_XSUB(j)  (1280 + 64 * (j))
#define XB_XGEN(j)  (2304 + 64 * (j))
#define XB_TOP      3328
#define XB_TOPGEN   3392
#define XCD_BAR_WORDS 3456
#define XB_SPIN_CAP (1u << 18)
__device__ __forceinline__ unsigned xb_ld(unsigned* p)              { return __hip_atomic_load(p, __ATOMIC_RELAXED, __HIP_MEMORY_SCOPE_AGENT); }
__device__ __forceinline__ unsigned xb_add(unsigned* p, unsigned v) { return __hip_atomic_fetch_add(p, v, __ATOMIC_RELAXED, __HIP_MEMORY_SCOPE_AGENT); }
__device__ __forceinline__ unsigned xb_xcc_id() { return (unsigned)__builtin_amdgcn_s_getreg((3 << 11) | 20) & 0xFu; }
#define XB_SPIN(cond, bar) do { unsigned _sp = 0; while (cond) { __builtin_amdgcn_s_sleep(1); \
    if ((++_sp & 255u) == 0u) { if (xb_ld(&(bar)[XB_TMO])) break; if (_sp > XB_SPIN_CAP) { atomicAdd(&(bar)[XB_TMO], 1u); break; } } } } while (0)
struct XcdBarrier { unsigned* bar; unsigned x; volatile LAS unsigned* st; };
__device__ __forceinline__ XcdBarrier xcd_barrier_post(unsigned* bar, volatile LAS unsigned* st) {
    XcdBarrier b; b.bar = bar; b.x = xb_xcc_id(); b.st = st;
    if (threadIdx.x == 0) (void)xb_add(&bar[XB_XCNT(b.x)], 1u);
    return b;
}
__device__ __forceinline__ void xcd_barrier_complete(unsigned* bar, unsigned x, unsigned& nloc, unsigned& nx) {
    const unsigned G = gridDim.x * gridDim.y * gridDim.z;
    unsigned sum, cnt, mine, sp = 0u;
    for (;;) {
        sum = 0u; cnt = 0u; mine = 0u;
#pragma unroll
        for (unsigned j = 0; j < 16; ++j) { const unsigned c = xb_ld(&bar[XB_XCNT(j)]); sum += c; cnt += (c > 0u) ? 1u : 0u; mine = (j == x) ? c : mine; }
        if (sum == G) break;
        __builtin_amdgcn_s_sleep(1);
        if ((++sp & 255u) == 0u) { if (xb_ld(&bar[XB_TMO])) break; if (sp > XB_SPIN_CAP) { atomicAdd(&bar[XB_TMO], 1u); break; } }
    }
    nloc = mine > 0u ? mine : 1u; nx = cnt > 0u ? cnt : 1u;
}
__device__ __forceinline__ void xcd_barrier(const XcdBarrier& b) {
    asm volatile("s_waitcnt vmcnt(0)" ::: "memory");
    __syncthreads();
    if (threadIdx.x == 0) {
        unsigned* bar = b.bar;
        __builtin_amdgcn_s_waitcnt(0);
        unsigned nloc = b.st[0], nx = b.st[1];
        if (nloc == 0u) { xcd_barrier_complete(bar, b.x, nloc, nx); b.st[0] = nloc; b.st[1] = nx; }
        const unsigned old = xb_add(&bar[XB_XSUB(b.x)], 1u);
        const unsigned gen = old / nloc;
        if (old + 1u == (gen + 1u) * nloc) {
            __builtin_amdgcn_fence(__ATOMIC_RELEASE, "agent");
            asm volatile("s_waitcnt vmcnt(0)" ::: "memory");
            const unsigned og = xb_add(&bar[XB_TOP], 1u);
            const unsigned tg = og / nx;
            if (og + 1u == (tg + 1u) * nx) xb_add(&bar[XB_TOPGEN], 1u);
            else XB_SPIN(xb_ld(&bar[XB_TOPGEN]) == tg, bar);
            __builtin_amdgcn_fence(__ATOMIC_ACQUIRE, "agent");
            xb_add(&bar[XB_XGEN(b.x)], 1u);
            asm volatile("s_waitcnt vmcnt(0)" ::: "memory");
        } else {
            XB_SPIN(xb_ld(&bar[XB_XGEN(b.x)]) == gen, bar);
            __builtin_amdgcn_fence(__ATOMIC_ACQUIRE, "agent");
            asm volatile("s_waitcnt vmcnt(0)" ::: "memory");
        }
    }
    __syncthreads();
}

struct Args { const float* in[33]; float* out; unsigned char* ws; int ph_lo, ph_hi, dup, pad; };
struct Frame {
    LAS unsigned char* lds;
    int tid, lane, wave;
    int vcu, G;
};
__device__ __forceinline__ float wave_sum(float v) {
#pragma unroll
    for (int o = 1; o < 64; o <<= 1) v += __shfl_xor(v, o);
    return v;
}
__device__ __forceinline__ unsigned f2bf(float f) { unsigned u = __builtin_bit_cast(unsigned, f); return (u + 0x7fffu + ((u >> 16) & 1u)) >> 16; }
__device__ __forceinline__ unsigned pk2(float lo, float hi) { return f2bf(lo) | (f2bf(hi) << 16); }

__device__ __forceinline__ void p0_transpose_item(const float* W, int K, int N, bf16* WT, LAS float* scr, int item, int lane) {
    const int nblk = N / 32, kb = item / nblk, nb = item % nblk, k0 = 64 * kb, n0 = 32 * nb;
#pragma unroll 8
    for (int i = 0; i < 32; ++i) { const int kk = 2 * i + (lane >> 5); scr[kk * 33 + (lane & 31)] = W[(size_t)(k0 + kk) * N + n0 + (lane & 31)]; }
    LDS_WAIT(); asm volatile("" ::: "memory");
    const int c = lane & 7;
#pragma unroll
    for (int j = 0; j < 4; ++j) { const int n = (lane >> 3) + 8 * j; const LAS float* s = scr + (8 * c) * 33 + n;
        v4u o; o.x = pk2(s[0 * 33], s[1 * 33]); o.y = pk2(s[2 * 33], s[3 * 33]); o.z = pk2(s[4 * 33], s[5 * 33]); o.w = pk2(s[6 * 33], s[7 * 33]);
        *(GAS v4u*)(WT + (size_t)(n0 + n) * K + k0 + 8 * c) = o; }
    LDS_WAIT(); asm volatile("" ::: "memory");
}
__device__ __forceinline__ void p0_mod(Frame& F, const Args& a) {
    LAS float* cact = (LAS float*)(F.lds + RING_OFF);
    LAS float* red = cact + 2 * 4096;
    const float* c = a.in[1]; const float* mw = a.in[2]; const float* mb = a.in[3]; float* MOD = (float*)(a.ws + WS_MOD);
    for (int i = F.tid; i < 2 * 4096; i += NWAVES * 64) cact[i] = siluf_(c[i]);
    __syncthreads();
    const int rg = F.lane >> 4, cq = F.lane & 15;
    for (int it = F.vcu; it < 4 * 192; it += F.G) {
        const int layer = it / 192, cb = it % 192;
        const float* wp = mw + (size_t)layer * 4096 * 12288 + (size_t)(F.wave * 4 + rg) * 12288 + cb * 64 + cq * 4;
        f32x4 a0 = {0.f, 0.f, 0.f, 0.f}, a1 = {0.f, 0.f, 0.f, 0.f};
#pragma unroll 8
        for (int s = 0; s < 128; ++s) { const f32x4 w = *(const GAS f32x4*)(wp + (size_t)s * 32 * 12288); const int k = F.wave * 4 + rg + 32 * s;
            const float c0 = cact[k], c1 = cact[4096 + k]; a0 += w * c0; a1 += w * c1; }
#pragma unroll
        for (int j = 0; j < 4; ++j) { a0[j] += __shfl_xor(a0[j], 16); a0[j] += __shfl_xor(a0[j], 32); a1[j] += __shfl_xor(a1[j], 16); a1[j] += __shfl_xor(a1[j], 32); }
        if (F.lane < 16) { *(LAS f32x4*)(red + (F.wave * 2 + 0) * 64 + cq * 4) = a0; *(LAS f32x4*)(red + (F.wave * 2 + 1) * 64 + cq * 4) = a1; }
        __syncthreads();
        if (F.tid < 128) { const int b = F.tid >> 6, col = F.tid & 63; float s = mb[layer * 12288 + cb * 64 + col];
#pragma unroll
            for (int w = 0; w < 8; ++w) s += red[(w * 2 + b) * 64 + col];
            MOD[((size_t)layer * 2 + b) * 12288 + cb * 64 + col] = s; }
        __syncthreads();
    }
}
__device__ __forceinline__ void p0_s5_group(Frame& F, const Args& a, int g) {
    constexpr int T = S5_T;
    LAS f32x2* pw = (LAS f32x2*)(F.lds + RING_OFF);
    LAS f32x2* bbar = pw + 2 * (T + 1) * 64;
    LAS f32x2* cc = bbar + 2 * 64 * 16;
    LAS float* kf = (LAS float*)(cc + 16 * 64);
    static_assert((2 * (T + 1) * 64 + 2 * 64 * 16 + 16 * 64) * 8 + 2 * T * 256 * 4 <= RING_BYTES, "s5 gen LDS");
    const float *b_re = a.in[9], *b_im = a.in[10], *c_re = a.in[11], *c_im = a.in[12], *dsk = a.in[13];
    float* LAMT = (float*)(a.ws + WS_LAMT);
    if (F.tid < 128) {
        const int dir = F.tid >> 6, p = F.tid & 63, gp = g * 64 + p;
        const float are = (dir ? a.in[16] : a.in[14])[gp], aim = (dir ? a.in[17] : a.in[15])[gp], ls = (dir ? a.in[19] : a.in[18])[gp];
        const float dt = expf(ls), mag = expf(are * dt), lr = mag * cosf(aim * dt), li = mag * sinf(aim * dt);
        const float den = are * are + aim * aim, nr = lr - 1.0f, rre = (nr * are + li * aim) / den, rim = (li * are - nr * aim) / den;
#pragma unroll
        for (int j = 0; j < 16; ++j) { const float br = b_re[(size_t)gp * 16 + j], bi = b_im[(size_t)gp * 16 + j]; bbar[(dir * 64 + p) * 16 + j] = (f32x2){rre * br - rim * bi, rre * bi + rim * br}; }
        float wr_ = 1.0f, wi_ = 0.0f; pw[(dir * (T + 1) + 0) * 64 + p] = (f32x2){1.0f, 0.0f};
        for (int t = 1; t <= T; ++t) { const float nr2 = wr_ * lr - wi_ * li, ni2 = wr_ * li + wi_ * lr; wr_ = nr2; wi_ = ni2; pw[(dir * (T + 1) + t) * 64 + p] = (f32x2){wr_, wi_}; }
        LAMT[((size_t)(g * 2 + dir) * 64 + p) * 2 + 0] = wr_; LAMT[((size_t)(g * 2 + dir) * 64 + p) * 2 + 1] = wi_;
    }
    for (int e = F.tid; e < 16 * 64; e += NWAVES * 64) cc[e] = (f32x2){c_re[(size_t)g * 1024 + e], c_im[(size_t)g * 1024 + e]};
    __syncthreads();
    {
        const int dir = F.tid >> 8, i = (F.tid >> 4) & 15, j = F.tid & 15;
        float acc[T];
#pragma unroll
        for (int t = 0; t < T; ++t) acc[t] = 0.f;
        for (int p = 0; p < 64; ++p) { const f32x2 C = cc[i * 64 + p], Bb = bbar[(dir * 64 + p) * 16 + j]; const float e = C.x * Bb.x - C.y * Bb.y, f = C.x * Bb.y + C.y * Bb.x;
#pragma unroll
            for (int t = 0; t < T; ++t) { const f32x2 w = pw[(dir * (T + 1) + t) * 64 + p]; acc[t] += w.x * e - w.y * f; } }
#pragma unroll
        for (int t = 0; t < T; ++t) kf[((dir * T + t) * 16 + i) * 16 + j] = acc[t];
    }
    __syncthreads();
    bf16* BY = (bf16*)(a.ws + WS_S5BY) + (size_t)g * (S5_KS * S5_KY);
    for (int q = F.tid; q < S5_KS * (S5_KY / 8); q += NWAVES * 64) {
        const int n = q / (S5_KY / 8), pc = q % (S5_KY / 8), t = n >> 4, i = n & 15, k0 = pc * 8; float v[8];
        if (k0 < S5_KS) { const int s = k0 >> 4, j0 = k0 & 15;
#pragma unroll
            for (int e = 0; e < 8; ++e) { const int j = j0 + e; float x;
                if (t > s) x = kf[((0 * T + (t - s)) * 16 + i) * 16 + j];
                else if (t < s) x = kf[((1 * T + (s - t)) * 16 + i) * 16 + j];
                else x = kf[((0 * T + 0) * 16 + i) * 16 + j] + kf[((1 * T + 0) * 16 + i) * 16 + j] + ((i == j) ? dsk[g * 16 + i] : 0.f);
                v[e] = x; }
        } else { const int kk = k0 - S5_KS, seg = kk >> 6, p0 = kk & 63, dir = seg >> 1, tp = dir ? (T - t) : (t + 1);
#pragma unroll
            for (int e = 0; e < 8; ++e) { const int p = p0 + e; const f32x2 w = pw[(dir * (T + 1) + tp) * 64 + p], C = cc[i * 64 + p];
                v[e] = (seg & 1) ? -(C.x * w.y + C.y * w.x) : (C.x * w.x - C.y * w.y); }
        }
        v4u o; o.x = pk2(v[0], v[1]); o.y = pk2(v[2], v[3]); o.z = pk2(v[4], v[5]); o.w = pk2(v[6], v[7]);
        *(GAS v4u*)(BY + (size_t)n * S5_KY + k0) = o;
    }
    bf16* BS = (bf16*)(a.ws + WS_S5BS) + (size_t)g * (256 * S5_KS);
    for (int q = F.tid; q < 256 * (S5_KS / 8); q += NWAVES * 64) {
        const int n = q / (S5_KS / 8), pc = q % (S5_KS / 8), k0 = pc * 8, s = k0 >> 4, j0 = k0 & 15, seg = n >> 6, p = n & 63, dir = seg >> 1;
        const f32x2 w = pw[(dir * (T + 1) + (dir ? s : (T - 1 - s))) * 64 + p]; float v[8];
#pragma unroll
        for (int e = 0; e < 8; ++e) { const f32x2 Bb = bbar[(dir * 64 + p) * 16 + j0 + e]; v[e] = (seg & 1) ? (w.x * Bb.y + w.y * Bb.x) : (w.x * Bb.x - w.y * Bb.y); }
        v4u o; o.x = pk2(v[0], v[1]); o.y = pk2(v[2], v[3]); o.z = pk2(v[4], v[5]); o.w = pk2(v[6], v[7]);
        *(GAS v4u*)(BS + (size_t)n * S5_KS + k0) = o;
    }
    __syncthreads();
}
__device__ __forceinline__ void p0_prologue(Frame& F, const Args& a) {
    p0_mod(F, a);
    {
        LAS float* scr = (LAS float*)(F.lds + RING_OFF + F.wave * 16384);
        const int gw = F.vcu * NWAVES + F.wave, NGW = F.G * NWAVES;
        constexpr int I_NAIN = 64 * 512, I_SQ = 64 * 128, I_S5IN = 64 * 256, I_GLAIN = 64 * 384;
        constexpr int NITEMS = 2 * I_NAIN + 2 * I_SQ + I_S5IN + 2 * I_SQ + I_GLAIN + I_SQ;
        unsigned char* ws = a.ws;
        for (int it = gw; it < NITEMS; it += NGW) {
            int r = it;
            if (r < I_NAIN) { p0_transpose_item(a.in[5], 4096, 16384, (bf16*)(ws + WS_W_NAIN0), scr, r, F.lane); continue; } r -= I_NAIN;
            if (r < I_NAIN) { p0_transpose_item(a.in[5] + (size_t)4096 * 16384, 4096, 16384, (bf16*)(ws + WS_W_NAIN1), scr, r, F.lane); continue; } r -= I_NAIN;
            if (r < I_SQ) { p0_transpose_item(a.in[7], 4096, 4096, (bf16*)(ws + WS_W_NAOUT0), scr, r, F.lane); continue; } r -= I_SQ;
            if (r < I_SQ) { p0_transpose_item(a.in[7] + (size_t)4096 * 4096, 4096, 4096, (bf16*)(ws + WS_W_NAOUT1), scr, r, F.lane); continue; } r -= I_SQ;
            if (r < I_S5IN) { p0_transpose_item(a.in[8], 4096, 8192, (bf16*)(ws + WS_W_S5IN), scr, r, F.lane); continue; } r -= I_S5IN;
            if (r < I_SQ) { p0_transpose_item(a.in[20], 4096, 4096, (bf16*)(ws + WS_W_S5GLU), scr, r, F.lane); continue; } r -= I_SQ;
            if (r < I_SQ) { p0_transpose_item(a.in[22], 4096, 4096, (bf16*)(ws + WS_W_S5OUT), scr, r, F.lane); continue; } r -= I_SQ;
            if (r < I_GLAIN) { p0_transpose_item(a.in[23], 4096, 12288, (bf16*)(ws + WS_W_GLAIN), scr, r, F.lane); continue; } r -= I_GLAIN;
            p0_transpose_item(a.in[31], 4096, 4096, (bf16*)(ws + WS_W_GLAOUT), scr, r, F.lane);
        }
        bf16* G1T = (bf16*)(ws + WS_W_GLAG1);
        for (int e = (F.vcu * NWAVES * 64 + F.tid); e < 256 * 4096 / 2; e += F.G * NWAVES * 64) {
            const int n = e / 2048, k = (e % 2048) * 2; float v0 = 0.f, v1 = 0.f;
            if (n < 16) { v0 = a.in[24][(size_t)k * 16 + n]; v1 = a.in[24][(size_t)(k + 1) * 16 + n]; }
            else if (n < 32) { v0 = a.in[27][(size_t)k * 16 + (n - 16)]; v1 = a.in[27][(size_t)(k + 1) * 16 + (n - 16)]; }
            *(GAS unsigned*)(G1T + (size_t)n * 4096 + k) = pk2(v0, v1);
        }
    }
    __syncthreads();
    for (int g = F.vcu; g < S5_G; g += F.G) p0_s5_group(F, a, g);
}

template <bool FINAL>
__device__ __forceinline__ void norm_phase(Frame& F, const float* xin, const float* nw, const float* mod  , bf16* H, float* outf) {
    LAS f32x2* tab = (LAS f32x2*)(F.lds + RING_OFF);
    for (int i = F.tid; i < 2 * 4096; i += NWAVES * 64) { const int b = i >> 12, c = i & 4095;
        if (FINAL) tab[i] = (f32x2){nw[c], 0.f};
        else tab[i] = (f32x2){nw[c] * (1.0f + mod[b * 12288 + 4096 + c]), mod[b * 12288 + c]}; }
    __syncthreads();
    const int gw = F.vcu * NWAVES + F.wave, NGW = F.G * NWAVES;
    for (int m = gw; m < M; m += NGW) {
        const int b = m >> 13; const GAS f32x4* xr = (const GAS f32x4*)(xin + (size_t)m * D) + F.lane;
        f32x4 v[16]; float s = 0.f;
#pragma unroll
        for (int j = 0; j < 16; ++j) { v[j] = xr[64 * j]; s += (v[j].x * v[j].x + v[j].y * v[j].y) + (v[j].z * v[j].z + v[j].w * v[j].w); }
        const float rstd = rsqrtf(wave_sum(s) * (1.f / D) + EPS);
#pragma unroll
        for (int j = 0; j < 16; ++j) { const int c = 4 * F.lane + 256 * j; const LAS f32x2* tp = tab + b * 4096 + c;
            const f32x2 t0 = tp[0], t1 = tp[1], t2 = tp[2], t3 = tp[3];
            const float o0 = v[j].x * rstd * t0.x + t0.y, o1 = v[j].y * rstd * t1.x + t1.y, o2 = v[j].z * rstd * t2.x + t2.y, o3 = v[j].w * rstd * t3.x + t3.y;
            if (FINAL) *((GAS f32x4*)(outf + (size_t)m * D) + F.lane + 64 * j) = (f32x4){o0, o1, o2, o3};
            else *(GAS v2u*)(H + (size_t)m * D + c) = (v2u){cvt_pk_bf16(o0, o1), cvt_pk_bf16(o2, o3)}; }
    }
    __syncthreads();
}

typedef short v4i16_t __attribute__((ext_vector_type(4)));
__device__ __forceinline__ s16x4 tr4(const LAS unsigned char* p) { return __builtin_bit_cast(s16x4, __builtin_amdgcn_ds_read_tr16_b64_v4i16((LAS v4i16_t*)p)); }
__device__ __forceinline__ bf16x8 cat8(s16x4 a, s16x4 b) { return (bf16x8){a[0], a[1], a[2], a[3], b[0], b[1], b[2], b[3]}; }
__device__ __forceinline__ bf16x8 pack8(f32x4 a, f32x4 b) { v4u w; w.x = cvt_pk_bf16(a[0], a[1]); w.y = cvt_pk_bf16(a[2], a[3]); w.z = cvt_pk_bf16(b[0], b[1]); w.w = cvt_pk_bf16(b[2], b[3]); return __builtin_bit_cast(bf16x8, w); }
#define MFMA16(a, b, c) __builtin_amdgcn_mfma_f32_16x16x32_bf16((a), (b), (c), 0, 0, 0)

constexpr int NA_PITCH = 272, NA_TILE = 64 * NA_PITCH;
__device__ __forceinline__ void na_attn_phase(Frame& F, const bf16* QKVG, bf16* Z, const float* rpb) {
    const int grp = F.wave >> 2, ct = F.wave & 3, lane = F.lane, li = lane & 15, g = lane >> 4, q4 = li >> 2, p4 = li & 3;
    const int c0 = ct * 16, kc0 = min(max(c0 - 8, 0), 32);
    const int ipw = (4096 + F.G - 1) / F.G;
    LAS unsigned char* const lbase = F.lds + RING_OFF;
    LAS float* const rp = (LAS float*)(lbase + 4 * NA_TILE + grp * 2048);
    for (int k = 0; k < ipw; ++k) {
        const int it = F.vcu * ipw + k; if (it >= 4096) break;
        const int b = it >> 11, hp = (it >> 7) & 15, r = ((it & 15) << 3) | ((it >> 4) & 7), h = hp * 2 + grp;
        const int rs = min(max(r - 4, 0), GROWS - 8);
        const size_t tok0 = (size_t)b * SEQ + (size_t)r * GRIDW;
        const bf16* qp = QKVG + (tok0 + c0 + li) * 16384 + h * 128 + 8 * g;
        bf16x8 qf[4];
#pragma unroll
        for (int ks = 0; ks < 4; ++ks) qf[ks] = *(const GAS bf16x8*)(qp + 32 * ks);
        for (int e = (F.tid & 255); e < 465; e += 256) rp[e] = rpb[h * 465 + e];
        v4u st[4];
        const bf16* kvbase = QKVG + ((size_t)b * SEQ + (size_t)rs * GRIDW + 16 * ct + g) * 16384 + h * 128 + li * 8;
#define NA_LOAD(t) do { _Pragma("unroll") for (int j = 0; j < 4; ++j) st[j] = *(const GAS v4u*)(kvbase + ((size_t)((t) & 7) * GRIDW + 4 * j) * 16384 + (((t) >> 3) ? 8192 : 4096)); } while (0)
#define NA_WRITE(buf) do { _Pragma("unroll") for (int j = 0; j < 4; ++j) *(LAS v4u*)(lbase + ((buf) * 2 + grp) * NA_TILE + (16 * ct + 4 * j + g) * NA_PITCH + li * 16) = st[j]; } while (0)
        NA_LOAD(0); NA_WRITE(0); __syncthreads();
        f32x4 S[8][2];
#pragma unroll
        for (int t = 0; t < 8; ++t) {
            NA_LOAD(t + 1);
            const LAS unsigned char* tb = lbase + ((t & 1) * 2 + grp) * NA_TILE;
            S[t][0] = (f32x4){0.f, 0.f, 0.f, 0.f}; S[t][1] = (f32x4){0.f, 0.f, 0.f, 0.f};
#pragma unroll
            for (int blk = 0; blk < 2; ++blk)
#pragma unroll
                for (int ks = 0; ks < 4; ++ks) { const bf16x8 A = *(const LAS bf16x8*)(tb + (kc0 + 16 * blk + li) * NA_PITCH + (32 * ks + 8 * g) * 2);
                    S[t][blk] = MFMA16(A, qf[ks], S[t][blk]); }
            NA_WRITE((t + 1) & 1);
            __syncthreads();
        }
        const int c = c0 + li, cs = min(max(c - 8, 0), GRIDW - 16);
        float mx = -1e30f;
#pragma unroll
        for (int t = 0; t < 8; ++t)
#pragma unroll
            for (int blk = 0; blk < 2; ++blk)
#pragma unroll
                for (int e = 0; e < 4; ++e) { const int kc = kc0 + 16 * blk + 4 * g + e; const bool valid = (kc >= cs) && (kc < cs + 16);
                    const int idx = valid ? ((rs + t - r + 7) * 31 + (kc - c + 15)) : 0;
                    const float s = valid ? (S[t][blk][e] * 0.08838834764831845f + rp[idx]) : -1e30f; S[t][blk][e] = s; mx = fmaxf(mx, s); }
        mx = fmaxf(mx, __shfl_xor(mx, 16)); mx = fmaxf(mx, __shfl_xor(mx, 32));
        float sum = 0.f;
#pragma unroll
        for (int t = 0; t < 8; ++t)
#pragma unroll
            for (int blk = 0; blk < 2; ++blk)
#pragma unroll
                for (int e = 0; e < 4; ++e) { const float p = __expf(S[t][blk][e] - mx); S[t][blk][e] = p; sum += p; }
        sum += __shfl_xor(sum, 16); sum += __shfl_xor(sum, 32);
        const float inv = 1.0f / sum;
        bf16x8 pb[8];
#pragma unroll
        for (int t = 0; t < 8; ++t) pb[t] = pack8(S[t][0], S[t][1]);
        f32x4 O[8];
#pragma unroll
        for (int db = 0; db < 8; ++db) O[db] = (f32x4){0.f, 0.f, 0.f, 0.f};
#pragma unroll
        for (int t = 8; t < 16; ++t) {
            if (t < 15) NA_LOAD(t + 1);
            const LAS unsigned char* tb = lbase + ((t & 1) * 2 + grp) * NA_TILE + (kc0 + 4 * g + q4) * NA_PITCH + 8 * p4;
#pragma unroll
            for (int db = 0; db < 8; ++db) { const s16x4 a0 = tr4(tb + 32 * db), a1 = tr4(tb + 16 * NA_PITCH + 32 * db);
                O[db] = MFMA16(cat8(a0, a1), pb[t - 8], O[db]); }
            if (t < 15) NA_WRITE((t + 1) & 1);
            __syncthreads();
        }
#undef NA_LOAD
#undef NA_WRITE
        bf16* zp = Z + (tok0 + c0 + li) * 4096 + h * 128 + 4 * g; const bf16* gp = QKVG + (tok0 + c0 + li) * 16384 + 12288 + h * 128 + 4 * g;
#pragma unroll
        for (int db = 0; db < 8; ++db) { const v2u gw = *(const GAS v2u*)(gp + 16 * db);
            const float z0 = O[db][0] * inv * siluf_(bf_lo(gw.x)), z1 = O[db][1] * inv * siluf_(bf_hi(gw.x)), z2 = O[db][2] * inv * siluf_(bf_lo(gw.y)), z3 = O[db][3] * inv * siluf_(bf_hi(gw.y));
            *(GAS v2u*)(zp + 16 * db) = (v2u){cvt_pk_bf16(z0, z1), cvt_pk_bf16(z2, z3)}; }
    }
    __syncthreads();
}

__device__ __forceinline__ void na_attn_phase2(Frame& F, const bf16* QKVG, bf16* Z, const float* rpb) {
    const int rq = F.wave >> 2, ct = F.wave & 3, lane = F.lane, li = lane & 15, g = lane >> 4, q4 = li >> 2, p4 = li & 3;
    const int c0 = ct * 16, kc0 = min(max(c0 - 8, 0), 32);
    LAS unsigned char* const lbase = F.lds + RING_OFF;
    LAS float* const rp = (LAS float*)(lbase + 6 * NA_TILE);
    const int ipw = (4096 + F.G - 1) / F.G, it0 = F.vcu * ipw;
    if (it0 >= 4096) return;
    const int nit = min(ipw, 4096 - it0);
    const bool xg = (F.G == 256);
#define NA2_ID(k_) (xg ? ((((F.vcu >> 5) * 8 + ((k_) >> 1)) << 6) | ((((k_) & 1) << 5) | (F.vcu & 31))) : (it0 + (k_)))
    const int id0 = NA2_ID(0);
    const int ptok = F.tid >> 4, pch = F.tid & 15;
    v4u R[1][3][2];
#define NA2_SEC (size_t)(2 * 32 * 8192) * 128
#define NA2_SRC(it_, ss_) (QKVG + (((ss_) >= 9) ? 2 : 1) * NA2_SEC + ((size_t)((it_) >> 6) * 8192 + (size_t)min(min(max(2 * ((it_) & 63) - 4, 0), GROWS - 8) + ((ss_) % 9), GROWS - 1) * GRIDW + ptok) * 128 + pch * 8)
#define NA2_LOADG(set_, it_, gq_) do { _Pragma("unroll") for (int jj_ = 0; jj_ < 3; ++jj_) { const bf16* s_ = NA2_SRC(it_, 3 * (gq_) + jj_); \
        R[set_][jj_][0] = *(const GAS v4u*)s_; R[set_][jj_][1] = *(const GAS v4u*)(s_ + 32 * 128); } } while (0)
#define NA2_WRITEG(set_, buf) do { _Pragma("unroll") for (int jj_ = 0; jj_ < 3; ++jj_) { LAS unsigned char* d_ = lbase + ((buf) * 3 + jj_) * NA_TILE + ptok * NA_PITCH + pch * 16; \
        *(LAS v4u*)d_ = R[set_][jj_][0]; *(LAS v4u*)(d_ + 32 * NA_PITCH) = R[set_][jj_][1]; } } while (0)
#define NA2_SCORE(kl, tb) do { S[kl][0] = (f32x4){0.f, 0.f, 0.f, 0.f}; S[kl][1] = (f32x4){0.f, 0.f, 0.f, 0.f}; \
        _Pragma("unroll") for (int blk = 0; blk < 2; ++blk) _Pragma("unroll") for (int ks = 0; ks < 4; ++ks) { \
            const bf16x8 A_ = *(const LAS bf16x8*)((tb) + (kc0 + 16 * blk + li) * NA_PITCH + (32 * ks + 8 * g) * 2); S[kl][blk] = MFMA16(A_, qf[ks], S[kl][blk]); } \
        _Pragma("unroll") for (int blk = 0; blk < 2; ++blk) _Pragma("unroll") for (int e = 0; e < 4; ++e) { const bool valid = ((blk ? vm1 : vm0) + (unsigned)e) < 16u; const float bias = bp[(kl) * 31 + blk * 16 + e]; \
            const float sv = valid ? (S[kl][blk][e] * 0.08838834764831845f + bias) : -1e30f; S[kl][blk][e] = sv; mx = fmaxf(mx, sv); } } while (0)
#define NA2_PV(kl, tb) do { const LAS unsigned char* t_ = (tb) + (kc0 + 4 * g + q4) * NA_PITCH + 8 * p4; \
        _Pragma("unroll") for (int blk = 0; blk < 2; ++blk) _Pragma("unroll") for (int e = 0; e < 4; ++e) { const float p_ = __expf(S[kl][blk][e] - mx); S[kl][blk][e] = p_; sum += p_; } \
        const bf16x8 pb_ = pack8(S[kl][0], S[kl][1]); \
        _Pragma("unroll") for (int db = 0; db < 8; ++db) O[db] = MFMA16(cat8(tr4(t_ + 32 * db), tr4(t_ + 16 * NA_PITCH + 32 * db)), pb_, O[db]); } while (0)
    NA2_LOADG(0, id0, 0);
    bf16x8 qf[4];
    { const int rp_ = id0 & 63, r_ = 2 * rp_ + rq;
      const bf16* qp = QKVG + ((size_t)(id0 >> 6) * 8192 + (size_t)r_ * GRIDW + c0 + li) * 128 + 8 * g;
#pragma unroll
      for (int ks = 0; ks < 4; ++ks) qf[ks] = *(const GAS bf16x8*)(qp + 32 * ks); }
    NA2_WRITEG(0, 0);
    for (int e = F.tid; e < 465; e += NWAVES * 64) rp[e] = rpb[((id0 >> 6) & 31) * 465 + e];
    __syncthreads();
    for (int k = 0; k < nit; ++k) {
        const int it = NA2_ID(k), itn = NA2_ID(k + 1), b = it >> 11, h = (it >> 6) & 31, rpi = it & 63;
        const int base = min(max(2 * rpi - 4, 0), GROWS - 8), r = 2 * rpi + rq, rsw = min(max(r - 4, 0), GROWS - 8), offw = rsw - base;
        const bool has_next = (k + 1 < nit);
        f32x4 S[8][2];
        int lz = F.lane; asm volatile("" : "+v"(lz)); const int liz = lz & 15, gz = lz >> 4, c = c0 + liz, cs = min(max(c - 8, 0), GRIDW - 16);
        const LAS float* bp = rp + (rsw - r + 7) * 31 + (kc0 + 4 * gz - c + 15);
        const unsigned vm0 = (unsigned)(kc0 + 4 * gz - cs), vm1 = vm0 + 16u;
        float mx = -1e30f, sum = 0.f;
#pragma unroll
        for (int gi = 0; gi < 3; ++gi) {
            NA2_LOADG(0, it, gi + 1);
#pragma unroll
            for (int jj = 0; jj < 3; ++jj) { const int j = 3 * gi + jj; const LAS unsigned char* tb = lbase + ((gi & 1) * 3 + jj) * NA_TILE;
                if (offw == 0) { if (j < 8) NA2_SCORE((j < 8 ? j : 0), tb); } else { if (j >= 1) NA2_SCORE((j >= 1 ? j - 1 : 0), tb); }
                asm volatile("" ::: "memory"); }
            NA2_WRITEG(0, (gi + 1) & 1);
            __syncthreads();
        }
        mx = fmaxf(mx, __shfl_xor(mx, 16)); mx = fmaxf(mx, __shfl_xor(mx, 32));
        f32x4 O[8];
#pragma unroll
        for (int db = 0; db < 8; ++db) O[db] = (f32x4){0.f, 0.f, 0.f, 0.f};
        v2u gw[8];
        bf16x8 qn[4];
#pragma unroll
        for (int gi = 0; gi < 3; ++gi) {
            const int sg = 3 + gi;
            if (sg + 1 < 6) NA2_LOADG(0, it, sg + 1); else if (has_next) NA2_LOADG(0, itn, 0);
            if (gi == 1 && has_next) { for (int e = F.tid; e < 465; e += NWAVES * 64) rp[e] = rpb[((itn >> 6) & 31) * 465 + e]; }
            if (gi == 2 && has_next) { const int rpn = itn & 63, rn = 2 * rpn + rq;
                const bf16* qp = QKVG + ((size_t)(itn >> 6) * 8192 + (size_t)rn * GRIDW + c0 + li) * 128 + 8 * g;
#pragma unroll
                for (int ks = 0; ks < 4; ++ks) qn[ks] = *(const GAS bf16x8*)(qp + 32 * ks); }
#pragma unroll
            for (int jj = 0; jj < 3; ++jj) { const int j = 3 * gi + jj; const LAS unsigned char* tb = lbase + ((sg & 1) * 3 + jj) * NA_TILE;
                if (offw == 0) { if (j < 8) NA2_PV((j < 8 ? j : 0), tb); } else { if (j >= 1) NA2_PV((j >= 1 ? j - 1 : 0), tb); }
                asm volatile("" ::: "memory"); }
            if (sg + 1 < 6 || has_next) NA2_WRITEG(0, (sg + 1) & 1);
            __syncthreads();
        }
        sum += __shfl_xor(sum, 16); sum += __shfl_xor(sum, 32);
        const float inv = __builtin_amdgcn_rcpf(sum);
        int lq = F.lane; asm volatile("" : "+v"(lq)); const int liq = lq & 15, gq = lq >> 4;
        const size_t mq = (size_t)b * SEQ + (size_t)r * GRIDW + c0 + liq;
        const bf16* gp = QKVG + 3 * NA2_SEC + ((size_t)(it >> 6) * 8192 + (size_t)r * GRIDW + c0 + liq) * 128 + 4 * gq;
        bf16* zp = Z + mq * 4096 + h * 128 + 4 * gq;
#pragma unroll
        for (int db = 0; db < 8; ++db) gw[db] = *(const GAS v2u*)(gp + 16 * db);
#pragma unroll
        for (int db = 0; db < 8; ++db) {
            const float z0 = O[db][0] * inv * siluf_(bf_lo(gw[db].x)), z1 = O[db][1] * inv * siluf_(bf_hi(gw[db].x)), z2 = O[db][2] * inv * siluf_(bf_lo(gw[db].y)), z3 = O[db][3] * inv * siluf_(bf_hi(gw[db].y));
            *(GAS v2u*)(zp + 16 * db) = (v2u){cvt_pk_bf16(z0, z1), cvt_pk_bf16(z2, z3)}; }
        if (has_next) {
#pragma unroll
            for (int ks = 0; ks < 4; ++ks) qf[ks] = qn[ks]; }
    }
#undef NA2_SRC
#undef NA2_SEC
#undef NA2_ID
#undef NA2_LOADG
#undef NA2_WRITEG
#undef NA2_SCORE
#undef NA2_PV
    __syncthreads();
}

__device__ __forceinline__ void s5_scan_phase(Frame& F, const Args& a) {
    const float* Sloc = (const float*)(a.ws + WS_S5_SLOC); bf16* Ug = (bf16*)(a.ws + WS_S5_UG); const float* LAMT = (const float*)(a.ws + WS_LAMT);
    const int t8 = F.tid & 255, b = t8 >> 7, dir = (t8 >> 6) & 1, p = t8 & 63;
    for (int gi = F.vcu * 2 + (F.tid >> 8); gi < S5_G; gi += F.G * 2) {
        const float lr = LAMT[((size_t)(gi * 2 + dir) * 64 + p) * 2 + 0], li = LAMT[((size_t)(gi * 2 + dir) * 64 + p) * 2 + 1];
        float xr = 0.f, xi = 0.f;
#pragma unroll 8
        for (int s = 0; s < S5_NCHB; ++s) { const int c = dir ? (S5_NCHB - 1 - s) : s; const size_t row = (size_t)gi * S5_NCH + b * S5_NCHB + c;
            bf16* up = Ug + row * S5_KY + S5_KS + dir * 128 + p;
            up[0] = (bf16)f2bf(xr); up[64] = (bf16)f2bf(xi);
            const float sr = Sloc[row * 256 + dir * 128 + p], si = Sloc[row * 256 + dir * 128 + 64 + p];
            const float nr = lr * xr - li * xi + sr, ni = lr * xi + li * xr + si; xr = nr; xi = ni; }
    }
}

__device__ __forceinline__ float log_sigmoidf_(float z) { return fminf(z, 0.f) - log1pf(expf(-fabsf(z))); }
__device__ __forceinline__ void gla_prep_phase(Frame& F, const Args& a) {
    const bf16* IN = (const bf16*)(a.ws + WS_GLA_IN); const float* G1P = (const float*)(a.ws + WS_GLA_G1P);
    bf16* PREP = (bf16*)(a.ws + WS_GLA_PREP); float* DECAY = (float*)(a.ws + WS_GLA_DECAY);
    LAS float* g1s = (LAS float*)(F.lds + RING_OFF);
    LAS float* Bc = g1s + 64 * 32;
    LAS float* bl = Bc + 2 * 64 * 256;
    static_assert((64 * 32 + 2 * 64 * 256 + 2 * 256) * 4 <= MISC_OFF, "gla prep LDS");
    const int ipw = (2048 + F.G - 1) / F.G; int cur_chunk = -1;
    for (int k = 0; k < ipw; ++k) {
        const int it = F.vcu * ipw + k; if (it >= 2048) break;
        const int cidx = it >> 3, h = it & 7, m0 = cidx * GLA_C, dbase = h * 256;
        if (cidx != cur_chunk) { cur_chunk = cidx;
            const int tok = F.tid >> 3, qd = F.tid & 7; f32x4 s4 = {0.f, 0.f, 0.f, 0.f};
#pragma unroll
            for (int ks = 0; ks < 4; ++ks) s4 += *(const GAS f32x4*)(G1P + ((size_t)ks * M + m0 + tok) * 32 + qd * 4);
            *(LAS f32x4*)(g1s + tok * 32 + qd * 4) = s4;
            __syncthreads(); }
        v4u q8[4], k8[4];
#pragma unroll
        for (int j = 0; j < 4; ++j) { const int e = F.tid + 512 * j, tok = e >> 5, c8 = (e & 31) * 8; const size_t m = (size_t)m0 + tok;
            q8[j] = *(const GAS v4u*)(IN + m * GLA_NIN + dbase + c8); k8[j] = *(const GAS v4u*)(IN + m * GLA_NIN + GLA_KW + dbase + c8); }
        {
            const int dir = F.tid >> 8, col = F.tid & 255, d = dbase + col;
            const float* w2 = dir ? a.in[28] : a.in[25]; const float bgd = (dir ? a.in[29] : a.in[26])[d];
            float w2r[16];
#pragma unroll
            for (int r = 0; r < 16; ++r) w2r[r] = w2[(size_t)r * GLA_KW + d];
            float run = 0.f;
#pragma unroll 4
            for (int s = 0; s < 64; ++s) { const int i = dir ? (63 - s) : s; const LAS f32x4* gp = (const LAS f32x4*)(g1s + i * 32 + dir * 16); float z = bgd;
                const f32x4 g0 = gp[0], g1 = gp[1], g2 = gp[2], g3 = gp[3];
                z += g0[0] * w2r[0] + g0[1] * w2r[1] + g0[2] * w2r[2] + g0[3] * w2r[3]; z += g1[0] * w2r[4] + g1[1] * w2r[5] + g1[2] * w2r[6] + g1[3] * w2r[7];
                z += g2[0] * w2r[8] + g2[1] * w2r[9] + g2[2] * w2r[10] + g2[3] * w2r[11]; z += g3[0] * w2r[12] + g3[1] * w2r[13] + g3[2] * w2r[14] + g3[3] * w2r[15];
                const float ls = fminf(z, 0.f) - __logf(1.0f + __expf(-fabsf(z)));
                run += ls * (1.0f / 16.0f); Bc[(dir * 64 + i) * 256 + col] = run; }
            bl[dir * 256 + col] = run;
        }
        __syncthreads();
#pragma unroll
        for (int j = 0; j < 4; ++j) { const int e = F.tid + 512 * j, tok = e >> 5, c8 = (e & 31) * 8; const size_t m = (size_t)m0 + tok;
            float qv[8], kv[8];
#pragma unroll
            for (int x = 0; x < 4; ++x) { qv[2 * x] = bf_lo(q8[j][x]) * 0.0625f; qv[2 * x + 1] = bf_hi(q8[j][x]) * 0.0625f; kv[2 * x] = bf_lo(k8[j][x]); kv[2 * x + 1] = bf_hi(k8[j][x]); }
#pragma unroll
            for (int dir = 0; dir < 2; ++dir) {
                f32x4 bbv[2], btv[2];
                bbv[0] = *(const LAS f32x4*)(Bc + (dir * 64 + tok) * 256 + c8); bbv[1] = *(const LAS f32x4*)(Bc + (dir * 64 + tok) * 256 + c8 + 4);
                btv[0] = *(const LAS f32x4*)(bl + dir * 256 + c8); btv[1] = *(const LAS f32x4*)(bl + dir * 256 + c8 + 4);
                float o0[8], o1[8], o2[8];
#pragma unroll
                for (int x = 0; x < 8; ++x) { const float bx = bbv[x >> 2][x & 3], tx = btv[x >> 2][x & 3]; o0[x] = qv[x] * __expf(bx); o1[x] = kv[x] * __expf(-bx); o2[x] = kv[x] * __expf(tx - bx); }
                v4u w0, w1, w2;
#pragma unroll
                for (int x = 0; x < 4; ++x) { w0[x] = cvt_pk_bf16(o0[2 * x], o0[2 * x + 1]); w1[x] = cvt_pk_bf16(o1[2 * x], o1[2 * x + 1]); w2[x] = cvt_pk_bf16(o2[2 * x], o2[2 * x + 1]); }
                bf16* pp = PREP + (size_t)(dir * 3) * M * GLA_KW + m * GLA_KW + dbase + c8;
                *(GAS v4u*)(pp) = w0; *(GAS v4u*)(pp + (size_t)M * GLA_KW) = w1; *(GAS v4u*)(pp + (size_t)2 * M * GLA_KW) = w2;
                if (tok == 0) { float* dp = DECAY + ((size_t)dir * GLA_NCH + cidx) * GLA_KW + dbase + c8;
                    *(GAS f32x4*)(dp) = (f32x4){__expf(btv[0][0]), __expf(btv[0][1]), __expf(btv[0][2]), __expf(btv[0][3])}; *(GAS f32x4*)(dp + 4) = (f32x4){__expf(btv[1][0]), __expf(btv[1][1]), __expf(btv[1][2]), __expf(btv[1][3])}; }
            }
        }
        __syncthreads();
    }
}

constexpr int GLA_PQ = 528, GLA_PV = 272, GLA_PV2 = 144, GLA_PVI = 1040;
__device__ __forceinline__ void gla_chain_role(Frame& F, const Args& a, int ch) {
    const bf16* IN = (const bf16*)(a.ws + WS_GLA_IN); const bf16* PREP = (const bf16*)(a.ws + WS_GLA_PREP); const float* DECAY = (const float*)(a.ws + WS_GLA_DECAY);
    const int b = ch >> 7, h = (ch >> 4) & 7, dir = (ch >> 3) & 1, vo = ch & 7;
    bf16* OUT = (bf16*)(a.ws + WS_GLA_O) + (size_t)(1 + dir) * M * 4096;
    const bf16* QS = PREP + (size_t)(dir * 3 + 0) * M * GLA_KW; const bf16* KE = PREP + (size_t)(dir * 3 + 2) * M * GLA_KW;
    LAS unsigned char* const qsT = F.lds + RING_OFF; LAS unsigned char* const keT = qsT + 64 * GLA_PQ; LAS unsigned char* const vT = keT + 64 * GLA_PQ; LAS float* const decT = (LAS float*)(vT + 64 * GLA_PV2);
    const int lane = F.lane, li = lane & 15, g = lane >> 4, q4 = li >> 2, p4 = li & 3, w = F.wave;
    f32x4 S[16];
#pragma unroll
    for (int dt = 0; dt < 16; ++dt) S[dt] = (f32x4){0.f, 0.f, 0.f, 0.f};
    v4u rq[4], rk[4], rv[1]; f32x4 rd = {0.f, 0.f, 0.f, 0.f};
#define GC_LOAD(sidx) do { const int cn_ = dir ? (GLA_NCHB - 1 - (sidx)) : (sidx); const size_t m0_ = ((size_t)b * GLA_NCHB + cn_) * GLA_C; \
        _Pragma("unroll") for (int j = 0; j < 4; ++j) { const int e = F.tid + 512 * j, tok = e >> 5, pc = e & 31; \
            rq[j] = *(const GAS v4u*)(QS + (m0_ + tok) * GLA_KW + h * 256 + pc * 8); rk[j] = *(const GAS v4u*)(KE + (m0_ + tok) * GLA_KW + h * 256 + pc * 8); } \
        { const int tok = F.tid >> 3, pc = F.tid & 7; rv[0] = *(const GAS v4u*)(IN + (m0_ + tok) * GLA_NIN + 4096 + h * 512 + vo * 64 + pc * 8); } \
        if (F.tid < 64) rd = *(const GAS f32x4*)(DECAY + ((size_t)dir * GLA_NCH + b * GLA_NCHB + cn_) * GLA_KW + h * 256 + F.tid * 4); } while (0)
    GC_LOAD(0);
    for (int sidx = 0; sidx < GLA_NCHB; ++sidx) {
#pragma unroll
        for (int j = 0; j < 4; ++j) { const int e = F.tid + 512 * j, tok = e >> 5, pc = e & 31; *(LAS v4u*)(qsT + tok * GLA_PQ + pc * 16) = rq[j]; *(LAS v4u*)(keT + tok * GLA_PQ + pc * 16) = rk[j]; }
        { const int tok = F.tid >> 3, pc = F.tid & 7; *(LAS v4u*)(vT + tok * GLA_PV2 + pc * 16) = rv[0]; }
        if (F.tid < 64) *(LAS f32x4*)(decT + F.tid * 4) = rd;
        __syncthreads();
        const int cn = dir ? (GLA_NCHB - 1 - sidx) : sidx; const size_t m0 = ((size_t)b * GLA_NCHB + cn) * GLA_C;
        if (sidx + 1 < GLA_NCHB) GC_LOAD(sidx + 1);
        if (w < 4) {
        v2u Sb[16];
#pragma unroll
        for (int dt = 0; dt < 16; ++dt) Sb[dt] = (v2u){cvt_pk_bf16(S[dt][0], S[dt][1]), cvt_pk_bf16(S[dt][2], S[dt][3])};
        {
            f32x4 acc[4];
#pragma unroll
            for (int ib = 0; ib < 4; ++ib) acc[ib] = (f32x4){0.f, 0.f, 0.f, 0.f};
            const LAS unsigned char* qrow = qsT + li * GLA_PQ + 8 * g;
#pragma unroll
            for (int ks = 0; ks < 8; ++ks) { const bf16x8 A = __builtin_bit_cast(bf16x8, (v4u){Sb[2 * ks].x, Sb[2 * ks].y, Sb[2 * ks + 1].x, Sb[2 * ks + 1].y});
#pragma unroll
                for (int ib = 0; ib < 4; ++ib) { const v2u b0 = *(const LAS v2u*)(qrow + 16 * ib * GLA_PQ + 64 * ks), b1 = *(const LAS v2u*)(qrow + 16 * ib * GLA_PQ + 64 * ks + 32);
                    acc[ib] = MFMA16(A, __builtin_bit_cast(bf16x8, (v4u){b0.x, b0.y, b1.x, b1.y}), acc[ib]); } }
#pragma unroll
            for (int ib = 0; ib < 4; ++ib)
                *(GAS v2u*)(OUT + (m0 + 16 * ib + li) * 4096 + h * 512 + vo * 64 + w * 16 + 4 * g) = (v2u){cvt_pk_bf16(acc[ib][0], acc[ib][1]), cvt_pk_bf16(acc[ib][2], acc[ib][3])};
        }
#pragma unroll
        for (int dt = 0; dt < 16; ++dt) S[dt] *= *(const LAS f32x4*)(decT + 16 * dt + 4 * g);
#pragma unroll
        for (int k2 = 0; k2 < 2; ++k2) { const LAS unsigned char* vb = vT + (32 * k2 + 8 * g + q4) * GLA_PV2 + (w * 16 + 4 * p4) * 2;
            const bf16x8 Bv = cat8(tr4(vb), tr4(vb + 4 * GLA_PV2));
            const LAS unsigned char* kb = keT + (32 * k2 + 8 * g + q4) * GLA_PQ + 8 * p4;
#pragma unroll
            for (int dt = 0; dt < 16; ++dt) { const bf16x8 A = cat8(tr4(kb + 32 * dt), tr4(kb + 4 * GLA_PQ + 32 * dt)); S[dt] = MFMA16(A, Bv, S[dt]); } }
        }
        __syncthreads();
    }
#undef GC_LOAD
}
__device__ __forceinline__ void gla_intra_role(Frame& F, const Args& a, int it) {
    const bf16* IN = (const bf16*)(a.ws + WS_GLA_IN); const bf16* PREP = (const bf16*)(a.ws + WS_GLA_PREP);
    bf16* OUT = (bf16*)(a.ws + WS_GLA_O);
    const int b = it >> 10, h = (it >> 7) & 7, cn = it & 127; const size_t m0 = ((size_t)b * GLA_NCHB + cn) * GLA_C;
    LAS unsigned char* const kfT = F.lds + RING_OFF; LAS unsigned char* const kbT = kfT + 64 * GLA_PQ; LAS unsigned char* const vT = kbT + 64 * GLA_PQ;
    const int lane = F.lane, li = lane & 15, g = lane >> 4, q4 = li >> 2, p4 = li & 3, ib = F.wave & 3, vh = F.wave >> 2;
    const bf16* KSF = PREP + (size_t)1 * M * GLA_KW; const bf16* KSB = PREP + (size_t)4 * M * GLA_KW;
    const bf16* QSF = PREP; const bf16* QSB = PREP + (size_t)3 * M * GLA_KW;
    {
        v4u r0[4], r1[4], r2[8];
#pragma unroll
        for (int j = 0; j < 4; ++j) { const int e = F.tid + 512 * j, tok = e >> 5, pc = e & 31; r0[j] = *(const GAS v4u*)(KSF + (m0 + tok) * GLA_KW + h * 256 + pc * 8); r1[j] = *(const GAS v4u*)(KSB + (m0 + tok) * GLA_KW + h * 256 + pc * 8); }
#pragma unroll
        for (int j = 0; j < 8; ++j) { const int e = F.tid + 512 * j, tok = e >> 6, pc = e & 63; r2[j] = *(const GAS v4u*)(IN + (m0 + tok) * GLA_NIN + 4096 + h * 512 + pc * 8); }
#pragma unroll
        for (int j = 0; j < 4; ++j) { const int e = F.tid + 512 * j, tok = e >> 5, pc = e & 31; *(LAS v4u*)(kfT + tok * GLA_PQ + pc * 16) = r0[j]; *(LAS v4u*)(kbT + tok * GLA_PQ + pc * 16) = r1[j]; }
#pragma unroll
        for (int j = 0; j < 8; ++j) { const int e = F.tid + 512 * j, tok = e >> 6, pc = e & 63; *(LAS v4u*)(vT + tok * GLA_PVI + pc * 16) = r2[j]; }
    }
    bf16x8 qf[8], qb[8];
#pragma unroll
    for (int ks = 0; ks < 8; ++ks) { qf[ks] = *(const GAS bf16x8*)(QSF + (m0 + 16 * ib + li) * GLA_KW + h * 256 + 32 * ks + 8 * g); qb[ks] = *(const GAS bf16x8*)(QSB + (m0 + 16 * ib + li) * GLA_KW + h * 256 + 32 * ks + 8 * g); }
    __syncthreads();
    f32x4 P[4];
#pragma unroll
    for (int jb = 0; jb < 4; ++jb) { f32x4 sf = {0.f, 0.f, 0.f, 0.f}, sb = {0.f, 0.f, 0.f, 0.f};
        if (jb <= ib) {
#pragma unroll
            for (int ks = 0; ks < 8; ++ks) sf = MFMA16(*(const LAS bf16x8*)(kfT + (16 * jb + li) * GLA_PQ + (32 * ks + 8 * g) * 2), qf[ks], sf); }
        if (jb >= ib) {
#pragma unroll
            for (int ks = 0; ks < 8; ++ks) sb = MFMA16(*(const LAS bf16x8*)(kbT + (16 * jb + li) * GLA_PQ + (32 * ks + 8 * g) * 2), qb[ks], sb); }
#pragma unroll
        for (int e = 0; e < 4; ++e) { const int ii = 16 * ib + li, jj = 16 * jb + 4 * g + e; P[jb][e] = (ii >= jj) ? sf[e] : sb[e]; } }
    if (MK_DIAG) { bool bad = false;
#pragma unroll
        for (int jb = 0; jb < 4; ++jb)
#pragma unroll
            for (int e = 0; e < 4; ++e) bad |= !(fabsf(P[jb][e]) < 1e30f);
        if (bad) atomicOr((unsigned*)(a.ws + WS_CTL) + 17, 1u << 4); }
    const bf16x8 Pb0 = pack8(P[0], P[1]), Pb1 = pack8(P[2], P[3]);
    bf16* op = OUT + (m0 + 16 * ib + li) * 4096 + h * 512 + vh * 256 + 4 * g;
    const LAS unsigned char* vb = vT + (4 * g + q4) * GLA_PVI + (vh * 256 + 4 * p4) * 2;
#pragma unroll
    for (int vt = 0; vt < 16; ++vt) { f32x4 acc = {0.f, 0.f, 0.f, 0.f};
        acc = MFMA16(cat8(tr4(vb + 32 * vt), tr4(vb + 16 * GLA_PVI + 32 * vt)), Pb0, acc);
        acc = MFMA16(cat8(tr4(vb + 32 * GLA_PVI + 32 * vt), tr4(vb + 48 * GLA_PVI + 32 * vt)), Pb1, acc);
        if (MK_DIAG && (!(fabsf(acc[0]) < 1e30f) || !(fabsf(acc[1]) < 1e30f) || !(fabsf(acc[2]) < 1e30f) || !(fabsf(acc[3]) < 1e30f))) atomicOr((unsigned*)(a.ws + WS_CTL) + 17, 1u << 5);
        *(GAS v2u*)(op + 16 * vt) = (v2u){cvt_pk_bf16(acc[0], acc[1]), cvt_pk_bf16(acc[2], acc[3])}; }
    __syncthreads();
}
__device__ __forceinline__ void gla_main_phase(Frame& F, const Args& a) {
    for (int ch = F.vcu; ch < 256; ch += F.G) gla_chain_role(F, a, ch);
    for (int it = F.vcu; it < 2048; it += F.G) gla_intra_role(F, a, it);
}
__device__ __forceinline__ void gla_combine_phase(Frame& F, const Args& a) {
    const bf16* IN = (const bf16*)(a.ws + WS_GLA_IN); const bf16* O = (const bf16*)(a.ws + WS_GLA_O); bf16* Z = (bf16*)(a.ws + WS_GLA_Z);
    const float* nw = a.in[30];
    float nwr[8];
#pragma unroll
    for (int x = 0; x < 8; ++x) nwr[x] = nw[F.lane * 8 + x];
    const int gw = F.vcu * NWAVES + F.wave, NGW = F.G * NWAVES;
    for (int m = gw; m < M; m += NGW) {
#pragma unroll 2
        for (int h = 0; h < 8; ++h) { const size_t off = (size_t)m * 4096 + h * 512 + F.lane * 8;
            const v4u x0 = *(const GAS v4u*)(O + off), x1 = *(const GAS v4u*)(O + (size_t)M * 4096 + off), x2 = *(const GAS v4u*)(O + (size_t)2 * M * 4096 + off);
            const v4u gg = *(const GAS v4u*)(IN + (size_t)m * GLA_NIN + 8192 + h * 512 + F.lane * 8);
            if (MK_DIAG) { bool b0 = false, b1 = false, b2 = false, b3 = false;
#pragma unroll
                for (int x = 0; x < 4; ++x) { b0 |= !(fabsf(bf_lo(x0[x])) < 1e30f) || !(fabsf(bf_hi(x0[x])) < 1e30f); b1 |= !(fabsf(bf_lo(x1[x])) < 1e30f) || !(fabsf(bf_hi(x1[x])) < 1e30f);
                    b2 |= !(fabsf(bf_lo(x2[x])) < 1e30f) || !(fabsf(bf_hi(x2[x])) < 1e30f); b3 |= !(fabsf(bf_lo(gg[x])) < 1e30f) || !(fabsf(bf_hi(gg[x])) < 1e30f); }
                const unsigned f = (b0 ? 1024u : 0u) | (b1 ? 2048u : 0u) | (b2 ? 4096u : 0u) | (b3 ? 8192u : 0u); if (f) atomicOr((unsigned*)(a.ws + WS_CTL) + 17, f); }
            float o[8]; float ss = 0.f;
#pragma unroll
            for (int x = 0; x < 4; ++x) { o[2 * x] = bf_lo(x0[x]) + bf_lo(x1[x]) + bf_lo(x2[x]); o[2 * x + 1] = bf_hi(x0[x]) + bf_hi(x1[x]) + bf_hi(x2[x]); ss += o[2 * x] * o[2 * x] + o[2 * x + 1] * o[2 * x + 1]; }
            const float rstd = rsqrtf(wave_sum(ss) * (1.0f / 512.0f) + EPS);
            v4u zw;
#pragma unroll
            for (int x = 0; x < 4; ++x) zw[x] = cvt_pk_bf16(o[2 * x] * rstd * nwr[2 * x] * siluf_(bf_lo(gg[x])), o[2 * x + 1] * rstd * nwr[2 * x + 1] * siluf_(bf_hi(gg[x])));
            *(GAS v4u*)(Z + off) = zw; }
    }
}

constexpr int NPH = 23;
__global__ void __launch_bounds__(NWAVES * 64, 2) fwd_kernel(Args args) {
    extern __shared__ __attribute__((aligned(16))) unsigned char lds[];
    Frame F;
    F.lds = (LAS unsigned char*)lds;
    F.tid = threadIdx.x; F.lane = F.tid & 63; F.wave = __builtin_amdgcn_readfirstlane(F.tid >> 6);
    F.G = gridDim.x; { const int bx = blockIdx.x; F.vcu = (F.G % 8 == 0) ? (bx % 8) * (F.G / 8) + bx / 8 : bx; }
    volatile LAS unsigned* MISC = (volatile LAS unsigned*)(F.lds + MISC_OFF);
    for (int u = F.tid; u < (LDS_BYTES - MISC_OFF) / 4; u += NWAVES * 64) MISC[u] = 0u;
    __syncthreads();
    unsigned char* ws = args.ws;
    const int lo = args.ph_lo, hi = args.ph_hi, rep = args.dup;
    XcdBarrier bar; bar.bar = (unsigned*)(ws + WS_CTL) + CW_BAR; bar.x = 0; bar.st = nullptr;
    if (hi - lo > 1) bar = xcd_barrier_post((unsigned*)(ws + WS_CTL) + CW_BAR, MISC + 8);
#define IN(k) (lo <= (k) && (k) < hi)
#define REP(k)
#if MK_PROF
    volatile LAS unsigned long long* PROF = (volatile LAS unsigned long long*)(F.lds + 135168);
    if (F.tid == 0) PROF[0] = __builtin_amdgcn_s_memrealtime();
#define SEAM(k) do { if (IN(k) && IN((k) + 1)) { if (F.tid == 0) PROF[32 + (k)] = __builtin_amdgcn_s_memrealtime(); xcd_barrier(bar); if (F.tid == 0) PROF[1 + (k)] = __builtin_amdgcn_s_memrealtime(); } } while (0)
#else
#define SEAM(k) do { if (IN(k) && IN((k) + 1)) xcd_barrier(bar); } while (0)
#endif
    const float* MOD = (const float*)(ws + WS_MOD);
    bf16* H = (bf16*)(ws + WS_H);
    float* XO = args.out;
    LAS unsigned char* ring = F.lds + RING_OFF;
    unsigned* const DFLAG = (unsigned*)(ws + WS_CTL) + 16;

    if (IN(0)) { REP(0) { p0_prologue(F, args); } } SEAM(0);

#if MK_NLAYERS >= 1
    if (IN(1)) { REP(1) { norm_phase<false>(F, args.in[0], args.in[4] + 0 * D, MOD + 0 * 2 * 12288, H, nullptr); } } SEAM(1);
    if (IN(2)) { REP(2) { pg8::Gemm g{H, (const bf16*)(ws + WS_W_NAIN0), 4096, 4096, 4096, DFLAG, 1u << 2}; pg8::StaticOrder S; S.init(M, 16384, F.G, (int)blockIdx.x);
        pg8::EpiNaIn E{(bf16*)(ws + WS_NA_QKVG)};
        pg8::gemm_phase<pg8::EpiNaIn, pg8::StaticOrder, false, true>(ring, g, S, E); } } SEAM(2);
    if (IN(3)) { REP(3) na_attn_phase2(F, (const bf16*)(ws + WS_NA_QKVG), (bf16*)(ws + WS_NA_Z), args.in[6] + 0 * 32 * 465); } SEAM(3);
    if (IN(4)) { REP(4) { pg8::Gemm g{(const bf16*)(ws + WS_NA_Z), (const bf16*)(ws + WS_W_NAOUT0), 4096, 4096, 4096, DFLAG, 1u << 4}; pg8::StaticOrder S; S.init(M, 4096, F.G, (int)blockIdx.x);
        pg8::EpiResid E{args.in[0], rep ? (float*)(ws + WS_SCR) : XO, D, MOD + 0 * 2 * 12288 + 8192, 12288, SEQ};
        pg8::gemm_phase<pg8::EpiResid, pg8::StaticOrder, true, true>(ring, g, S, E); } } SEAM(4);
#endif
#if MK_NLAYERS >= 2
    if (IN(5)) { REP(5) { norm_phase<false>(F, XO, args.in[4] + 1 * D, MOD + 1 * 2 * 12288, H, nullptr); } } SEAM(5);
    if (IN(6)) { REP(6) { pg8::Gemm g{H, (const bf16*)(ws + WS_W_S5IN), 4096, 4096, 4096, DFLAG, 1u << 6}; pg8::StaticOrder S; S.init(M, 8192, F.G, (int)blockIdx.x);
        pg8::EpiS5In<S5_T, S5_NCH, S5_KY> E{(bf16*)(ws + WS_S5_UG), (bf16*)(ws + WS_S5_GS)};
        pg8::gemm_phase<pg8::EpiS5In<S5_T, S5_NCH, S5_KY>, pg8::StaticOrder, true, true>(ring, g, S, E); } } SEAM(6);
    if (IN(7)) { REP(7) { pg8::Gemm g{(const bf16*)(ws + WS_S5_UG), (const bf16*)(ws + WS_S5BS), S5_KS, S5_KY, S5_KS, DFLAG, 1u << 7}; pg8::BatchedOrder S; S.init(S5_G, S5_NCH / 256, 1, F.G, (int)blockIdx.x);
        pg8::EpiF32 E{(float*)(ws + WS_S5_SLOC), 256};
        pg8::gemm_phase<pg8::EpiF32, pg8::BatchedOrder, true, true>(ring, g, S, E); } } SEAM(7);
    if (IN(8)) { REP(8) { s5_scan_phase(F, args); } } SEAM(8);
    if (IN(9)) { REP(9) { pg8::Gemm g{(const bf16*)(ws + WS_S5_UG), (const bf16*)(ws + WS_S5BY), S5_KY, S5_KY, S5_KY, DFLAG, 1u << 9}; pg8::BatchedOrder S; S.init(S5_G, S5_NCH / 256, S5_KS / 256, F.G, (int)blockIdx.x);
        pg8::EpiS5Y<S5_T, S5_NCH / 256> E{(bf16*)(ws + WS_S5_Y)};
        pg8::gemm_phase<pg8::EpiS5Y<S5_T, S5_NCH / 256>, pg8::BatchedOrder, true, true>(ring, g, S, E); } } SEAM(9);
    if (IN(10)) { REP(10) { pg8::Gemm g{(const bf16*)(ws + WS_S5_Y), (const bf16*)(ws + WS_W_S5GLU), 4096, 4096, 4096, DFLAG, 1u << 10}; pg8::StaticOrder S; S.init(M, 4096, F.G, (int)blockIdx.x);
        pg8::EpiGlu E{(const bf16*)(ws + WS_S5_Y), (const bf16*)(ws + WS_S5_GS), args.in[21], (bf16*)(ws + WS_S5_Z)};
        pg8::gemm_phase<pg8::EpiGlu, pg8::StaticOrder, true, true>(ring, g, S, E); } } SEAM(10);
    if (IN(11)) { REP(11) { pg8::Gemm g{(const bf16*)(ws + WS_S5_Z), (const bf16*)(ws + WS_W_S5OUT), 4096, 4096, 4096, DFLAG, 1u << 11}; pg8::StaticOrder S; S.init(M, 4096, F.G, (int)blockIdx.x);
        pg8::EpiResid E{XO, rep ? (float*)(ws + WS_SCR) : XO, D, MOD + 1 * 2 * 12288 + 8192, 12288, SEQ};
        pg8::gemm_phase<pg8::EpiResid, pg8::StaticOrder, true, true>(ring, g, S, E); } } SEAM(11);
#endif
#if MK_NLAYERS >= 3
    if (IN(12)) { REP(12) { norm_phase<false>(F, XO, args.in[4] + 2 * D, MOD + 2 * 2 * 12288, H, nullptr); } } SEAM(12);
    if (IN(13)) { REP(13) { { pg8::Gemm g{H, (const bf16*)(ws + WS_W_GLAIN), 4096, 4096, 4096, DFLAG, 1u << 13}; pg8::StaticOrder S; S.init(M, GLA_NIN, F.G, (int)blockIdx.x);
          pg8::EpiBf16 E{(bf16*)(ws + WS_GLA_IN), GLA_NIN};
          pg8::gemm_phase<pg8::EpiBf16, pg8::StaticOrder, true, true>(ring, g, S, E); }
        { pg8::Gemm g{H, (const bf16*)(ws + WS_W_GLAG1), 1024, 4096, 4096, DFLAG, 1u << 13}; pg8::SplitKOrder S; S.init(M, 4, 1024, F.G, (int)blockIdx.x);
          pg8::EpiGate E{(float*)(ws + WS_GLA_G1P), M};
          pg8::gemm_phase<pg8::EpiGate, pg8::SplitKOrder, true, true>(ring, g, S, E); } } } SEAM(13);
    if (IN(14)) { REP(14) { gla_prep_phase(F, args); } } SEAM(14);
    if (IN(15)) { REP(15) { gla_main_phase(F, args); } } SEAM(15);
    if (IN(16)) { REP(16) { gla_combine_phase(F, args); } } SEAM(16);
    if (IN(17)) { REP(17) { pg8::Gemm g{(const bf16*)(ws + WS_GLA_Z), (const bf16*)(ws + WS_W_GLAOUT), 4096, 4096, 4096, DFLAG, 1u << 17}; pg8::StaticOrder S; S.init(M, 4096, F.G, (int)blockIdx.x);
        pg8::EpiResid E{XO, rep ? (float*)(ws + WS_SCR) : XO, D, MOD + 2 * 2 * 12288 + 8192, 12288, SEQ};
        pg8::gemm_phase<pg8::EpiResid, pg8::StaticOrder, true, true>(ring, g, S, E); } } SEAM(17);
#endif
#if MK_NLAYERS >= 4
    if (IN(18)) { REP(18) { norm_phase<false>(F, XO, args.in[4] + 3 * D, MOD + 3 * 2 * 12288, H, nullptr); } } SEAM(18);
    if (IN(19)) { REP(19) { pg8::Gemm g{H, (const bf16*)(ws + WS_W_NAIN1), 4096, 4096, 4096, DFLAG, 1u << 19}; pg8::StaticOrder S; S.init(M, 16384, F.G, (int)blockIdx.x);
        pg8::EpiNaIn E{(bf16*)(ws + WS_NA_QKVG)};
        pg8::gemm_phase<pg8::EpiNaIn, pg8::StaticOrder, false, true>(ring, g, S, E); } } SEAM(19);
    if (IN(20)) { REP(20) na_attn_phase2(F, (const bf16*)(ws + WS_NA_QKVG), (bf16*)(ws + WS_NA_Z), args.in[6] + 1 * 32 * 465); } SEAM(20);
    if (IN(21)) { REP(21) { pg8::Gemm g{(const bf16*)(ws + WS_NA_Z), (const bf16*)(ws + WS_W_NAOUT1), 4096, 4096, 4096, DFLAG, 1u << 21}; pg8::StaticOrder S; S.init(M, 4096, F.G, (int)blockIdx.x);
        pg8::EpiResid E{XO, rep ? (float*)(ws + WS_SCR) : XO, D, MOD + 3 * 2 * 12288 + 8192, 12288, SEQ};
        pg8::gemm_phase<pg8::EpiResid, pg8::StaticOrder, true, true>(ring, g, S, E); } } SEAM(21);
#endif
    if (IN(22)) { REP(22) norm_phase<true>(F, (MK_NLAYERS >= 1) ? (const float*)XO : args.in[0], args.in[32], nullptr, nullptr, XO); }
#if MK_DIAG
    if (IN(22)) { __syncthreads(); const unsigned f = __hip_atomic_load(DFLAG, __ATOMIC_RELAXED, __HIP_MEMORY_SCOPE_AGENT);
        const unsigned f2 = __hip_atomic_load(DFLAG + 1, __ATOMIC_RELAXED, __HIP_MEMORY_SCOPE_AGENT);
        if (f != 0u || f2 != 0u) { const int k = f2 ? (24 + __builtin_ctz(f2)) : __builtin_ctz(f); float mk = 10.f; for (int i = 0; i < k; ++i) mk *= 10.f;
            const int gw = F.vcu * NWAVES + F.wave, NGW = F.G * NWAVES;
            for (int m = gw; m < M; m += NGW) for (int j = 0; j < 16; ++j) *((GAS f32x4*)(XO + (size_t)m * D) + F.lane + 64 * j) = (f32x4){mk, mk, mk, mk}; }
        else { const int gw = F.vcu * NWAVES + F.wave, NGW = F.G * NWAVES;
            for (int m = gw; m < M; m += NGW) for (int j = 0; j < 16; ++j) { GAS f32x4* p = (GAS f32x4*)(XO + (size_t)m * D) + F.lane + 64 * j; f32x4 v = *p; bool ch = false;
                for (int e = 0; e < 4; ++e) if (!(__builtin_fabsf(v[e]) < 3.0e38f)) { v[e] = 3.0e30f; ch = true; } if (ch) *p = v; } } }
#endif
#if MK_PROF
    if (F.tid == 0) PROF[32 + 22] = __builtin_amdgcn_s_memrealtime();
    xcd_barrier(bar);
    if (F.tid == 0) PROF[1 + 22] = __builtin_amdgcn_s_memrealtime();
    __syncthreads();
    if (blockIdx.x == 0) {
        float d[23], w[23];
        for (int k = 0; k < 23; ++k) { d[k] = (float)(PROF[1 + k] - PROF[k]) * 0.01f; w[k] = (float)(PROF[1 + k] - PROF[32 + k]) * 0.01f; }
        (void)w;
        const float A = (float)(MK_PROF_A) * 1.0e4f, B = (float)(MK_PROF_B) * 1.0e3f;
        for (size_t i = F.tid; i < (size_t)M * D; i += NWAVES * 64) XO[i] = (i == 0) ? A : B;
    }
#endif
#undef IN
#undef REP
#undef SEAM
}

extern "C" void kernel_launch(void* const* d_in, const int* in_sizes, int n_in, void* d_out, int out_size, void* d_ws, size_t ws_size, hipStream_t stream) {
    static int grid = 0;
    if (grid == 0) {
        if (n_in != 33 || in_sizes[0] != M * D || out_size != M * D || ws_size < WS_END) {
            fprintf(stderr, "kernel_launch: built for 33 inputs, x/out of %d floats, >= %zu bytes of workspace; got n_in %d, in0 %d, out %d, ws %zu; nothing launched\n", M * D, (size_t)WS_END, n_in, n_in > 0 ? in_sizes[0] : -1, out_size, ws_size);
            grid = -1; return; }
        int dev = 0, cus = 0, per_cu = 0;
        if (hipGetDevice(&dev) != hipSuccess || hipDeviceGetAttribute(&cus, hipDeviceAttributeMultiprocessorCount, dev) != hipSuccess) { fprintf(stderr, "kernel_launch: device query failed\n"); grid = -1; return; }
        if (hipFuncSetAttribute((const void*)fwd_kernel, hipFuncAttributeMaxDynamicSharedMemorySize, LDS_BYTES) != hipSuccess) { fprintf(stderr, "kernel_launch: hipFuncSetAttribute failed\n"); grid = -1; return; }
        if (hipOccupancyMaxActiveBlocksPerMultiprocessor(&per_cu, (const void*)fwd_kernel, NWAVES * 64, LDS_BYTES) != hipSuccess || per_cu < 1)
            fprintf(stderr, "kernel_launch: note: occupancy query reports %d workgroups per CU\n", per_cu);
        (void)hipGetLastError();
        grid = cus;
        if (grid != 256) fprintf(stderr, "kernel_launch: note: %d CUs (tuned for 256)\n", grid);
        if (grid < 136) { fprintf(stderr, "kernel_launch: needs >= 136 CUs\n"); grid = -1; return; }
    }
    if (grid < 0) return;
    if (hipMemsetAsync((char*)d_ws + WS_CTL, 0, CTL_ZERO_BYTES, stream) != hipSuccess) { fprintf(stderr, "kernel_launch: memset failed\n"); return; }
    Args a{};
    for (int i = 0; i < 33; ++i) a.in[i] = (const float*)d_in[i];
    a.out = (float*)d_out; a.ws = (unsigned char*)d_ws;
#if MK_ONE_LAUNCH
    a.ph_lo = 0; a.ph_hi = NPH;
    hipLaunchKernelGGL(fwd_kernel, dim3(grid), dim3(NWAVES * 64), LDS_BYTES, stream, a);
#else
    for (int ph = 0; ph < NPH; ++ph) { a.ph_lo = ph; a.ph_hi = ph + 1; a.dup = 0;
        hipLaunchKernelGGL(fwd_kernel, dim3(grid), dim3(NWAVES * 64), LDS_BYTES, stream, a);
        if ((MK_DUP >> ph) & 1u) { a.dup = 1; hipLaunchKernelGGL(fwd_kernel, dim3(grid), dim3(NWAVES * 64), LDS_BYTES, stream, a); } }
#endif
    const hipError_t le = hipPeekAtLastError();
    if (le != hipSuccess) fprintf(stderr, "kernel_launch: launch failed: %s\n", hipGetErrorName(le));
}
```

```cpp
#include <hip/hip_runtime.h>
#include <cstdio>
#include <cstdint>

#ifndef MK_ONE_LAUNCH
#define MK_ONE_LAUNCH 1
#endif
#ifndef MK_DIAG
#define MK_DIAG 0
#endif
#ifndef MK_PROF
#define MK_PROF 0
#endif
#define MK_PROF_A (d[2]+d[19]+d[4]+d[21]+d[6]+d[10]+d[11]+d[13]+d[17])
#define MK_PROF_B (d[0])
#ifndef MK_DUP
#define MK_DUP 0u
#endif
#ifndef MK_NLAYERS
#define MK_NLAYERS 4
#endif

namespace pg8 {
#define PG8_LAS __attribute__((address_space(3)))
typedef unsigned short bf16_t;
typedef short bf16x8 __attribute__((ext_vector_type(8)));
typedef float f32x4 __attribute__((ext_vector_type(4)));
typedef unsigned u32x4 __attribute__((ext_vector_type(4)));
typedef unsigned u32x2 __attribute__((ext_vector_type(2)));
constexpr int BM = 256, BK = 64, HALF = 128, HTB = HALF * BK * 2  , STAGE_BYTES = 8 * HTB, NXCD = 8, WGM = 8;

__host__ __device__ __forceinline__ int lds_byte(int r, int c) { const int st = (r >> 4) * 2 + (c >> 5), rr = r & 15, cc = c & 31, ob = rr * 64 + cc * 2; return st * 1024 + (ob ^ (((ob >> 9) & 1) << 5)); }
__host__ __device__ __forceinline__ void stage_rc(int b, int& R, int& C) { const int st = b / 1024, sb = b % 1024, swz = sb ^ (((sb >> 9) & 1) << 5); R = (st >> 1) * 16 + swz / 64; C = (st & 1) * 32 + (swz % 64) / 2; }
__host__ __device__ __forceinline__ int perm32(int rho) { const int n = rho >> 4, i = rho & 15; return 8 * (i >> 2) + 4 * n + (i & 3); }

struct Unit { int pm, pn, pb, koff; };
struct Gemm { const bf16_t* A; const bf16_t* Bt; int K, lda, ldb; unsigned* dflag; unsigned dbit; };

struct StaticOrder {
    int nM, nN, nwg, G, c;
    __host__ __device__ void init(int M, int N, int G_, int c_) { nM = M / BM; nN = N / BM; nwg = nM * nN; G = G_; c = c_; }
    __host__ __device__ bool next(int i, Unit& u) const {
        const long L = (long)i * G + c; if (L >= nwg) return false;
        int wgid = (int)L; { const int q = nwg / NXCD, r = nwg % NXCD, xcd = wgid % NXCD, off = wgid / NXCD; wgid = (xcd < r ? xcd * (q + 1) : r * (q + 1) + (xcd - r) * q) + off; }
        const int nig = WGM * nN, gid = wgid / nig, fm = gid * WGM, gsz = (nM - fm) < WGM ? (nM - fm) : WGM;
        u.pm = fm + ((wgid % nig) % gsz); u.pn = (wgid % nig) / gsz; u.pb = u.pn; u.koff = 0; return true;
    }
    __device__ __forceinline__ void a_ready(const Unit&) const {}
    __device__ __forceinline__ void done(const Unit&) const {}
};
struct BatchedOrder {
    int nPm, nPn, total, G, c;
    __host__ __device__ void init(int ngroups, int nPm_, int nPn_, int G_, int c_) { nPm = nPm_; nPn = nPn_; total = ngroups * nPm * nPn; G = G_; c = c_; }
    __host__ __device__ bool next(int i, Unit& u) const {
        long L = (long)i * G + c; if (L >= total) return false;
        const int upg = nPm * nPn;
        if (G % 8 == 0 && (G / 8) % upg == 0 && total % G == 0) {
            const int x = c % 8, q = c / 8, gpx = (G / 8) / upg;
            L = ((long)(i * 8 + x) * gpx + q / upg) * upg + q % upg; }
        const int g = (int)L / upg, rem = (int)L % upg, pmi = rem / nPn, pni = rem % nPn;
        u.pm = g * nPm + pmi; u.pn = pni; u.pb = g * nPn + pni; u.koff = 0; return true;
    }
    __device__ __forceinline__ void a_ready(const Unit&) const {}
    __device__ __forceinline__ void done(const Unit&) const {}
};
struct SplitKOrder {
    int nM, nsplit, kslice, G, c;
    __host__ __device__ void init(int M, int nsplit_, int kslice_, int G_, int c_) { nM = M / BM; nsplit = nsplit_; kslice = kslice_; G = G_; c = c_; }
    __host__ __device__ bool next(int i, Unit& u) const {
        const long L = (long)i * G + c; if (L >= (long)nM * nsplit) return false;
        u.pm = (int)L / nsplit; u.pn = (int)L % nsplit; u.pb = 0; u.koff = u.pn * kslice; return true;
    }
    __device__ __forceinline__ void a_ready(const Unit&) const {}
    __device__ __forceinline__ void done(const Unit&) const {}
};

typedef float f32x2_t __attribute__((ext_vector_type(2))); typedef __bf16 bf16x2_t __attribute__((ext_vector_type(2)));
__device__ __forceinline__ unsigned cvt_pk_bf16(float lo, float hi) { f32x2_t v = {lo, hi}; bf16x2_t b = __builtin_convertvector(v, bf16x2_t); return __builtin_bit_cast(unsigned, b); }
__device__ __forceinline__ float bf_lo(unsigned w) { return __uint_as_float(w << 16); }
__device__ __forceinline__ float bf_hi(unsigned w) { return __uint_as_float(w & 0xffff0000u); }
__device__ __forceinline__ float sigmoidf_(float x) { return __builtin_amdgcn_rcpf(1.0f + __expf(-x)); }
__device__ __forceinline__ float siluf_(float x) { return x * __builtin_amdgcn_rcpf(1.0f + __expf(-x)); }
__device__ __forceinline__ float gelu_tanh(float x) { const float z = 0.7978845608028654f * (x + 0.044715f * x * x * x); return x * __builtin_amdgcn_rcpf(1.0f + __expf(-2.0f * z)); }

struct EpiBf16 {
    static constexpr bool PERM = true, AFTER_DRAIN = false;
    bf16_t* O; int ldc;
    __device__ __forceinline__ void operator()(const f32x4 (&acc)[2][2][4][2], const Unit& u, int wr, int wc, int fr, int fq) const {
        const int row0 = u.pm * BM + wr * 64 + fr, col0 = u.pn * BM + wc * 32 + 8 * fq;
#pragma unroll
        for (int ai = 0; ai < 2; ++ai)
#pragma unroll
            for (int m = 0; m < 4; ++m) { bf16_t* rowp = O + (size_t)(row0 + ai * HALF + m * 16) * ldc + col0;
#pragma unroll
                for (int bj = 0; bj < 2; ++bj) { const f32x4 v0 = acc[ai][bj][m][0], v1 = acc[ai][bj][m][1];
                    u32x4 w; w.x = cvt_pk_bf16(v0[0], v0[1]); w.y = cvt_pk_bf16(v0[2], v0[3]); w.z = cvt_pk_bf16(v1[0], v1[1]); w.w = cvt_pk_bf16(v1[2], v1[3]);
                    *(u32x4*)(rowp + bj * HALF) = w; } }
    }
};
struct EpiNaIn {
    static constexpr bool PERM = true, AFTER_DRAIN = false;
    bf16_t* O;
    __device__ __forceinline__ void operator()(const f32x4 (&acc)[2][2][4][2], const Unit& u, int wr, int wc, int fr, int fq) const {
        const int row0 = u.pm * BM + wr * 64 + fr, col0 = u.pn * BM + wc * 32 + 8 * fq;
#pragma unroll
        for (int ai = 0; ai < 2; ++ai)
#pragma unroll
            for (int m = 0; m < 4; ++m) { const int row = row0 + ai * HALF + m * 16, b = row >> 13, l = row & 8191;
#pragma unroll
                for (int bj = 0; bj < 2; ++bj) { const f32x4 v0 = acc[ai][bj][m][0], v1 = acc[ai][bj][m][1]; const int n = col0 + bj * HALF, sec = n >> 12, hd = (n >> 7) & 31, d = n & 127;
                    u32x4 w; w.x = cvt_pk_bf16(v0[0], v0[1]); w.y = cvt_pk_bf16(v0[2], v0[3]); w.z = cvt_pk_bf16(v1[0], v1[1]); w.w = cvt_pk_bf16(v1[2], v1[3]);
                    *(u32x4*)(O + ((size_t)((sec * 2 + b) * 32 + hd) * 8192 + l) * 128 + d) = w; } }
    }
};
struct EpiResid {
    static constexpr bool PERM = false, AFTER_DRAIN = false;
    const float* base; float* out; int ldc; const float* gate0; int gate_stride; int rows_per_batch;
    __device__ __forceinline__ void operator()(const f32x4 (&acc)[2][2][4][2], const Unit& u, int wr, int wc, int fr, int fq) const {
        const int row0 = u.pm * BM + wr * 64 + fr, col0 = u.pn * BM + wc * 32 + 4 * fq;
        const float* gp = gate0 + (size_t)((u.pm * BM) / rows_per_batch) * gate_stride + col0;
        f32x4 gv[2][2];
#pragma unroll
        for (int bj = 0; bj < 2; ++bj)
#pragma unroll
            for (int n = 0; n < 2; ++n) gv[bj][n] = *(const f32x4*)(gp + bj * HALF + n * 16);
#pragma unroll
        for (int ai = 0; ai < 2; ++ai)
#pragma unroll
            for (int m = 0; m < 4; ++m) { const size_t off = (size_t)(row0 + ai * HALF + m * 16) * ldc + col0;
#pragma unroll
                for (int bj = 0; bj < 2; ++bj)
#pragma unroll
                    for (int n = 0; n < 2; ++n) { const f32x4 bs = *(const f32x4*)(base + off + bj * HALF + n * 16);
                        *(f32x4*)(out + off + bj * HALF + n * 16) = bs + gv[bj][n] * acc[ai][bj][m][n]; }
                if (m & 1) asm volatile("" ::: "memory"); }
    }
};
struct EpiF32 {
    static constexpr bool PERM = false, AFTER_DRAIN = false;
    float* C; int ldc;
    __device__ __forceinline__ void operator()(const f32x4 (&acc)[2][2][4][2], const Unit& u, int wr, int wc, int fr, int fq) const {
        const int row0 = u.pm * BM + wr * 64 + fr, col0 = u.pn * BM + wc * 32 + 4 * fq;
#pragma unroll
        for (int ai = 0; ai < 2; ++ai)
#pragma unroll
            for (int m = 0; m < 4; ++m) { float* rowp = C + (size_t)(row0 + ai * HALF + m * 16) * ldc + col0;
#pragma unroll
                for (int bj = 0; bj < 2; ++bj)
#pragma unroll
                    for (int n = 0; n < 2; ++n) *(f32x4*)(rowp + bj * HALF + n * 16) = acc[ai][bj][m][n]; }
    }
};
struct EpiGate {
    static constexpr bool PERM = false, AFTER_DRAIN = false;
    float* P; int rows;
    __device__ __forceinline__ void operator()(const f32x4 (&acc)[2][2][4][2], const Unit& u, int wr, int wc, int fr, int fq) const {
        if (wc != 0) return;
        const int row0 = u.pm * BM + wr * 64 + fr;
#pragma unroll
        for (int ai = 0; ai < 2; ++ai)
#pragma unroll
            for (int m = 0; m < 4; ++m) { float* rowp = P + ((size_t)u.pn * rows + (row0 + ai * HALF + m * 16)) * 32 + 4 * fq;
#pragma unroll
                for (int n = 0; n < 2; ++n) *(f32x4*)(rowp + n * 16) = acc[ai][0][m][n]; }
    }
};
template <int T, int NCH, int KY> struct EpiS5In {
    static constexpr bool PERM = true, AFTER_DRAIN = false;
    bf16_t* Ug; bf16_t* Gs;
    __device__ __forceinline__ void operator()(const f32x4 (&acc)[2][2][4][2], const Unit& u, int wr, int wc, int fr, int fq) const {
        const int row0 = u.pm * BM + wr * 64 + fr, col0 = u.pn * BM + wc * 32 + 8 * fq;
#pragma unroll
        for (int ai = 0; ai < 2; ++ai)
#pragma unroll
            for (int m = 0; m < 4; ++m) { const int row = row0 + ai * HALF + m * 16;
#pragma unroll
                for (int bj = 0; bj < 2; ++bj) { const f32x4 v0 = acc[ai][bj][m][0], v1 = acc[ai][bj][m][1]; const int col = col0 + bj * HALF;
                    u32x4 w; w.x = cvt_pk_bf16(v0[0], v0[1]); w.y = cvt_pk_bf16(v0[2], v0[3]); w.z = cvt_pk_bf16(v1[0], v1[1]); w.w = cvt_pk_bf16(v1[2], v1[3]);
                    if (col < 4096) { const int g = col >> 4, i0 = col & 15, chunk = row / T, t = row % T;
                        *(u32x4*)(Ug + ((size_t)g * NCH + chunk) * KY + t * 16 + i0) = w; }
                    else *(u32x4*)(Gs + (size_t)row * 4096 + (col - 4096)) = w; } }
    }
};
template <int T, int NPM> struct EpiS5Y {
    static constexpr bool PERM = true, AFTER_DRAIN = false;
    bf16_t* Y;
    __device__ __forceinline__ void operator()(const f32x4 (&acc)[2][2][4][2], const Unit& u, int wr, int wc, int fr, int fq) const {
        const int g = u.pm / NPM, chunk0 = (u.pm % NPM) * BM + wr * 64 + fr, col0 = u.pn * BM + wc * 32 + 8 * fq;
#pragma unroll
        for (int ai = 0; ai < 2; ++ai)
#pragma unroll
            for (int m = 0; m < 4; ++m) { const int chunk = chunk0 + ai * HALF + m * 16;
#pragma unroll
                for (int bj = 0; bj < 2; ++bj) { f32x4 v0 = acc[ai][bj][m][0], v1 = acc[ai][bj][m][1]; const int n = col0 + bj * HALF, t = n >> 4, i0 = n & 15;
#pragma unroll
                    for (int j = 0; j < 4; ++j) { v0[j] = gelu_tanh(v0[j]); v1[j] = gelu_tanh(v1[j]); }
                    u32x4 w; w.x = cvt_pk_bf16(v0[0], v0[1]); w.y = cvt_pk_bf16(v0[2], v0[3]); w.z = cvt_pk_bf16(v1[0], v1[1]); w.w = cvt_pk_bf16(v1[2], v1[3]);
                    *(u32x4*)(Y + (size_t)(chunk * T + t) * 4096 + g * 16 + i0) = w; } }
    }
};
struct EpiGlu {
    static constexpr bool PERM = true, AFTER_DRAIN = false;
    const bf16_t* Y; const bf16_t* Gs; const float* bias; bf16_t* Z;
    __device__ __forceinline__ void operator()(const f32x4 (&acc)[2][2][4][2], const Unit& u, int wr, int wc, int fr, int fq) const {
        const int row0 = u.pm * BM + wr * 64 + fr, col0 = u.pn * BM + wc * 32 + 8 * fq;
        f32x4 bv[2][2];
#pragma unroll
        for (int bj = 0; bj < 2; ++bj)
#pragma unroll
            for (int n = 0; n < 2; ++n) bv[bj][n] = *(const f32x4*)(bias + col0 + bj * HALF + 4 * n);
#pragma unroll
        for (int ai = 0; ai < 2; ++ai)
#pragma unroll
            for (int m = 0; m < 4; ++m) { const size_t off = (size_t)(row0 + ai * HALF + m * 16) * 4096 + col0;
#pragma unroll
                for (int bj = 0; bj < 2; ++bj) { const u32x4 yw = *(const u32x4*)(Y + off + bj * HALF), gw = *(const u32x4*)(Gs + off + bj * HALF);
                    const f32x4 a0 = acc[ai][bj][m][0] + bv[bj][0], a1 = acc[ai][bj][m][1] + bv[bj][1];
                    float o[8];
#pragma unroll
                    for (int j = 0; j < 4; ++j) { const unsigned yj = yw[j], gj = gw[j];
                        const float aa = (j < 2) ? a0[2 * j] : a1[2 * j - 4], ab = (j < 2) ? a0[2 * j + 1] : a1[2 * j - 3];
                        o[2 * j] = bf_lo(yj) * sigmoidf_(aa) * siluf_(bf_lo(gj)); o[2 * j + 1] = bf_hi(yj) * sigmoidf_(ab) * siluf_(bf_hi(gj)); }
                    u32x4 w; w.x = cvt_pk_bf16(o[0], o[1]); w.y = cvt_pk_bf16(o[2], o[3]); w.z = cvt_pk_bf16(o[4], o[5]); w.w = cvt_pk_bf16(o[6], o[7]);
                    *(u32x4*)(Z + off + bj * HALF) = w; }
                asm volatile("" ::: "memory"); }
    }
};

template <class Epi, class Sched, bool ALIGN_EPI = false, bool SP2 = false>
__device__ __forceinline__ void gemm_phase(PG8_LAS unsigned char* lds, const Gemm g, const Sched& S, const Epi& E) {
    const int tid = threadIdx.x, wid = __builtin_amdgcn_readfirstlane(tid >> 6), lane = tid & 63, wr = wid >> 2, wc = wid & 3, fr = lane & 15, fq = lane >> 4;
    const int K = g.K, nt = K / BK, lda = g.lda, ldb = g.ldb;
    unsigned voffA[2], voffB[2];
#pragma unroll
    for (int i = 0; i < 2; ++i) { int R, C; stage_rc(tid * 16 + i * 8192, R, C); const int Rb = Epi::PERM ? ((R & ~31) + perm32(R & 31)) : R;
        voffA[i] = (unsigned)(R * lda + C) * 2u; voffB[i] = (unsigned)(Rb * ldb + C) * 2u; }
    const size_t kstep = (size_t)(BK * 2);
    const size_t hstepA = (size_t)HALF * lda * 2, hstepB = (size_t)HALF * ldb * 2;
    const size_t tstepA = 2 * hstepA, tstepB = 2 * hstepB;
    const unsigned ldsw = (unsigned)wid * 1024u;
    const int aoff = lds_byte(wr * 64 + fr, fq * 8), boff = lds_byte(wc * 32 + fr, fq * 8);
#define PG8_SA(b, h) (((b) * 2 + (h)) * HTB)
#define PG8_SB(b, h) ((4 + (b) * 2 + (h)) * HTB)
#define PG8_STAGE(bufoff, gbase, voff) do { _Pragma("unroll") for (int _i = 0; _i < 2; ++_i) \
        __builtin_amdgcn_global_load_lds((const unsigned*)((const char*)(gbase) + (voff)[_i]), (PG8_LAS unsigned*)(lds + (bufoff) + ldsw + _i * 8192), 16, 0, 0); } while (0)
#define PG8_LDA(dst, b, h) do { _Pragma("unroll") for (int m = 0; m < 4; ++m) _Pragma("unroll") for (int k = 0; k < 2; ++k) dst[m][k] = *(const PG8_LAS bf16x8*)(lds + PG8_SA(b, h) + aoff + m * 2048 + k * 1024); } while (0)
#define PG8_LDB(dst, b, h) do { _Pragma("unroll") for (int n = 0; n < 2; ++n) _Pragma("unroll") for (int k = 0; k < 2; ++k) dst[n][k] = *(const PG8_LAS bf16x8*)(lds + PG8_SB(b, h) + boff + n * 2048 + k * 1024); } while (0)
#define PG8_MMA(ai, bj, At, Bt) do { __builtin_amdgcn_s_setprio(1); _Pragma("unroll") for (int m = 0; m < 4; ++m) _Pragma("unroll") for (int n = 0; n < 2; ++n) _Pragma("unroll") for (int k = 0; k < 2; ++k) \
        acc[ai][bj][m][n] = __builtin_amdgcn_mfma_f32_16x16x32_bf16(Bt[n][k], At[m][k], acc[ai][bj][m][n], 0, 0, 0); __builtin_amdgcn_s_setprio(0); } while (0)
#define PG8_WAIT_V(n) asm volatile("s_waitcnt vmcnt(" #n ")" ::: "memory")
#define PG8_WAIT_L(n) asm volatile("s_waitcnt lgkmcnt(" #n ")" ::: "memory")
#define PG8_BAR __builtin_amdgcn_s_barrier()
#define PG8_SCHED __builtin_amdgcn_sched_barrier(0)
    Unit cur, nxt; int ui = 0;
    if (!S.next(0, cur)) return;
    f32x4 acc[2][2][4][2];
#pragma unroll
    for (int a = 0; a < 2; ++a)
#pragma unroll
        for (int b = 0; b < 2; ++b)
#pragma unroll
            for (int m = 0; m < 4; ++m)
#pragma unroll
                for (int n = 0; n < 2; ++n) acc[a][b][m][n] = (f32x4){0.f, 0.f, 0.f, 0.f};
    bf16x8 At[4][2], B0[2][2], B1[2][2];
    const char* cA = (const char*)g.A + (size_t)cur.pm * tstepA + (size_t)cur.koff * 2; const char* cB = (const char*)g.Bt + (size_t)cur.pb * tstepB + (size_t)cur.koff * 2;
    S.a_ready(cur);
    if constexpr (SP2) {
        PG8_STAGE(PG8_SB(0, 0), cB, voffB); PG8_STAGE(PG8_SB(0, 1), cB + hstepB, voffB); PG8_STAGE(PG8_SA(0, 0), cA, voffA); PG8_STAGE(PG8_SA(0, 1), cA + hstepA, voffA);
        if (wr == 1) PG8_BAR;
        PG8_WAIT_V(2); PG8_BAR;
        PG8_STAGE(PG8_SB(1, 0), cB + kstep, voffB); PG8_STAGE(PG8_SA(1, 0), cA + kstep, voffA); PG8_STAGE(PG8_SB(1, 1), cB + hstepB + kstep, voffB);
        PG8_WAIT_V(6); PG8_BAR;
    } else {
        PG8_STAGE(PG8_SB(0, 0), cB, voffB); PG8_STAGE(PG8_SA(0, 0), cA, voffA); PG8_STAGE(PG8_SB(0, 1), cB + hstepB, voffB); PG8_STAGE(PG8_SA(0, 1), cA + hstepA, voffA);
        if (wr == 1) PG8_BAR;
        PG8_WAIT_V(4); PG8_BAR;
        PG8_STAGE(PG8_SB(1, 0), cB + kstep, voffB); PG8_STAGE(PG8_SA(1, 0), cA + kstep, voffA); PG8_STAGE(PG8_SB(1, 1), cB + hstepB + kstep, voffB);
        PG8_WAIT_V(6); PG8_BAR;
    }
    for (;;) {
        const bool has_next = S.next(ui + 1, nxt);
        const char* nA = has_next ? (const char*)g.A + (size_t)nxt.pm * tstepA + (size_t)nxt.koff * 2 : cA; const char* nB = has_next ? (const char*)g.Bt + (size_t)nxt.pb * tstepB + (size_t)nxt.koff * 2 : cB;
        for (int t = 0; t < nt; t += 2) {
            const bool last = (t == nt - 2);
            const char* a1 = cA + (size_t)(t + 1) * kstep;
            const char* a2 = last ? nA : cA + (size_t)(t + 2) * kstep; const char* b2 = last ? nB : cB + (size_t)(t + 2) * kstep;
            const char* a3 = a2 + kstep; const char* b3 = b2 + kstep;
            if (last && has_next) S.a_ready(nxt);
            if constexpr (SP2) {
            PG8_LDB(B0, 0, 0); PG8_LDB(B1, 0, 1); PG8_SCHED; PG8_LDA(At, 0, 0); PG8_STAGE(PG8_SA(1, 1), a1 + hstepA, voffA);
            PG8_WAIT_V(8); PG8_WAIT_L(0); PG8_BAR; PG8_MMA(0, 0, At, B0); PG8_MMA(0, 1, At, B1); PG8_BAR; PG8_SCHED;
            PG8_LDA(At, 0, 1); PG8_STAGE(PG8_SB(0, 0), b2, voffB); PG8_STAGE(PG8_SB(0, 1), b2 + hstepB, voffB); PG8_STAGE(PG8_SA(0, 0), a2, voffA);
            PG8_WAIT_V(8); PG8_WAIT_L(0); PG8_BAR; PG8_MMA(1, 0, At, B0); PG8_MMA(1, 1, At, B1); PG8_BAR; PG8_SCHED;
            PG8_LDB(B0, 1, 0); PG8_LDB(B1, 1, 1); PG8_SCHED; PG8_LDA(At, 1, 0); PG8_STAGE(PG8_SA(0, 1), a2 + hstepA, voffA);
            PG8_WAIT_V(8); PG8_WAIT_L(0); PG8_BAR; PG8_MMA(0, 0, At, B0); PG8_MMA(0, 1, At, B1); PG8_BAR; PG8_SCHED;
            PG8_LDA(At, 1, 1); PG8_STAGE(PG8_SB(1, 0), b3, voffB); PG8_STAGE(PG8_SB(1, 1), b3 + hstepB, voffB); PG8_STAGE(PG8_SA(1, 0), a3, voffA);
            PG8_WAIT_V(8); PG8_WAIT_L(0); PG8_BAR; PG8_MMA(1, 0, At, B0); PG8_MMA(1, 1, At, B1); PG8_BAR; PG8_SCHED;
            } else {
            PG8_LDB(B0, 0, 0); PG8_SCHED; PG8_LDA(At, 0, 0); PG8_STAGE(PG8_SA(1, 1), a1 + hstepA, voffA);
            PG8_WAIT_L(8); PG8_BAR; PG8_WAIT_L(0); PG8_MMA(0, 0, At, B0); PG8_BAR; PG8_SCHED;
            PG8_LDB(B1, 0, 1); PG8_STAGE(PG8_SB(0, 0), b2, voffB);
            PG8_BAR; PG8_WAIT_L(0); PG8_MMA(0, 1, At, B1); PG8_BAR;
            PG8_LDA(At, 0, 1); PG8_STAGE(PG8_SA(0, 0), a2, voffA);
            PG8_BAR; PG8_WAIT_L(0); PG8_MMA(1, 0, At, B0); PG8_BAR; PG8_SCHED;
            PG8_STAGE(PG8_SB(0, 1), b2 + hstepB, voffB);
            PG8_WAIT_V(6); PG8_BAR; PG8_MMA(1, 1, At, B1); PG8_BAR;
            PG8_LDB(B0, 1, 0); PG8_SCHED; PG8_LDA(At, 1, 0); PG8_STAGE(PG8_SA(0, 1), a2 + hstepA, voffA);
            PG8_WAIT_L(8); PG8_BAR; PG8_WAIT_L(0); PG8_MMA(0, 0, At, B0); PG8_BAR; PG8_SCHED;
            PG8_LDB(B1, 1, 1); PG8_STAGE(PG8_SB(1, 0), b3, voffB);
            PG8_BAR; PG8_WAIT_L(0); PG8_MMA(0, 1, At, B1); PG8_BAR;
            PG8_LDA(At, 1, 1); PG8_STAGE(PG8_SA(1, 0), a3, voffA);
            PG8_BAR; PG8_WAIT_L(0); PG8_MMA(1, 0, At, B0); PG8_BAR; PG8_SCHED;
            PG8_STAGE(PG8_SB(1, 1), b3 + hstepB, voffB);
            PG8_WAIT_V(6); PG8_BAR; PG8_MMA(1, 1, At, B1); PG8_BAR;
            }
        }
        if constexpr (ALIGN_EPI) { if (wr == 0) PG8_BAR; }
#if MK_DIAG
        { bool bad = false;
#pragma unroll
          for (int a_ = 0; a_ < 2; ++a_)
#pragma unroll
            for (int b_ = 0; b_ < 2; ++b_)
#pragma unroll
              for (int m_ = 0; m_ < 4; ++m_)
#pragma unroll
                for (int n_ = 0; n_ < 2; ++n_)
#pragma unroll
                  for (int j_ = 0; j_ < 4; ++j_) bad |= !(__builtin_fabsf(acc[a_][b_][m_][n_][j_]) < 3.0e38f);
          if (bad && g.dflag) atomicOr(g.dflag, g.dbit); }
#endif
        if constexpr (!Epi::AFTER_DRAIN) { E(acc, cur, wr, wc, fr, fq); S.done(cur); }
        if (!has_next) break;
#pragma unroll
        for (int a = 0; a < 2; ++a)
#pragma unroll
            for (int b = 0; b < 2; ++b)
#pragma unroll
                for (int m = 0; m < 4; ++m)
#pragma unroll
                    for (int n = 0; n < 2; ++n) acc[a][b][m][n] = (f32x4){0.f, 0.f, 0.f, 0.f};
        cur = nxt; cA = nA; cB = nB; ++ui;
        if constexpr (ALIGN_EPI) { if (wr == 1) PG8_BAR; }
    }
    PG8_WAIT_V(0);
    if constexpr (!ALIGN_EPI) { if (wr == 0) PG8_BAR; }
    PG8_BAR;
    if constexpr (Epi::AFTER_DRAIN) { E.fused(acc, cur, wr, wc, fr, fq, lds, wid, lane); S.done(cur); }
#undef PG8_SA
#undef PG8_SB
#undef PG8_STAGE
#undef PG8_LDA
#undef PG8_LDB
#undef PG8_MMA
#undef PG8_WAIT_V
#undef PG8_WAIT_L
#undef PG8_BAR
#undef PG8_SCHED
}

}

constexpr int NWAVES = 8;
constexpr int BATCH = 2, SEQ = 8192, D = 4096, M = BATCH * SEQ;
constexpr int GRIDW = 64, GROWS = SEQ / GRIDW;
constexpr int NA_HEADS = 32, NA_HD = 128;
constexpr int S5_G = 256, S5_P = 64, S5_I = 16, S5_T = 32, S5_NCH = M / S5_T  , S5_NCHB = SEQ / S5_T  , S5_KS = S5_T * 16  , S5_KY = S5_KS + 256  ;
constexpr int GLA_H = 8, GLA_DK = 256, GLA_DV = 512, GLA_KW = 2048, GLA_C = 64, GLA_NCH = M / GLA_C  , GLA_NCHB = SEQ / GLA_C  , GLA_NIN = 12288;
constexpr float EPS = 1e-6f;

constexpr size_t MiB = 1u << 20;
constexpr size_t WS_CTL = 0, CTL_ZERO_BYTES = 64 * 1024;
constexpr size_t WS_MOD = 1 * MiB;
constexpr size_t WS_LAMT = 2 * MiB;
constexpr size_t WS_W_NAIN0 = 4 * MiB, WS_W_NAIN1 = WS_W_NAIN0 + 128 * MiB, WS_W_NAOUT0 = WS_W_NAIN1 + 128 * MiB, WS_W_NAOUT1 = WS_W_NAOUT0 + 32 * MiB;
constexpr size_t WS_W_S5IN = WS_W_NAOUT1 + 32 * MiB, WS_W_S5GLU = WS_W_S5IN + 64 * MiB, WS_W_S5OUT = WS_W_S5GLU + 32 * MiB;
constexpr size_t WS_W_GLAIN = WS_W_S5OUT + 32 * MiB, WS_W_GLAG1 = WS_W_GLAIN + 96 * MiB, WS_W_GLAOUT = WS_W_GLAG1 + 2 * MiB;
constexpr size_t WS_S5BS = WS_W_GLAOUT + 32 * MiB;
constexpr size_t WS_S5BY = WS_S5BS + 64 * MiB;
constexpr size_t WS_H = WS_S5BY + 192 * MiB;
constexpr size_t WS_ACT = WS_H + 128 * MiB;
constexpr size_t WS_NA_QKVG = WS_ACT;
constexpr size_t WS_NA_Z = WS_ACT + 512 * MiB;
constexpr size_t WS_S5_UG = WS_ACT;
constexpr size_t WS_S5_GS = WS_S5_UG + 192 * MiB;
constexpr size_t WS_S5_SLOC = WS_S5_GS + 128 * MiB;
constexpr size_t WS_S5_Y = WS_S5_SLOC + 128 * MiB;
constexpr size_t WS_S5_Z = WS_S5_Y + 128 * MiB;
constexpr size_t WS_GLA_IN = WS_ACT;
constexpr size_t WS_GLA_G1P = WS_GLA_IN + 384 * MiB;
constexpr size_t WS_GLA_PREP = WS_GLA_G1P + 8 * MiB;
constexpr size_t WS_GLA_DECAY = WS_GLA_PREP + 384 * MiB;
constexpr size_t WS_GLA_O = WS_GLA_DECAY + 4 * MiB;
constexpr size_t WS_GLA_Z = WS_GLA_O + 384 * MiB;
constexpr size_t WS_SCR = WS_GLA_Z + 128 * MiB;
constexpr size_t WS_END = WS_SCR + 256 * MiB;
static_assert(WS_S5_Z + 128 * MiB <= WS_SCR && WS_NA_Z + 128 * MiB <= WS_SCR, "ws map");
constexpr int CW_BAR = 1024;
static_assert((CW_BAR + 3456) * 4 <= (int)CTL_ZERO_BYTES, "CTL words inside the memset region");

constexpr int RING_OFF = 0, RING_BYTES = 131072;
constexpr int LDS_BYTES = 147456;
constexpr int MISC_OFF = LDS_BYTES - 256;

#define GAS __attribute__((address_space(1)))
#define LAS __attribute__((address_space(3)))
typedef unsigned short bf16;
typedef unsigned v4u __attribute__((ext_vector_type(4)));
typedef unsigned v2u __attribute__((ext_vector_type(2)));
typedef float f32x4 __attribute__((ext_vector_type(4)));
typedef float f32x2 __attribute__((ext_vector_type(2)));
typedef short bf16x8 __attribute__((ext_vector_type(8)));
typedef short s16x4 __attribute__((ext_vector_type(4)));
typedef GAS unsigned gu32;
#define LDS_WAIT() asm volatile("s_waitcnt lgkmcnt(0)" ::: "memory")
#define VM_WAIT() asm volatile("s_waitcnt vmcnt(0)" ::: "memory")
using pg8::cvt_pk_bf16; using pg8::bf_lo; using pg8::bf_hi; using pg8::siluf_; using pg8::sigmoidf_;

#define XB_TMO      128
#define XB_XCNT(j)  (256  + 64 * (j))
#define XB_XSUB(j)  (1280 + 64 * (j))
#define XB_XGEN(j)  (2304 + 64 * (j))
#define XB_TOP      3328
#define XB_TOPGEN   3392
#define XCD_BAR_WORDS 3456
#define XB_SPIN_CAP (1u << 18)
__device__ __forceinline__ unsigned xb_ld(unsigned* p)              { return __hip_atomic_load(p, __ATOMIC_RELAXED, __HIP_MEMORY_SCOPE_AGENT); }
__device__ __forceinline__ unsigned xb_add(unsigned* p, unsigned v) { return __hip_atomic_fetch_add(p, v, __ATOMIC_RELAXED, __HIP_MEMORY_SCOPE_AGENT); }
__device__ __forceinline__ unsigned xb_xcc_id() { return (unsigned)__builtin_amdgcn_s_getreg((3 << 11) | 20) & 0xFu; }
#define XB_SPIN(cond, bar) do { unsigned _sp = 0; while (cond) { __builtin_amdgcn_s_sleep(1); \
    if ((++_sp & 255u) == 0u) { if (xb_ld(&(bar)[XB_TMO])) break; if (_sp > XB_SPIN_CAP) { atomicAdd(&(bar)[XB_TMO], 1u); break; } } } } while (0)
struct XcdBarrier { unsigned* bar; unsigned x; volatile LAS unsigned* st; };
__device__ __forceinline__ XcdBarrier xcd_barrier_post(unsigned* bar, volatile LAS unsigned* st) {
    XcdBarrier b; b.bar = bar; b.x = xb_xcc_id(); b.st = st;
    if (threadIdx.x == 0) (void)xb_add(&bar[XB_XCNT(b.x)], 1u);
    return b;
}
__device__ __forceinline__ void xcd_barrier_complete(unsigned* bar, unsigned x, unsigned& nloc, unsigned& nx) {
    const unsigned G = gridDim.x * gridDim.y * gridDim.z;
    unsigned sum, cnt, mine, sp = 0u;
    for (;;) {
        sum = 0u; cnt = 0u; mine = 0u;
#pragma unroll
        for (unsigned j = 0; j < 16; ++j) { const unsigned c = xb_ld(&bar[XB_XCNT(j)]); sum += c; cnt += (c > 0u) ? 1u : 0u; mine = (j == x) ? c : mine; }
        if (sum == G) break;
        __builtin_amdgcn_s_sleep(1);
        if ((++sp & 255u) == 0u) { if (xb_ld(&bar[XB_TMO])) break; if (sp > XB_SPIN_CAP) { atomicAdd(&bar[XB_TMO], 1u); break; } }
    }
    nloc = mine > 0u ? mine : 1u; nx = cnt > 0u ? cnt : 1u;
}
__device__ __forceinline__ void xcd_barrier(const XcdBarrier& b) {
    asm volatile("s_waitcnt vmcnt(0)" ::: "memory");
    __syncthreads();
    if (threadIdx.x == 0) {
        unsigned* bar = b.bar;
        __builtin_amdgcn_s_waitcnt(0);
        unsigned nloc = b.st[0], nx = b.st[1];
        if (nloc == 0u) { xcd_barrier_complete(bar, b.x, nloc, nx); b.st[0] = nloc; b.st[1] = nx; }
        const unsigned old = xb_add(&bar[XB_XSUB(b.x)], 1u);
        const unsigned gen = old / nloc;
        if (old + 1u == (gen + 1u) * nloc) {
            __builtin_amdgcn_fence(__ATOMIC_RELEASE, "agent");
            asm volatile("s_waitcnt vmcnt(0)" ::: "memory");
            const unsigned og = xb_add(&bar[XB_TOP], 1u);
            const unsigned tg = og / nx;
            if (og + 1u == (tg + 1u) * nx) xb_add(&bar[XB_TOPGEN], 1u);
            else XB_SPIN(xb_ld(&bar[XB_TOPGEN]) == tg, bar);
            __builtin_amdgcn_fence(__ATOMIC_ACQUIRE, "agent");
            xb_add(&bar[XB_XGEN(b.x)], 1u);
            asm volatile("s_waitcnt vmcnt(0)" ::: "memory");
        } else {
            XB_SPIN(xb_ld(&bar[XB_XGEN(b.x)]) == gen, bar);
            __builtin_amdgcn_fence(__ATOMIC_ACQUIRE, "agent");
            asm volatile("s_waitcnt vmcnt(0)" ::: "memory");
        }
    }
    __syncthreads();
}

struct Args { const float* in[33]; float* out; unsigned char* ws; int ph_lo, ph_hi, dup, pad; };
struct Frame {
    LAS unsigned char* lds;
    int tid, lane, wave;
    int vcu, G;
};
__device__ __forceinline__ float wave_sum(float v) {
#pragma unroll
    for (int o = 1; o < 64; o <<= 1) v += __shfl_xor(v, o);
    return v;
}
__device__ __forceinline__ unsigned f2bf(float f) { unsigned u = __builtin_bit_cast(unsigned, f); return (u + 0x7fffu + ((u >> 16) & 1u)) >> 16; }
__device__ __forceinline__ unsigned pk2(float lo, float hi) { return f2bf(lo) | (f2bf(hi) << 16); }

__device__ __forceinline__ void p0_transpose_item(const float* W, int K, int N, bf16* WT, LAS float* scr, int item, int lane) {
    const int nblk = N / 32, kb = item / nblk, nb = item % nblk, k0 = 64 * kb, n0 = 32 * nb;
#pragma unroll 8
    for (int i = 0; i < 32; ++i) { const int kk = 2 * i + (lane >> 5); scr[kk * 33 + (lane & 31)] = W[(size_t)(k0 + kk) * N + n0 + (lane & 31)]; }
    LDS_WAIT(); asm volatile("" ::: "memory");
    const int c = lane & 7;
#pragma unroll
    for (int j = 0; j < 4; ++j) { const int n = (lane >> 3) + 8 * j; const LAS float* s = scr + (8 * c) * 33 + n;
        v4u o; o.x = pk2(s[0 * 33], s[1 * 33]); o.y = pk2(s[2 * 33], s[3 * 33]); o.z = pk2(s[4 * 33], s[5 * 33]); o.w = pk2(s[6 * 33], s[7 * 33]);
        *(GAS v4u*)(WT + (size_t)(n0 + n) * K + k0 + 8 * c) = o; }
    LDS_WAIT(); asm volatile("" ::: "memory");
}
__device__ __forceinline__ void p0_mod(Frame& F, const Args& a) {
    LAS float* cact = (LAS float*)(F.lds + RING_OFF);
    LAS float* red = cact + 2 * 4096;
    const float* c = a.in[1]; const float* mw = a.in[2]; const float* mb = a.in[3]; float* MOD = (float*)(a.ws + WS_MOD);
    for (int i = F.tid; i < 2 * 4096; i += NWAVES * 64) cact[i] = siluf_(c[i]);
    __syncthreads();
    const int rg = F.lane >> 4, cq = F.lane & 15;
    for (int it = F.vcu; it < 4 * 192; it += F.G) {
        const int layer = it / 192, cb = it % 192;
        const float* wp = mw + (size_t)layer * 4096 * 12288 + (size_t)(F.wave * 4 + rg) * 12288 + cb * 64 + cq * 4;
        f32x4 a0 = {0.f, 0.f, 0.f, 0.f}, a1 = {0.f, 0.f, 0.f, 0.f};
#pragma unroll 8
        for (int s = 0; s < 128; ++s) { const f32x4 w = *(const GAS f32x4*)(wp + (size_t)s * 32 * 12288); const int k = F.wave * 4 + rg + 32 * s;
            const float c0 = cact[k], c1 = cact[4096 + k]; a0 += w * c0; a1 += w * c1; }
#pragma unroll
        for (int j = 0; j < 4; ++j) { a0[j] += __shfl_xor(a0[j], 16); a0[j] += __shfl_xor(a0[j], 32); a1[j] += __shfl_xor(a1[j], 16); a1[j] += __shfl_xor(a1[j], 32); }
        if (F.lane < 16) { *(LAS f32x4*)(red + (F.wave * 2 + 0) * 64 + cq * 4) = a0; *(LAS f32x4*)(red + (F.wave * 2 + 1) * 64 + cq * 4) = a1; }
        __syncthreads();
        if (F.tid < 128) { const int b = F.tid >> 6, col = F.tid & 63; float s = mb[layer * 12288 + cb * 64 + col];
#pragma unroll
            for (int w = 0; w < 8; ++w) s += red[(w * 2 + b) * 64 + col];
            MOD[((size_t)layer * 2 + b) * 12288 + cb * 64 + col] = s; }
        __syncthreads();
    }
}
__device__ __forceinline__ void p0_s5_group(Frame& F, const Args& a, int g) {
    constexpr int T = S5_T;
    LAS f32x2* pw = (LAS f32x2*)(F.lds + RING_OFF);
    LAS f32x2* bbar = pw + 2 * (T + 1) * 64;
    LAS f32x2* cc = bbar + 2 * 64 * 16;
    LAS float* kf = (LAS float*)(cc + 16 * 64);
    static_assert((2 * (T + 1) * 64 + 2 * 64 * 16 + 16 * 64) * 8 + 2 * T * 256 * 4 <= RING_BYTES, "s5 gen LDS");
    const float *b_re = a.in[9], *b_im = a.in[10], *c_re = a.in[11], *c_im = a.in[12], *dsk = a.in[13];
    float* LAMT = (float*)(a.ws + WS_LAMT);
    if (F.tid < 128) {
        const int dir = F.tid >> 6, p = F.tid & 63, gp = g * 64 + p;
        const float are = (dir ? a.in[16] : a.in[14])[gp], aim = (dir ? a.in[17] : a.in[15])[gp], ls = (dir ? a.in[19] : a.in[18])[gp];
        const float dt = expf(ls), mag = expf(are * dt), lr = mag * cosf(aim * dt), li = mag * sinf(aim * dt);
        const float den = are * are + aim * aim, nr = lr - 1.0f, rre = (nr * are + li * aim) / den, rim = (li * are - nr * aim) / den;
#pragma unroll
        for (int j = 0; j < 16; ++j) { const float br = b_re[(size_t)gp * 16 + j], bi = b_im[(size_t)gp * 16 + j]; bbar[(dir * 64 + p) * 16 + j] = (f32x2){rre * br - rim * bi, rre * bi + rim * br}; }
        float wr_ = 1.0f, wi_ = 0.0f; pw[(dir * (T + 1) + 0) * 64 + p] = (f32x2){1.0f, 0.0f};
        for (int t = 1; t <= T; ++t) { const float nr2 = wr_ * lr - wi_ * li, ni2 = wr_ * li + wi_ * lr; wr_ = nr2; wi_ = ni2; pw[(dir * (T + 1) + t) * 64 + p] = (f32x2){wr_, wi_}; }
        LAMT[((size_t)(g * 2 + dir) * 64 + p) * 2 + 0] = wr_; LAMT[((size_t)(g * 2 + dir) * 64 + p) * 2 + 1] = wi_;
    }
    for (int e = F.tid; e < 16 * 64; e += NWAVES * 64) cc[e] = (f32x2){c_re[(size_t)g * 1024 + e], c_im[(size_t)g * 1024 + e]};
    __syncthreads();
    {
        const int dir = F.tid >> 8, i = (F.tid >> 4) & 15, j = F.tid & 15;
        float acc[T];
#pragma unroll
        for (int t = 0; t < T; ++t) acc[t] = 0.f;
        for (int p = 0; p < 64; ++p) { const f32x2 C = cc[i * 64 + p], Bb = bbar[(dir * 64 + p) * 16 + j]; const float e = C.x * Bb.x - C.y * Bb.y, f = C.x * Bb.y + C.y * Bb.x;
#pragma unroll
            for (int t = 0; t < T; ++t) { const f32x2 w = pw[(dir * (T + 1) + t) * 64 + p]; acc[t] += w.x * e - w.y * f; } }
#pragma unroll
        for (int t = 0; t < T; ++t) kf[((dir * T + t) * 16 + i) * 16 + j] = acc[t];
    }
    __syncthreads();
    bf16* BY = (bf16*)(a.ws + WS_S5BY) + (size_t)g * (S5_KS * S5_KY);
    for (int q = F.tid; q < S5_KS * (S5_KY / 8); q += NWAVES * 64) {
        const int n = q / (S5_KY / 8), pc = q % (S5_KY / 8), t = n >> 4, i = n & 15, k0 = pc * 8; float v[8];
        if (k0 < S5_KS) { const int s = k0 >> 4, j0 = k0 & 15;
#pragma unroll
            for (int e = 0; e < 8; ++e) { const int j = j0 + e; float x;
                if (t > s) x = kf[((0 * T + (t - s)) * 16 + i) * 16 + j];
                else if (t < s) x = kf[((1 * T + (s - t)) * 16 + i) * 16 + j];
                else x = kf[((0 * T + 0) * 16 + i) * 16 + j] + kf[((1 * T + 0) * 16 + i) * 16 + j] + ((i == j) ? dsk[g * 16 + i] : 0.f);
                v[e] = x; }
        } else { const int kk = k0 - S5_KS, seg = kk >> 6, p0 = kk & 63, dir = seg >> 1, tp = dir ? (T - t) : (t + 1);
#pragma unroll
            for (int e = 0; e < 8; ++e) { const int p = p0 + e; const f32x2 w = pw[(dir * (T + 1) + tp) * 64 + p], C = cc[i * 64 + p];
                v[e] = (seg & 1) ? -(C.x * w.y + C.y * w.x) : (C.x * w.x - C.y * w.y); }
        }
        v4u o; o.x = pk2(v[0], v[1]); o.y = pk2(v[2], v[3]); o.z = pk2(v[4], v[5]); o.w = pk2(v[6], v[7]);
        *(GAS v4u*)(BY + (size_t)n * S5_KY + k0) = o;
    }
    bf16* BS = (bf16*)(a.ws + WS_S5BS) + (size_t)g * (256 * S5_KS);
    for (int q = F.tid; q < 256 * (S5_KS / 8); q += NWAVES * 64) {
        const int n = q / (S5_KS / 8), pc = q % (S5_KS / 8), k0 = pc * 8, s = k0 >> 4, j0 = k0 & 15, seg = n >> 6, p = n & 63, dir = seg >> 1;
        const f32x2 w = pw[(dir * (T + 1) + (dir ? s : (T - 1 - s))) * 64 + p]; float v[8];
#pragma unroll
        for (int e = 0; e < 8; ++e) { const f32x2 Bb = bbar[(dir * 64 + p) * 16 + j0 + e]; v[e] = (seg & 1) ? (w.x * Bb.y + w.y * Bb.x) : (w.x * Bb.x - w.y * Bb.y); }
        v4u o; o.x = pk2(v[0], v[1]); o.y = pk2(v[2], v[3]); o.z = pk2(v[4], v[5]); o.w = pk2(v[6], v[7]);
        *(GAS v4u*)(BS + (size_t)n * S5_KS + k0) = o;
    }
    __syncthreads();
}
__device__ __forceinline__ void p0_prologue(Frame& F, const Args& a) {
    p0_mod(F, a);
    {
        LAS float* scr = (LAS float*)(F.lds + RING_OFF + F.wave * 16384);
        const int gw = F.vcu * NWAVES + F.wave, NGW = F.G * NWAVES;
        constexpr int I_NAIN = 64 * 512, I_SQ = 64 * 128, I_S5IN = 64 * 256, I_GLAIN = 64 * 384;
        constexpr int NITEMS = 2 * I_NAIN + 2 * I_SQ + I_S5IN + 2 * I_SQ + I_GLAIN + I_SQ;
        unsigned char* ws = a.ws;
        for (int it = gw; it < NITEMS; it += NGW) {
            int r = it;
            if (r < I_NAIN) { p0_transpose_item(a.in[5], 4096, 16384, (bf16*)(ws + WS_W_NAIN0), scr, r, F.lane); continue; } r -= I_NAIN;
            if (r < I_NAIN) { p0_transpose_item(a.in[5] + (size_t)4096 * 16384, 4096, 16384, (bf16*)(ws + WS_W_NAIN1), scr, r, F.lane); continue; } r -= I_NAIN;
            if (r < I_SQ) { p0_transpose_item(a.in[7], 4096, 4096, (bf16*)(ws + WS_W_NAOUT0), scr, r, F.lane); continue; } r -= I_SQ;
            if (r < I_SQ) { p0_transpose_item(a.in[7] + (size_t)4096 * 4096, 4096, 4096, (bf16*)(ws + WS_W_NAOUT1), scr, r, F.lane); continue; } r -= I_SQ;
            if (r < I_S5IN) { p0_transpose_item(a.in[8], 4096, 8192, (bf16*)(ws + WS_W_S5IN), scr, r, F.lane); continue; } r -= I_S5IN;
            if (r < I_SQ) { p0_transpose_item(a.in[20], 4096, 4096, (bf16*)(ws + WS_W_S5GLU), scr, r, F.lane); continue; } r -= I_SQ;
            if (r < I_SQ) { p0_transpose_item(a.in[22], 4096, 4096, (bf16*)(ws + WS_W_S5OUT), scr, r, F.lane); continue; } r -= I_SQ;
            if (r < I_GLAIN) { p0_transpose_item(a.in[23], 4096, 12288, (bf16*)(ws + WS_W_GLAIN), scr, r, F.lane); continue; } r -= I_GLAIN;
            p0_transpose_item(a.in[31], 4096, 4096, (bf16*)(ws + WS_W_GLAOUT), scr, r, F.lane);
        }
        bf16* G1T = (bf16*)(ws + WS_W_GLAG1);
        for (int e = (F.vcu * NWAVES * 64 + F.tid); e < 256 * 4096 / 2; e += F.G * NWAVES * 64) {
            const int n = e / 2048, k = (e % 2048) * 2; float v0 = 0.f, v1 = 0.f;
            if (n < 16) { v0 = a.in[24][(size_t)k * 16 + n]; v1 = a.in[24][(size_t)(k + 1) * 16 + n]; }
            else if (n < 32) { v0 = a.in[27][(size_t)k * 16 + (n - 16)]; v1 = a.in[27][(size_t)(k + 1) * 16 + (n - 16)]; }
            *(GAS unsigned*)(G1T + (size_t)n * 4096 + k) = pk2(v0, v1);
        }
    }
    __syncthreads();
    for (int g = F.vcu; g < S5_G; g += F.G) p0_s5_group(F, a, g);
}

template <bool FINAL>
__device__ __forceinline__ void norm_phase(Frame& F, const float* xin, const float* nw, const float* mod  , bf16* H, float* outf) {
    LAS f32x2* tab = (LAS f32x2*)(F.lds + RING_OFF);
    for (int i = F.tid; i < 2 * 4096; i += NWAVES * 64) { const int b = i >> 12, c = i & 4095;
        if (FINAL) tab[i] = (f32x2){nw[c], 0.f};
        else tab[i] = (f32x2){nw[c] * (1.0f + mod[b * 12288 + 4096 + c]), mod[b * 12288 + c]}; }
    __syncthreads();
    const int gw = F.vcu * NWAVES + F.wave, NGW = F.G * NWAVES;
    for (int m = gw; m < M; m += NGW) {
        const int b = m >> 13; const GAS f32x4* xr = (const GAS f32x4*)(xin + (size_t)m * D) + F.lane;
        f32x4 v[16]; float s = 0.f;
#pragma unroll
        for (int j = 0; j < 16; ++j) { v[j] = xr[64 * j]; s += (v[j].x * v[j].x + v[j].y * v[j].y) + (v[j].z * v[j].z + v[j].w * v[j].w); }
        const float rstd = rsqrtf(wave_sum(s) * (1.f / D) + EPS);
#pragma unroll
        for (int j = 0; j < 16; ++j) { const int c = 4 * F.lane + 256 * j; const LAS f32x2* tp = tab + b * 4096 + c;
            const f32x2 t0 = tp[0], t1 = tp[1], t2 = tp[2], t3 = tp[3];
            const float o0 = v[j].x * rstd * t0.x + t0.y, o1 = v[j].y * rstd * t1.x + t1.y, o2 = v[j].z * rstd * t2.x + t2.y, o3 = v[j].w * rstd * t3.x + t3.y;
            if (FINAL) *((GAS f32x4*)(outf + (size_t)m * D) + F.lane + 64 * j) = (f32x4){o0, o1, o2, o3};
            else *(GAS v2u*)(H + (size_t)m * D + c) = (v2u){cvt_pk_bf16(o0, o1), cvt_pk_bf16(o2, o3)}; }
    }
    __syncthreads();
}

typedef short v4i16_t __attribute__((ext_vector_type(4)));
__device__ __forceinline__ s16x4 tr4(const LAS unsigned char* p) { return __builtin_bit_cast(s16x4, __builtin_amdgcn_ds_read_tr16_b64_v4i16((LAS v4i16_t*)p)); }
__device__ __forceinline__ bf16x8 cat8(s16x4 a, s16x4 b) { return (bf16x8){a[0], a[1], a[2], a[3], b[0], b[1], b[2], b[3]}; }
__device__ __forceinline__ bf16x8 pack8(f32x4 a, f32x4 b) { v4u w; w.x = cvt_pk_bf16(a[0], a[1]); w.y = cvt_pk_bf16(a[2], a[3]); w.z = cvt_pk_bf16(b[0], b[1]); w.w = cvt_pk_bf16(b[2], b[3]); return __builtin_bit_cast(bf16x8, w); }
#define MFMA16(a, b, c) __builtin_amdgcn_mfma_f32_16x16x32_bf16((a), (b), (c), 0, 0, 0)

constexpr int NA_PITCH = 288, NA_TILE = 64 * NA_PITCH;
__device__ __forceinline__ void na_attn_phase(Frame& F, const bf16* QKVG, bf16* Z, const float* rpb) {
    const int grp = F.wave >> 2, ct = F.wave & 3, lane = F.lane, li = lane & 15, g = lane >> 4, q4 = li >> 2, p4 = li & 3;
    const int c0 = ct * 16, kc0 = min(max(c0 - 8, 0), 32);
    const int ipw = (4096 + F.G - 1) / F.G;
    LAS unsigned char* const lbase = F.lds + RING_OFF;
    LAS float* const rp = (LAS float*)(lbase + 4 * NA_TILE + grp * 2048);
    for (int k = 0; k < ipw; ++k) {
        const int it = F.vcu * ipw + k; if (it >= 4096) break;
        const int b = it >> 11, hp = (it >> 7) & 15, r = ((it & 15) << 3) | ((it >> 4) & 7), h = hp * 2 + grp;
        const int rs = min(max(r - 4, 0), GROWS - 8);
        const size_t tok0 = (size_t)b * SEQ + (size_t)r * GRIDW;
        const bf16* qp = QKVG + (tok0 + c0 + li) * 16384 + h * 128 + 8 * g;
        bf16x8 qf[4];
#pragma unroll
        for (int ks = 0; ks < 4; ++ks) qf[ks] = *(const GAS bf16x8*)(qp + 32 * ks);
        for (int e = (F.tid & 255); e < 465; e += 256) rp[e] = rpb[h * 465 + e];
        v4u st[4];
        const bf16* kvbase = QKVG + ((size_t)b * SEQ + (size_t)rs * GRIDW + 16 * ct + g) * 16384 + h * 128 + li * 8;
#define NA_LOAD(t) do { _Pragma("unroll") for (int j = 0; j < 4; ++j) st[j] = *(const GAS v4u*)(kvbase + ((size_t)((t) & 7) * GRIDW + 4 * j) * 16384 + (((t) >> 3) ? 8192 : 4096)); } while (0)
#define NA_WRITE(buf) do { _Pragma("unroll") for (int j = 0; j < 4; ++j) *(LAS v4u*)(lbase + ((buf) * 2 + grp) * NA_TILE + (16 * ct + 4 * j + g) * NA_PITCH + li * 16) = st[j]; } while (0)
        NA_LOAD(0); NA_WRITE(0); __syncthreads();
        f32x4 S[8][2];
#pragma unroll
        for (int t = 0; t < 8; ++t) {
            NA_LOAD(t + 1);
            const LAS unsigned char* tb = lbase + ((t & 1) * 2 + grp) * NA_TILE;
            S[t][0] = (f32x4){0.f, 0.f, 0.f, 0.f}; S[t][1] = (f32x4){0.f, 0.f, 0.f, 0.f};
#pragma unroll
            for (int blk = 0; blk < 2; ++blk)
#pragma unroll
                for (int ks = 0; ks < 4; ++ks) { const bf16x8 A = *(const LAS bf16x8*)(tb + (kc0 + 16 * blk + li) * NA_PITCH + (32 * ks + 8 * g) * 2);
                    S[t][blk] = MFMA16(A, qf[ks], S[t][blk]); }
            NA_WRITE((t + 1) & 1);
            __syncthreads();
        }
        const int c = c0 + li, cs = min(max(c - 8, 0), GRIDW - 16);
        float mx = -1e30f;
#pragma unroll
        for (int t = 0; t < 8; ++t)
#pragma unroll
            for (int blk = 0; blk < 2; ++blk)
#pragma unroll
                for (int e = 0; e < 4; ++e) { const int kc = kc0 + 16 * blk + 4 * g + e; const bool valid = (kc >= cs) && (kc < cs + 16);
                    const int idx = valid ? ((rs + t - r + 7) * 31 + (kc - c + 15)) : 0;
                    const float s = valid ? (S[t][blk][e] * 0.08838834764831845f + rp[idx]) : -1e30f; S[t][blk][e] = s; mx = fmaxf(mx, s); }
        mx = fmaxf(mx, __shfl_xor(mx, 16)); mx = fmaxf(mx, __shfl_xor(mx, 32));
        float sum = 0.f;
#pragma unroll
        for (int t = 0; t < 8; ++t)
#pragma unroll
            for (int blk = 0; blk < 2; ++blk)
#pragma unroll
                for (int e = 0; e < 4; ++e) { const float p = __expf(S[t][blk][e] - mx); S[t][blk][e] = p; sum += p; }
        sum += __shfl_xor(sum, 16); sum += __shfl_xor(sum, 32);
        const float inv = 1.0f / sum;
        bf16x8 pb[8];
#pragma unroll
        for (int t = 0; t < 8; ++t) pb[t] = pack8(S[t][0], S[t][1]);
        f32x4 O[8];
#pragma unroll
        for (int db = 0; db < 8; ++db) O[db] = (f32x4){0.f, 0.f, 0.f, 0.f};
#pragma unroll
        for (int t = 8; t < 16; ++t) {
            if (t < 15) NA_LOAD(t + 1);
            const LAS unsigned char* tb = lbase + ((t & 1) * 2 + grp) * NA_TILE + (kc0 + 4 * g + q4) * NA_PITCH + 8 * p4;
#pragma unroll
            for (int db = 0; db < 8; ++db) { const s16x4 a0 = tr4(tb + 32 * db), a1 = tr4(tb + 16 * NA_PITCH + 32 * db);
                O[db] = MFMA16(cat8(a0, a1), pb[t - 8], O[db]); }
            if (t < 15) NA_WRITE((t + 1) & 1);
            __syncthreads();
        }
#undef NA_LOAD
#undef NA_WRITE
        bf16* zp = Z + (tok0 + c0 + li) * 4096 + h * 128 + 4 * g; const bf16* gp = QKVG + (tok0 + c0 + li) * 16384 + 12288 + h * 128 + 4 * g;
#pragma unroll
        for (int db = 0; db < 8; ++db) { const v2u gw = *(const GAS v2u*)(gp + 16 * db);
            const float z0 = O[db][0] * inv * siluf_(bf_lo(gw.x)), z1 = O[db][1] * inv * siluf_(bf_hi(gw.x)), z2 = O[db][2] * inv * siluf_(bf_lo(gw.y)), z3 = O[db][3] * inv * siluf_(bf_hi(gw.y));
            *(GAS v2u*)(zp + 16 * db) = (v2u){cvt_pk_bf16(z0, z1), cvt_pk_bf16(z2, z3)}; }
    }
    __syncthreads();
}

__device__ __forceinline__ void na_attn_phase2(Frame& F, const bf16* QKVG, bf16* Z, const float* rpb) {
    const int rq = F.wave >> 2, ct = F.wave & 3, lane = F.lane, li = lane & 15, g = lane >> 4, q4 = li >> 2, p4 = li & 3;
    const int c0 = ct * 16, kc0 = min(max(c0 - 8, 0), 32);
    LAS unsigned char* const lbase = F.lds + RING_OFF;
    LAS float* const rp = (LAS float*)(lbase + 6 * NA_TILE);
    const int ipw = (4096 + F.G - 1) / F.G, it0 = F.vcu * ipw;
    if (it0 >= 4096) return;
    const int nit = min(ipw, 4096 - it0);
    const bool xg = (F.G == 256);
#define NA2_ID(k_) (xg ? ((((F.vcu >> 5) * 8 + ((k_) >> 1)) << 6) | ((((k_) & 1) << 5) | (F.vcu & 31))) : (it0 + (k_)))
    const int id0 = NA2_ID(0);
    const int ptok = F.tid >> 4, pch = F.tid & 15;
    v4u R[1][3][2];
#define NA2_SEC (size_t)(2 * 32 * 8192) * 128
#define NA2_SRC(it_, ss_) (QKVG + (((ss_) >= 9) ? 2 : 1) * NA2_SEC + ((size_t)((it_) >> 6) * 8192 + (size_t)min(min(max(2 * ((it_) & 63) - 4, 0), GROWS - 8) + ((ss_) % 9), GROWS - 1) * GRIDW + ptok) * 128 + pch * 8)
#define NA2_LOADG(set_, it_, gq_) do { _Pragma("unroll") for (int jj_ = 0; jj_ < 3; ++jj_) { const bf16* s_ = NA2_SRC(it_, 3 * (gq_) + jj_); \
        R[set_][jj_][0] = *(const GAS v4u*)s_; R[set_][jj_][1] = *(const GAS v4u*)(s_ + 32 * 128); } } while (0)
#define NA2_WRITEG(set_, buf) do { _Pragma("unroll") for (int jj_ = 0; jj_ < 3; ++jj_) { LAS unsigned char* d_ = lbase + ((buf) * 3 + jj_) * NA_TILE + ptok * NA_PITCH + pch * 16; \
        *(LAS v4u*)d_ = R[set_][jj_][0]; *(LAS v4u*)(d_ + 32 * NA_PITCH) = R[set_][jj_][1]; } } while (0)
#define NA2_SCORE(kl, tb) do { S[kl][0] = (f32x4){0.f, 0.f, 0.f, 0.f}; S[kl][1] = (f32x4){0.f, 0.f, 0.f, 0.f}; \
        _Pragma("unroll") for (int blk = 0; blk < 2; ++blk) _Pragma("unroll") for (int ks = 0; ks < 4; ++ks) { \
            const bf16x8 A_ = *(const LAS bf16x8*)((tb) + (kc0 + 16 * blk + li) * NA_PITCH + (32 * ks + 8 * g) * 2); S[kl][blk] = MFMA16(A_, qf[ks], S[kl][blk]); } \
        _Pragma("unroll") for (int blk = 0; blk < 2; ++blk) _Pragma("unroll") for (int e = 0; e < 4; ++e) { const bool valid = ((blk ? vm1 : vm0) + (unsigned)e) < 16u; const float bias = bp[(kl) * 31 + blk * 16 + e]; \
            const float sv = valid ? (S[kl][blk][e] * 0.08838834764831845f + bias) : -1e30f; S[kl][blk][e] = sv; mx = fmaxf(mx, sv); } } while (0)
#define NA2_PV(kl, tb) do { const LAS unsigned char* t_ = (tb) + (kc0 + 4 * g + q4) * NA_PITCH + 8 * p4; \
        _Pragma("unroll") for (int blk = 0; blk < 2; ++blk) _Pragma("unroll") for (int e = 0; e < 4; ++e) { const float p_ = __expf(S[kl][blk][e] - mx); S[kl][blk][e] = p_; sum += p_; } \
        const bf16x8 pb_ = pack8(S[kl][0], S[kl][1]); \
        _Pragma("unroll") for (int db = 0; db < 8; ++db) O[db] = MFMA16(cat8(tr4(t_ + 32 * db), tr4(t_ + 16 * NA_PITCH + 32 * db)), pb_, O[db]); } while (0)
    NA2_LOADG(0, id0, 0);
    bf16x8 qf[4];
    { const int rp_ = id0 & 63, r_ = 2 * rp_ + rq;
      const bf16* qp = QKVG + ((size_t)(id0 >> 6) * 8192 + (size_t)r_ * GRIDW + c0 + li) * 128 + 8 * g;
#pragma unroll
      for (int ks = 0; ks < 4; ++ks) qf[ks] = *(const GAS bf16x8*)(qp + 32 * ks); }
    NA2_WRITEG(0, 0);
    for (int e = F.tid; e < 465; e += NWAVES * 64) rp[e] = rpb[((id0 >> 6) & 31) * 465 + e];
    __syncthreads();
    for (int k = 0; k < nit; ++k) {
        const int it = NA2_ID(k), itn = NA2_ID(k + 1), b = it >> 11, h = (it >> 6) & 31, rpi = it & 63;
        const int base = min(max(2 * rpi - 4, 0), GROWS - 8), r = 2 * rpi + rq, rsw = min(max(r - 4, 0), GROWS - 8), offw = rsw - base;
        const bool has_next = (k + 1 < nit);
        f32x4 S[8][2];
        int lz = F.lane; asm volatile("" : "+v"(lz)); const int liz = lz & 15, gz = lz >> 4, c = c0 + liz, cs = min(max(c - 8, 0), GRIDW - 16);
        const LAS float* bp = rp + (rsw - r + 7) * 31 + (kc0 + 4 * gz - c + 15);
        const unsigned vm0 = (unsigned)(kc0 + 4 * gz - cs), vm1 = vm0 + 16u;
        float mx = -1e30f, sum = 0.f;
#pragma unroll
        for (int gi = 0; gi < 3; ++gi) {
            NA2_LOADG(0, it, gi + 1);
#pragma unroll
            for (int jj = 0; jj < 3; ++jj) { const int j = 3 * gi + jj; const LAS unsigned char* tb = lbase + ((gi & 1) * 3 + jj) * NA_TILE;
                if (offw == 0) { if (j < 8) NA2_SCORE((j < 8 ? j : 0), tb); } else { if (j >= 1) NA2_SCORE((j >= 1 ? j - 1 : 0), tb); }
                asm volatile("" ::: "memory"); }
            NA2_WRITEG(0, (gi + 1) & 1);
            __syncthreads();
        }
        mx = fmaxf(mx, __shfl_xor(mx, 16)); mx = fmaxf(mx, __shfl_xor(mx, 32));
        f32x4 O[8];
#pragma unroll
        for (int db = 0; db < 8; ++db) O[db] = (f32x4){0.f, 0.f, 0.f, 0.f};
        v2u gw[8];
        bf16x8 qn[4];
#pragma unroll
        for (int gi = 0; gi < 3; ++gi) {
            const int sg = 3 + gi;
            if (sg + 1 < 6) NA2_LOADG(0, it, sg + 1); else if (has_next) NA2_LOADG(0, itn, 0);
            if (gi == 1 && has_next) { for (int e = F.tid; e < 465; e += NWAVES * 64) rp[e] = rpb[((itn >> 6) & 31) * 465 + e]; }
            if (gi == 2 && has_next) { const int rpn = itn & 63, rn = 2 * rpn + rq;
                const bf16* qp = QKVG + ((size_t)(itn >> 6) * 8192 + (size_t)rn * GRIDW + c0 + li) * 128 + 8 * g;
#pragma unroll
                for (int ks = 0; ks < 4; ++ks) qn[ks] = *(const GAS bf16x8*)(qp + 32 * ks); }
#pragma unroll
            for (int jj = 0; jj < 3; ++jj) { const int j = 3 * gi + jj; const LAS unsigned char* tb = lbase + ((sg & 1) * 3 + jj) * NA_TILE;
                if (offw == 0) { if (j < 8) NA2_PV((j < 8 ? j : 0), tb); } else { if (j >= 1) NA2_PV((j >= 1 ? j - 1 : 0), tb); }
                asm volatile("" ::: "memory"); }
            if (sg + 1 < 6 || has_next) NA2_WRITEG(0, (sg + 1) & 1);
            __syncthreads();
        }
        sum += __shfl_xor(sum, 16); sum += __shfl_xor(sum, 32);
        const float inv = __builtin_amdgcn_rcpf(sum);
        int lq = F.lane; asm volatile("" : "+v"(lq)); const int liq = lq & 15, gq = lq >> 4;
        const size_t mq = (size_t)b * SEQ + (size_t)r * GRIDW + c0 + liq;
        const bf16* gp = QKVG + 3 * NA2_SEC + ((size_t)(it >> 6) * 8192 + (size_t)r * GRIDW + c0 + liq) * 128 + 4 * gq;
        bf16* zp = Z + mq * 4096 + h * 128 + 4 * gq;
#pragma unroll
        for (int db = 0; db < 8; ++db) gw[db] = *(const GAS v2u*)(gp + 16 * db);
#pragma unroll
        for (int db = 0; db < 8; ++db) {
            const float z0 = O[db][0] * inv * siluf_(bf_lo(gw[db].x)), z1 = O[db][1] * inv * siluf_(bf_hi(gw[db].x)), z2 = O[db][2] * inv * siluf_(bf_lo(gw[db].y)), z3 = O[db][3] * inv * siluf_(bf_hi(gw[db].y));
            *(GAS v2u*)(zp + 16 * db) = (v2u){cvt_pk_bf16(z0, z1), cvt_pk_bf16(z2, z3)}; }
        if (has_next) {
#pragma unroll
            for (int ks = 0; ks < 4; ++ks) qf[ks] = qn[ks]; }
    }
#undef NA2_SRC
#undef NA2_SEC
#undef NA2_ID
#undef NA2_LOADG
#undef NA2_WRITEG
#undef NA2_SCORE
#undef NA2_PV
    __syncthreads();
}

__device__ __forceinline__ void s5_scan_phase(Frame& F, const Args& a) {
    const float* Sloc = (const float*)(a.ws + WS_S5_SLOC); bf16* Ug = (bf16*)(a.ws + WS_S5_UG); const float* LAMT = (const float*)(a.ws + WS_LAMT);
    const int t8 = F.tid & 255, b = t8 >> 7, dir = (t8 >> 6) & 1, p = t8 & 63;
    for (int gi = F.vcu * 2 + (F.tid >> 8); gi < S5_G; gi += F.G * 2) {
        const float lr = LAMT[((size_t)(gi * 2 + dir) * 64 + p) * 2 + 0], li = LAMT[((size_t)(gi * 2 + dir) * 64 + p) * 2 + 1];
        float xr = 0.f, xi = 0.f;
#pragma unroll 8
        for (int s = 0; s < S5_NCHB; ++s) { const int c = dir ? (S5_NCHB - 1 - s) : s; const size_t row = (size_t)gi * S5_NCH + b * S5_NCHB + c;
            bf16* up = Ug + row * S5_KY + S5_KS + dir * 128 + p;
            up[0] = (bf16)f2bf(xr); up[64] = (bf16)f2bf(xi);
            const float sr = Sloc[row * 256 + dir * 128 + p], si = Sloc[row * 256 + dir * 128 + 64 + p];
            const float nr = lr * xr - li * xi + sr, ni = lr * xi + li * xr + si; xr = nr; xi = ni; }
    }
}

__device__ __forceinline__ float log_sigmoidf_(float z) { return fminf(z, 0.f) - log1pf(expf(-fabsf(z))); }
__device__ __forceinline__ void gla_prep_phase(Frame& F, const Args& a) {
    const bf16* IN = (const bf16*)(a.ws + WS_GLA_IN); const float* G1P = (const float*)(a.ws + WS_GLA_G1P);
    bf16* PREP = (bf16*)(a.ws + WS_GLA_PREP); float* DECAY = (float*)(a.ws + WS_GLA_DECAY);
    LAS float* g1s = (LAS float*)(F.lds + RING_OFF);
    LAS float* Bc = g1s + 64 * 32;
    LAS float* bl = Bc + 2 * 64 * 256;
    static_assert((64 * 32 + 2 * 64 * 256 + 2 * 256) * 4 <= MISC_OFF, "gla prep LDS");
    const int ipw = (2048 + F.G - 1) / F.G; int cur_chunk = -1;
    for (int k = 0; k < ipw; ++k) {
        const int it = F.vcu * ipw + k; if (it >= 2048) break;
        const int cidx = it >> 3, h = it & 7, m0 = cidx * GLA_C, dbase = h * 256;
        if (cidx != cur_chunk) { cur_chunk = cidx;
            const int tok = F.tid >> 3, qd = F.tid & 7; f32x4 s4 = {0.f, 0.f, 0.f, 0.f};
#pragma unroll
            for (int ks = 0; ks < 4; ++ks) s4 += *(const GAS f32x4*)(G1P + ((size_t)ks * M + m0 + tok) * 32 + qd * 4);
            *(LAS f32x4*)(g1s + tok * 32 + qd * 4) = s4;
            __syncthreads(); }
        v4u q8[4], k8[4];
#pragma unroll
        for (int j = 0; j < 4; ++j) { const int e = F.tid + 512 * j, tok = e >> 5, c8 = (e & 31) * 8; const size_t m = (size_t)m0 + tok;
            q8[j] = *(const GAS v4u*)(IN + m * GLA_NIN + dbase + c8); k8[j] = *(const GAS v4u*)(IN + m * GLA_NIN + GLA_KW + dbase + c8); }
        {
            const int dir = F.tid >> 8, col = F.tid & 255, d = dbase + col;
            const float* w2 = dir ? a.in[28] : a.in[25]; const float bgd = (dir ? a.in[29] : a.in[26])[d];
            float w2r[16];
#pragma unroll
            for (int r = 0; r < 16; ++r) w2r[r] = w2[(size_t)r * GLA_KW + d];
            float run = 0.f;
#pragma unroll 4
            for (int s = 0; s < 64; ++s) { const int i = dir ? (63 - s) : s; const LAS f32x4* gp = (const LAS f32x4*)(g1s + i * 32 + dir * 16); float z = bgd;
                const f32x4 g0 = gp[0], g1 = gp[1], g2 = gp[2], g3 = gp[3];
                z += g0[0] * w2r[0] + g0[1] * w2r[1] + g0[2] * w2r[2] + g0[3] * w2r[3]; z += g1[0] * w2r[4] + g1[1] * w2r[5] + g1[2] * w2r[6] + g1[3] * w2r[7];
                z += g2[0] * w2r[8] + g2[1] * w2r[9] + g2[2] * w2r[10] + g2[3] * w2r[11]; z += g3[0] * w2r[12] + g3[1] * w2r[13] + g3[2] * w2r[14] + g3[3] * w2r[15];
                const float ls = fminf(z, 0.f) - __logf(1.0f + __expf(-fabsf(z)));
                run += ls * (1.0f / 16.0f); Bc[(dir * 64 + i) * 256 + col] = run; }
            bl[dir * 256 + col] = run;
        }
        __syncthreads();
#pragma unroll
        for (int j = 0; j < 4; ++j) { const int e = F.tid + 512 * j, tok = e >> 5, c8 = (e & 31) * 8; const size_t m = (size_t)m0 + tok;
            float qv[8], kv[8];
#pragma unroll
            for (int x = 0; x < 4; ++x) { qv[2 * x] = bf_lo(q8[j][x]) * 0.0625f; qv[2 * x + 1] = bf_hi(q8[j][x]) * 0.0625f; kv[2 * x] = bf_lo(k8[j][x]); kv[2 * x + 1] = bf_hi(k8[j][x]); }
#pragma unroll
            for (int dir = 0; dir < 2; ++dir) {
                f32x4 bbv[2], btv[2];
                bbv[0] = *(const LAS f32x4*)(Bc + (dir * 64 + tok) * 256 + c8); bbv[1] = *(const LAS f32x4*)(Bc + (dir * 64 + tok) * 256 + c8 + 4);
                btv[0] = *(const LAS f32x4*)(bl + dir * 256 + c8); btv[1] = *(const LAS f32x4*)(bl + dir * 256 + c8 + 4);
                float o0[8], o1[8], o2[8];
#pragma unroll
                for (int x = 0; x < 8; ++x) { const float bx = bbv[x >> 2][x & 3], tx = btv[x >> 2][x & 3]; o0[x] = qv[x] * __expf(bx); o1[x] = kv[x] * __expf(-bx); o2[x] = kv[x] * __expf(tx - bx); }
                v4u w0, w1, w2;
#pragma unroll
                for (int x = 0; x < 4; ++x) { w0[x] = cvt_pk_bf16(o0[2 * x], o0[2 * x + 1]); w1[x] = cvt_pk_bf16(o1[2 * x], o1[2 * x + 1]); w2[x] = cvt_pk_bf16(o2[2 * x], o2[2 * x + 1]); }
                bf16* pp = PREP + (size_t)(dir * 3) * M * GLA_KW + m * GLA_KW + dbase + c8;
                *(GAS v4u*)(pp) = w0; *(GAS v4u*)(pp + (size_t)M * GLA_KW) = w1; *(GAS v4u*)(pp + (size_t)2 * M * GLA_KW) = w2;
                if (tok == 0) { float* dp = DECAY + ((size_t)dir * GLA_NCH + cidx) * GLA_KW + dbase + c8;
                    *(GAS f32x4*)(dp) = (f32x4){__expf(btv[0][0]), __expf(btv[0][1]), __expf(btv[0][2]), __expf(btv[0][3])}; *(GAS f32x4*)(dp + 4) = (f32x4){__expf(btv[1][0]), __expf(btv[1][1]), __expf(btv[1][2]), __expf(btv[1][3])}; }
            }
        }
        __syncthreads();
    }
}

constexpr int GLA_PQ = 528, GLA_PV = 272, GLA_PV2 = 144, GLA_PVI = 1040;
__device__ __forceinline__ void gla_chain_role(Frame& F, const Args& a, int ch) {
    const bf16* IN = (const bf16*)(a.ws + WS_GLA_IN); const bf16* PREP = (const bf16*)(a.ws + WS_GLA_PREP); const float* DECAY = (const float*)(a.ws + WS_GLA_DECAY);
    const int b = ch >> 7, h = (ch >> 4) & 7, dir = (ch >> 3) & 1, vo = ch & 7;
    bf16* OUT = (bf16*)(a.ws + WS_GLA_O) + (size_t)(1 + dir) * M * 4096;
    const bf16* QS = PREP + (size_t)(dir * 3 + 0) * M * GLA_KW; const bf16* KE = PREP + (size_t)(dir * 3 + 2) * M * GLA_KW;
    LAS unsigned char* const qsT = F.lds + RING_OFF; LAS unsigned char* const keT = qsT + 64 * GLA_PQ; LAS unsigned char* const vT = keT + 64 * GLA_PQ; LAS float* const decT = (LAS float*)(vT + 64 * GLA_PV2);
    const int lane = F.lane, li = lane & 15, g = lane >> 4, q4 = li >> 2, p4 = li & 3, w = F.wave;
    f32x4 S[16];
#pragma unroll
    for (int dt = 0; dt < 16; ++dt) S[dt] = (f32x4){0.f, 0.f, 0.f, 0.f};
    v4u rq[4], rk[4], rv[1]; f32x4 rd = {0.f, 0.f, 0.f, 0.f};
#define GC_LOAD(sidx) do { const int cn_ = dir ? (GLA_NCHB - 1 - (sidx)) : (sidx); const size_t m0_ = ((size_t)b * GLA_NCHB + cn_) * GLA_C; \
        _Pragma("unroll") for (int j = 0; j < 4; ++j) { const int e = F.tid + 512 * j, tok = e >> 5, pc = e & 31; \
            rq[j] = *(const GAS v4u*)(QS + (m0_ + tok) * GLA_KW + h * 256 + pc * 8); rk[j] = *(const GAS v4u*)(KE + (m0_ + tok) * GLA_KW + h * 256 + pc * 8); } \
        { const int tok = F.tid >> 3, pc = F.tid & 7; rv[0] = *(const GAS v4u*)(IN + (m0_ + tok) * GLA_NIN + 4096 + h * 512 + vo * 64 + pc * 8); } \
        if (F.tid < 64) rd = *(const GAS f32x4*)(DECAY + ((size_t)dir * GLA_NCH + b * GLA_NCHB + cn_) * GLA_KW + h * 256 + F.tid * 4); } while (0)
    GC_LOAD(0);
    for (int sidx = 0; sidx < GLA_NCHB; ++sidx) {
#pragma unroll
        for (int j = 0; j < 4; ++j) { const int e = F.tid + 512 * j, tok = e >> 5, pc = e & 31; *(LAS v4u*)(qsT + tok * GLA_PQ + pc * 16) = rq[j]; *(LAS v4u*)(keT + tok * GLA_PQ + pc * 16) = rk[j]; }
        { const int tok = F.tid >> 3, pc = F.tid & 7; *(LAS v4u*)(vT + tok * GLA_PV2 + pc * 16) = rv[0]; }
        if (F.tid < 64) *(LAS f32x4*)(decT + F.tid * 4) = rd;
        __syncthreads();
        const int cn = dir ? (GLA_NCHB - 1 - sidx) : sidx; const size_t m0 = ((size_t)b * GLA_NCHB + cn) * GLA_C;
        if (sidx + 1 < GLA_NCHB) GC_LOAD(sidx + 1);
        if (w < 4) {
        v2u Sb[16];
#pragma unroll
        for (int dt = 0; dt < 16; ++dt) Sb[dt] = (v2u){cvt_pk_bf16(S[dt][0], S[dt][1]), cvt_pk_bf16(S[dt][2], S[dt][3])};
        {
            f32x4 acc[4];
#pragma unroll
            for (int ib = 0; ib < 4; ++ib) acc[ib] = (f32x4){0.f, 0.f, 0.f, 0.f};
            const LAS unsigned char* qrow = qsT + li * GLA_PQ + 8 * g;
#pragma unroll
            for (int ks = 0; ks < 8; ++ks) { const bf16x8 A = __builtin_bit_cast(bf16x8, (v4u){Sb[2 * ks].x, Sb[2 * ks].y, Sb[2 * ks + 1].x, Sb[2 * ks + 1].y});
#pragma unroll
                for (int ib = 0; ib < 4; ++ib) { const v2u b0 = *(const LAS v2u*)(qrow + 16 * ib * GLA_PQ + 64 * ks), b1 = *(const LAS v2u*)(qrow + 16 * ib * GLA_PQ + 64 * ks + 32);
                    acc[ib] = MFMA16(A, __builtin_bit_cast(bf16x8, (v4u){b0.x, b0.y, b1.x, b1.y}), acc[ib]); } }
#pragma unroll
            for (int ib = 0; ib < 4; ++ib)
                *(GAS v2u*)(OUT + (m0 + 16 * ib + li) * 4096 + h * 512 + vo * 64 + w * 16 + 4 * g) = (v2u){cvt_pk_bf16(acc[ib][0], acc[ib][1]), cvt_pk_bf16(acc[ib][2], acc[ib][3])};
        }
#pragma unroll
        for (int dt = 0; dt < 16; ++dt) S[dt] *= *(const LAS f32x4*)(decT + 16 * dt + 4 * g);
#pragma unroll
        for (int k2 = 0; k2 < 2; ++k2) { const LAS unsigned char* vb = vT + (32 * k2 + 8 * g + q4) * GLA_PV2 + (w * 16 + 4 * p4) * 2;
            const bf16x8 Bv = cat8(tr4(vb), tr4(vb + 4 * GLA_PV2));
            const LAS unsigned char* kb = keT + (32 * k2 + 8 * g + q4) * GLA_PQ + 8 * p4;
#pragma unroll
            for (int dt = 0; dt < 16; ++dt) { const bf16x8 A = cat8(tr4(kb + 32 * dt), tr4(kb + 4 * GLA_PQ + 32 * dt)); S[dt] = MFMA16(A, Bv, S[dt]); } }
        }
        __syncthreads();
    }
#undef GC_LOAD
}
__device__ __forceinline__ void gla_intra_role(Frame& F, const Args& a, int it) {
    const bf16* IN = (const bf16*)(a.ws + WS_GLA_IN); const bf16* PREP = (const bf16*)(a.ws + WS_GLA_PREP);
    bf16* OUT = (bf16*)(a.ws + WS_GLA_O);
    const int b = it >> 10, h = (it >> 7) & 7, cn = it & 127; const size_t m0 = ((size_t)b * GLA_NCHB + cn) * GLA_C;
    LAS unsigned char* const kfT = F.lds + RING_OFF; LAS unsigned char* const kbT = kfT + 64 * GLA_PQ; LAS unsigned char* const vT = kbT + 64 * GLA_PQ;
    const int lane = F.lane, li = lane & 15, g = lane >> 4, q4 = li >> 2, p4 = li & 3, ib = F.wave & 3, vh = F.wave >> 2;
    const bf16* KSF = PREP + (size_t)1 * M * GLA_KW; const bf16* KSB = PREP + (size_t)4 * M * GLA_KW;
    const bf16* QSF = PREP; const bf16* QSB = PREP + (size_t)3 * M * GLA_KW;
    {
        v4u r0[4], r1[4], r2[8];
#pragma unroll
        for (int j = 0; j < 4; ++j) { const int e = F.tid + 512 * j, tok = e >> 5, pc = e & 31; r0[j] = *(const GAS v4u*)(KSF + (m0 + tok) * GLA_KW + h * 256 + pc * 8); r1[j] = *(const GAS v4u*)(KSB + (m0 + tok) * GLA_KW + h * 256 + pc * 8); }
#pragma unroll
        for (int j = 0; j < 8; ++j) { const int e = F.tid + 512 * j, tok = e >> 6, pc = e & 63; r2[j] = *(const GAS v4u*)(IN + (m0 + tok) * GLA_NIN + 4096 + h * 512 + pc * 8); }
#pragma unroll
        for (int j = 0; j < 4; ++j) { const int e = F.tid + 512 * j, tok = e >> 5, pc = e & 31; *(LAS v4u*)(kfT + tok * GLA_PQ + pc * 16) = r0[j]; *(LAS v4u*)(kbT + tok * GLA_PQ + pc * 16) = r1[j]; }
#pragma unroll
        for (int j = 0; j < 8; ++j) { const int e = F.tid + 512 * j, tok = e >> 6, pc = e & 63; *(LAS v4u*)(vT + tok * GLA_PVI + pc * 16) = r2[j]; }
    }
    bf16x8 qf[8], qb[8];
#pragma unroll
    for (int ks = 0; ks < 8; ++ks) { qf[ks] = *(const GAS bf16x8*)(QSF + (m0 + 16 * ib + li) * GLA_KW + h * 256 + 32 * ks + 8 * g); qb[ks] = *(const GAS bf16x8*)(QSB + (m0 + 16 * ib + li) * GLA_KW + h * 256 + 32 * ks + 8 * g); }
    __syncthreads();
    f32x4 P[4];
#pragma unroll
    for (int jb = 0; jb < 4; ++jb) { f32x4 sf = {0.f, 0.f, 0.f, 0.f}, sb = {0.f, 0.f, 0.f, 0.f};
        if (jb <= ib) {
#pragma unroll
            for (int ks = 0; ks < 8; ++ks) sf = MFMA16(*(const LAS bf16x8*)(kfT + (16 * jb + li) * GLA_PQ + (32 * ks + 8 * g) * 2), qf[ks], sf); }
        if (jb >= ib) {
#pragma unroll
            for (int ks = 0; ks < 8; ++ks) sb = MFMA16(*(const LAS bf16x8*)(kbT + (16 * jb + li) * GLA_PQ + (32 * ks + 8 * g) * 2), qb[ks], sb); }
#pragma unroll
        for (int e = 0; e < 4; ++e) { const int ii = 16 * ib + li, jj = 16 * jb + 4 * g + e; P[jb][e] = (ii >= jj) ? sf[e] : sb[e]; } }
    if (MK_DIAG) { bool bad = false;
#pragma unroll
        for (int jb = 0; jb < 4; ++jb)
#pragma unroll
            for (int e = 0; e < 4; ++e) bad |= !(fabsf(P[jb][e]) < 1e30f);
        if (bad) atomicOr((unsigned*)(a.ws + WS_CTL) + 17, 1u << 4); }
    const bf16x8 Pb0 = pack8(P[0], P[1]), Pb1 = pack8(P[2], P[3]);
    bf16* op = OUT + (m0 + 16 * ib + li) * 4096 + h * 512 + vh * 256 + 4 * g;
    const LAS unsigned char* vb = vT + (4 * g + q4) * GLA_PVI + (vh * 256 + 4 * p4) * 2;
#pragma unroll
    for (int vt = 0; vt < 16; ++vt) { f32x4 acc = {0.f, 0.f, 0.f, 0.f};
        acc = MFMA16(cat8(tr4(vb + 32 * vt), tr4(vb + 16 * GLA_PVI + 32 * vt)), Pb0, acc);
        acc = MFMA16(cat8(tr4(vb + 32 * GLA_PVI + 32 * vt), tr4(vb + 48 * GLA_PVI + 32 * vt)), Pb1, acc);
        if (MK_DIAG && (!(fabsf(acc[0]) < 1e30f) || !(fabsf(acc[1]) < 1e30f) || !(fabsf(acc[2]) < 1e30f) || !(fabsf(acc[3]) < 1e30f))) atomicOr((unsigned*)(a.ws + WS_CTL) + 17, 1u << 5);
        *(GAS v2u*)(op + 16 * vt) = (v2u){cvt_pk_bf16(acc[0], acc[1]), cvt_pk_bf16(acc[2], acc[3])}; }
    __syncthreads();
}
__device__ __forceinline__ void gla_main_phase(Frame& F, const Args& a) {
    for (int ch = F.vcu; ch < 256; ch += F.G) gla_chain_role(F, a, ch);
    for (int it = F.vcu; it < 2048; it += F.G) gla_intra_role(F, a, it);
}
__device__ __forceinline__ void gla_combine_phase(Frame& F, const Args& a) {
    const bf16* IN = (const bf16*)(a.ws + WS_GLA_IN); const bf16* O = (const bf16*)(a.ws + WS_GLA_O); bf16* Z = (bf16*)(a.ws + WS_GLA_Z);
    const float* nw = a.in[30];
    float nwr[8];
#pragma unroll
    for (int x = 0; x < 8; ++x) nwr[x] = nw[F.lane * 8 + x];
    const int gw = F.vcu * NWAVES + F.wave, NGW = F.G * NWAVES;
    for (int m = gw; m < M; m += NGW) {
#pragma unroll 2
        for (int h = 0; h < 8; ++h) { const size_t off = (size_t)m * 4096 + h * 512 + F.lane * 8;
            const v4u x0 = *(const GAS v4u*)(O + off), x1 = *(const GAS v4u*)(O + (size_t)M * 4096 + off), x2 = *(const GAS v4u*)(O + (size_t)2 * M * 4096 + off);
            const v4u gg = *(const GAS v4u*)(IN + (size_t)m * GLA_NIN + 8192 + h * 512 + F.lane * 8);
            if (MK_DIAG) { bool b0 = false, b1 = false, b2 = false, b3 = false;
#pragma unroll
                for (int x = 0; x < 4; ++x) { b0 |= !(fabsf(bf_lo(x0[x])) < 1e30f) || !(fabsf(bf_hi(x0[x])) < 1e30f); b1 |= !(fabsf(bf_lo(x1[x])) < 1e30f) || !(fabsf(bf_hi(x1[x])) < 1e30f);
                    b2 |= !(fabsf(bf_lo(x2[x])) < 1e30f) || !(fabsf(bf_hi(x2[x])) < 1e30f); b3 |= !(fabsf(bf_lo(gg[x])) < 1e30f) || !(fabsf(bf_hi(gg[x])) < 1e30f); }
                const unsigned f = (b0 ? 1024u : 0u) | (b1 ? 2048u : 0u) | (b2 ? 4096u : 0u) | (b3 ? 8192u : 0u); if (f) atomicOr((unsigned*)(a.ws + WS_CTL) + 17, f); }
            float o[8]; float ss = 0.f;
#pragma unroll
            for (int x = 0; x < 4; ++x) { o[2 * x] = bf_lo(x0[x]) + bf_lo(x1[x]) + bf_lo(x2[x]); o[2 * x + 1] = bf_hi(x0[x]) + bf_hi(x1[x]) + bf_hi(x2[x]); ss += o[2 * x] * o[2 * x] + o[2 * x + 1] * o[2 * x + 1]; }
            const float rstd = rsqrtf(wave_sum(ss) * (1.0f / 512.0f) + EPS);
            v4u zw;
#pragma unroll
            for (int x = 0; x < 4; ++x) zw[x] = cvt_pk_bf16(o[2 * x] * rstd * nwr[2 * x] * siluf_(bf_lo(gg[x])), o[2 * x + 1] * rstd * nwr[2 * x + 1] * siluf_(bf_hi(gg[x])));
            *(GAS v4u*)(Z + off) = zw; }
    }
}

constexpr int NPH = 23;
__global__ void __launch_bounds__(NWAVES * 64, 2) fwd_kernel(Args args) {
    extern __shared__ __attribute__((aligned(16))) unsigned char lds[];
    Frame F;
    F.lds = (LAS unsigned char*)lds;
    F.tid = threadIdx.x; F.lane = F.tid & 63; F.wave = __builtin_amdgcn_readfirstlane(F.tid >> 6);
    F.G = gridDim.x; { const int bx = blockIdx.x; F.vcu = (F.G % 8 == 0) ? (bx % 8) * (F.G / 8) + bx / 8 : bx; }
    volatile LAS unsigned* MISC = (volatile LAS unsigned*)(F.lds + MISC_OFF);
    for (int u = F.tid; u < (LDS_BYTES - MISC_OFF) / 4; u += NWAVES * 64) MISC[u] = 0u;
    __syncthreads();
    unsigned char* ws = args.ws;
    const int lo = args.ph_lo, hi = args.ph_hi, rep = args.dup;
    XcdBarrier bar; bar.bar = (unsigned*)(ws + WS_CTL) + CW_BAR; bar.x = 0; bar.st = nullptr;
    if (hi - lo > 1) bar = xcd_barrier_post((unsigned*)(ws + WS_CTL) + CW_BAR, MISC + 8);
#define IN(k) (lo <= (k) && (k) < hi)
#define REP(k)
#if MK_PROF
    volatile LAS unsigned long long* PROF = (volatile LAS unsigned long long*)(F.lds + 135168);
    if (F.tid == 0) PROF[0] = __builtin_amdgcn_s_memrealtime();
#define SEAM(k) do { if (IN(k) && IN((k) + 1)) { if (F.tid == 0) PROF[32 + (k)] = __builtin_amdgcn_s_memrealtime(); xcd_barrier(bar); if (F.tid == 0) PROF[1 + (k)] = __builtin_amdgcn_s_memrealtime(); } } while (0)
#else
#define SEAM(k) do { if (IN(k) && IN((k) + 1)) xcd_barrier(bar); } while (0)
#endif
    const float* MOD = (const float*)(ws + WS_MOD);
    bf16* H = (bf16*)(ws + WS_H);
    float* XO = args.out;
    LAS unsigned char* ring = F.lds + RING_OFF;
    unsigned* const DFLAG = (unsigned*)(ws + WS_CTL) + 16;

    if (IN(0)) { REP(0) { p0_prologue(F, args); } } SEAM(0);

#if MK_NLAYERS >= 1
    if (IN(1)) { REP(1) { norm_phase<false>(F, args.in[0], args.in[4] + 0 * D, MOD + 0 * 2 * 12288, H, nullptr); } } SEAM(1);
    if (IN(2)) { REP(2) { pg8::Gemm g{H, (const bf16*)(ws + WS_W_NAIN0), 4096, 4096, 4096, DFLAG, 1u << 2}; pg8::StaticOrder S; S.init(M, 16384, F.G, (int)blockIdx.x);
        pg8::EpiNaIn E{(bf16*)(ws + WS_NA_QKVG)};
        pg8::gemm_phase<pg8::EpiNaIn, pg8::StaticOrder, false, true>(ring, g, S, E); } } SEAM(2);
    if (IN(3)) { REP(3) na_attn_phase2(F, (const bf16*)(ws + WS_NA_QKVG), (bf16*)(ws + WS_NA_Z), args.in[6] + 0 * 32 * 465); } SEAM(3);
    if (IN(4)) { REP(4) { pg8::Gemm g{(const bf16*)(ws + WS_NA_Z), (const bf16*)(ws + WS_W_NAOUT0), 4096, 4096, 4096, DFLAG, 1u << 4}; pg8::StaticOrder S; S.init(M, 4096, F.G, (int)blockIdx.x);
        pg8::EpiResid E{args.in[0], rep ? (float*)(ws + WS_SCR) : XO, D, MOD + 0 * 2 * 12288 + 8192, 12288, SEQ};
        pg8::gemm_phase<pg8::EpiResid, pg8::StaticOrder, true, true>(ring, g, S, E); } } SEAM(4);
#endif
#if MK_NLAYERS >= 2
    if (IN(5)) { REP(5) { norm_phase<false>(F, XO, args.in[4] + 1 * D, MOD + 1 * 2 * 12288, H, nullptr); } } SEAM(5);
    if (IN(6)) { REP(6) { pg8::Gemm g{H, (const bf16*)(ws + WS_W_S5IN), 4096, 4096, 4096, DFLAG, 1u << 6}; pg8::StaticOrder S; S.init(M, 8192, F.G, (int)blockIdx.x);
        pg8::EpiS5In<S5_T, S5_NCH, S5_KY> E{(bf16*)(ws + WS_S5_UG), (bf16*)(ws + WS_S5_GS)};
        pg8::gemm_phase<pg8::EpiS5In<S5_T, S5_NCH, S5_KY>, pg8::StaticOrder, true, true>(ring, g, S, E); } } SEAM(6);
    if (IN(7)) { REP(7) { pg8::Gemm g{(const bf16*)(ws + WS_S5_UG), (const bf16*)(ws + WS_S5BS), S5_KS, S5_KY, S5_KS, DFLAG, 1u << 7}; pg8::BatchedOrder S; S.init(S5_G, S5_NCH / 256, 1, F.G, (int)blockIdx.x);
        pg8::EpiF32 E{(float*)(ws + WS_S5_SLOC), 256};
        pg8::gemm_phase<pg8::EpiF32, pg8::BatchedOrder, true, true>(ring, g, S, E); } } SEAM(7);
    if (IN(8)) { REP(8) { s5_scan_phase(F, args); } } SEAM(8);
    if (IN(9)) { REP(9) { pg8::Gemm g{(const bf16*)(ws + WS_S5_UG), (const bf16*)(ws + WS_S5BY), S5_KY, S5_KY, S5_KY, DFLAG, 1u << 9}; pg8::BatchedOrder S; S.init(S5_G, S5_NCH / 256, S5_KS / 256, F.G, (int)blockIdx.x);
        pg8::EpiS5Y<S5_T, S5_NCH / 256> E{(bf16*)(ws + WS_S5_Y)};
        pg8::gemm_phase<pg8::EpiS5Y<S5_T, S5_NCH / 256>, pg8::BatchedOrder, true, true>(ring, g, S, E); } } SEAM(9);
    if (IN(10)) { REP(10) { pg8::Gemm g{(const bf16*)(ws + WS_S5_Y), (const bf16*)(ws + WS_W_S5GLU), 4096, 4096, 4096, DFLAG, 1u << 10}; pg8::StaticOrder S; S.init(M, 4096, F.G, (int)blockIdx.x);
        pg8::EpiGlu E{(const bf16*)(ws + WS_S5_Y), (const bf16*)(ws + WS_S5_GS), args.in[21], (bf16*)(ws + WS_S5_Z)};
        pg8::gemm_phase<pg8::EpiGlu, pg8::StaticOrder, true, true>(ring, g, S, E); } } SEAM(10);
    if (IN(11)) { REP(11) { pg8::Gemm g{(const bf16*)(ws + WS_S5_Z), (const bf16*)(ws + WS_W_S5OUT), 4096, 4096, 4096, DFLAG, 1u << 11}; pg8::StaticOrder S; S.init(M, 4096, F.G, (int)blockIdx.x);
        pg8::EpiResid E{XO, rep ? (float*)(ws + WS_SCR) : XO, D, MOD + 1 * 2 * 12288 + 8192, 12288, SEQ};
        pg8::gemm_phase<pg8::EpiResid, pg8::StaticOrder, true, true>(ring, g, S, E); } } SEAM(11);
#endif
#if MK_NLAYERS >= 3
    if (IN(12)) { REP(12) { norm_phase<false>(F, XO, args.in[4] + 2 * D, MOD + 2 * 2 * 12288, H, nullptr); } } SEAM(12);
    if (IN(13)) { REP(13) { { pg8::Gemm g{H, (const bf16*)(ws + WS_W_GLAIN), 4096, 4096, 4096, DFLAG, 1u << 13}; pg8::StaticOrder S; S.init(M, GLA_NIN, F.G, (int)blockIdx.x);
          pg8::EpiBf16 E{(bf16*)(ws + WS_GLA_IN), GLA_NIN};
          pg8::gemm_phase<pg8::EpiBf16, pg8::StaticOrder, true, true>(ring, g, S, E); }
        { pg8::Gemm g{H, (const bf16*)(ws + WS_W_GLAG1), 1024, 4096, 4096, DFLAG, 1u << 13}; pg8::SplitKOrder S; S.init(M, 4, 1024, F.G, (int)blockIdx.x);
          pg8::EpiGate E{(float*)(ws + WS_GLA_G1P), M};
          pg8::gemm_phase<pg8::EpiGate, pg8::SplitKOrder, true, true>(ring, g, S, E); } } } SEAM(13);
    if (IN(14)) { REP(14) { gla_prep_phase(F, args); } } SEAM(14);
    if (IN(15)) { REP(15) { gla_main_phase(F, args); } } SEAM(15);
    if (IN(16)) { REP(16) { gla_combine_phase(F, args); } } SEAM(16);
    if (IN(17)) { REP(17) { pg8::Gemm g{(const bf16*)(ws + WS_GLA_Z), (const bf16*)(ws + WS_W_GLAOUT), 4096, 4096, 4096, DFLAG, 1u << 17}; pg8::StaticOrder S; S.init(M, 4096, F.G, (int)blockIdx.x);
        pg8::EpiResid E{XO, rep ? (float*)(ws + WS_SCR) : XO, D, MOD + 2 * 2 * 12288 + 8192, 12288, SEQ};
        pg8::gemm_phase<pg8::EpiResid, pg8::StaticOrder, true, true>(ring, g, S, E); } } SEAM(17);
#endif
#if MK_NLAYERS >= 4
    if (IN(18)) { REP(18) { norm_phase<false>(F, XO, args.in[4] + 3 * D, MOD + 3 * 2 * 12288, H, nullptr); } } SEAM(18);
    if (IN(19)) { REP(19) { pg8::Gemm g{H, (const bf16*)(ws + WS_W_NAIN1), 4096, 4096, 4096, DFLAG, 1u << 19}; pg8::StaticOrder S; S.init(M, 16384, F.G, (int)blockIdx.x);
        pg8::EpiNaIn E{(bf16*)(ws + WS_NA_QKVG)};
        pg8::gemm_phase<pg8::EpiNaIn, pg8::StaticOrder, false, true>(ring, g, S, E); } } SEAM(19);
    if (IN(20)) { REP(20) na_attn_phase2(F, (const bf16*)(ws + WS_NA_QKVG), (bf16*)(ws + WS_NA_Z), args.in[6] + 1 * 32 * 465); } SEAM(20);
    if (IN(21)) { REP(21) { pg8::Gemm g{(const bf16*)(ws + WS_NA_Z), (const bf16*)(ws + WS_W_NAOUT1), 4096, 4096, 4096, DFLAG, 1u << 21}; pg8::StaticOrder S; S.init(M, 4096, F.G, (int)blockIdx.x);
        pg8::EpiResid E{XO, rep ? (float*)(ws + WS_SCR) : XO, D, MOD + 3 * 2 * 12288 + 8192, 12288, SEQ};
        pg8::gemm_phase<pg8::EpiResid, pg8::StaticOrder, true, true>(ring, g, S, E); } } SEAM(21);
#endif
    if (IN(22)) { REP(22) norm_phase<true>(F, (MK_NLAYERS >= 1) ? (const float*)XO : args.in[0], args.in[32], nullptr, nullptr, XO); }
#if MK_DIAG
    if (IN(22)) { __syncthreads(); const unsigned f = __hip_atomic_load(DFLAG, __ATOMIC_RELAXED, __HIP_MEMORY_SCOPE_AGENT);
        const unsigned f2 = __hip_atomic_load(DFLAG + 1, __ATOMIC_RELAXED, __HIP_MEMORY_SCOPE_AGENT);
        if (f != 0u || f2 != 0u) { const int k = f2 ? (24 + __builtin_ctz(f2)) : __builtin_ctz(f); float mk = 10.f; for (int i = 0; i < k; ++i) mk *= 10.f;
            const int gw = F.vcu * NWAVES + F.wave, NGW = F.G * NWAVES;
            for (int m = gw; m < M; m += NGW) for (int j = 0; j < 16; ++j) *((GAS f32x4*)(XO + (size_t)m * D) + F.lane + 64 * j) = (f32x4){mk, mk, mk, mk}; }
        else { const int gw = F.vcu * NWAVES + F.wave, NGW = F.G * NWAVES;
            for (int m = gw; m < M; m += NGW) for (int j = 0; j < 16; ++j) { GAS f32x4* p = (GAS f32x4*)(XO + (size_t)m * D) + F.lane + 64 * j; f32x4 v = *p; bool ch = false;
                for (int e = 0; e < 4; ++e) if (!(__builtin_fabsf(v[e]) < 3.0e38f)) { v[e] = 3.0e30f; ch = true; } if (ch) *p = v; } } }
#endif
#if MK_PROF
    if (F.tid == 0) PROF[32 + 22] = __builtin_amdgcn_s_memrealtime();
    xcd_barrier(bar);
    if (F.tid == 0) PROF[1 + 22] = __builtin_amdgcn_s_memrealtime();
    __syncthreads();
    if (blockIdx.x == 0) {
        float d[23], w[23];
        for (int k = 0; k < 23; ++k) { d[k] = (float)(PROF[1 + k] - PROF[k]) * 0.01f; w[k] = (float)(PROF[1 + k] - PROF[32 + k]) * 0.01f; }
        (void)w;
        const float A = (float)(MK_PROF_A) * 1.0e4f, B = (float)(MK_PROF_B) * 1.0e3f;
        for (size_t i = F.tid; i < (size_t)M * D; i += NWAVES * 64) XO[i] = (i == 0) ? A : B;
    }
#endif
#undef IN
#undef REP
#undef SEAM
}

extern "C" void kernel_launch(void* const* d_in, const int* in_sizes, int n_in, void* d_out, int out_size, void* d_ws, size_t ws_size, hipStream_t stream) {
    static int grid = 0;
    if (grid == 0) {
        if (n_in != 33 || in_sizes[0] != M * D || out_size != M * D || ws_size < WS_END) {
            fprintf(stderr, "kernel_launch: built for 33 inputs, x/out of %d floats, >= %zu bytes of workspace; got n_in %d, in0 %d, out %d, ws %zu; nothing launched\n", M * D, (size_t)WS_END, n_in, n_in > 0 ? in_sizes[0] : -1, out_size, ws_size);
            grid = -1; return; }
        int dev = 0, cus = 0, per_cu = 0;
        if (hipGetDevice(&dev) != hipSuccess || hipDeviceGetAttribute(&cus, hipDeviceAttributeMultiprocessorCount, dev) != hipSuccess) { fprintf(stderr, "kernel_launch: device query failed\n"); grid = -1; return; }
        if (hipFuncSetAttribute((const void*)fwd_kernel, hipFuncAttributeMaxDynamicSharedMemorySize, LDS_BYTES) != hipSuccess) { fprintf(stderr, "kernel_launch: hipFuncSetAttribute failed\n"); grid = -1; return; }
        if (hipOccupancyMaxActiveBlocksPerMultiprocessor(&per_cu, (const void*)fwd_kernel, NWAVES * 64, LDS_BYTES) != hipSuccess || per_cu < 1)
            fprintf(stderr, "kernel_launch: note: occupancy query reports %d workgroups per CU\n", per_cu);
        (void)hipGetLastError();
        grid = cus;
        if (grid != 256) fprintf(stderr, "kernel_launch: note: %d CUs (tuned for 256)\n", grid);
        if (grid < 136) { fprintf(stderr, "kernel_launch: needs >= 136 CUs\n"); grid = -1; return; }
    }
    if (grid < 0) return;
    if (hipMemsetAsync((char*)d_ws + WS_CTL, 0, CTL_ZERO_BYTES, stream) != hipSuccess) { fprintf(stderr, "kernel_launch: memset failed\n"); return; }
    Args a{};
    for (int i = 0; i < 33; ++i) a.in[i] = (const float*)d_in[i];
    a.out = (float*)d_out; a.ws = (unsigned char*)d_ws;
#if MK_ONE_LAUNCH
    a.ph_lo = 0; a.ph_hi = NPH;
    hipLaunchKernelGGL(fwd_kernel, dim3(grid), dim3(NWAVES * 64), LDS_BYTES, stream, a);
#else
    for (int ph = 0; ph < NPH; ++ph) { a.ph_lo = ph; a.ph_hi = ph + 1; a.dup = 0;
        hipLaunchKernelGGL(fwd_kernel, dim3(grid), dim3(NWAVES * 64), LDS_BYTES, stream, a);
        if ((MK_DUP >> ph) & 1u) { a.dup = 1; hipLaunchKernelGGL(fwd_kernel, dim3(grid), dim3(NWAVES * 64), LDS_BYTES, stream, a); } }
#endif
    const hipError_t le = hipPeekAtLastError();
    if (le != hipSuccess) fprintf(stderr, "kernel_launch: launch failed: %s\n", hipGetErrorName(le));
}
```

```cpp
#include <hip/hip_runtime.h>
#include <cstdio>
#include <cstdint>

#ifndef MK_ONE_LAUNCH
#define MK_ONE_LAUNCH 1
#endif
#ifndef MK_DIAG
#define MK_DIAG 0
#endif
#ifndef MK_PROF
#define MK_PROF 0
#endif
#define MK_PROF_A (d[2]+d[19]+d[4]+d[21]+d[6]+d[10]+d[11]+d[13]+d[17])
#define MK_PROF_B (d[0])
#ifndef MK_DUP
#define MK_DUP 0u
#endif
#ifndef MK_NLAYERS
#define MK_NLAYERS 4
#endif

namespace pg8 {
#define PG8_LAS __attribute__((address_space(3)))
typedef unsigned short bf16_t;
typedef short bf16x8 __attribute__((ext_vector_type(8)));
typedef float f32x4 __attribute__((ext_vector_type(4)));
typedef unsigned u32x4 __attribute__((ext_vector_type(4)));
typedef unsigned u32x2 __attribute__((ext_vector_type(2)));
constexpr int BM = 256, BK = 64, HALF = 128, HTB = HALF * BK * 2  , STAGE_BYTES = 8 * HTB, NXCD = 8, WGM = 8;

__host__ __device__ __forceinline__ int lds_byte(int r, int c) { const int st = (r >> 4) * 2 + (c >> 5), rr = r & 15, cc = c & 31, ob = rr * 64 + cc * 2; return st * 1024 + (ob ^ (((ob >> 9) & 1) << 5)); }
__host__ __device__ __forceinline__ void stage_rc(int b, int& R, int& C) { const int st = b / 1024, sb = b % 1024, swz = sb ^ (((sb >> 9) & 1) << 5); R = (st >> 1) * 16 + swz / 64; C = (st & 1) * 32 + (swz % 64) / 2; }
__host__ __device__ __forceinline__ int perm32(int rho) { const int n = rho >> 4, i = rho & 15; return 8 * (i >> 2) + 4 * n + (i & 3); }

struct Unit { int pm, pn, pb, koff; };
struct Gemm { const bf16_t* A; const bf16_t* Bt; int K, lda, ldb; unsigned* dflag; unsigned dbit; };

struct StaticOrder {
    int nM, nN, nwg, G, c;
    __host__ __device__ void init(int M, int N, int G_, int c_) { nM = M / BM; nN = N / BM; nwg = nM * nN; G = G_; c = c_; }
    __host__ __device__ bool next(int i, Unit& u) const {
        const long L = (long)i * G + c; if (L >= nwg) return false;
        int wgid = (int)L; { const int q = nwg / NXCD, r = nwg % NXCD, xcd = wgid % NXCD, off = wgid / NXCD; wgid = (xcd < r ? xcd * (q + 1) : r * (q + 1) + (xcd - r) * q) + off; }
        const int nig = WGM * nN, gid = wgid / nig, fm = gid * WGM, gsz = (nM - fm) < WGM ? (nM - fm) : WGM;
        u.pm = fm + ((wgid % nig) % gsz); u.pn = (wgid % nig) / gsz; u.pb = u.pn; u.koff = 0; return true;
    }
    __device__ __forceinline__ void a_ready(const Unit&) const {}
    __device__ __forceinline__ void done(const Unit&) const {}
};
struct BatchedOrder {
    int nPm, nPn, total, G, c;
    __host__ __device__ void init(int ngroups, int nPm_, int nPn_, int G_, int c_) { nPm = nPm_; nPn = nPn_; total = ngroups * nPm * nPn; G = G_; c = c_; }
    __host__ __device__ bool next(int i, Unit& u) const {
        long L = (long)i * G + c; if (L >= total) return false;
        const int upg = nPm * nPn;
        if (G % 8 == 0 && (G / 8) % upg == 0 && total % G == 0) {
            const int x = c % 8, q = c / 8, gpx = (G / 8) / upg;
            L = ((long)(i * 8 + x) * gpx + q / upg) * upg + q % upg; }
        const int g = (int)L / upg, rem = (int)L % upg, pmi = rem / nPn, pni = rem % nPn;
        u.pm = g * nPm + pmi; u.pn = pni; u.pb = g * nPn + pni; u.koff = 0; return true;
    }
    __device__ __forceinline__ void a_ready(const Unit&) const {}
    __device__ __forceinline__ void done(const Unit&) const {}
};
struct SplitKOrder {
    int nM, nsplit, kslice, G, c;
    __host__ __device__ void init(int M, int nsplit_, int kslice_, int G_, int c_) { nM = M / BM; nsplit = nsplit_; kslice = kslice_; G = G_; c = c_; }
    __host__ __device__ bool next(int i, Unit& u) const {
        const long L = (long)i * G + c; if (L >= (long)nM * nsplit) return false;
        u.pm = (int)L / nsplit; u.pn = (int)L % nsplit; u.pb = 0; u.koff = u.pn * kslice; return true;
    }
    __device__ __forceinline__ void a_ready(const Unit&) const {}
    __device__ __forceinline__ void done(const Unit&) const {}
};

typedef float f32x2_t __attribute__((ext_vector_type(2))); typedef __bf16 bf16x2_t __attribute__((ext_vector_type(2)));
__device__ __forceinline__ unsigned cvt_pk_bf16(float lo, float hi) { f32x2_t v = {lo, hi}; bf16x2_t b = __builtin_convertvector(v, bf16x2_t); return __builtin_bit_cast(unsigned, b); }
__device__ __forceinline__ float bf_lo(unsigned w) { return __uint_as_float(w << 16); }
__device__ __forceinline__ float bf_hi(unsigned w) { return __uint_as_float(w & 0xffff0000u); }
__device__ __forceinline__ float sigmoidf_(float x) { return __builtin_amdgcn_rcpf(1.0f + __expf(-x)); }
__device__ __forceinline__ float siluf_(float x) { return x * __builtin_amdgcn_rcpf(1.0f + __expf(-x)); }
__device__ __forceinline__ float gelu_tanh(float x) { const float z = 0.7978845608028654f * (x + 0.044715f * x * x * x); return x * __builtin_amdgcn_rcpf(1.0f + __expf(-2.0f * z)); }

struct EpiBf16 {
    static constexpr bool PERM = true, AFTER_DRAIN = false;
    bf16_t* O; int ldc;
    __device__ __forceinline__ void operator()(const f32x4 (&acc)[2][2][4][2], const Unit& u, int wr, int wc, int fr, int fq) const {
        const int row0 = u.pm * BM + wr * 64 + fr, col0 = u.pn * BM + wc * 32 + 8 * fq;
#pragma unroll
        for (int ai = 0; ai < 2; ++ai)
#pragma unroll
            for (int m = 0; m < 4; ++m) { bf16_t* rowp = O + (size_t)(row0 + ai * HALF + m * 16) * ldc + col0;
#pragma unroll
                for (int bj = 0; bj < 2; ++bj) { const f32x4 v0 = acc[ai][bj][m][0], v1 = acc[ai][bj][m][1];
                    u32x4 w; w.x = cvt_pk_bf16(v0[0], v0[1]); w.y = cvt_pk_bf16(v0[2], v0[3]); w.z = cvt_pk_bf16(v1[0], v1[1]); w.w = cvt_pk_bf16(v1[2], v1[3]);
                    *(u32x4*)(rowp + bj * HALF) = w; } }
    }
};
struct EpiNaIn {
    static constexpr bool PERM = true, AFTER_DRAIN = false;
    bf16_t* O;
    __device__ __forceinline__ void operator()(const f32x4 (&acc)[2][2][4][2], const Unit& u, int wr, int wc, int fr, int fq) const {
        const int row0 = u.pm * BM + wr * 64 + fr, col0 = u.pn * BM + wc * 32 + 8 * fq;
#pragma unroll
        for (int ai = 0; ai < 2; ++ai)
#pragma unroll
            for (int m = 0; m < 4; ++m) { const int row = row0 + ai * HALF + m * 16, b = row >> 13, l = row & 8191;
#pragma unroll
                for (int bj = 0; bj < 2; ++bj) { const f32x4 v0 = acc[ai][bj][m][0], v1 = acc[ai][bj][m][1]; const int n = col0 + bj * HALF, sec = n >> 12, hd = (n >> 7) & 31, d = n & 127;
                    u32x4 w; w.x = cvt_pk_bf16(v0[0], v0[1]); w.y = cvt_pk_bf16(v0[2], v0[3]); w.z = cvt_pk_bf16(v1[0], v1[1]); w.w = cvt_pk_bf16(v1[2], v1[3]);
                    *(u32x4*)(O + ((size_t)((sec * 2 + b) * 32 + hd) * 8192 + l) * 128 + d) = w; } }
    }
};
struct EpiResid {
    static constexpr bool PERM = false, AFTER_DRAIN = false;
    const float* base; float* out; int ldc; const float* gate0; int gate_stride; int rows_per_batch;
    __device__ __forceinline__ void operator()(const f32x4 (&acc)[2][2][4][2], const Unit& u, int wr, int wc, int fr, int fq) const {
        const int row0 = u.pm * BM + wr * 64 + fr, col0 = u.pn * BM + wc * 32 + 4 * fq;
        const float* gp = gate0 + (size_t)((u.pm * BM) / rows_per_batch) * gate_stride + col0;
        f32x4 gv[2][2];
#pragma unroll
        for (int bj = 0; bj < 2; ++bj)
#pragma unroll
            for (int n = 0; n < 2; ++n) gv[bj][n] = *(const f32x4*)(gp + bj * HALF + n * 16);
#pragma unroll
        for (int ai = 0; ai < 2; ++ai)
#pragma unroll
            for (int m = 0; m < 4; ++m) { const size_t off = (size_t)(row0 + ai * HALF + m * 16) * ldc + col0;
#pragma unroll
                for (int bj = 0; bj < 2; ++bj)
#pragma unroll
                    for (int n = 0; n < 2; ++n) { const f32x4 bs = *(const f32x4*)(base + off + bj * HALF + n * 16);
                        *(f32x4*)(out + off + bj * HALF + n * 16) = bs + gv[bj][n] * acc[ai][bj][m][n]; }
                if (m & 1) asm volatile("" ::: "memory"); }
    }
};
struct EpiF32 {
    static constexpr bool PERM = false, AFTER_DRAIN = false;
    float* C; int ldc;
    __device__ __forceinline__ void operator()(const f32x4 (&acc)[2][2][4][2], const Unit& u, int wr, int wc, int fr, int fq) const {
        const int row0 = u.pm * BM + wr * 64 + fr, col0 = u.pn * BM + wc * 32 + 4 * fq;
#pragma unroll
        for (int ai = 0; ai < 2; ++ai)
#pragma unroll
            for (int m = 0; m < 4; ++m) { float* rowp = C + (size_t)(row0 + ai * HALF + m * 16) * ldc + col0;
#pragma unroll
                for (int bj = 0; bj < 2; ++bj)
#pragma unroll
                    for (int n = 0; n < 2; ++n) *(f32x4*)(rowp + bj * HALF + n * 16) = acc[ai][bj][m][n]; }
    }
};
struct EpiGate {
    static constexpr bool PERM = false, AFTER_DRAIN = false;
    float* P; int rows;
    __device__ __forceinline__ void operator()(const f32x4 (&acc)[2][2][4][2], const Unit& u, int wr, int wc, int fr, int fq) const {
        if (wc != 0) return;
        const int row0 = u.pm * BM + wr * 64 + fr;
#pragma unroll
        for (int ai = 0; ai < 2; ++ai)
#pragma unroll
            for (int m = 0; m < 4; ++m) { float* rowp = P + ((size_t)u.pn * rows + (row0 + ai * HALF + m * 16)) * 32 + 4 * fq;
#pragma unroll
                for (int n = 0; n < 2; ++n) *(f32x4*)(rowp + n * 16) = acc[ai][0][m][n]; }
    }
};
template <int T, int NCH, int KY> struct EpiS5In {
    static constexpr bool PERM = true, AFTER_DRAIN = false;
    bf16_t* Ug; bf16_t* Gs;
    __device__ __forceinline__ void operator()(const f32x4 (&acc)[2][2][4][2], const Unit& u, int wr, int wc, int fr, int fq) const {
        const int row0 = u.pm * BM + wr * 64 + fr, col0 = u.pn * BM + wc * 32 + 8 * fq;
#pragma unroll
        for (int ai = 0; ai < 2; ++ai)
#pragma unroll
            for (int m = 0; m < 4; ++m) { const int row = row0 + ai * HALF + m * 16;
#pragma unroll
                for (int bj = 0; bj < 2; ++bj) { const f32x4 v0 = acc[ai][bj][m][0], v1 = acc[ai][bj][m][1]; const int col = col0 + bj * HALF;
                    u32x4 w; w.x = cvt_pk_bf16(v0[0], v0[1]); w.y = cvt_pk_bf16(v0[2], v0[3]); w.z = cvt_pk_bf16(v1[0], v1[1]); w.w = cvt_pk_bf16(v1[2], v1[3]);
                    if (col < 4096) { const int g = col >> 4, i0 = col & 15, chunk = row / T, t = row % T;
                        *(u32x4*)(Ug + ((size_t)g * NCH + chunk) * KY + t * 16 + i0) = w; }
                    else *(u32x4*)(Gs + (size_t)row * 4096 + (col - 4096)) = w; } }
    }
};
template <int T, int NPM> struct EpiS5Y {
    static constexpr bool PERM = true, AFTER_DRAIN = false;
    bf16_t* Y;
    __device__ __forceinline__ void operator()(const f32x4 (&acc)[2][2][4][2], const Unit& u, int wr, int wc, int fr, int fq) const {
        const int g = u.pm / NPM, chunk0 = (u.pm % NPM) * BM + wr * 64 + fr, col0 = u.pn * BM + wc * 32 + 8 * fq;
#pragma unroll
        for (int ai = 0; ai < 2; ++ai)
#pragma unroll
            for (int m = 0; m < 4; ++m) { const int chunk = chunk0 + ai * HALF + m * 16;
#pragma unroll
                for (int bj = 0; bj < 2; ++bj) { f32x4 v0 = acc[ai][bj][m][0], v1 = acc[ai][bj][m][1]; const int n = col0 + bj * HALF, t = n >> 4, i0 = n & 15;
#pragma unroll
                    for (int j = 0; j < 4; ++j) { v0[j] = gelu_tanh(v0[j]); v1[j] = gelu_tanh(v1[j]); }
                    u32x4 w; w.x = cvt_pk_bf16(v0[0], v0[1]); w.y = cvt_pk_bf16(v0[2], v0[3]); w.z = cvt_pk_bf16(v1[0], v1[1]); w.w = cvt_pk_bf16(v1[2], v1[3]);
                    *(u32x4*)(Y + (size_t)(chunk * T + t) * 4096 + g * 16 + i0) = w; } }
    }
};
struct EpiGlu {
    static constexpr bool PERM = true, AFTER_DRAIN = false;
    const bf16_t* Y; const bf16_t* Gs; const float* bias; bf16_t* Z;
    __device__ __forceinline__ void operator()(const f32x4 (&acc)[2][2][4][2], const Unit& u, int wr, int wc, int fr, int fq) const {
        const int row0 = u.pm * BM + wr * 64 + fr, col0 = u.pn * BM + wc * 32 + 8 * fq;
        f32x4 bv[2][2];
#pragma unroll
        for (int bj = 0; bj < 2; ++bj)
#pragma unroll
            for (int n = 0; n < 2; ++n) bv[bj][n] = *(const f32x4*)(bias + col0 + bj * HALF + 4 * n);
#pragma unroll
        for (int ai = 0; ai < 2; ++ai)
#pragma unroll
            for (int m = 0; m < 4; ++m) { const size_t off = (size_t)(row0 + ai * HALF + m * 16) * 4096 + col0;
#pragma unroll
                for (int bj = 0; bj < 2; ++bj) { const u32x4 yw = *(const u32x4*)(Y + off + bj * HALF), gw = *(const u32x4*)(Gs + off + bj * HALF);
                    const f32x4 a0 = acc[ai][bj][m][0] + bv[bj][0], a1 = acc[ai][bj][m][1] + bv[bj][1];
                    float o[8];
#pragma unroll
                    for (int j = 0; j < 4; ++j) { const unsigned yj = yw[j], gj = gw[j];
                        const float aa = (j < 2) ? a0[2 * j] : a1[2 * j - 4], ab = (j < 2) ? a0[2 * j + 1] : a1[2 * j - 3];
                        o[2 * j] = bf_lo(yj) * sigmoidf_(aa) * siluf_(bf_lo(gj)); o[2 * j + 1] = bf_hi(yj) * sigmoidf_(ab) * siluf_(bf_hi(gj)); }
                    u32x4 w; w.x = cvt_pk_bf16(o[0], o[1]); w.y = cvt_pk_bf16(o[2], o[3]); w.z = cvt_pk_bf16(o[4], o[5]); w.w = cvt_pk_bf16(o[6], o[7]);
                    *(u32x4*)(Z + off + bj * HALF) = w; }
                asm volatile("" ::: "memory"); }
    }
};

template <class Epi, class Sched, bool ALIGN_EPI = false, bool SP2 = false>
__device__ __forceinline__ void gemm_phase(PG8_LAS unsigned char* lds, const Gemm g, const Sched& S, const Epi& E) {
    const int tid = threadIdx.x, wid = __builtin_amdgcn_readfirstlane(tid >> 6), lane = tid & 63, wr = wid >> 2, wc = wid & 3, fr = lane & 15, fq = lane >> 4;
    const int K = g.K, nt = K / BK, lda = g.lda, ldb = g.ldb;
    unsigned voffA[2], voffB[2];
#pragma unroll
    for (int i = 0; i < 2; ++i) { int R, C; stage_rc(tid * 16 + i * 8192, R, C); const int Rb = Epi::PERM ? ((R & ~31) + perm32(R & 31)) : R;
        voffA[i] = (unsigned)(R * lda + C) * 2u; voffB[i] = (unsigned)(Rb * ldb + C) * 2u; }
    const size_t kstep = (size_t)(BK * 2);
    const size_t hstepA = (size_t)HALF * lda * 2, hstepB = (size_t)HALF * ldb * 2;
    const size_t tstepA = 2 * hstepA, tstepB = 2 * hstepB;
    const unsigned ldsw = (unsigned)wid * 1024u;
    const int aoff = lds_byte(wr * 64 + fr, fq * 8), boff = lds_byte(wc * 32 + fr, fq * 8);
#define PG8_SA(b, h) (((b) * 2 + (h)) * HTB)
#define PG8_SB(b, h) ((4 + (b) * 2 + (h)) * HTB)
#define PG8_STAGE(bufoff, gbase, voff) do { _Pragma("unroll") for (int _i = 0; _i < 2; ++_i) \
        __builtin_amdgcn_global_load_lds((const unsigned*)((const char*)(gbase) + (voff)[_i]), (PG8_LAS unsigned*)(lds + (bufoff) + ldsw + _i * 8192), 16, 0, 0); } while (0)
#define PG8_LDA(dst, b, h) do { _Pragma("unroll") for (int m = 0; m < 4; ++m) _Pragma("unroll") for (int k = 0; k < 2; ++k) dst[m][k] = *(const PG8_LAS bf16x8*)(lds + PG8_SA(b, h) + aoff + m * 2048 + k * 1024); } while (0)
#define PG8_LDB(dst, b, h) do { _Pragma("unroll") for (int n = 0; n < 2; ++n) _Pragma("unroll") for (int k = 0; k < 2; ++k) dst[n][k] = *(const PG8_LAS bf16x8*)(lds + PG8_SB(b, h) + boff + n * 2048 + k * 1024); } while (0)
#define PG8_MMA(ai, bj, At, Bt) do { __builtin_amdgcn_s_setprio(1); _Pragma("unroll") for (int m = 0; m < 4; ++m) _Pragma("unroll") for (int n = 0; n < 2; ++n) _Pragma("unroll") for (int k = 0; k < 2; ++k) \
        acc[ai][bj][m][n] = __builtin_amdgcn_mfma_f32_16x16x32_bf16(Bt[n][k], At[m][k], acc[ai][bj][m][n], 0, 0, 0); __builtin_amdgcn_s_setprio(0); } while (0)
#define PG8_WAIT_V(n) asm volatile("s_waitcnt vmcnt(" #n ")" ::: "memory")
#define PG8_WAIT_L(n) asm volatile("s_waitcnt lgkmcnt(" #n ")" ::: "memory")
#define PG8_BAR __builtin_amdgcn_s_barrier()
#define PG8_SCHED __builtin_amdgcn_sched_barrier(0)
    Unit cur, nxt; int ui = 0;
    if (!S.next(0, cur)) return;
    f32x4 acc[2][2][4][2];
#pragma unroll
    for (int a = 0; a < 2; ++a)
#pragma unroll
        for (int b = 0; b < 2; ++b)
#pragma unroll
            for (int m = 0; m < 4; ++m)
#pragma unroll
                for (int n = 0; n < 2; ++n) acc[a][b][m][n] = (f32x4){0.f, 0.f, 0.f, 0.f};
    bf16x8 At[4][2], B0[2][2], B1[2][2];
    const char* cA = (const char*)g.A + (size_t)cur.pm * tstepA + (size_t)cur.koff * 2; const char* cB = (const char*)g.Bt + (size_t)cur.pb * tstepB + (size_t)cur.koff * 2;
    S.a_ready(cur);
    if constexpr (SP2) {
        PG8_STAGE(PG8_SB(0, 0), cB, voffB); PG8_STAGE(PG8_SB(0, 1), cB + hstepB, voffB); PG8_STAGE(PG8_SA(0, 0), cA, voffA); PG8_STAGE(PG8_SA(0, 1), cA + hstepA, voffA);
        if (wr == 1) PG8_BAR;
        PG8_WAIT_V(2); PG8_BAR;
        PG8_STAGE(PG8_SB(1, 0), cB + kstep, voffB); PG8_STAGE(PG8_SA(1, 0), cA + kstep, voffA); PG8_STAGE(PG8_SB(1, 1), cB + hstepB + kstep, voffB);
        PG8_WAIT_V(6); PG8_BAR;
    } else {
        PG8_STAGE(PG8_SB(0, 0), cB, voffB); PG8_STAGE(PG8_SA(0, 0), cA, voffA); PG8_STAGE(PG8_SB(0, 1), cB + hstepB, voffB); PG8_STAGE(PG8_SA(0, 1), cA + hstepA, voffA);
        if (wr == 1) PG8_BAR;
        PG8_WAIT_V(4); PG8_BAR;
        PG8_STAGE(PG8_SB(1, 0), cB + kstep, voffB); PG8_STAGE(PG8_SA(1, 0), cA + kstep, voffA); PG8_STAGE(PG8_SB(1, 1), cB + hstepB + kstep, voffB);
        PG8_WAIT_V(6); PG8_BAR;
    }
    for (;;) {
        const bool has_next = S.next(ui + 1, nxt);
        const char* nA = has_next ? (const char*)g.A + (size_t)nxt.pm * tstepA + (size_t)nxt.koff * 2 : cA; const char* nB = has_next ? (const char*)g.Bt + (size_t)nxt.pb * tstepB + (size_t)nxt.koff * 2 : cB;
        for (int t = 0; t < nt; t += 2) {
            const bool last = (t == nt - 2);
            const char* a1 = cA + (size_t)(t + 1) * kstep;
            const char* a2 = last ? nA : cA + (size_t)(t + 2) * kstep; const char* b2 = last ? nB : cB + (size_t)(t + 2) * kstep;
            const char* a3 = a2 + kstep; const char* b3 = b2 + kstep;
            if (last && has_next) S.a_ready(nxt);
            if constexpr (SP2) {
            PG8_LDB(B0, 0, 0); PG8_LDB(B1, 0, 1); PG8_SCHED; PG8_LDA(At, 0, 0); PG8_STAGE(PG8_SA(1, 1), a1 + hstepA, voffA);
            PG8_WAIT_V(8); PG8_WAIT_L(0); PG8_BAR; PG8_MMA(0, 0, At, B0); PG8_MMA(0, 1, At, B1); PG8_BAR; PG8_SCHED;
            PG8_LDA(At, 0, 1); PG8_STAGE(PG8_SB(0, 0), b2, voffB); PG8_STAGE(PG8_SB(0, 1), b2 + hstepB, voffB); PG8_STAGE(PG8_SA(0, 0), a2, voffA);
            PG8_WAIT_V(8); PG8_WAIT_L(0); PG8_BAR; PG8_MMA(1, 0, At, B0); PG8_MMA(1, 1, At, B1); PG8_BAR; PG8_SCHED;
            PG8_LDB(B0, 1, 0); PG8_LDB(B1, 1, 1); PG8_SCHED; PG8_LDA(At, 1, 0); PG8_STAGE(PG8_SA(0, 1), a2 + hstepA, voffA);
            PG8_WAIT_V(8); PG8_WAIT_L(0); PG8_BAR; PG8_MMA(0, 0, At, B0); PG8_MMA(0, 1, At, B1); PG8_BAR; PG8_SCHED;
            PG8_LDA(At, 1, 1); PG8_STAGE(PG8_SB(1, 0), b3, voffB); PG8_STAGE(PG8_SB(1, 1), b3 + hstepB, voffB); PG8_STAGE(PG8_SA(1, 0), a3, voffA);
            PG8_WAIT_V(8); PG8_WAIT_L(0); PG8_BAR; PG8_MMA(1, 0, At, B0); PG8_MMA(1, 1, At, B1); PG8_BAR; PG8_SCHED;
            } else {
            PG8_LDB(B0, 0, 0); PG8_SCHED; PG8_LDA(At, 0, 0); PG8_STAGE(PG8_SA(1, 1), a1 + hstepA, voffA);
            PG8_WAIT_L(8); PG8_BAR; PG8_WAIT_L(0); PG8_MMA(0, 0, At, B0); PG8_BAR; PG8_SCHED;
            PG8_LDB(B1, 0, 1); PG8_STAGE(PG8_SB(0, 0), b2, voffB);
            PG8_BAR; PG8_WAIT_L(0); PG8_MMA(0, 1, At, B1); PG8_BAR;
            PG8_LDA(At, 0, 1); PG8_STAGE(PG8_SA(0, 0), a2, voffA);
            PG8_BAR; PG8_WAIT_L(0); PG8_MMA(1, 0, At, B0); PG8_BAR; PG8_SCHED;
            PG8_STAGE(PG8_SB(0, 1), b2 + hstepB, voffB);
            PG8_WAIT_V(6); PG8_BAR; PG8_MMA(1, 1, At, B1); PG8_BAR;
            PG8_LDB(B0, 1, 0); PG8_SCHED; PG8_LDA(At, 1, 0); PG8_STAGE(PG8_SA(0, 1), a2 + hstepA, voffA);
            PG8_WAIT_L(8); PG8_BAR; PG8_WAIT_L(0); PG8_MMA(0, 0, At, B0); PG8_BAR; PG8_SCHED;
            PG8_LDB(B1, 1, 1); PG8_STAGE(PG8_SB(1, 0), b3, voffB);
            PG8_BAR; PG8_WAIT_L(0); PG8_MMA(0, 1, At, B1); PG8_BAR;
            PG8_LDA(At, 1, 1); PG8_STAGE(PG8_SA(1, 0), a3, voffA);
            PG8_BAR; PG8_WAIT_L(0); PG8_MMA(1, 0, At, B0); PG8_BAR; PG8_SCHED;
            PG8_STAGE(PG8_SB(1, 1), b3 + hstepB, voffB);
            PG8_WAIT_V(6); PG8_BAR; PG8_MMA(1, 1, At, B1); PG8_BAR;
            }
        }
        if constexpr (ALIGN_EPI) { if (wr == 0) PG8_BAR; }
#if MK_DIAG
        { bool bad = false;
#pragma unroll
          for (int a_ = 0; a_ < 2; ++a_)
#pragma unroll
            for (int b_ = 0; b_ < 2; ++b_)
#pragma unroll
              for (int m_ = 0; m_ < 4; ++m_)
#pragma unroll
                for (int n_ = 0; n_ < 2; ++n_)
#pragma unroll
                  for (int j_ = 0; j_ < 4; ++j_) bad |= !(__builtin_fabsf(acc[a_][b_][m_][n_][j_]) < 3.0e38f);
          if (bad && g.dflag) atomicOr(g.dflag, g.dbit); }
#endif
        if constexpr (!Epi::AFTER_DRAIN) { E(acc, cur, wr, wc, fr, fq); S.done(cur); }
        if (!has_next) break;
#pragma unroll
        for (int a = 0; a < 2; ++a)
#pragma unroll
            for (int b = 0; b < 2; ++b)
#pragma unroll
                for (int m = 0; m < 4; ++m)
#pragma unroll
                    for (int n = 0; n < 2; ++n) acc[a][b][m][n] = (f32x4){0.f, 0.f, 0.f, 0.f};
        cur = nxt; cA = nA; cB = nB; ++ui;
        if constexpr (ALIGN_EPI) { if (wr == 1) PG8_BAR; }
    }
    PG8_WAIT_V(0);
    if constexpr (!ALIGN_EPI) { if (wr == 0) PG8_BAR; }
    PG8_BAR;
    if constexpr (Epi::AFTER_DRAIN) { E.fused(acc, cur, wr, wc, fr, fq, lds, wid, lane); S.done(cur); }
#undef PG8_SA
#undef PG8_SB
#undef PG8_STAGE
#undef PG8_LDA
#undef PG8_LDB
#undef PG8_MMA
#undef PG8_WAIT_V
#undef PG8_WAIT_L
#undef PG8_BAR
#undef PG8_SCHED
}

}

constexpr int NWAVES = 8;
constexpr int BATCH = 2, SEQ = 8192, D = 4096, M = BATCH * SEQ;
constexpr int GRIDW = 64, GROWS = SEQ / GRIDW;
constexpr int NA_HEADS = 32, NA_HD = 128;
constexpr int S5_G = 256, S5_P = 64, S5_I = 16, S5_T = 32, S5_NCH = M / S5_T  , S5_NCHB = SEQ / S5_T  , S5_KS = S5_T * 16  , S5_KY = S5_KS + 256  ;
constexpr int GLA_H = 8, GLA_DK = 256, GLA_DV = 512, GLA_KW = 2048, GLA_C = 64, GLA_NCH = M / GLA_C  , GLA_NCHB = SEQ / GLA_C  , GLA_NIN = 12288;
constexpr float EPS = 1e-6f;

constexpr size_t MiB = 1u << 20;
constexpr size_t WS_CTL = 0, CTL_ZERO_BYTES = 64 * 1024;
constexpr size_t WS_MOD = 1 * MiB;
constexpr size_t WS_LAMT = 2 * MiB;
constexpr size_t WS_W_NAIN0 = 4 * MiB, WS_W_NAIN1 = WS_W_NAIN0 + 128 * MiB, WS_W_NAOUT0 = WS_W_NAIN1 + 128 * MiB, WS_W_NAOUT1 = WS_W_NAOUT0 + 32 * MiB;
constexpr size_t WS_W_S5IN = WS_W_NAOUT1 + 32 * MiB, WS_W_S5GLU = WS_W_S5IN + 64 * MiB, WS_W_S5OUT = WS_W_S5GLU + 32 * MiB;
constexpr size_t WS_W_GLAIN = WS_W_S5OUT + 32 * MiB, WS_W_GLAG1 = WS_W_GLAIN + 96 * MiB, WS_W_GLAOUT = WS_W_GLAG1 + 2 * MiB;
constexpr size_t WS_S5BS = WS_W_GLAOUT + 32 * MiB;
constexpr size_t WS_S5BY = WS_S5BS + 64 * MiB;
constexpr size_t WS_H = WS_S5BY + 192 * MiB;
constexpr size_t WS_ACT = WS_H + 128 * MiB;
constexpr size_t WS_NA_QKVG = WS_ACT;
constexpr size_t WS_NA_Z = WS_ACT + 512 * MiB;
constexpr size_t WS_S5_UG = WS_ACT;
constexpr size_t WS_S5_GS = WS_S5_UG + 192 * MiB;
constexpr size_t WS_S5_SLOC = WS_S5_GS + 128 * MiB;
constexpr size_t WS_S5_Y = WS_S5_SLOC + 128 * MiB;
constexpr size_t WS_S5_Z = WS_S5_Y + 128 * MiB;
constexpr size_t WS_GLA_IN = WS_ACT;
constexpr size_t WS_GLA_G1P = WS_GLA_IN + 384 * MiB;
constexpr size_t WS_GLA_PREP = WS_GLA_G1P + 8 * MiB;
constexpr size_t WS_GLA_DECAY = WS_GLA_PREP + 384 * MiB;
constexpr size_t WS_GLA_O = WS_GLA_DECAY + 4 * MiB;
constexpr size_t WS_GLA_Z = WS_GLA_O + 384 * MiB;
constexpr size_t WS_SCR = WS_GLA_Z + 128 * MiB;
constexpr size_t WS_END = WS_SCR + 256 * MiB;
static_assert(WS_S5_Z + 128 * MiB <= WS_SCR && WS_NA_Z + 128 * MiB <= WS_SCR, "ws map");
constexpr int CW_BAR = 1024;
static_assert((CW_BAR + 3456) * 4 <= (int)CTL_ZERO_BYTES, "CTL words inside the memset region");

constexpr int RING_OFF = 0, RING_BYTES = 131072;
constexpr int LDS_BYTES = 147456;
constexpr int MISC_OFF = LDS_BYTES - 256;

#define GAS __attribute__((address_space(1)))
#define LAS __attribute__((address_space(3)))
typedef unsigned short bf16;
typedef unsigned v4u __attribute__((ext_vector_type(4)));
typedef unsigned v2u __attribute__((ext_vector_type(2)));
typedef float f32x4 __attribute__((ext_vector_type(4)));
typedef float f32x2 __attribute__((ext_vector_type(2)));
typedef short bf16x8 __attribute__((ext_vector_type(8)));
typedef short s16x4 __attribute__((ext_vector_type(4)));
typedef GAS unsigned gu32;
#define LDS_WAIT() asm volatile("s_waitcnt lgkmcnt(0)" ::: "memory")
#define VM_WAIT() asm volatile("s_waitcnt vmcnt(0)" ::: "memory")
using pg8::cvt_pk_bf16; using pg8::bf_lo; using pg8::bf_hi; using pg8::siluf_; using pg8::sigmoidf_;

#define XB_TMO      128
#define XB_XCNT(j)  (256  + 64 * (j))
#define XB_XSUB(j)  (1280 + 64 * (j))
#define XB_XGEN(j)  (2304 + 64 * (j))
#define XB_TOP      3328
#define XB_TOPGEN   3392
#define XCD_BAR_WORDS 3456
#define XB_SPIN_CAP (1u << 18)
__device__ __forceinline__ unsigned xb_ld(unsigned* p)              { return __hip_atomic_load(p, __ATOMIC_RELAXED, __HIP_MEMORY_SCOPE_AGENT); }
__device__ __forceinline__ unsigned xb_add(unsigned* p, unsigned v) { return __hip_atomic_fetch_add(p, v, __ATOMIC_RELAXED, __HIP_MEMORY_SCOPE_AGENT); }
__device__ __forceinline__ unsigned xb_xcc_id() { return (unsigned)__builtin_amdgcn_s_getreg((3 << 11) | 20) & 0xFu; }
#define XB_SPIN(cond, bar) do { unsigned _sp = 0; while (cond) { __builtin_amdgcn_s_sleep(1); \
    if ((++_sp & 255u) == 0u) { if (xb_ld(&(bar)[XB_TMO])) break; if (_sp > XB_SPIN_CAP) { atomicAdd(&(bar)[XB_TMO], 1u); break; } } } } while (0)
struct XcdBarrier { unsigned* bar; unsigned x; volatile LAS unsigned* st; };
__device__ __forceinline__ XcdBarrier xcd_barrier_post(unsigned* bar, volatile LAS unsigned* st) {
    XcdBarrier b; b.bar = bar; b.x = xb_xcc_id(); b.st = st;
    if (threadIdx.x == 0) (void)xb_add(&bar[XB_XCNT(b.x)], 1u);
    return b;
}
__device__ __forceinline__ void xcd_barrier_complete(unsigned* bar, unsigned x, unsigned& nloc, unsigned& nx) {
    const unsigned G = gridDim.x * gridDim.y * gridDim.z;
    unsigned sum, cnt, mine, sp = 0u;
    for (;;) {
        sum = 0u; cnt = 0u; mine = 0u;
#pragma unroll
        for (unsigned j = 0; j < 16; ++j) { const unsigned c = xb_ld(&bar[XB_XCNT(j)]); sum += c; cnt += (c > 0u) ? 1u : 0u; mine = (j == x) ? c : mine; }
        if (sum == G) break;
        __builtin_amdgcn_s_sleep(1);
        if ((++sp & 255u) == 0u) { if (xb_ld(&bar[XB_TMO])) break; if (sp > XB_SPIN_CAP) { atomicAdd(&bar[XB_TMO], 1u); break; } }
    }
    nloc = mine > 0u ? mine : 1u; nx = cnt > 0u ? cnt : 1u;
}
__device__ __forceinline__ void xcd_barrier(const XcdBarrier& b) {
    asm volatile("s_waitcnt vmcnt(0)" ::: "memory");
    __syncthreads();
    if (threadIdx.x == 0) {
        unsigned* bar = b.bar;
        __builtin_amdgcn_s_waitcnt(0);
        unsigned nloc = b.st[0], nx = b.st[1];
        if (nloc == 0u) { xcd_barrier_complete(bar, b.x, nloc, nx); b.st[0] = nloc; b.st[1] = nx; }
        const unsigned old = xb_add(&bar[XB_XSUB(b.x)], 1u);
        const unsigned gen = old / nloc;
        if (old + 1u == (gen + 1u) * nloc) {
            __builtin_amdgcn_fence(__ATOMIC_RELEASE, "agent");
            asm volatile("s_waitcnt vmcnt(0)" ::: "memory");
            const unsigned og = xb_add(&bar[XB_TOP], 1u);
            const unsigned tg = og / nx;
            if (og + 1u == (tg + 1u) * nx) xb_add(&bar[XB_TOPGEN], 1u);
            else XB_SPIN(xb_ld(&bar[XB_TOPGEN]) == tg, bar);
            __builtin_amdgcn_fence(__ATOMIC_ACQUIRE, "agent");
            xb_add(&bar[XB_XGEN(b.x)], 1u);
            asm volatile("s_waitcnt vmcnt(0)" ::: "memory");
        } else {
            XB_SPIN(xb_ld(&bar[XB_XGEN(b.x)]) == gen, bar);
            __builtin_amdgcn_fence(__ATOMIC_ACQUIRE, "agent");
            asm volatile("s_waitcnt vmcnt(0)" ::: "memory");
        }
    }
    __syncthreads();
}

struct Args { const float* in[33]; float* out; unsigned char* ws; int ph_lo, ph_hi, dup, pad; };
struct Frame {
    LAS unsigned char* lds;
    int tid, lane, wave;
    int vcu, G;
};
__device__ __forceinline__ float wave_sum(float v) {
#pragma unroll
    for (int o = 1; o < 64; o <<= 1) v += __shfl_xor(v, o);
    return v;
}
__device__ __forceinline__ unsigned f2bf(float f) { unsigned u = __builtin_bit_cast(unsigned, f); return (u + 0x7fffu + ((u >> 16) & 1u)) >> 16; }
__device__ __forceinline__ unsigned pk2(float lo, float hi) { return f2bf(lo) | (f2bf(hi) << 16); }

__device__ __forceinline__ void p0_transpose_item(const float* W, int K, int N, bf16* WT, LAS float* scr, int item, int lane) {
    const int nblk = N / 32, kb = item / nblk, nb = item % nblk, k0 = 64 * kb, n0 = 32 * nb;
#pragma unroll 8
    for (int i = 0; i < 32; ++i) { const int kk = 2 * i + (lane >> 5); scr[kk * 33 + (lane & 31)] = __builtin_nontemporal_load(W + (size_t)(k0 + kk) * N + n0 + (lane & 31)); }
    LDS_WAIT(); asm volatile("" ::: "memory");
    const int c = lane & 7;
#pragma unroll
    for (int j = 0; j < 4; ++j) { const int n = (lane >> 3) + 8 * j; const LAS float* s = scr + (8 * c) * 33 + n;
        v4u o; o.x = pk2(s[0 * 33], s[1 * 33]); o.y = pk2(s[2 * 33], s[3 * 33]); o.z = pk2(s[4 * 33], s[5 * 33]); o.w = pk2(s[6 * 33], s[7 * 33]);
        *(GAS v4u*)(WT + (size_t)(n0 + n) * K + k0 + 8 * c) = o; }
    LDS_WAIT(); asm volatile("" ::: "memory");
}
__device__ __forceinline__ void p0_mod(Frame& F, const Args& a) {
    LAS float* cact = (LAS float*)(F.lds + RING_OFF);
    LAS float* red = cact + 2 * 4096;
    const float* c = a.in[1]; const float* mw = a.in[2]; const float* mb = a.in[3]; float* MOD = (float*)(a.ws + WS_MOD);
    for (int i = F.tid; i < 2 * 4096; i += NWAVES * 64) cact[i] = siluf_(c[i]);
    __syncthreads();
    const int rg = F.lane >> 4, cq = F.lane & 15;
    for (int it = F.vcu; it < 4 * 192; it += F.G) {
        const int layer = it / 192, cb = it % 192;
        const float* wp = mw + (size_t)layer * 4096 * 12288 + (size_t)(F.wave * 4 + rg) * 12288 + cb * 64 + cq * 4;
        f32x4 a0 = {0.f, 0.f, 0.f, 0.f}, a1 = {0.f, 0.f, 0.f, 0.f};
#pragma unroll 8
        for (int s = 0; s < 128; ++s) { const f32x4 w = __builtin_nontemporal_load((const GAS f32x4*)(wp + (size_t)s * 32 * 12288)); const int k = F.wave * 4 + rg + 32 * s;
            const float c0 = cact[k], c1 = cact[4096 + k]; a0 += w * c0; a1 += w * c1; }
#pragma unroll
        for (int j = 0; j < 4; ++j) { a0[j] += __shfl_xor(a0[j], 16); a0[j] += __shfl_xor(a0[j], 32); a1[j] += __shfl_xor(a1[j], 16); a1[j] += __shfl_xor(a1[j], 32); }
        if (F.lane < 16) { *(LAS f32x4*)(red + (F.wave * 2 + 0) * 64 + cq * 4) = a0; *(LAS f32x4*)(red + (F.wave * 2 + 1) * 64 + cq * 4) = a1; }
        __syncthreads();
        if (F.tid < 128) { const int b = F.tid >> 6, col = F.tid & 63; float s = mb[layer * 12288 + cb * 64 + col];
#pragma unroll
            for (int w = 0; w < 8; ++w) s += red[(w * 2 + b) * 64 + col];
            MOD[((size_t)layer * 2 + b) * 12288 + cb * 64 + col] = s; }
        __syncthreads();
    }
}
__device__ __forceinline__ void p0_s5_group(Frame& F, const Args& a, int g) {
    constexpr int T = S5_T;
    LAS f32x2* pw = (LAS f32x2*)(F.lds + RING_OFF);
    LAS f32x2* bbar = pw + 2 * (T + 1) * 64;
    LAS f32x2* cc = bbar + 2 * 64 * 16;
    LAS float* kf = (LAS float*)(cc + 16 * 64);
    static_assert((2 * (T + 1) * 64 + 2 * 64 * 16 + 16 * 64) * 8 + 2 * T * 256 * 4 <= RING_BYTES, "s5 gen LDS");
    const float *b_re = a.in[9], *b_im = a.in[10], *c_re = a.in[11], *c_im = a.in[12], *dsk = a.in[13];
    float* LAMT = (float*)(a.ws + WS_LAMT);
    if (F.tid < 128) {
        const int dir = F.tid >> 6, p = F.tid & 63, gp = g * 64 + p;
        const float are = (dir ? a.in[16] : a.in[14])[gp], aim = (dir ? a.in[17] : a.in[15])[gp], ls = (dir ? a.in[19] : a.in[18])[gp];
        const float dt = expf(ls), mag = expf(are * dt), lr = mag * cosf(aim * dt), li = mag * sinf(aim * dt);
        const float den = are * are + aim * aim, nr = lr - 1.0f, rre = (nr * are + li * aim) / den, rim = (li * are - nr * aim) / den;
#pragma unroll
        for (int j = 0; j < 16; ++j) { const float br = b_re[(size_t)gp * 16 + j], bi = b_im[(size_t)gp * 16 + j]; bbar[(dir * 64 + p) * 16 + j] = (f32x2){rre * br - rim * bi, rre * bi + rim * br}; }
        float wr_ = 1.0f, wi_ = 0.0f; pw[(dir * (T + 1) + 0) * 64 + p] = (f32x2){1.0f, 0.0f};
        for (int t = 1; t <= T; ++t) { const float nr2 = wr_ * lr - wi_ * li, ni2 = wr_ * li + wi_ * lr; wr_ = nr2; wi_ = ni2; pw[(dir * (T + 1) + t) * 64 + p] = (f32x2){wr_, wi_}; }
        LAMT[((size_t)(g * 2 + dir) * 64 + p) * 2 + 0] = wr_; LAMT[((size_t)(g * 2 + dir) * 64 + p) * 2 + 1] = wi_;
    }
    for (int e = F.tid; e < 16 * 64; e += NWAVES * 64) cc[e] = (f32x2){c_re[(size_t)g * 1024 + e], c_im[(size_t)g * 1024 + e]};
    __syncthreads();
    {
        const int dir = F.tid >> 8, i = (F.tid >> 4) & 15, jp = (F.tid >> 1) & 7, th = F.tid & 1;
        float acc0[T / 2], acc1[T / 2];
#pragma unroll
        for (int t = 0; t < T / 2; ++t) { acc0[t] = 0.f; acc1[t] = 0.f; }
        const LAS f32x2* pwp = pw + (dir * (T + 1) + (T / 2) * th) * 64;
        for (int p = 0; p < 64; ++p) { const f32x2 C = cc[i * 64 + p]; const f32x4 Bb = *(const LAS f32x4*)(bbar + (dir * 64 + p) * 16 + 2 * jp);
            const float e0 = C.x * Bb[0] - C.y * Bb[1], f0 = C.x * Bb[1] + C.y * Bb[0], e1 = C.x * Bb[2] - C.y * Bb[3], f1 = C.x * Bb[3] + C.y * Bb[2];
#pragma unroll
            for (int t = 0; t < T / 2; ++t) { const f32x2 w = pwp[t * 64 + p]; acc0[t] += w.x * e0 - w.y * f0; acc1[t] += w.x * e1 - w.y * f1; } }
#pragma unroll
        for (int t = 0; t < T / 2; ++t) *(LAS f32x2*)(kf + ((dir * T + (T / 2) * th + t) * 16 + i) * 16 + 2 * jp) = (f32x2){acc0[t], acc1[t]};
    }
    __syncthreads();
    {
        bf16* BY = (bf16*)(a.ws + WS_S5BY) + (size_t)g * (S5_KS * S5_KY);
        const int i = F.tid >> 5, pcg = F.tid & 31; const float dsk_i = dsk[g * 16 + i];
        const int segc = pcg >> 3, p0c = (pcg & 7) * 8, dirc = segc >> 1;
        for (int t = 0; t < T; ++t) { bf16* rowp = BY + (size_t)(t * 16 + i) * S5_KY;
#pragma unroll
            for (int jq = 0; jq < 2; ++jq) { const int pc = pcg + 32 * jq, sidx = pc >> 1, j0 = (pc & 1) * 8, lag = t - sidx; f32x4 v0, v1;
                if (lag != 0) { const LAS float* kp = kf + (((lag > 0 ? 0 : 1) * T + (lag > 0 ? lag : -lag)) * 16 + i) * 16 + j0; v0 = *(const LAS f32x4*)kp; v1 = *(const LAS f32x4*)(kp + 4); }
                else { const LAS float* k0p = kf + (i * 16 + j0); const LAS float* k1p = kf + ((T * 16 + i) * 16 + j0);
                    v0 = *(const LAS f32x4*)k0p + *(const LAS f32x4*)k1p; v1 = *(const LAS f32x4*)(k0p + 4) + *(const LAS f32x4*)(k1p + 4);
#pragma unroll
                    for (int e = 0; e < 4; ++e) { if (j0 + e == i) v0[e] += dsk_i; if (j0 + 4 + e == i) v1[e] += dsk_i; } }
                *(GAS v4u*)(rowp + pc * 8) = (v4u){cvt_pk_bf16(v0[0], v0[1]), cvt_pk_bf16(v0[2], v0[3]), cvt_pk_bf16(v1[0], v1[1]), cvt_pk_bf16(v1[2], v1[3])}; }
            { const int tp = dirc ? (T - t) : (t + 1); const LAS f32x2* wp = pw + (dirc * (T + 1) + tp) * 64 + p0c; const LAS f32x2* cp = cc + i * 64 + p0c; float v[8];
#pragma unroll
              for (int e = 0; e < 8; ++e) { const f32x2 w = wp[e], C = cp[e]; v[e] = (segc & 1) ? -(C.x * w.y + C.y * w.x) : (C.x * w.x - C.y * w.y); }
              *(GAS v4u*)(rowp + S5_KS + pcg * 8) = (v4u){cvt_pk_bf16(v[0], v[1]), cvt_pk_bf16(v[2], v[3]), cvt_pk_bf16(v[4], v[5]), cvt_pk_bf16(v[6], v[7])}; }
        }
    }
    {
        bf16* BS = (bf16*)(a.ws + WS_S5BS) + (size_t)g * (256 * S5_KS);
        const int pc = F.tid & 63, sidx = pc >> 1, j0 = (pc & 1) * 8;
        for (int ps = 0; ps < 32; ++ps) { const int n = 8 * ps + (F.tid >> 6), seg = n >> 6, p = n & 63, dir = seg >> 1;
            const f32x2 w = pw[(dir * (T + 1) + (dir ? sidx : (T - 1 - sidx))) * 64 + p]; const LAS f32x2* bp = bbar + (dir * 64 + p) * 16 + j0; float v[8];
#pragma unroll
            for (int e = 0; e < 8; ++e) { const f32x2 Bb = bp[e]; v[e] = (seg & 1) ? (w.x * Bb.y + w.y * Bb.x) : (w.x * Bb.x - w.y * Bb.y); }
            *(GAS v4u*)(BS + (size_t)n * S5_KS + pc * 8) = (v4u){cvt_pk_bf16(v[0], v[1]), cvt_pk_bf16(v[2], v[3]), cvt_pk_bf16(v[4], v[5]), cvt_pk_bf16(v[6], v[7])};
        }
    }
    __syncthreads();
}
__device__ __forceinline__ void p0_prologue(Frame& F, const Args& a) {
    p0_mod(F, a);
    {
        LAS float* scr = (LAS float*)(F.lds + RING_OFF + F.wave * 16384);
        const int gw = F.vcu * NWAVES + F.wave, NGW = F.G * NWAVES;
        constexpr int I_NAIN = 64 * 512, I_SQ = 64 * 128, I_S5IN = 64 * 256, I_GLAIN = 64 * 384;
        constexpr int NITEMS = 2 * I_NAIN + 2 * I_SQ + I_S5IN + 2 * I_SQ + I_GLAIN + I_SQ;
        unsigned char* ws = a.ws;
        for (int it = gw; it < NITEMS; it += NGW) {
            int r = it;
            if (r < I_NAIN) { p0_transpose_item(a.in[5], 4096, 16384, (bf16*)(ws + WS_W_NAIN0), scr, r, F.lane); continue; } r -= I_NAIN;
            if (r < I_NAIN) { p0_transpose_item(a.in[5] + (size_t)4096 * 16384, 4096, 16384, (bf16*)(ws + WS_W_NAIN1), scr, r, F.lane); continue; } r -= I_NAIN;
            if (r < I_SQ) { p0_transpose_item(a.in[7], 4096, 4096, (bf16*)(ws + WS_W_NAOUT0), scr, r, F.lane); continue; } r -= I_SQ;
            if (r < I_SQ) { p0_transpose_item(a.in[7] + (size_t)4096 * 4096, 4096, 4096, (bf16*)(ws + WS_W_NAOUT1), scr, r, F.lane); continue; } r -= I_SQ;
            if (r < I_S5IN) { p0_transpose_item(a.in[8], 4096, 8192, (bf16*)(ws + WS_W_S5IN), scr, r, F.lane); continue; } r -= I_S5IN;
            if (r < I_SQ) { p0_transpose_item(a.in[20], 4096, 4096, (bf16*)(ws + WS_W_S5GLU), scr, r, F.lane); continue; } r -= I_SQ;
            if (r < I_SQ) { p0_transpose_item(a.in[22], 4096, 4096, (bf16*)(ws + WS_W_S5OUT), scr, r, F.lane); continue; } r -= I_SQ;
            if (r < I_GLAIN) { p0_transpose_item(a.in[23], 4096, 12288, (bf16*)(ws + WS_W_GLAIN), scr, r, F.lane); continue; } r -= I_GLAIN;
            p0_transpose_item(a.in[31], 4096, 4096, (bf16*)(ws + WS_W_GLAOUT), scr, r, F.lane);
        }
        bf16* G1T = (bf16*)(ws + WS_W_GLAG1);
        for (int e = (F.vcu * NWAVES * 64 + F.tid); e < 256 * 4096 / 2; e += F.G * NWAVES * 64) {
            const int n = e / 2048, k = (e % 2048) * 2; float v0 = 0.f, v1 = 0.f;
            if (n < 16) { v0 = a.in[24][(size_t)k * 16 + n]; v1 = a.in[24][(size_t)(k + 1) * 16 + n]; }
            else if (n < 32) { v0 = a.in[27][(size_t)k * 16 + (n - 16)]; v1 = a.in[27][(size_t)(k + 1) * 16 + (n - 16)]; }
            *(GAS unsigned*)(G1T + (size_t)n * 4096 + k) = pk2(v0, v1);
        }
    }
    __syncthreads();
    for (int g = F.vcu; g < S5_G; g += F.G) p0_s5_group(F, a, g);
}

template <bool FINAL>
__device__ __forceinline__ void norm_phase(Frame& F, const float* xin, const float* nw, const float* mod  , bf16* H, float* outf) {
    LAS f32x2* tab = (LAS f32x2*)(F.lds + RING_OFF);
    for (int i = F.tid; i < 2 * 4096; i += NWAVES * 64) { const int b = i >> 12, c = i & 4095;
        if (FINAL) tab[i] = (f32x2){nw[c], 0.f};
        else tab[i] = (f32x2){nw[c] * (1.0f + mod[b * 12288 + 4096 + c]), mod[b * 12288 + c]}; }
    __syncthreads();
    const int gw = F.vcu * NWAVES + F.wave, NGW = F.G * NWAVES;
    for (int m = gw; m < M; m += NGW) {
        const int b = m >> 13; const GAS f32x4* xr = (const GAS f32x4*)(xin + (size_t)m * D) + F.lane;
        f32x4 v[16]; float s = 0.f;
#pragma unroll
        for (int j = 0; j < 16; ++j) { v[j] = __builtin_nontemporal_load(xr + 64 * j); s += (v[j].x * v[j].x + v[j].y * v[j].y) + (v[j].z * v[j].z + v[j].w * v[j].w); }
        const float rstd = rsqrtf(wave_sum(s) * (1.f / D) + EPS);
#pragma unroll
        for (int j = 0; j < 16; ++j) { const int c = 4 * F.lane + 256 * j; const LAS f32x2* tp = tab + b * 4096 + c;
            const f32x2 t0 = tp[0], t1 = tp[1], t2 = tp[2], t3 = tp[3];
            const float o0 = v[j].x * rstd * t0.x + t0.y, o1 = v[j].y * rstd * t1.x + t1.y, o2 = v[j].z * rstd * t2.x + t2.y, o3 = v[j].w * rstd * t3.x + t3.y;
            if (FINAL) *((GAS f32x4*)(outf + (size_t)m * D) + F.lane + 64 * j) = (f32x4){o0, o1, o2, o3};
            else *(GAS v2u*)(H + (size_t)m * D + c) = (v2u){cvt_pk_bf16(o0, o1), cvt_pk_bf16(o2, o3)}; }
    }
    __syncthreads();
}

typedef short v4i16_t __attribute__((ext_vector_type(4)));
__device__ __forceinline__ s16x4 tr4(const LAS unsigned char* p) { return __builtin_bit_cast(s16x4, __builtin_amdgcn_ds_read_tr16_b64_v4i16((LAS v4i16_t*)p)); }
__device__ __forceinline__ bf16x8 cat8(s16x4 a, s16x4 b) { return (bf16x8){a[0], a[1], a[2], a[3], b[0], b[1], b[2], b[3]}; }
__device__ __forceinline__ bf16x8 pack8(f32x4 a, f32x4 b) { v4u w; w.x = cvt_pk_bf16(a[0], a[1]); w.y = cvt_pk_bf16(a[2], a[3]); w.z = cvt_pk_bf16(b[0], b[1]); w.w = cvt_pk_bf16(b[2], b[3]); return __builtin_bit_cast(bf16x8, w); }
#define MFMA16(a, b, c) __builtin_amdgcn_mfma_f32_16x16x32_bf16((a), (b), (c), 0, 0, 0)

constexpr int NA_PITCH = 288, NA_TILE = 64 * NA_PITCH;
__device__ __forceinline__ void na_attn_phase(Frame& F, const bf16* QKVG, bf16* Z, const float* rpb) {
    const int grp = F.wave >> 2, ct = F.wave & 3, lane = F.lane, li = lane & 15, g = lane >> 4, q4 = li >> 2, p4 = li & 3;
    const int c0 = ct * 16, kc0 = min(max(c0 - 8, 0), 32);
    const int ipw = (4096 + F.G - 1) / F.G;
    LAS unsigned char* const lbase = F.lds + RING_OFF;
    LAS float* const rp = (LAS float*)(lbase + 4 * NA_TILE + grp * 2048);
    for (int k = 0; k < ipw; ++k) {
        const int it = F.vcu * ipw + k; if (it >= 4096) break;
        const int b = it >> 11, hp = (it >> 7) & 15, r = ((it & 15) << 3) | ((it >> 4) & 7), h = hp * 2 + grp;
        const int rs = min(max(r - 4, 0), GROWS - 8);
        const size_t tok0 = (size_t)b * SEQ + (size_t)r * GRIDW;
        const bf16* qp = QKVG + (tok0 + c0 + li) * 16384 + h * 128 + 8 * g;
        bf16x8 qf[4];
#pragma unroll
        for (int ks = 0; ks < 4; ++ks) qf[ks] = *(const GAS bf16x8*)(qp + 32 * ks);
        for (int e = (F.tid & 255); e < 465; e += 256) rp[e] = rpb[h * 465 + e];
        v4u st[4];
        const bf16* kvbase = QKVG + ((size_t)b * SEQ + (size_t)rs * GRIDW + 16 * ct + g) * 16384 + h * 128 + li * 8;
#define NA_LOAD(t) do { _Pragma("unroll") for (int j = 0; j < 4; ++j) st[j] = *(const GAS v4u*)(kvbase + ((size_t)((t) & 7) * GRIDW + 4 * j) * 16384 + (((t) >> 3) ? 8192 : 4096)); } while (0)
#define NA_WRITE(buf) do { _Pragma("unroll") for (int j = 0; j < 4; ++j) *(LAS v4u*)(lbase + ((buf) * 2 + grp) * NA_TILE + (16 * ct + 4 * j + g) * NA_PITCH + li * 16) = st[j]; } while (0)
        NA_LOAD(0); NA_WRITE(0); __syncthreads();
        f32x4 S[8][2];
#pragma unroll
        for (int t = 0; t < 8; ++t) {
            NA_LOAD(t + 1);
            const LAS unsigned char* tb = lbase + ((t & 1) * 2 + grp) * NA_TILE;
            S[t][0] = (f32x4){0.f, 0.f, 0.f, 0.f}; S[t][1] = (f32x4){0.f, 0.f, 0.f, 0.f};
#pragma unroll
            for (int blk = 0; blk < 2; ++blk)
#pragma unroll
                for (int ks = 0; ks < 4; ++ks) { const bf16x8 A = *(const LAS bf16x8*)(tb + (kc0 + 16 * blk + li) * NA_PITCH + (32 * ks + 8 * g) * 2);
                    S[t][blk] = MFMA16(A, qf[ks], S[t][blk]); }
            NA_WRITE((t + 1) & 1);
            __syncthreads();
        }
        const int c = c0 + li, cs = min(max(c - 8, 0), GRIDW - 16);
        float mx = -1e30f;
#pragma unroll
        for (int t = 0; t < 8; ++t)
#pragma unroll
            for (int blk = 0; blk < 2; ++blk)
#pragma unroll
                for (int e = 0; e < 4; ++e) { const int kc = kc0 + 16 * blk + 4 * g + e; const bool valid = (kc >= cs) && (kc < cs + 16);
                    const int idx = valid ? ((rs + t - r + 7) * 31 + (kc - c + 15)) : 0;
                    const float s = valid ? (S[t][blk][e] * 0.08838834764831845f + rp[idx]) : -1e30f; S[t][blk][e] = s; mx = fmaxf(mx, s); }
        mx = fmaxf(mx, __shfl_xor(mx, 16)); mx = fmaxf(mx, __shfl_xor(mx, 32));
        float sum = 0.f;
#pragma unroll
        for (int t = 0; t < 8; ++t)
#pragma unroll
            for (int blk = 0; blk < 2; ++blk)
#pragma unroll
                for (int e = 0; e < 4; ++e) { const float p = __expf(S[t][blk][e] - mx); S[t][blk][e] = p; sum += p; }
        sum += __shfl_xor(sum, 16); sum += __shfl_xor(sum, 32);
        const float inv = 1.0f / sum;
        bf16x8 pb[8];
#pragma unroll
        for (int t = 0; t < 8; ++t) pb[t] = pack8(S[t][0], S[t][1]);
        f32x4 O[8];
#pragma unroll
        for (int db = 0; db < 8; ++db) O[db] = (f32x4){0.f, 0.f, 0.f, 0.f};
#pragma unroll
        for (int t = 8; t < 16; ++t) {
            if (t < 15) NA_LOAD(t + 1);
            const LAS unsigned char* tb = lbase + ((t & 1) * 2 + grp) * NA_TILE + (kc0 + 4 * g + q4) * NA_PITCH + 8 * p4;
#pragma unroll
            for (int db = 0; db < 8; ++db) { const s16x4 a0 = tr4(tb + 32 * db), a1 = tr4(tb + 16 * NA_PITCH + 32 * db);
                O[db] = MFMA16(cat8(a0, a1), pb[t - 8], O[db]); }
            if (t < 15) NA_WRITE((t + 1) & 1);
            __syncthreads();
        }
#undef NA_LOAD
#undef NA_WRITE
        bf16* zp = Z + (tok0 + c0 + li) * 4096 + h * 128 + 4 * g; const bf16* gp = QKVG + (tok0 + c0 + li) * 16384 + 12288 + h * 128 + 4 * g;
#pragma unroll
        for (int db = 0; db < 8; ++db) { const v2u gw = *(const GAS v2u*)(gp + 16 * db);
            const float z0 = O[db][0] * inv * siluf_(bf_lo(gw.x)), z1 = O[db][1] * inv * siluf_(bf_hi(gw.x)), z2 = O[db][2] * inv * siluf_(bf_lo(gw.y)), z3 = O[db][3] * inv * siluf_(bf_hi(gw.y));
            *(GAS v2u*)(zp + 16 * db) = (v2u){cvt_pk_bf16(z0, z1), cvt_pk_bf16(z2, z3)}; }
    }
    __syncthreads();
}

__device__ __forceinline__ void na_attn_phase2(Frame& F, const bf16* QKVG, bf16* Z, const float* rpb) {
    const int rq = F.wave >> 2, ct = F.wave & 3, lane = F.lane, li = lane & 15, g = lane >> 4, q4 = li >> 2, p4 = li & 3;
    const int c0 = ct * 16, kc0 = min(max(c0 - 8, 0), 32);
    LAS unsigned char* const lbase = F.lds + RING_OFF;
    LAS float* const rp = (LAS float*)(lbase + 6 * NA_TILE);
    const int ipw = (4096 + F.G - 1) / F.G, it0 = F.vcu * ipw;
    if (it0 >= 4096) return;
    const int nit = min(ipw, 4096 - it0);
    const bool xg = (F.G == 256);
#define NA2_ID(k_) (xg ? ((((F.vcu >> 5) * 8 + ((k_) >> 1)) << 6) | ((((k_) & 1) << 5) | (F.vcu & 31))) : (it0 + (k_)))
    const int id0 = NA2_ID(0);
    const int ptok = F.tid >> 4, pch = F.tid & 15;
    v4u R[1][3][2];
#define NA2_SEC (size_t)(2 * 32 * 8192) * 128
#define NA2_SRC(it_, ss_) (QKVG + (((ss_) >= 9) ? 2 : 1) * NA2_SEC + ((size_t)((it_) >> 6) * 8192 + (size_t)min(min(max(2 * ((it_) & 63) - 4, 0), GROWS - 8) + ((ss_) % 9), GROWS - 1) * GRIDW + ptok) * 128 + pch * 8)
#define NA2_LOADG(set_, it_, gq_) do { _Pragma("unroll") for (int jj_ = 0; jj_ < 3; ++jj_) { const bf16* s_ = NA2_SRC(it_, 3 * (gq_) + jj_); \
        R[set_][jj_][0] = *(const GAS v4u*)s_; R[set_][jj_][1] = *(const GAS v4u*)(s_ + 32 * 128); } } while (0)
#define NA2_WRITEG(set_, buf) do { _Pragma("unroll") for (int jj_ = 0; jj_ < 3; ++jj_) { LAS unsigned char* d_ = lbase + ((buf) * 3 + jj_) * NA_TILE + ptok * NA_PITCH + pch * 16; \
        *(LAS v4u*)d_ = R[set_][jj_][0]; *(LAS v4u*)(d_ + 32 * NA_PITCH) = R[set_][jj_][1]; } } while (0)
#define NA2_SCORE(kl, tb) do { S[kl][0] = (f32x4){0.f, 0.f, 0.f, 0.f}; S[kl][1] = (f32x4){0.f, 0.f, 0.f, 0.f}; \
        _Pragma("unroll") for (int blk = 0; blk < 2; ++blk) _Pragma("unroll") for (int ks = 0; ks < 4; ++ks) { \
            const bf16x8 A_ = *(const LAS bf16x8*)((tb) + (kc0 + 16 * blk + li) * NA_PITCH + (32 * ks + 8 * g) * 2); S[kl][blk] = MFMA16(A_, qf[ks], S[kl][blk]); } \
        _Pragma("unroll") for (int blk = 0; blk < 2; ++blk) _Pragma("unroll") for (int e = 0; e < 4; ++e) { const bool valid = ((blk ? vm1 : vm0) + (unsigned)e) < 16u; const float bias = bp[(kl) * 31 + blk * 16 + e]; \
            const float sv = valid ? (S[kl][blk][e] * 0.08838834764831845f + bias) : -1e30f; S[kl][blk][e] = sv; mx = fmaxf(mx, sv); } } while (0)
#define NA2_PV(kl, tb) do { const LAS unsigned char* t_ = (tb) + (kc0 + 4 * g + q4) * NA_PITCH + 8 * p4; \
        _Pragma("unroll") for (int blk = 0; blk < 2; ++blk) _Pragma("unroll") for (int e = 0; e < 4; ++e) { const float p_ = __expf(S[kl][blk][e] - mx); S[kl][blk][e] = p_; sum += p_; } \
        const bf16x8 pb_ = pack8(S[kl][0], S[kl][1]); \
        _Pragma("unroll") for (int db = 0; db < 8; ++db) O[db] = MFMA16(cat8(tr4(t_ + 32 * db), tr4(t_ + 16 * NA_PITCH + 32 * db)), pb_, O[db]); } while (0)
    NA2_LOADG(0, id0, 0);
    bf16x8 qf[4];
    { const int rp_ = id0 & 63, r_ = 2 * rp_ + rq;
      const bf16* qp = QKVG + ((size_t)(id0 >> 6) * 8192 + (size_t)r_ * GRIDW + c0 + li) * 128 + 8 * g;
#pragma unroll
      for (int ks = 0; ks < 4; ++ks) qf[ks] = *(const GAS bf16x8*)(qp + 32 * ks); }
    NA2_WRITEG(0, 0);
    for (int e = F.tid; e < 465; e += NWAVES * 64) rp[e] = rpb[((id0 >> 6) & 31) * 465 + e];
    __syncthreads();
    for (int k = 0; k < nit; ++k) {
        const int it = NA2_ID(k), itn = NA2_ID(k + 1), b = it >> 11, h = (it >> 6) & 31, rpi = it & 63;
        const int base = min(max(2 * rpi - 4, 0), GROWS - 8), r = 2 * rpi + rq, rsw = min(max(r - 4, 0), GROWS - 8), offw = rsw - base;
        const bool has_next = (k + 1 < nit);
        f32x4 S[8][2];
        int lz = F.lane; asm volatile("" : "+v"(lz)); const int liz = lz & 15, gz = lz >> 4, c = c0 + liz, cs = min(max(c - 8, 0), GRIDW - 16);
        const LAS float* bp = rp + (rsw - r + 7) * 31 + (kc0 + 4 * gz - c + 15);
        const unsigned vm0 = (unsigned)(kc0 + 4 * gz - cs), vm1 = vm0 + 16u;
        float mx = -1e30f, sum = 0.f;
#pragma unroll
        for (int gi = 0; gi < 3; ++gi) {
            NA2_LOADG(0, it, gi + 1);
#pragma unroll
            for (int jj = 0; jj < 3; ++jj) { const int j = 3 * gi + jj; const LAS unsigned char* tb = lbase + ((gi & 1) * 3 + jj) * NA_TILE;
                if (offw == 0) { if (j < 8) NA2_SCORE((j < 8 ? j : 0), tb); } else { if (j >= 1) NA2_SCORE((j >= 1 ? j - 1 : 0), tb); }
                asm volatile("" ::: "memory"); }
            NA2_WRITEG(0, (gi + 1) & 1);
            __syncthreads();
        }
        mx = fmaxf(mx, __shfl_xor(mx, 16)); mx = fmaxf(mx, __shfl_xor(mx, 32));
        f32x4 O[8];
#pragma unroll
        for (int db = 0; db < 8; ++db) O[db] = (f32x4){0.f, 0.f, 0.f, 0.f};
        v2u gw[8];
        bf16x8 qn[4];
#pragma unroll
        for (int gi = 0; gi < 3; ++gi) {
            const int sg = 3 + gi;
            if (sg + 1 < 6) NA2_LOADG(0, it, sg + 1); else if (has_next) NA2_LOADG(0, itn, 0);
            if (gi == 1 && has_next) { for (int e = F.tid; e < 465; e += NWAVES * 64) rp[e] = rpb[((itn >> 6) & 31) * 465 + e]; }
            if (gi == 2 && has_next) { const int rpn = itn & 63, rn = 2 * rpn + rq;
                const bf16* qp = QKVG + ((size_t)(itn >> 6) * 8192 + (size_t)rn * GRIDW + c0 + li) * 128 + 8 * g;
#pragma unroll
                for (int ks = 0; ks < 4; ++ks) qn[ks] = *(const GAS bf16x8*)(qp + 32 * ks); }
#pragma unroll
            for (int jj = 0; jj < 3; ++jj) { const int j = 3 * gi + jj; const LAS unsigned char* tb = lbase + ((sg & 1) * 3 + jj) * NA_TILE;
                if (offw == 0) { if (j < 8) NA2_PV((j < 8 ? j : 0), tb); } else { if (j >= 1) NA2_PV((j >= 1 ? j - 1 : 0), tb); }
                asm volatile("" ::: "memory"); }
            if (sg + 1 < 6 || has_next) NA2_WRITEG(0, (sg + 1) & 1);
            __syncthreads();
        }
        sum += __shfl_xor(sum, 16); sum += __shfl_xor(sum, 32);
        const float inv = __builtin_amdgcn_rcpf(sum);
        int lq = F.lane; asm volatile("" : "+v"(lq)); const int liq = lq & 15, gq = lq >> 4;
        const size_t mq = (size_t)b * SEQ + (size_t)r * GRIDW + c0 + liq;
        const bf16* gp = QKVG + 3 * NA2_SEC + ((size_t)(it >> 6) * 8192 + (size_t)r * GRIDW + c0 + liq) * 128 + 4 * gq;
        bf16* zp = Z + mq * 4096 + h * 128 + 4 * gq;
#pragma unroll
        for (int db = 0; db < 8; ++db) gw[db] = *(const GAS v2u*)(gp + 16 * db);
#pragma unroll
        for (int db = 0; db < 8; ++db) {
            const float z0 = O[db][0] * inv * siluf_(bf_lo(gw[db].x)), z1 = O[db][1] * inv * siluf_(bf_hi(gw[db].x)), z2 = O[db][2] * inv * siluf_(bf_lo(gw[db].y)), z3 = O[db][3] * inv * siluf_(bf_hi(gw[db].y));
            *(GAS v2u*)(zp + 16 * db) = (v2u){cvt_pk_bf16(z0, z1), cvt_pk_bf16(z2, z3)}; }
        if (has_next) {
#pragma unroll
            for (int ks = 0; ks < 4; ++ks) qf[ks] = qn[ks]; }
    }
#undef NA2_SRC
#undef NA2_SEC
#undef NA2_ID
#undef NA2_LOADG
#undef NA2_WRITEG
#undef NA2_SCORE
#undef NA2_PV
    __syncthreads();
}

__device__ __forceinline__ void s5_scan_phase(Frame& F, const Args& a) {
    const float* Sloc = (const float*)(a.ws + WS_S5_SLOC); bf16* Ug = (bf16*)(a.ws + WS_S5_UG); const float* LAMT = (const float*)(a.ws + WS_LAMT);
    const int t8 = F.tid & 255, b = t8 >> 7, dir = (t8 >> 6) & 1, p = t8 & 63;
    for (int gi = F.vcu * 2 + (F.tid >> 8); gi < S5_G; gi += F.G * 2) {
        const float lr = LAMT[((size_t)(gi * 2 + dir) * 64 + p) * 2 + 0], li = LAMT[((size_t)(gi * 2 + dir) * 64 + p) * 2 + 1];
        float xr = 0.f, xi = 0.f;
#pragma unroll 8
        for (int s = 0; s < S5_NCHB; ++s) { const int c = dir ? (S5_NCHB - 1 - s) : s; const size_t row = (size_t)gi * S5_NCH + b * S5_NCHB + c;
            bf16* up = Ug + row * S5_KY + S5_KS + dir * 128 + p;
            up[0] = (bf16)f2bf(xr); up[64] = (bf16)f2bf(xi);
            const float sr = Sloc[row * 256 + dir * 128 + p], si = Sloc[row * 256 + dir * 128 + 64 + p];
            const float nr = lr * xr - li * xi + sr, ni = lr * xi + li * xr + si; xr = nr; xi = ni; }
    }
}

__device__ __forceinline__ float log_sigmoidf_(float z) { return fminf(z, 0.f) - log1pf(expf(-fabsf(z))); }
__device__ __forceinline__ void gla_prep_phase(Frame& F, const Args& a) {
    const bf16* IN = (const bf16*)(a.ws + WS_GLA_IN); const float* G1P = (const float*)(a.ws + WS_GLA_G1P);
    bf16* PREP = (bf16*)(a.ws + WS_GLA_PREP); float* DECAY = (float*)(a.ws + WS_GLA_DECAY);
    LAS float* g1s = (LAS float*)(F.lds + RING_OFF);
    LAS float* Bc = g1s + 64 * 32;
    LAS float* bl = Bc + 2 * 64 * 256;
    static_assert((64 * 32 + 2 * 64 * 256 + 2 * 256) * 4 <= MISC_OFF, "gla prep LDS");
    const int ipw = (2048 + F.G - 1) / F.G; int cur_chunk = -1;
    for (int k = 0; k < ipw; ++k) {
        const int it = F.vcu * ipw + k; if (it >= 2048) break;
        const int cidx = it >> 3, h = it & 7, m0 = cidx * GLA_C, dbase = h * 256;
        if (cidx != cur_chunk) { cur_chunk = cidx;
            const int tok = F.tid >> 3, qd = F.tid & 7; f32x4 s4 = {0.f, 0.f, 0.f, 0.f};
#pragma unroll
            for (int ks = 0; ks < 4; ++ks) s4 += *(const GAS f32x4*)(G1P + ((size_t)ks * M + m0 + tok) * 32 + qd * 4);
            *(LAS f32x4*)(g1s + tok * 32 + qd * 4) = s4;
            __syncthreads(); }
        v4u q8[4], k8[4];
#pragma unroll
        for (int j = 0; j < 4; ++j) { const int e = F.tid + 512 * j, tok = e >> 5, c8 = (e & 31) * 8; const size_t m = (size_t)m0 + tok;
            q8[j] = __builtin_nontemporal_load((const GAS v4u*)(IN + m * GLA_NIN + dbase + c8)); k8[j] = __builtin_nontemporal_load((const GAS v4u*)(IN + m * GLA_NIN + GLA_KW + dbase + c8)); }
        {
            const int dir = F.tid >> 8, col = F.tid & 255, d = dbase + col;
            const float* w2 = dir ? a.in[28] : a.in[25]; const float bgd = (dir ? a.in[29] : a.in[26])[d];
            float w2r[16];
#pragma unroll
            for (int r = 0; r < 16; ++r) w2r[r] = w2[(size_t)r * GLA_KW + d];
            float run = 0.f;
#pragma unroll 4
            for (int s = 0; s < 64; ++s) { const int i = dir ? (63 - s) : s; const LAS f32x4* gp = (const LAS f32x4*)(g1s + i * 32 + dir * 16); float z = bgd;
                const f32x4 g0 = gp[0], g1 = gp[1], g2 = gp[2], g3 = gp[3];
                z += g0[0] * w2r[0] + g0[1] * w2r[1] + g0[2] * w2r[2] + g0[3] * w2r[3]; z += g1[0] * w2r[4] + g1[1] * w2r[5] + g1[2] * w2r[6] + g1[3] * w2r[7];
                z += g2[0] * w2r[8] + g2[1] * w2r[9] + g2[2] * w2r[10] + g2[3] * w2r[11]; z += g3[0] * w2r[12] + g3[1] * w2r[13] + g3[2] * w2r[14] + g3[3] * w2r[15];
                const float ls = fminf(z, 0.f) - __logf(1.0f + __expf(-fabsf(z)));
                run += ls * (1.0f / 16.0f); Bc[(dir * 64 + i) * 256 + col] = run; }
            bl[dir * 256 + col] = run;
        }
        __syncthreads();
#pragma unroll
        for (int j = 0; j < 4; ++j) { const int e = F.tid + 512 * j, tok = e >> 5, c8 = (e & 31) * 8; const size_t m = (size_t)m0 + tok;
            float qv[8], kv[8];
#pragma unroll
            for (int x = 0; x < 4; ++x) { qv[2 * x] = bf_lo(q8[j][x]) * 0.0625f; qv[2 * x + 1] = bf_hi(q8[j][x]) * 0.0625f; kv[2 * x] = bf_lo(k8[j][x]); kv[2 * x + 1] = bf_hi(k8[j][x]); }
#pragma unroll
            for (int dir = 0; dir < 2; ++dir) {
                f32x4 bbv[2], btv[2];
                bbv[0] = *(const LAS f32x4*)(Bc + (dir * 64 + tok) * 256 + c8); bbv[1] = *(const LAS f32x4*)(Bc + (dir * 64 + tok) * 256 + c8 + 4);
                btv[0] = *(const LAS f32x4*)(bl + dir * 256 + c8); btv[1] = *(const LAS f32x4*)(bl + dir * 256 + c8 + 4);
                float o0[8], o1[8];
#pragma unroll
                for (int x = 0; x < 8; ++x) { const float bx = bbv[x >> 2][x & 3]; o0[x] = qv[x] * __expf(bx); o1[x] = kv[x] * __expf(-bx); }
                v4u w0, w1;
#pragma unroll
                for (int x = 0; x < 4; ++x) { w0[x] = cvt_pk_bf16(o0[2 * x], o0[2 * x + 1]); w1[x] = cvt_pk_bf16(o1[2 * x], o1[2 * x + 1]); }
                bf16* pp = PREP + (size_t)(dir * 3) * M * GLA_KW + m * GLA_KW + dbase + c8;
                *(GAS v4u*)(pp) = w0; *(GAS v4u*)(pp + (size_t)M * GLA_KW) = w1;
                if (tok == 0) { float* dp = DECAY + ((size_t)dir * GLA_NCH + cidx) * GLA_KW + dbase + c8;
                    *(GAS f32x4*)(dp) = (f32x4){__expf(btv[0][0]), __expf(btv[0][1]), __expf(btv[0][2]), __expf(btv[0][3])}; *(GAS f32x4*)(dp + 4) = (f32x4){__expf(btv[1][0]), __expf(btv[1][1]), __expf(btv[1][2]), __expf(btv[1][3])}; }
            }
        }
        __syncthreads();
    }
}

constexpr int GLA_PQ = 528, GLA_PV = 272, GLA_PV2 = 144, GLA_PVI = 1040;
__device__ __forceinline__ void gla_chain_role(Frame& F, const Args& a, int ch) {
    const bf16* IN = (const bf16*)(a.ws + WS_GLA_IN); const bf16* PREP = (const bf16*)(a.ws + WS_GLA_PREP); const float* DECAY = (const float*)(a.ws + WS_GLA_DECAY);
    const int b = ch >> 7, h = (ch >> 4) & 7, dir = (ch >> 3) & 1, vo = ch & 7;
    bf16* OUT = (bf16*)(a.ws + WS_GLA_O) + (size_t)(1 + dir) * M * 4096;
    const bf16* QS = PREP + (size_t)(dir * 3 + 0) * M * GLA_KW; const bf16* KE = PREP + (size_t)(dir * 3 + 1) * M * GLA_KW;
    LAS unsigned char* const qsT = F.lds + RING_OFF; LAS unsigned char* const keT = qsT + 64 * GLA_PQ; LAS unsigned char* const vT = keT + 64 * GLA_PQ; LAS float* const decT = (LAS float*)(vT + 64 * GLA_PV2);
    const int lane = F.lane, li = lane & 15, g = lane >> 4, q4 = li >> 2, p4 = li & 3, w = F.wave;
    f32x4 S[16];
#pragma unroll
    for (int dt = 0; dt < 16; ++dt) S[dt] = (f32x4){0.f, 0.f, 0.f, 0.f};
    v4u rq[4], rk[4], rv[1]; f32x4 rd = {0.f, 0.f, 0.f, 0.f};
#define GC_LOAD(sidx) do { const int cn_ = dir ? (GLA_NCHB - 1 - (sidx)) : (sidx); const size_t m0_ = ((size_t)b * GLA_NCHB + cn_) * GLA_C; \
        _Pragma("unroll") for (int j = 0; j < 4; ++j) { const int e = F.tid + 512 * j, tok = e >> 5, pc = e & 31; \
            rq[j] = *(const GAS v4u*)(QS + (m0_ + tok) * GLA_KW + h * 256 + pc * 8); rk[j] = *(const GAS v4u*)(KE + (m0_ + tok) * GLA_KW + h * 256 + pc * 8); } \
        { const int tok = F.tid >> 3, pc = F.tid & 7; rv[0] = *(const GAS v4u*)(IN + (m0_ + tok) * GLA_NIN + 4096 + h * 512 + vo * 64 + pc * 8); } \
        if (F.tid < 64) rd = *(const GAS f32x4*)(DECAY + ((size_t)dir * GLA_NCH + b * GLA_NCHB + cn_) * GLA_KW + h * 256 + F.tid * 4); } while (0)
    GC_LOAD(0);
    for (int sidx = 0; sidx < GLA_NCHB; ++sidx) {
#pragma unroll
        for (int j = 0; j < 4; ++j) { const int e = F.tid + 512 * j, tok = e >> 5, pc = e & 31; *(LAS v4u*)(qsT + tok * GLA_PQ + pc * 16) = rq[j]; *(LAS v4u*)(keT + tok * GLA_PQ + pc * 16) = rk[j]; }
        { const int tok = F.tid >> 3, pc = F.tid & 7; *(LAS v4u*)(vT + tok * GLA_PV2 + pc * 16) = rv[0]; }
        if (F.tid < 64) *(LAS f32x4*)(decT + F.tid * 4) = rd;
        __syncthreads();
        const int cn = dir ? (GLA_NCHB - 1 - sidx) : sidx; const size_t m0 = ((size_t)b * GLA_NCHB + cn) * GLA_C;
        if (sidx + 1 < GLA_NCHB) GC_LOAD(sidx + 1);
        if (w < 4) {
        v2u Sb[16];
#pragma unroll
        for (int dt = 0; dt < 16; ++dt) Sb[dt] = (v2u){cvt_pk_bf16(S[dt][0], S[dt][1]), cvt_pk_bf16(S[dt][2], S[dt][3])};
        {
            f32x4 acc[4];
#pragma unroll
            for (int ib = 0; ib < 4; ++ib) acc[ib] = (f32x4){0.f, 0.f, 0.f, 0.f};
            const LAS unsigned char* qrow = qsT + li * GLA_PQ + 8 * g;
#pragma unroll
            for (int ks = 0; ks < 8; ++ks) { const bf16x8 A = __builtin_bit_cast(bf16x8, (v4u){Sb[2 * ks].x, Sb[2 * ks].y, Sb[2 * ks + 1].x, Sb[2 * ks + 1].y});
#pragma unroll
                for (int ib = 0; ib < 4; ++ib) { const v2u b0 = *(const LAS v2u*)(qrow + 16 * ib * GLA_PQ + 64 * ks), b1 = *(const LAS v2u*)(qrow + 16 * ib * GLA_PQ + 64 * ks + 32);
                    acc[ib] = MFMA16(A, __builtin_bit_cast(bf16x8, (v4u){b0.x, b0.y, b1.x, b1.y}), acc[ib]); } }
#pragma unroll
            for (int ib = 0; ib < 4; ++ib)
                *(GAS v2u*)(OUT + (m0 + 16 * ib + li) * 4096 + h * 512 + vo * 64 + w * 16 + 4 * g) = (v2u){cvt_pk_bf16(acc[ib][0], acc[ib][1]), cvt_pk_bf16(acc[ib][2], acc[ib][3])};
        }
#pragma unroll
        for (int k2 = 0; k2 < 2; ++k2) { const LAS unsigned char* vb = vT + (32 * k2 + 8 * g + q4) * GLA_PV2 + (w * 16 + 4 * p4) * 2;
            const bf16x8 Bv = cat8(tr4(vb), tr4(vb + 4 * GLA_PV2));
            const LAS unsigned char* kb = keT + (32 * k2 + 8 * g + q4) * GLA_PQ + 8 * p4;
#pragma unroll
            for (int dt = 0; dt < 16; ++dt) { const bf16x8 A = cat8(tr4(kb + 32 * dt), tr4(kb + 4 * GLA_PQ + 32 * dt)); S[dt] = MFMA16(A, Bv, S[dt]); } }
#pragma unroll
        for (int dt = 0; dt < 16; ++dt) S[dt] *= *(const LAS f32x4*)(decT + 16 * dt + 4 * g);
        }
        __syncthreads();
    }
#undef GC_LOAD
}
__device__ __forceinline__ void gla_intra_role(Frame& F, const Args& a, int it) {
    const bf16* IN = (const bf16*)(a.ws + WS_GLA_IN); const bf16* PREP = (const bf16*)(a.ws + WS_GLA_PREP);
    bf16* OUT = (bf16*)(a.ws + WS_GLA_O);
    const int b = it >> 10, h = (it >> 7) & 7, cn = it & 127; const size_t m0 = ((size_t)b * GLA_NCHB + cn) * GLA_C;
    LAS unsigned char* const kfT = F.lds + RING_OFF; LAS unsigned char* const kbT = kfT + 64 * GLA_PQ; LAS unsigned char* const vT = kbT + 64 * GLA_PQ;
    const int lane = F.lane, li = lane & 15, g = lane >> 4, q4 = li >> 2, p4 = li & 3, ib = F.wave & 3, vh = F.wave >> 2;
    const bf16* KSF = PREP + (size_t)1 * M * GLA_KW; const bf16* KSB = PREP + (size_t)4 * M * GLA_KW;
    const bf16* QSF = PREP; const bf16* QSB = PREP + (size_t)3 * M * GLA_KW;
    {
        v4u r0[4], r1[4], r2[8];
#pragma unroll
        for (int j = 0; j < 4; ++j) { const int e = F.tid + 512 * j, tok = e >> 5, pc = e & 31; r0[j] = *(const GAS v4u*)(KSF + (m0 + tok) * GLA_KW + h * 256 + pc * 8); r1[j] = *(const GAS v4u*)(KSB + (m0 + tok) * GLA_KW + h * 256 + pc * 8); }
#pragma unroll
        for (int j = 0; j < 8; ++j) { const int e = F.tid + 512 * j, tok = e >> 6, pc = e & 63; r2[j] = *(const GAS v4u*)(IN + (m0 + tok) * GLA_NIN + 4096 + h * 512 + pc * 8); }
#pragma unroll
        for (int j = 0; j < 4; ++j) { const int e = F.tid + 512 * j, tok = e >> 5, pc = e & 31; *(LAS v4u*)(kfT + tok * GLA_PQ + pc * 16) = r0[j]; *(LAS v4u*)(kbT + tok * GLA_PQ + pc * 16) = r1[j]; }
#pragma unroll
        for (int j = 0; j < 8; ++j) { const int e = F.tid + 512 * j, tok = e >> 6, pc = e & 63; *(LAS v4u*)(vT + tok * GLA_PVI + pc * 16) = r2[j]; }
    }
    bf16x8 qf[8], qb[8];
#pragma unroll
    for (int ks = 0; ks < 8; ++ks) { qf[ks] = *(const GAS bf16x8*)(QSF + (m0 + 16 * ib + li) * GLA_KW + h * 256 + 32 * ks + 8 * g); qb[ks] = *(const GAS bf16x8*)(QSB + (m0 + 16 * ib + li) * GLA_KW + h * 256 + 32 * ks + 8 * g); }
    __syncthreads();
    f32x4 P[4];
#pragma unroll
    for (int jb = 0; jb < 4; ++jb) { f32x4 sf = {0.f, 0.f, 0.f, 0.f}, sb = {0.f, 0.f, 0.f, 0.f};
        if (jb <= ib) {
#pragma unroll
            for (int ks = 0; ks < 8; ++ks) sf = MFMA16(*(const LAS bf16x8*)(kfT + (16 * jb + li) * GLA_PQ + (32 * ks + 8 * g) * 2), qf[ks], sf); }
        if (jb >= ib) {
#pragma unroll
            for (int ks = 0; ks < 8; ++ks) sb = MFMA16(*(const LAS bf16x8*)(kbT + (16 * jb + li) * GLA_PQ + (32 * ks + 8 * g) * 2), qb[ks], sb); }
#pragma unroll
        for (int e = 0; e < 4; ++e) { const int ii = 16 * ib + li, jj = 16 * jb + 4 * g + e; P[jb][e] = (ii >= jj) ? sf[e] : sb[e]; } }
    if (MK_DIAG) { bool bad = false;
#pragma unroll
        for (int jb = 0; jb < 4; ++jb)
#pragma unroll
            for (int e = 0; e < 4; ++e) bad |= !(fabsf(P[jb][e]) < 1e30f);
        if (bad) atomicOr((unsigned*)(a.ws + WS_CTL) + 17, 1u << 4); }
    const bf16x8 Pb0 = pack8(P[0], P[1]), Pb1 = pack8(P[2], P[3]);
    bf16* op = OUT + (m0 + 16 * ib + li) * 4096 + h * 512 + vh * 256 + 4 * g;
    const LAS unsigned char* vb = vT + (4 * g + q4) * GLA_PVI + (vh * 256 + 4 * p4) * 2;
#pragma unroll
    for (int vt = 0; vt < 16; ++vt) { f32x4 acc = {0.f, 0.f, 0.f, 0.f};
        acc = MFMA16(cat8(tr4(vb + 32 * vt), tr4(vb + 16 * GLA_PVI + 32 * vt)), Pb0, acc);
        acc = MFMA16(cat8(tr4(vb + 32 * GLA_PVI + 32 * vt), tr4(vb + 48 * GLA_PVI + 32 * vt)), Pb1, acc);
        if (MK_DIAG && (!(fabsf(acc[0]) < 1e30f) || !(fabsf(acc[1]) < 1e30f) || !(fabsf(acc[2]) < 1e30f) || !(fabsf(acc[3]) < 1e30f))) atomicOr((unsigned*)(a.ws + WS_CTL) + 17, 1u << 5);
        *(GAS v2u*)(op + 16 * vt) = (v2u){cvt_pk_bf16(acc[0], acc[1]), cvt_pk_bf16(acc[2], acc[3])}; }
    __syncthreads();
}
__device__ __forceinline__ void gla_main_phase(Frame& F, const Args& a) {
    for (int ch = F.vcu; ch < 256; ch += F.G) gla_chain_role(F, a, ch);
    for (int it = F.vcu; it < 2048; it += F.G) gla_intra_role(F, a, it);
}
__device__ __forceinline__ void gla_combine_phase(Frame& F, const Args& a) {
    const bf16* IN = (const bf16*)(a.ws + WS_GLA_IN); const bf16* O = (const bf16*)(a.ws + WS_GLA_O); bf16* Z = (bf16*)(a.ws + WS_GLA_Z);
    const float* nw = a.in[30];
    float nwr[8];
#pragma unroll
    for (int x = 0; x < 8; ++x) nwr[x] = nw[F.lane * 8 + x];
    const int gw = F.vcu * NWAVES + F.wave, NGW = F.G * NWAVES;
    for (int m = gw; m < M; m += NGW) {
#pragma unroll 2
        for (int h = 0; h < 8; ++h) { const size_t off = (size_t)m * 4096 + h * 512 + F.lane * 8;
            const v4u x0 = __builtin_nontemporal_load((const GAS v4u*)(O + off)), x1 = __builtin_nontemporal_load((const GAS v4u*)(O + (size_t)M * 4096 + off)), x2 = __builtin_nontemporal_load((const GAS v4u*)(O + (size_t)2 * M * 4096 + off));
            const v4u gg = __builtin_nontemporal_load((const GAS v4u*)(IN + (size_t)m * GLA_NIN + 8192 + h * 512 + F.lane * 8));
            if (MK_DIAG) { bool b0 = false, b1 = false, b2 = false, b3 = false;
#pragma unroll
                for (int x = 0; x < 4; ++x) { b0 |= !(fabsf(bf_lo(x0[x])) < 1e30f) || !(fabsf(bf_hi(x0[x])) < 1e30f); b1 |= !(fabsf(bf_lo(x1[x])) < 1e30f) || !(fabsf(bf_hi(x1[x])) < 1e30f);
                    b2 |= !(fabsf(bf_lo(x2[x])) < 1e30f) || !(fabsf(bf_hi(x2[x])) < 1e30f); b3 |= !(fabsf(bf_lo(gg[x])) < 1e30f) || !(fabsf(bf_hi(gg[x])) < 1e30f); }
                const unsigned f = (b0 ? 1024u : 0u) | (b1 ? 2048u : 0u) | (b2 ? 4096u : 0u) | (b3 ? 8192u : 0u); if (f) atomicOr((unsigned*)(a.ws + WS_CTL) + 17, f); }
            float o[8]; float ss = 0.f;
#pragma unroll
            for (int x = 0; x < 4; ++x) { o[2 * x] = bf_lo(x0[x]) + bf_lo(x1[x]) + bf_lo(x2[x]); o[2 * x + 1] = bf_hi(x0[x]) + bf_hi(x1[x]) + bf_hi(x2[x]); ss += o[2 * x] * o[2 * x] + o[2 * x + 1] * o[2 * x + 1]; }
            const float rstd = rsqrtf(wave_sum(ss) * (1.0f / 512.0f) + EPS);
            v4u zw;
#pragma unroll
            for (int x = 0; x < 4; ++x) zw[x] = cvt_pk_bf16(o[2 * x] * rstd * nwr[2 * x] * siluf_(bf_lo(gg[x])), o[2 * x + 1] * rstd * nwr[2 * x + 1] * siluf_(bf_hi(gg[x])));
            *(GAS v4u*)(Z + off) = zw; }
    }
}

constexpr int NPH = 23;
__global__ void __launch_bounds__(NWAVES * 64, 2) fwd_kernel(Args args) {
    extern __shared__ __attribute__((aligned(16))) unsigned char lds[];
    Frame F;
    F.lds = (LAS unsigned char*)lds;
    F.tid = threadIdx.x; F.lane = F.tid & 63; F.wave = __builtin_amdgcn_readfirstlane(F.tid >> 6);
    F.G = gridDim.x; { const int bx = blockIdx.x; F.vcu = (F.G % 8 == 0) ? (bx % 8) * (F.G / 8) + bx / 8 : bx; }
    volatile LAS unsigned* MISC = (volatile LAS unsigned*)(F.lds + MISC_OFF);
    for (int u = F.tid; u < (LDS_BYTES - MISC_OFF) / 4; u += NWAVES * 64) MISC[u] = 0u;
    __syncthreads();
    unsigned char* ws = args.ws;
    const int lo = args.ph_lo, hi = args.ph_hi, rep = args.dup;
    XcdBarrier bar; bar.bar = (unsigned*)(ws + WS_CTL) + CW_BAR; bar.x = 0; bar.st = nullptr;
    if (hi - lo > 1) bar = xcd_barrier_post((unsigned*)(ws + WS_CTL) + CW_BAR, MISC + 8);
#define IN(k) (lo <= (k) && (k) < hi)
#define REP(k)
#if MK_PROF
    volatile LAS unsigned long long* PROF = (volatile LAS unsigned long long*)(F.lds + 135168);
    if (F.tid == 0) PROF[0] = __builtin_amdgcn_s_memrealtime();
#define SEAM(k) do { if (IN(k) && IN((k) + 1)) { if (F.tid == 0) PROF[32 + (k)] = __builtin_amdgcn_s_memrealtime(); xcd_barrier(bar); if (F.tid == 0) PROF[1 + (k)] = __builtin_amdgcn_s_memrealtime(); } } while (0)
#else
#define SEAM(k) do { if (IN(k) && IN((k) + 1)) xcd_barrier(bar); } while (0)
#endif
    const float* MOD = (const float*)(ws + WS_MOD);
    bf16* H = (bf16*)(ws + WS_H);
    float* XO = args.out;
    LAS unsigned char* ring = F.lds + RING_OFF;
    unsigned* const DFLAG = (unsigned*)(ws + WS_CTL) + 16;

    if (IN(0)) { REP(0) { p0_prologue(F, args); } } SEAM(0);

#if MK_NLAYERS >= 1
    if (IN(1)) { REP(1) { norm_phase<false>(F, args.in[0], args.in[4] + 0 * D, MOD + 0 * 2 * 12288, H, nullptr); } } SEAM(1);
    if (IN(2)) { REP(2) { pg8::Gemm g{H, (const bf16*)(ws + WS_W_NAIN0), 4096, 4096, 4096, DFLAG, 1u << 2}; pg8::StaticOrder S; S.init(M, 16384, F.G, (int)blockIdx.x);
        pg8::EpiNaIn E{(bf16*)(ws + WS_NA_QKVG)};
        pg8::gemm_phase<pg8::EpiNaIn, pg8::StaticOrder, false, true>(ring, g, S, E); } } SEAM(2);
    if (IN(3)) { REP(3) na_attn_phase2(F, (const bf16*)(ws + WS_NA_QKVG), (bf16*)(ws + WS_NA_Z), args.in[6] + 0 * 32 * 465); } SEAM(3);
    if (IN(4)) { REP(4) { pg8::Gemm g{(const bf16*)(ws + WS_NA_Z), (const bf16*)(ws + WS_W_NAOUT0), 4096, 4096, 4096, DFLAG, 1u << 4}; pg8::StaticOrder S; S.init(M, 4096, F.G, (int)blockIdx.x);
        pg8::EpiResid E{args.in[0], rep ? (float*)(ws + WS_SCR) : XO, D, MOD + 0 * 2 * 12288 + 8192, 12288, SEQ};
        pg8::gemm_phase<pg8::EpiResid, pg8::StaticOrder, true, true>(ring, g, S, E); } } SEAM(4);
#endif
#if MK_NLAYERS >= 2
    if (IN(5)) { REP(5) { norm_phase<false>(F, XO, args.in[4] + 1 * D, MOD + 1 * 2 * 12288, H, nullptr); } } SEAM(5);
    if (IN(6)) { REP(6) { pg8::Gemm g{H, (const bf16*)(ws + WS_W_S5IN), 4096, 4096, 4096, DFLAG, 1u << 6}; pg8::StaticOrder S; S.init(M, 8192, F.G, (int)blockIdx.x);
        pg8::EpiS5In<S5_T, S5_NCH, S5_KY> E{(bf16*)(ws + WS_S5_UG), (bf16*)(ws + WS_S5_GS)};
        pg8::gemm_phase<pg8::EpiS5In<S5_T, S5_NCH, S5_KY>, pg8::StaticOrder, true, true>(ring, g, S, E); } } SEAM(6);
    if (IN(7)) { REP(7) { pg8::Gemm g{(const bf16*)(ws + WS_S5_UG), (const bf16*)(ws + WS_S5BS), S5_KS, S5_KY, S5_KS, DFLAG, 1u << 7}; pg8::BatchedOrder S; S.init(S5_G, S5_NCH / 256, 1, F.G, (int)blockIdx.x);
        pg8::EpiF32 E{(float*)(ws + WS_S5_SLOC), 256};
        pg8::gemm_phase<pg8::EpiF32, pg8::BatchedOrder, true, true>(ring, g, S, E); } } SEAM(7);
    if (IN(8)) { REP(8) { s5_scan_phase(F, args); } } SEAM(8);
    if (IN(9)) { REP(9) { pg8::Gemm g{(const bf16*)(ws + WS_S5_UG), (const bf16*)(ws + WS_S5BY), S5_KY, S5_KY, S5_KY, DFLAG, 1u << 9}; pg8::BatchedOrder S; S.init(S5_G, S5_NCH / 256, S5_KS / 256, F.G, (int)blockIdx.x);
        pg8::EpiS5Y<S5_T, S5_NCH / 256> E{(bf16*)(ws + WS_S5_Y)};
        pg8::gemm_phase<pg8::EpiS5Y<S5_T, S5_NCH / 256>, pg8::BatchedOrder, true, true>(ring, g, S, E); } } SEAM(9);
    if (IN(10)) { REP(10) { pg8::Gemm g{(const bf16*)(ws + WS_S5_Y), (const bf16*)(ws + WS_W_S5GLU), 4096, 4096, 4096, DFLAG, 1u << 10}; pg8::StaticOrder S; S.init(M, 4096, F.G, (int)blockIdx.x);
        pg8::EpiGlu E{(const bf16*)(ws + WS_S5_Y), (const bf16*)(ws + WS_S5_GS), args.in[21], (bf16*)(ws + WS_S5_Z)};
        pg8::gemm_phase<pg8::EpiGlu, pg8::StaticOrder, true, true>(ring, g, S, E); } } SEAM(10);
    if (IN(11)) { REP(11) { pg8::Gemm g{(const bf16*)(ws + WS_S5_Z), (const bf16*)(ws + WS_W_S5OUT), 4096, 4096, 4096, DFLAG, 1u << 11}; pg8::StaticOrder S; S.init(M, 4096, F.G, (int)blockIdx.x);
        pg8::EpiResid E{XO, rep ? (float*)(ws + WS_SCR) : XO, D, MOD + 1 * 2 * 12288 + 8192, 12288, SEQ};
        pg8::gemm_phase<pg8::EpiResid, pg8::StaticOrder, true, true>(ring, g, S, E); } } SEAM(11);
#endif
#if MK_NLAYERS >= 3
    if (IN(12)) { REP(12) { norm_phase<false>(F, XO, args.in[4] + 2 * D, MOD + 2 * 2 * 12288, H, nullptr); } } SEAM(12);
    if (IN(13)) { REP(13) { { pg8::Gemm g{H, (const bf16*)(ws + WS_W_GLAIN), 4096, 4096, 4096, DFLAG, 1u << 13}; pg8::StaticOrder S; S.init(M, GLA_NIN, F.G, (int)blockIdx.x);
          pg8::EpiBf16 E{(bf16*)(ws + WS_GLA_IN), GLA_NIN};
          pg8::gemm_phase<pg8::EpiBf16, pg8::StaticOrder, true, true>(ring, g, S, E); }
        { pg8::Gemm g{H, (const bf16*)(ws + WS_W_GLAG1), 1024, 4096, 4096, DFLAG, 1u << 13}; pg8::SplitKOrder S; S.init(M, 4, 1024, F.G, (int)blockIdx.x);
          pg8::EpiGate E{(float*)(ws + WS_GLA_G1P), M};
          pg8::gemm_phase<pg8::EpiGate, pg8::SplitKOrder, true, true>(ring, g, S, E); } } } SEAM(13);
    if (IN(14)) { REP(14) { gla_prep_phase(F, args); } } SEAM(14);
    if (IN(15)) { REP(15) { gla_main_phase(F, args); } } SEAM(15);
    if (IN(16)) { REP(16) { gla_combine_phase(F, args); } } SEAM(16);
    if (IN(17)) { REP(17) { pg8::Gemm g{(const bf16*)(ws + WS_GLA_Z), (const bf16*)(ws + WS_W_GLAOUT), 4096, 4096, 4096, DFLAG, 1u << 17}; pg8::StaticOrder S; S.init(M, 4096, F.G, (int)blockIdx.x);
        pg8::EpiResid E{XO, rep ? (float*)(ws + WS_SCR) : XO, D, MOD + 2 * 2 * 12288 + 8192, 12288, SEQ};
        pg8::gemm_phase<pg8::EpiResid, pg8::StaticOrder, true, true>(ring, g, S, E); } } SEAM(17);
#endif
#if MK_NLAYERS >= 4
    if (IN(18)) { REP(18) { norm_phase<false>(F, XO, args.in[4] + 3 * D, MOD + 3 * 2 * 12288, H, nullptr); } } SEAM(18);
    if (IN(19)) { REP(19) { pg8::Gemm g{H, (const bf16*)(ws + WS_W_NAIN1), 4096, 4096, 4096, DFLAG, 1u << 19}; pg8::StaticOrder S; S.init(M, 16384, F.G, (int)blockIdx.x);
        pg8::EpiNaIn E{(bf16*)(ws + WS_NA_QKVG)};
        pg8::gemm_phase<pg8::EpiNaIn, pg8::StaticOrder, false, true>(ring, g, S, E); } } SEAM(19);
    if (IN(20)) { REP(20) na_attn_phase2(F, (const bf16*)(ws + WS_NA_QKVG), (bf16*)(ws + WS_NA_Z), args.in[6] + 1 * 32 * 465); } SEAM(20);
    if (IN(21)) { REP(21) { pg8::Gemm g{(const bf16*)(ws + WS_NA_Z), (const bf16*)(ws + WS_W_NAOUT1), 4096, 4096, 4096, DFLAG, 1u << 21}; pg8::StaticOrder S; S.init(M, 4096, F.G, (int)blockIdx.x);
        pg8::EpiResid E{XO, rep ? (float*)(ws + WS_SCR) : XO, D, MOD + 3 * 2 * 12288 + 8192, 12288, SEQ};
        pg8::gemm_phase<pg8::EpiResid, pg8::StaticOrder, true, true>(ring, g, S, E); } } SEAM(21);
#endif
    if (IN(22)) { REP(22) norm_phase<true>(F, (MK_NLAYERS >= 1) ? (const float*)XO : args.in[0], args.in[32], nullptr, nullptr, XO); }
#if MK_DIAG
    if (IN(22)) { __syncthreads(); const unsigned f = __hip_atomic_load(DFLAG, __ATOMIC_RELAXED, __HIP_MEMORY_SCOPE_AGENT);
        const unsigned f2 = __hip_atomic_load(DFLAG + 1, __ATOMIC_RELAXED, __HIP_MEMORY_SCOPE_AGENT);
        if (f != 0u || f2 != 0u) { const int k = f2 ? (24 + __builtin_ctz(f2)) : __builtin_ctz(f); float mk = 10.f; for (int i = 0; i < k; ++i) mk *= 10.f;
            const int gw = F.vcu * NWAVES + F.wave, NGW = F.G * NWAVES;
            for (int m = gw; m < M; m += NGW) for (int j = 0; j < 16; ++j) *((GAS f32x4*)(XO + (size_t)m * D) + F.lane + 64 * j) = (f32x4){mk, mk, mk, mk}; }
        else { const int gw = F.vcu * NWAVES + F.wave, NGW = F.G * NWAVES;
            for (int m = gw; m < M; m += NGW) for (int j = 0; j < 16; ++j) { GAS f32x4* p = (GAS f32x4*)(XO + (size_t)m * D) + F.lane + 64 * j; f32x4 v = *p; bool ch = false;
                for (int e = 0; e < 4; ++e) if (!(__builtin_fabsf(v[e]) < 3.0e38f)) { v[e] = 3.0e30f; ch = true; } if (ch) *p = v; } } }
#endif
#if MK_PROF
    if (F.tid == 0) PROF[32 + 22] = __builtin_amdgcn_s_memrealtime();
    xcd_barrier(bar);
    if (F.tid == 0) PROF[1 + 22] = __builtin_amdgcn_s_memrealtime();
    __syncthreads();
    if (blockIdx.x == 0) {
        float d[23], w[23];
        for (int k = 0; k < 23; ++k) { d[k] = (float)(PROF[1 + k] - PROF[k]) * 0.01f; w[k] = (float)(PROF[1 + k] - PROF[32 + k]) * 0.01f; }
        (void)w;
        const float A = (float)(MK_PROF_A) * 1.0e4f, B = (float)(MK_PROF_B) * 1.0e3f;
        for (size_t i = F.tid; i < (size_t)M * D; i += NWAVES * 64) XO[i] = (i == 0) ? A : B;
    }
#endif
#undef IN
#undef REP
#undef SEAM
}

extern "C" void kernel_launch(void* const* d_in, const int* in_sizes, int n_in, void* d_out, int out_size, void* d_ws, size_t ws_size, hipStream_t stream) {
    static int grid = 0;
    if (grid == 0) {
        if (n_in != 33 || in_sizes[0] != M * D || out_size != M * D || ws_size < WS_END) {
            fprintf(stderr, "kernel_launch: built for 33 inputs, x/out of %d floats, >= %zu bytes of workspace; got n_in %d, in0 %d, out %d, ws %zu; nothing launched\n", M * D, (size_t)WS_END, n_in, n_in > 0 ? in_sizes[0] : -1, out_size, ws_size);
            grid = -1; return; }
        int dev = 0, cus = 0, per_cu = 0;
        if (hipGetDevice(&dev) != hipSuccess || hipDeviceGetAttribute(&cus, hipDeviceAttributeMultiprocessorCount, dev) != hipSuccess) { fprintf(stderr, "kernel_launch: device query failed\n"); grid = -1; return; }
        if (hipFuncSetAttribute((const void*)fwd_kernel, hipFuncAttributeMaxDynamicSharedMemorySize, LDS_BYTES) != hipSuccess) { fprintf(stderr, "kernel_launch: hipFuncSetAttribute failed\n"); grid = -1; return; }
        if (hipOccupancyMaxActiveBlocksPerMultiprocessor(&per_cu, (const void*)fwd_kernel, NWAVES * 64, LDS_BYTES) != hipSuccess || per_cu < 1)
            fprintf(stderr, "kernel_launch: note: occupancy query reports %d workgroups per CU\n", per_cu);
        (void)hipGetLastError();
        grid = cus;
        if (grid != 256) fprintf(stderr, "kernel_launch: note: %d CUs (tuned for 256)\n", grid);
        if (grid < 136) { fprintf(stderr, "kernel_launch: needs >= 136 CUs\n"); grid = -1; return; }
    }
    if (grid < 0) return;
    if (hipMemsetAsync((char*)d_ws + WS_CTL, 0, CTL_ZERO_BYTES, stream) != hipSuccess) { fprintf(stderr, "kernel_launch: memset failed\n"); return; }
    Args a{};
    for (int i = 0; i < 33; ++i) a.in[i] = (const float*)d_in[i];
    a.out = (float*)d_out; a.ws = (unsigned char*)d_ws;
#if MK_ONE_LAUNCH
    a.ph_lo = 0; a.ph_hi = NPH;
    hipLaunchKernelGGL(fwd_kernel, dim3(grid), dim3(NWAVES * 64), LDS_BYTES, stream, a);
#else
    for (int ph = 0; ph < NPH; ++ph) { a.ph_lo = ph; a.ph_hi = ph + 1; a.dup = 0;
        hipLaunchKernelGGL(fwd_kernel, dim3(grid), dim3(NWAVES * 64), LDS_BYTES, stream, a);
        if ((MK_DUP >> ph) & 1u) { a.dup = 1; hipLaunchKernelGGL(fwd_kernel, dim3(grid), dim3(NWAVES * 64), LDS_BYTES, stream, a); } }
#endif
    const hipError_t le = hipPeekAtLastError();
    if (le != hipSuccess) fprintf(stderr, "kernel_launch: launch failed: %s\n", hipGetErrorName(le));
}
```

```cpp
#include <hip/hip_runtime.h>
#include <cstdio>
#include <cstdint>

#ifndef MK_ONE_LAUNCH
#define MK_ONE_LAUNCH 1
#endif
#ifndef MK_DIAG
#define MK_DIAG 0
#endif
#ifndef MK_PROF
#define MK_PROF 0
#endif
#define MK_PROF_A (d[2]+d[19]+d[4]+d[21]+d[6]+d[10]+d[11]+d[13]+d[17])
#define MK_PROF_B (d[0])
#ifndef MK_DUP
#define MK_DUP 0u
#endif
#ifndef MK_NLAYERS
#define MK_NLAYERS 4
#endif

namespace pg8 {
#define PG8_LAS __attribute__((address_space(3)))
typedef unsigned short bf16_t;
typedef short bf16x8 __attribute__((ext_vector_type(8)));
typedef float f32x4 __attribute__((ext_vector_type(4)));
typedef unsigned u32x4 __attribute__((ext_vector_type(4)));
typedef unsigned u32x2 __attribute__((ext_vector_type(2)));
constexpr int BM = 256, BK = 64, HALF = 128, HTB = HALF * BK * 2  , STAGE_BYTES = 8 * HTB, NXCD = 8, WGM = 8;

__host__ __device__ __forceinline__ int lds_byte(int r, int c) { const int st = (r >> 4) * 2 + (c >> 5), rr = r & 15, cc = c & 31, ob = rr * 64 + cc * 2; return st * 1024 + (ob ^ (((ob >> 9) & 1) << 5)); }
__host__ __device__ __forceinline__ void stage_rc(int b, int& R, int& C) { const int st = b / 1024, sb = b % 1024, swz = sb ^ (((sb >> 9) & 1) << 5); R = (st >> 1) * 16 + swz / 64; C = (st & 1) * 32 + (swz % 64) / 2; }
__host__ __device__ __forceinline__ int perm32(int rho) { const int n = rho >> 4, i = rho & 15; return 8 * (i >> 2) + 4 * n + (i & 3); }

struct Unit { int pm, pn, pb, koff; };
struct Gemm { const bf16_t* A; const bf16_t* Bt; int K, lda, ldb; unsigned* dflag; unsigned dbit; };

struct StaticOrder {
    int nM, nN, nwg, G, c;
    __host__ __device__ void init(int M, int N, int G_, int c_) { nM = M / BM; nN = N / BM; nwg = nM * nN; G = G_; c = c_; }
    __host__ __device__ bool next(int i, Unit& u) const {
        const long L = (long)i * G + c; if (L >= nwg) return false;
        int wgid = (int)L; { const int q = nwg / NXCD, r = nwg % NXCD, xcd = wgid % NXCD, off = wgid / NXCD; wgid = (xcd < r ? xcd * (q + 1) : r * (q + 1) + (xcd - r) * q) + off; }
        const int nig = WGM * nN, gid = wgid / nig, fm = gid * WGM, gsz = (nM - fm) < WGM ? (nM - fm) : WGM;
        u.pm = fm + ((wgid % nig) % gsz); u.pn = (wgid % nig) / gsz; u.pb = u.pn; u.koff = 0; return true;
    }
    __device__ __forceinline__ void a_ready(const Unit&) const {}
    __device__ __forceinline__ void done(const Unit&) const {}
};
struct BatchedOrder {
    int nPm, nPn, total, G, c;
    __host__ __device__ void init(int ngroups, int nPm_, int nPn_, int G_, int c_) { nPm = nPm_; nPn = nPn_; total = ngroups * nPm * nPn; G = G_; c = c_; }
    __host__ __device__ bool next(int i, Unit& u) const {
        long L = (long)i * G + c; if (L >= total) return false;
        const int upg = nPm * nPn;
        if (G % 8 == 0 && (G / 8) % upg == 0 && total % G == 0) {
            const int x = c % 8, q = c / 8, gpx = (G / 8) / upg;
            L = ((long)(i * 8 + x) * gpx + q / upg) * upg + q % upg; }
        const int g = (int)L / upg, rem = (int)L % upg, pmi = rem / nPn, pni = rem % nPn;
        u.pm = g * nPm + pmi; u.pn = pni; u.pb = g * nPn + pni; u.koff = 0; return true;
    }
    __device__ __forceinline__ void a_ready(const Unit&) const {}
    __device__ __forceinline__ void done(const Unit&) const {}
};
struct SplitKOrder {
    int nM, nsplit, kslice, G, c;
    __host__ __device__ void init(int M, int nsplit_, int kslice_, int G_, int c_) { nM = M / BM; nsplit = nsplit_; kslice = kslice_; G = G_; c = c_; }
    __host__ __device__ bool next(int i, Unit& u) const {
        const long L = (long)i * G + c; if (L >= (long)nM * nsplit) return false;
        u.pm = (int)L / nsplit; u.pn = (int)L % nsplit; u.pb = 0; u.koff = u.pn * kslice; return true;
    }
    __device__ __forceinline__ void a_ready(const Unit&) const {}
    __device__ __forceinline__ void done(const Unit&) const {}
};

typedef float f32x2_t __attribute__((ext_vector_type(2))); typedef __bf16 bf16x2_t __attribute__((ext_vector_type(2)));
__device__ __forceinline__ unsigned cvt_pk_bf16(float lo, float hi) { f32x2_t v = {lo, hi}; bf16x2_t b = __builtin_convertvector(v, bf16x2_t); return __builtin_bit_cast(unsigned, b); }
__device__ __forceinline__ float bf_lo(unsigned w) { return __uint_as_float(w << 16); }
__device__ __forceinline__ float bf_hi(unsigned w) { return __uint_as_float(w & 0xffff0000u); }
__device__ __forceinline__ float sigmoidf_(float x) { return __builtin_amdgcn_rcpf(1.0f + __expf(-x)); }
__device__ __forceinline__ float siluf_(float x) { return x * __builtin_amdgcn_rcpf(1.0f + __expf(-x)); }
__device__ __forceinline__ float gelu_tanh(float x) { const float z = 0.7978845608028654f * (x + 0.044715f * x * x * x); return x * __builtin_amdgcn_rcpf(1.0f + __expf(-2.0f * z)); }

struct EpiBf16 {
    static constexpr bool PERM = true, AFTER_DRAIN = false;
    bf16_t* O; int ldc;
    __device__ __forceinline__ void operator()(const f32x4 (&acc)[2][2][4][2], const Unit& u, int wr, int wc, int fr, int fq) const {
        const int row0 = u.pm * BM + wr * 64 + fr, col0 = u.pn * BM + wc * 32 + 8 * fq;
#pragma unroll
        for (int ai = 0; ai < 2; ++ai)
#pragma unroll
            for (int m = 0; m < 4; ++m) { bf16_t* rowp = O + (size_t)(row0 + ai * HALF + m * 16) * ldc + col0;
#pragma unroll
                for (int bj = 0; bj < 2; ++bj) { const f32x4 v0 = acc[ai][bj][m][0], v1 = acc[ai][bj][m][1];
                    u32x4 w; w.x = cvt_pk_bf16(v0[0], v0[1]); w.y = cvt_pk_bf16(v0[2], v0[3]); w.z = cvt_pk_bf16(v1[0], v1[1]); w.w = cvt_pk_bf16(v1[2], v1[3]);
                    *(u32x4*)(rowp + bj * HALF) = w; } }
    }
};
struct EpiNaIn {
    static constexpr bool PERM = true, AFTER_DRAIN = false;
    bf16_t* O;
    __device__ __forceinline__ void operator()(const f32x4 (&acc)[2][2][4][2], const Unit& u, int wr, int wc, int fr, int fq) const {
        const int row0 = u.pm * BM + wr * 64 + fr, col0 = u.pn * BM + wc * 32 + 8 * fq;
#pragma unroll
        for (int ai = 0; ai < 2; ++ai)
#pragma unroll
            for (int m = 0; m < 4; ++m) { const int row = row0 + ai * HALF + m * 16, b = row >> 13, l = row & 8191;
#pragma unroll
                for (int bj = 0; bj < 2; ++bj) { const f32x4 v0 = acc[ai][bj][m][0], v1 = acc[ai][bj][m][1]; const int n = col0 + bj * HALF, sec = n >> 12, hd = (n >> 7) & 31, d = n & 127;
                    u32x4 w; w.x = cvt_pk_bf16(v0[0], v0[1]); w.y = cvt_pk_bf16(v0[2], v0[3]); w.z = cvt_pk_bf16(v1[0], v1[1]); w.w = cvt_pk_bf16(v1[2], v1[3]);
                    *(u32x4*)(O + ((size_t)((sec * 2 + b) * 32 + hd) * 8192 + l) * 128 + d) = w; } }
    }
};
struct EpiResid {
    static constexpr bool PERM = false, AFTER_DRAIN = false;
    const float* base; float* out; int ldc; const float* gate0; int gate_stride; int rows_per_batch;
    __device__ __forceinline__ void operator()(const f32x4 (&acc)[2][2][4][2], const Unit& u, int wr, int wc, int fr, int fq) const {
        const int row0 = u.pm * BM + wr * 64 + fr, col0 = u.pn * BM + wc * 32 + 4 * fq;
        const float* gp = gate0 + (size_t)((u.pm * BM) / rows_per_batch) * gate_stride + col0;
        f32x4 gv[2][2];
#pragma unroll
        for (int bj = 0; bj < 2; ++bj)
#pragma unroll
            for (int n = 0; n < 2; ++n) gv[bj][n] = *(const f32x4*)(gp + bj * HALF + n * 16);
#pragma unroll
        for (int ai = 0; ai < 2; ++ai)
#pragma unroll
            for (int m = 0; m < 4; ++m) { const size_t off = (size_t)(row0 + ai * HALF + m * 16) * ldc + col0;
#pragma unroll
                for (int bj = 0; bj < 2; ++bj)
#pragma unroll
                    for (int n = 0; n < 2; ++n) { const f32x4 bs = *(const f32x4*)(base + off + bj * HALF + n * 16);
                        *(f32x4*)(out + off + bj * HALF + n * 16) = bs + gv[bj][n] * acc[ai][bj][m][n]; }
                if (m & 1) asm volatile("" ::: "memory"); }
    }
};
struct EpiF32 {
    static constexpr bool PERM = false, AFTER_DRAIN = false;
    float* C; int ldc;
    __device__ __forceinline__ void operator()(const f32x4 (&acc)[2][2][4][2], const Unit& u, int wr, int wc, int fr, int fq) const {
        const int row0 = u.pm * BM + wr * 64 + fr, col0 = u.pn * BM + wc * 32 + 4 * fq;
#pragma unroll
        for (int ai = 0; ai < 2; ++ai)
#pragma unroll
            for (int m = 0; m < 4; ++m) { float* rowp = C + (size_t)(row0 + ai * HALF + m * 16) * ldc + col0;
#pragma unroll
                for (int bj = 0; bj < 2; ++bj)
#pragma unroll
                    for (int n = 0; n < 2; ++n) *(f32x4*)(rowp + bj * HALF + n * 16) = acc[ai][bj][m][n]; }
    }
};
struct EpiGate {
    static constexpr bool PERM = false, AFTER_DRAIN = false;
    float* P; int rows;
    __device__ __forceinline__ void operator()(const f32x4 (&acc)[2][2][4][2], const Unit& u, int wr, int wc, int fr, int fq) const {
        if (wc != 0) return;
        const int row0 = u.pm * BM + wr * 64 + fr;
#pragma unroll
        for (int ai = 0; ai < 2; ++ai)
#pragma unroll
            for (int m = 0; m < 4; ++m) { float* rowp = P + ((size_t)u.pn * rows + (row0 + ai * HALF + m * 16)) * 32 + 4 * fq;
#pragma unroll
                for (int n = 0; n < 2; ++n) *(f32x4*)(rowp + n * 16) = acc[ai][0][m][n]; }
    }
};
template <int T, int NCH, int KY> struct EpiS5In {
    static constexpr bool PERM = true, AFTER_DRAIN = false;
    bf16_t* Ug; bf16_t* Gs;
    __device__ __forceinline__ void operator()(const f32x4 (&acc)[2][2][4][2], const Unit& u, int wr, int wc, int fr, int fq) const {
        const int row0 = u.pm * BM + wr * 64 + fr, col0 = u.pn * BM + wc * 32 + 8 * fq;
#pragma unroll
        for (int ai = 0; ai < 2; ++ai)
#pragma unroll
            for (int m = 0; m < 4; ++m) { const int row = row0 + ai * HALF + m * 16;
#pragma unroll
                for (int bj = 0; bj < 2; ++bj) { const f32x4 v0 = acc[ai][bj][m][0], v1 = acc[ai][bj][m][1]; const int col = col0 + bj * HALF;
                    u32x4 w; w.x = cvt_pk_bf16(v0[0], v0[1]); w.y = cvt_pk_bf16(v0[2], v0[3]); w.z = cvt_pk_bf16(v1[0], v1[1]); w.w = cvt_pk_bf16(v1[2], v1[3]);
                    if (col < 4096) { const int g = col >> 4, i0 = col & 15, chunk = row / T, t = row % T;
                        *(u32x4*)(Ug + ((size_t)g * NCH + chunk) * KY + t * 16 + i0) = w; }
                    else *(u32x4*)(Gs + (size_t)row * 4096 + (col - 4096)) = w; } }
    }
};
template <int T, int NPM> struct EpiS5Y {
    static constexpr bool PERM = true, AFTER_DRAIN = false;
    bf16_t* Y;
    __device__ __forceinline__ void operator()(const f32x4 (&acc)[2][2][4][2], const Unit& u, int wr, int wc, int fr, int fq) const {
        const int g = u.pm / NPM, chunk0 = (u.pm % NPM) * BM + wr * 64 + fr, col0 = u.pn * BM + wc * 32 + 8 * fq;
#pragma unroll
        for (int ai = 0; ai < 2; ++ai)
#pragma unroll
            for (int m = 0; m < 4; ++m) { const int chunk = chunk0 + ai * HALF + m * 16;
#pragma unroll
                for (int bj = 0; bj < 2; ++bj) { f32x4 v0 = acc[ai][bj][m][0], v1 = acc[ai][bj][m][1]; const int n = col0 + bj * HALF, t = n >> 4, i0 = n & 15;
#pragma unroll
                    for (int j = 0; j < 4; ++j) { v0[j] = gelu_tanh(v0[j]); v1[j] = gelu_tanh(v1[j]); }
                    u32x4 w; w.x = cvt_pk_bf16(v0[0], v0[1]); w.y = cvt_pk_bf16(v0[2], v0[3]); w.z = cvt_pk_bf16(v1[0], v1[1]); w.w = cvt_pk_bf16(v1[2], v1[3]);
                    *(u32x4*)(Y + (size_t)(chunk * T + t) * 4096 + g * 16 + i0) = w; } }
    }
};
struct EpiGlu {
    static constexpr bool PERM = true, AFTER_DRAIN = false;
    const bf16_t* Y; const bf16_t* Gs; const float* bias; bf16_t* Z;
    __device__ __forceinline__ void operator()(const f32x4 (&acc)[2][2][4][2], const Unit& u, int wr, int wc, int fr, int fq) const {
        const int row0 = u.pm * BM + wr * 64 + fr, col0 = u.pn * BM + wc * 32 + 8 * fq;
        f32x4 bv[2][2];
#pragma unroll
        for (int bj = 0; bj < 2; ++bj)
#pragma unroll
            for (int n = 0; n < 2; ++n) bv[bj][n] = *(const f32x4*)(bias + col0 + bj * HALF + 4 * n);
#pragma unroll
        for (int ai = 0; ai < 2; ++ai)
#pragma unroll
            for (int m = 0; m < 4; ++m) { const size_t off = (size_t)(row0 + ai * HALF + m * 16) * 4096 + col0;
#pragma unroll
                for (int bj = 0; bj < 2; ++bj) { const u32x4 yw = *(const u32x4*)(Y + off + bj * HALF), gw = *(const u32x4*)(Gs + off + bj * HALF);
                    const f32x4 a0 = acc[ai][bj][m][0] + bv[bj][0], a1 = acc[ai][bj][m][1] + bv[bj][1];
                    float o[8];
#pragma unroll
                    for (int j = 0; j < 4; ++j) { const unsigned yj = yw[j], gj = gw[j];
                        const float aa = (j < 2) ? a0[2 * j] : a1[2 * j - 4], ab = (j < 2) ? a0[2 * j + 1] : a1[2 * j - 3];
                        o[2 * j] = bf_lo(yj) * sigmoidf_(aa) * siluf_(bf_lo(gj)); o[2 * j + 1] = bf_hi(yj) * sigmoidf_(ab) * siluf_(bf_hi(gj)); }
                    u32x4 w; w.x = cvt_pk_bf16(o[0], o[1]); w.y = cvt_pk_bf16(o[2], o[3]); w.z = cvt_pk_bf16(o[4], o[5]); w.w = cvt_pk_bf16(o[6], o[7]);
                    *(u32x4*)(Z + off + bj * HALF) = w; }
                asm volatile("" ::: "memory"); }
    }
};

template <class Epi, class Sched, bool ALIGN_EPI = false, bool SP2 = false>
__device__ __forceinline__ void gemm_phase(PG8_LAS unsigned char* lds, const Gemm g, const Sched& S, const Epi& E) {
    const int tid = threadIdx.x, wid = __builtin_amdgcn_readfirstlane(tid >> 6), lane = tid & 63, wr = wid >> 2, wc = wid & 3, fr = lane & 15, fq = lane >> 4;
    const int K = g.K, nt = K / BK, lda = g.lda, ldb = g.ldb;
    unsigned voffA[2], voffB[2];
#pragma unroll
    for (int i = 0; i < 2; ++i) { int R, C; stage_rc(tid * 16 + i * 8192, R, C); const int Rb = Epi::PERM ? ((R & ~31) + perm32(R & 31)) : R;
        voffA[i] = (unsigned)(R * lda + C) * 2u; voffB[i] = (unsigned)(Rb * ldb + C) * 2u; }
    const size_t kstep = (size_t)(BK * 2);
    const size_t hstepA = (size_t)HALF * lda * 2, hstepB = (size_t)HALF * ldb * 2;
    const size_t tstepA = 2 * hstepA, tstepB = 2 * hstepB;
    const unsigned ldsw = (unsigned)wid * 1024u;
    const int aoff = lds_byte(wr * 64 + fr, fq * 8), boff = lds_byte(wc * 32 + fr, fq * 8);
#define PG8_SA(b, h) (((b) * 2 + (h)) * HTB)
#define PG8_SB(b, h) ((4 + (b) * 2 + (h)) * HTB)
#define PG8_STAGE(bufoff, gbase, voff) do { _Pragma("unroll") for (int _i = 0; _i < 2; ++_i) \
        __builtin_amdgcn_global_load_lds((const unsigned*)((const char*)(gbase) + (voff)[_i]), (PG8_LAS unsigned*)(lds + (bufoff) + ldsw + _i * 8192), 16, 0, 0); } while (0)
#define PG8_LDA(dst, b, h) do { _Pragma("unroll") for (int m = 0; m < 4; ++m) _Pragma("unroll") for (int k = 0; k < 2; ++k) dst[m][k] = *(const PG8_LAS bf16x8*)(lds + PG8_SA(b, h) + aoff + m * 2048 + k * 1024); } while (0)
#define PG8_LDB(dst, b, h) do { _Pragma("unroll") for (int n = 0; n < 2; ++n) _Pragma("unroll") for (int k = 0; k < 2; ++k) dst[n][k] = *(const PG8_LAS bf16x8*)(lds + PG8_SB(b, h) + boff + n * 2048 + k * 1024); } while (0)
#define PG8_MMA(ai, bj, At, Bt) do { __builtin_amdgcn_s_setprio(1); _Pragma("unroll") for (int m = 0; m < 4; ++m) _Pragma("unroll") for (int n = 0; n < 2; ++n) _Pragma("unroll") for (int k = 0; k < 2; ++k) \
        acc[ai][bj][m][n] = __builtin_amdgcn_mfma_f32_16x16x32_bf16(Bt[n][k], At[m][k], acc[ai][bj][m][n], 0, 0, 0); __builtin_amdgcn_s_setprio(0); } while (0)
#define PG8_WAIT_V(n) asm volatile("s_waitcnt vmcnt(" #n ")" ::: "memory")
#define PG8_WAIT_L(n) asm volatile("s_waitcnt lgkmcnt(" #n ")" ::: "memory")
#define PG8_BAR __builtin_amdgcn_s_barrier()
#define PG8_SCHED __builtin_amdgcn_sched_barrier(0)
    Unit cur, nxt; int ui = 0;
    if (!S.next(0, cur)) return;
    f32x4 acc[2][2][4][2];
#pragma unroll
    for (int a = 0; a < 2; ++a)
#pragma unroll
        for (int b = 0; b < 2; ++b)
#pragma unroll
            for (int m = 0; m < 4; ++m)
#pragma unroll
                for (int n = 0; n < 2; ++n) acc[a][b][m][n] = (f32x4){0.f, 0.f, 0.f, 0.f};
    bf16x8 At[4][2], B0[2][2], B1[2][2];
    const char* cA = (const char*)g.A + (size_t)cur.pm * tstepA + (size_t)cur.koff * 2; const char* cB = (const char*)g.Bt + (size_t)cur.pb * tstepB + (size_t)cur.koff * 2;
    S.a_ready(cur);
    if constexpr (SP2) {
        PG8_STAGE(PG8_SB(0, 0), cB, voffB); PG8_STAGE(PG8_SB(0, 1), cB + hstepB, voffB); PG8_STAGE(PG8_SA(0, 0), cA, voffA); PG8_STAGE(PG8_SA(0, 1), cA + hstepA, voffA);
        if (wr == 1) PG8_BAR;
        PG8_WAIT_V(2); PG8_BAR;
        PG8_STAGE(PG8_SB(1, 0), cB + kstep, voffB); PG8_STAGE(PG8_SA(1, 0), cA + kstep, voffA); PG8_STAGE(PG8_SB(1, 1), cB + hstepB + kstep, voffB);
        PG8_WAIT_V(6); PG8_BAR;
    } else {
        PG8_STAGE(PG8_SB(0, 0), cB, voffB); PG8_STAGE(PG8_SA(0, 0), cA, voffA); PG8_STAGE(PG8_SB(0, 1), cB + hstepB, voffB); PG8_STAGE(PG8_SA(0, 1), cA + hstepA, voffA);
        if (wr == 1) PG8_BAR;
        PG8_WAIT_V(4); PG8_BAR;
        PG8_STAGE(PG8_SB(1, 0), cB + kstep, voffB); PG8_STAGE(PG8_SA(1, 0), cA + kstep, voffA); PG8_STAGE(PG8_SB(1, 1), cB + hstepB + kstep, voffB);
        PG8_WAIT_V(6); PG8_BAR;
    }
    for (;;) {
        const bool has_next = S.next(ui + 1, nxt);
        const char* nA = has_next ? (const char*)g.A + (size_t)nxt.pm * tstepA + (size_t)nxt.koff * 2 : cA; const char* nB = has_next ? (const char*)g.Bt + (size_t)nxt.pb * tstepB + (size_t)nxt.koff * 2 : cB;
        for (int t = 0; t < nt; t += 2) {
            const bool last = (t == nt - 2);
            const char* a1 = cA + (size_t)(t + 1) * kstep;
            const char* a2 = last ? nA : cA + (size_t)(t + 2) * kstep; const char* b2 = last ? nB : cB + (size_t)(t + 2) * kstep;
            const char* a3 = a2 + kstep; const char* b3 = b2 + kstep;
            if (last && has_next) S.a_ready(nxt);
            if constexpr (SP2) {
            PG8_LDB(B0, 0, 0); PG8_LDB(B1, 0, 1); PG8_SCHED; PG8_LDA(At, 0, 0); PG8_STAGE(PG8_SA(1, 1), a1 + hstepA, voffA);
            PG8_WAIT_V(8); PG8_WAIT_L(0); PG8_BAR; PG8_MMA(0, 0, At, B0); PG8_MMA(0, 1, At, B1); PG8_BAR; PG8_SCHED;
            PG8_LDA(At, 0, 1); PG8_STAGE(PG8_SB(0, 0), b2, voffB); PG8_STAGE(PG8_SB(0, 1), b2 + hstepB, voffB); PG8_STAGE(PG8_SA(0, 0), a2, voffA);
            PG8_WAIT_V(8); PG8_WAIT_L(0); PG8_BAR; PG8_MMA(1, 0, At, B0); PG8_MMA(1, 1, At, B1); PG8_BAR; PG8_SCHED;
            PG8_LDB(B0, 1, 0); PG8_LDB(B1, 1, 1); PG8_SCHED; PG8_LDA(At, 1, 0); PG8_STAGE(PG8_SA(0, 1), a2 + hstepA, voffA);
            PG8_WAIT_V(8); PG8_WAIT_L(0); PG8_BAR; PG8_MMA(0, 0, At, B0); PG8_MMA(0, 1, At, B1); PG8_BAR; PG8_SCHED;
            PG8_LDA(At, 1, 1); PG8_STAGE(PG8_SB(1, 0), b3, voffB); PG8_STAGE(PG8_SB(1, 1), b3 + hstepB, voffB); PG8_STAGE(PG8_SA(1, 0), a3, voffA);
            PG8_WAIT_V(8); PG8_WAIT_L(0); PG8_BAR; PG8_MMA(1, 0, At, B0); PG8_MMA(1, 1, At, B1); PG8_BAR; PG8_SCHED;
            } else {
            PG8_LDB(B0, 0, 0); PG8_SCHED; PG8_LDA(At, 0, 0); PG8_STAGE(PG8_SA(1, 1), a1 + hstepA, voffA);
            PG8_WAIT_L(8); PG8_BAR; PG8_WAIT_L(0); PG8_MMA(0, 0, At, B0); PG8_BAR; PG8_SCHED;
            PG8_LDB(B1, 0, 1); PG8_STAGE(PG8_SB(0, 0), b2, voffB);
            PG8_BAR; PG8_WAIT_L(0); PG8_MMA(0, 1, At, B1); PG8_BAR;
            PG8_LDA(At, 0, 1); PG8_STAGE(PG8_SA(0, 0), a2, voffA);
            PG8_BAR; PG8_WAIT_L(0); PG8_MMA(1, 0, At, B0); PG8_BAR; PG8_SCHED;
            PG8_STAGE(PG8_SB(0, 1), b2 + hstepB, voffB);
            PG8_WAIT_V(6); PG8_BAR; PG8_MMA(1, 1, At, B1); PG8_BAR;
            PG8_LDB(B0, 1, 0); PG8_SCHED; PG8_LDA(At, 1, 0); PG8_STAGE(PG8_SA(0, 1), a2 + hstepA, voffA);
            PG8_WAIT_L(8); PG8_BAR; PG8_WAIT_L(0); PG8_MMA(0, 0, At, B0); PG8_BAR; PG8_SCHED;
            PG8_LDB(B1, 1, 1); PG8_STAGE(PG8_SB(1, 0), b3, voffB);
            PG8_BAR; PG8_WAIT_L(0); PG8_MMA(0, 1, At, B1); PG8_BAR;
            PG8_LDA(At, 1, 1); PG8_STAGE(PG8_SA(1, 0), a3, voffA);
            PG8_BAR; PG8_WAIT_L(0); PG8_MMA(1, 0, At, B0); PG8_BAR; PG8_SCHED;
            PG8_STAGE(PG8_SB(1, 1), b3 + hstepB, voffB);
            PG8_WAIT_V(6); PG8_BAR; PG8_MMA(1, 1, At, B1); PG8_BAR;
            }
        }
        if constexpr (ALIGN_EPI) { if (wr == 0) PG8_BAR; }
#if MK_DIAG
        { bool bad = false;
#pragma unroll
          for (int a_ = 0; a_ < 2; ++a_)
#pragma unroll
            for (int b_ = 0; b_ < 2; ++b_)
#pragma unroll
              for (int m_ = 0; m_ < 4; ++m_)
#pragma unroll
                for (int n_ = 0; n_ < 2; ++n_)
#pragma unroll
                  for (int j_ = 0; j_ < 4; ++j_) bad |= !(__builtin_fabsf(acc[a_][b_][m_][n_][j_]) < 3.0e38f);
          if (bad && g.dflag) atomicOr(g.dflag, g.dbit); }
#endif
        if constexpr (!Epi::AFTER_DRAIN) { E(acc, cur, wr, wc, fr, fq); S.done(cur); }
        if (!has_next) break;
#pragma unroll
        for (int a = 0; a < 2; ++a)
#pragma unroll
            for (int b = 0; b < 2; ++b)
#pragma unroll
                for (int m = 0; m < 4; ++m)
#pragma unroll
                    for (int n = 0; n < 2; ++n) acc[a][b][m][n] = (f32x4){0.f, 0.f, 0.f, 0.f};
        cur = nxt; cA = nA; cB = nB; ++ui;
        if constexpr (ALIGN_EPI) { if (wr == 1) PG8_BAR; }
    }
    PG8_WAIT_V(0);
    if constexpr (!ALIGN_EPI) { if (wr == 0) PG8_BAR; }
    PG8_BAR;
    if constexpr (Epi::AFTER_DRAIN) { E.fused(acc, cur, wr, wc, fr, fq, lds, wid, lane); S.done(cur); }
#undef PG8_SA
#undef PG8_SB
#undef PG8_STAGE
#undef PG8_LDA
#undef PG8_LDB
#undef PG8_MMA
#undef PG8_WAIT_V
#undef PG8_WAIT_L
#undef PG8_BAR
#undef PG8_SCHED
}

}

constexpr int NWAVES = 8;
constexpr int BATCH = 2, SEQ = 8192, D = 4096, M = BATCH * SEQ;
constexpr int GRIDW = 64, GROWS = SEQ / GRIDW;
constexpr int NA_HEADS = 32, NA_HD = 128;
constexpr int S5_G = 256, S5_P = 64, S5_I = 16, S5_T = 32, S5_NCH = M / S5_T  , S5_NCHB = SEQ / S5_T  , S5_KS = S5_T * 16  , S5_KY = S5_KS + 256  ;
constexpr int GLA_H = 8, GLA_DK = 256, GLA_DV = 512, GLA_KW = 2048, GLA_C = 64, GLA_NCH = M / GLA_C  , GLA_NCHB = SEQ / GLA_C  , GLA_NIN = 12288;
constexpr float EPS = 1e-6f;

constexpr size_t MiB = 1u << 20;
constexpr size_t WS_CTL = 0, CTL_ZERO_BYTES = 64 * 1024;
constexpr size_t WS_MOD = 1 * MiB;
constexpr size_t WS_LAMT = 2 * MiB;
constexpr size_t WS_W_NAIN0 = 4 * MiB, WS_W_NAIN1 = WS_W_NAIN0 + 128 * MiB, WS_W_NAOUT0 = WS_W_NAIN1 + 128 * MiB, WS_W_NAOUT1 = WS_W_NAOUT0 + 32 * MiB;
constexpr size_t WS_W_S5IN = WS_W_NAOUT1 + 32 * MiB, WS_W_S5GLU = WS_W_S5IN + 64 * MiB, WS_W_S5OUT = WS_W_S5GLU + 32 * MiB;
constexpr size_t WS_W_GLAIN = WS_W_S5OUT + 32 * MiB, WS_W_GLAG1 = WS_W_GLAIN + 96 * MiB, WS_W_GLAOUT = WS_W_GLAG1 + 2 * MiB;
constexpr size_t WS_S5BS = WS_W_GLAOUT + 32 * MiB;
constexpr size_t WS_S5BY = WS_S5BS + 64 * MiB;
constexpr size_t WS_H = WS_S5BY + 192 * MiB;
constexpr size_t WS_ACT = WS_H + 128 * MiB;
constexpr size_t WS_NA_QKVG = WS_ACT;
constexpr size_t WS_NA_Z = WS_ACT + 512 * MiB;
constexpr size_t WS_S5_UG = WS_ACT;
constexpr size_t WS_S5_GS = WS_S5_UG + 192 * MiB;
constexpr size_t WS_S5_SLOC = WS_S5_GS + 128 * MiB;
constexpr size_t WS_S5_Y = WS_S5_SLOC + 128 * MiB;
constexpr size_t WS_S5_Z = WS_S5_Y + 128 * MiB;
constexpr size_t WS_GLA_IN = WS_ACT;
constexpr size_t WS_GLA_G1P = WS_GLA_IN + 384 * MiB;
constexpr size_t WS_GLA_PREP = WS_GLA_G1P + 8 * MiB;
constexpr size_t WS_GLA_DECAY = WS_GLA_PREP + 384 * MiB;
constexpr size_t WS_GLA_O = WS_GLA_DECAY + 4 * MiB;
constexpr size_t WS_GLA_Z = WS_GLA_O + 384 * MiB;
constexpr size_t WS_SCR = WS_GLA_Z + 128 * MiB;
constexpr size_t WS_END = WS_SCR + 256 * MiB;
static_assert(WS_S5_Z + 128 * MiB <= WS_SCR && WS_NA_Z + 128 * MiB <= WS_SCR, "ws map");
constexpr int CW_BAR = 1024;
static_assert((CW_BAR + 3456) * 4 <= (int)CTL_ZERO_BYTES, "CTL words inside the memset region");

constexpr int RING_OFF = 0, RING_BYTES = 131072;
constexpr int LDS_BYTES = 147456;
constexpr int MISC_OFF = LDS_BYTES - 256;

#define GAS __attribute__((address_space(1)))
#define LAS __attribute__((address_space(3)))
typedef unsigned short bf16;
typedef unsigned v4u __attribute__((ext_vector_type(4)));
typedef unsigned v2u __attribute__((ext_vector_type(2)));
typedef float f32x4 __attribute__((ext_vector_type(4)));
typedef float f32x2 __attribute__((ext_vector_type(2)));
typedef short bf16x8 __attribute__((ext_vector_type(8)));
typedef short s16x4 __attribute__((ext_vector_type(4)));
typedef GAS unsigned gu32;
#define LDS_WAIT() asm volatile("s_waitcnt lgkmcnt(0)" ::: "memory")
#define VM_WAIT() asm volatile("s_waitcnt vmcnt(0)" ::: "memory")
using pg8::cvt_pk_bf16; using pg8::bf_lo; using pg8::bf_hi; using pg8::siluf_; using pg8::sigmoidf_;

#define XB_TMO      128
#define XB_XCNT(j)  (256  + 64 * (j))
#define XB_XSUB(j)  (1280 + 64 * (j))
#define XB_XGEN(j)  (2304 + 64 * (j))
#define XB_TOP      3328
#define XB_TOPGEN   3392
#define XCD_BAR_WORDS 3456
#define XB_SPIN_CAP (1u << 18)
__device__ __forceinline__ unsigned xb_ld(unsigned* p)              { return __hip_atomic_load(p, __ATOMIC_RELAXED, __HIP_MEMORY_SCOPE_AGENT); }
__device__ __forceinline__ unsigned xb_add(unsigned* p, unsigned v) { return __hip_atomic_fetch_add(p, v, __ATOMIC_RELAXED, __HIP_MEMORY_SCOPE_AGENT); }
__device__ __forceinline__ unsigned xb_xcc_id() { return (unsigned)__builtin_amdgcn_s_getreg((3 << 11) | 20) & 0xFu; }
#define XB_SPIN(cond, bar) do { unsigned _sp = 0; while (cond) { __builtin_amdgcn_s_sleep(1); \
    if ((++_sp & 255u) == 0u) { if (xb_ld(&(bar)[XB_TMO])) break; if (_sp > XB_SPIN_CAP) { atomicAdd(&(bar)[XB_TMO], 1u); break; } } } } while (0)
struct XcdBarrier { unsigned* bar; unsigned x; volatile LAS unsigned* st; };
__device__ __forceinline__ XcdBarrier xcd_barrier_post(unsigned* bar, volatile LAS unsigned* st) {
    XcdBarrier b; b.bar = bar; b.x = xb_xcc_id(); b.st = st;
    if (threadIdx.x == 0) (void)xb_add(&bar[XB_XCNT(b.x)], 1u);
    return b;
}
__device__ __forceinline__ void xcd_barrier_complete(unsigned* bar, unsigned x, unsigned& nloc, unsigned& nx) {
    const unsigned G = gridDim.x * gridDim.y * gridDim.z;
    unsigned sum, cnt, mine, sp = 0u;
    for (;;) {
        sum = 0u; cnt = 0u; mine = 0u;
#pragma unroll
        for (unsigned j = 0; j < 16; ++j) { const unsigned c = xb_ld(&bar[XB_XCNT(j)]); sum += c; cnt += (c > 0u) ? 1u : 0u; mine = (j == x) ? c : mine; }
        if (sum == G) break;
        __builtin_amdgcn_s_sleep(1);
        if ((++sp & 255u) == 0u) { if (xb_ld(&bar[XB_TMO])) break; if (sp > XB_SPIN_CAP) { atomicAdd(&bar[XB_TMO], 1u); break; } }
    }
    nloc = mine > 0u ? mine : 1u; nx = cnt > 0u ? cnt : 1u;
}
__device__ __forceinline__ void xcd_barrier(const XcdBarrier& b) {
    asm volatile("s_waitcnt vmcnt(0)" ::: "memory");
    __syncthreads();
    if (threadIdx.x == 0) {
        unsigned* bar = b.bar;
        __builtin_amdgcn_s_waitcnt(0);
        unsigned nloc = b.st[0], nx = b.st[1];
        if (nloc == 0u) { xcd_barrier_complete(bar, b.x, nloc, nx); b.st[0] = nloc; b.st[1] = nx; }
        const unsigned old = xb_add(&bar[XB_XSUB(b.x)], 1u);
        const unsigned gen = old / nloc;
        if (old + 1u == (gen + 1u) * nloc) {
            __builtin_amdgcn_fence(__ATOMIC_RELEASE, "agent");
            asm volatile("s_waitcnt vmcnt(0)" ::: "memory");
            const unsigned og = xb_add(&bar[XB_TOP], 1u);
            const unsigned tg = og / nx;
            if (og + 1u == (tg + 1u) * nx) xb_add(&bar[XB_TOPGEN], 1u);
            else XB_SPIN(xb_ld(&bar[XB_TOPGEN]) == tg, bar);
            __builtin_amdgcn_fence(__ATOMIC_ACQUIRE, "agent");
            xb_add(&bar[XB_XGEN(b.x)], 1u);
            asm volatile("s_waitcnt vmcnt(0)" ::: "memory");
        } else {
            XB_SPIN(xb_ld(&bar[XB_XGEN(b.x)]) == gen, bar);
            __builtin_amdgcn_fence(__ATOMIC_ACQUIRE, "agent");
            asm volatile("s_waitcnt vmcnt(0)" ::: "memory");
        }
    }
    __syncthreads();
}

struct Args { const float* in[33]; float* out; unsigned char* ws; int ph_lo, ph_hi, dup, pad; };
struct Frame {
    LAS unsigned char* lds;
    int tid, lane, wave;
    int vcu, G;
};
__device__ __forceinline__ float wave_sum(float v) {
#pragma unroll
    for (int o = 1; o < 64; o <<= 1) v += __shfl_xor(v, o);
    return v;
}
__device__ __forceinline__ unsigned f2bf(float f) { unsigned u = __builtin_bit_cast(unsigned, f); return (u + 0x7fffu + ((u >> 16) & 1u)) >> 16; }
__device__ __forceinline__ unsigned pk2(float lo, float hi) { return f2bf(lo) | (f2bf(hi) << 16); }

__device__ __forceinline__ void p0_transpose_item(const float* W, int K, int N, bf16* WT, LAS float* scr, int item, int lane) {
    const int nblk = N / 32, kb = item / nblk, nb = item % nblk, k0 = 64 * kb, n0 = 32 * nb;
#pragma unroll 8
    for (int i = 0; i < 32; ++i) { const int kk = 2 * i + (lane >> 5); scr[kk * 33 + (lane & 31)] = __builtin_nontemporal_load(W + (size_t)(k0 + kk) * N + n0 + (lane & 31)); }
    LDS_WAIT(); asm volatile("" ::: "memory");
    const int c = lane & 7;
#pragma unroll
    for (int j = 0; j < 4; ++j) { const int n = (lane >> 3) + 8 * j; const LAS float* s = scr + (8 * c) * 33 + n;
        v4u o; o.x = pk2(s[0 * 33], s[1 * 33]); o.y = pk2(s[2 * 33], s[3 * 33]); o.z = pk2(s[4 * 33], s[5 * 33]); o.w = pk2(s[6 * 33], s[7 * 33]);
        *(GAS v4u*)(WT + (size_t)(n0 + n) * K + k0 + 8 * c) = o; }
    LDS_WAIT(); asm volatile("" ::: "memory");
}
__device__ __forceinline__ void p0_mod(Frame& F, const Args& a) {
    LAS float* cact = (LAS float*)(F.lds + RING_OFF);
    LAS float* red = cact + 2 * 4096;
    const float* c = a.in[1]; const float* mw = a.in[2]; const float* mb = a.in[3]; float* MOD = (float*)(a.ws + WS_MOD);
    for (int i = F.tid; i < 2 * 4096; i += NWAVES * 64) cact[i] = siluf_(c[i]);
    __syncthreads();
    const int rg = F.lane >> 4, cq = F.lane & 15;
    for (int it = F.vcu; it < 4 * 192; it += F.G) {
        const int layer = it / 192, cb = it % 192;
        const float* wp = mw + (size_t)layer * 4096 * 12288 + (size_t)(F.wave * 4 + rg) * 12288 + cb * 64 + cq * 4;
        f32x4 a0 = {0.f, 0.f, 0.f, 0.f}, a1 = {0.f, 0.f, 0.f, 0.f};
#pragma unroll 8
        for (int s = 0; s < 128; ++s) { const f32x4 w = __builtin_nontemporal_load((const GAS f32x4*)(wp + (size_t)s * 32 * 12288)); const int k = F.wave * 4 + rg + 32 * s;
            const float c0 = cact[k], c1 = cact[4096 + k]; a0 += w * c0; a1 += w * c1; }
#pragma unroll
        for (int j = 0; j < 4; ++j) { a0[j] += __shfl_xor(a0[j], 16); a0[j] += __shfl_xor(a0[j], 32); a1[j] += __shfl_xor(a1[j], 16); a1[j] += __shfl_xor(a1[j], 32); }
        if (F.lane < 16) { *(LAS f32x4*)(red + (F.wave * 2 + 0) * 64 + cq * 4) = a0; *(LAS f32x4*)(red + (F.wave * 2 + 1) * 64 + cq * 4) = a1; }
        __syncthreads();
        if (F.tid < 128) { const int b = F.tid >> 6, col = F.tid & 63; float s = mb[layer * 12288 + cb * 64 + col];
#pragma unroll
            for (int w = 0; w < 8; ++w) s += red[(w * 2 + b) * 64 + col];
            MOD[((size_t)layer * 2 + b) * 12288 + cb * 64 + col] = s; }
        __syncthreads();
    }
}
__device__ __forceinline__ void p0_s5_group(Frame& F, const Args& a, int g) {
    constexpr int T = S5_T;
    LAS f32x2* pw = (LAS f32x2*)(F.lds + RING_OFF);
    LAS f32x2* bbar = pw + 2 * (T + 1) * 64;
    LAS f32x2* cc = bbar + 2 * 64 * 16;
    LAS float* kf = (LAS float*)(cc + 16 * 64);
    static_assert((2 * (T + 1) * 64 + 2 * 64 * 16 + 16 * 64) * 8 + 2 * T * 256 * 4 <= RING_BYTES, "s5 gen LDS");
    const float *b_re = a.in[9], *b_im = a.in[10], *c_re = a.in[11], *c_im = a.in[12], *dsk = a.in[13];
    float* LAMT = (float*)(a.ws + WS_LAMT);
    if (F.tid < 128) {
        const int dir = F.tid >> 6, p = F.tid & 63, gp = g * 64 + p;
        const float are = (dir ? a.in[16] : a.in[14])[gp], aim = (dir ? a.in[17] : a.in[15])[gp], ls = (dir ? a.in[19] : a.in[18])[gp];
        const float dt = expf(ls), mag = expf(are * dt), lr = mag * cosf(aim * dt), li = mag * sinf(aim * dt);
        const float den = are * are + aim * aim, nr = lr - 1.0f, rre = (nr * are + li * aim) / den, rim = (li * are - nr * aim) / den;
#pragma unroll
        for (int j = 0; j < 16; ++j) { const float br = b_re[(size_t)gp * 16 + j], bi = b_im[(size_t)gp * 16 + j]; bbar[(dir * 64 + p) * 16 + j] = (f32x2){rre * br - rim * bi, rre * bi + rim * br}; }
        float wr_ = 1.0f, wi_ = 0.0f; pw[(dir * (T + 1) + 0) * 64 + p] = (f32x2){1.0f, 0.0f};
        for (int t = 1; t <= T; ++t) { const float nr2 = wr_ * lr - wi_ * li, ni2 = wr_ * li + wi_ * lr; wr_ = nr2; wi_ = ni2; pw[(dir * (T + 1) + t) * 64 + p] = (f32x2){wr_, wi_}; }
        LAMT[((size_t)(g * 2 + dir) * 64 + p) * 2 + 0] = wr_; LAMT[((size_t)(g * 2 + dir) * 64 + p) * 2 + 1] = wi_;
    }
    for (int e = F.tid; e < 16 * 64; e += NWAVES * 64) cc[e] = (f32x2){c_re[(size_t)g * 1024 + e], c_im[(size_t)g * 1024 + e]};
    __syncthreads();
    {
        const int dir = F.tid >> 8, i = (F.tid >> 4) & 15, jp = (F.tid >> 1) & 7, th = F.tid & 1;
        float acc0[T / 2], acc1[T / 2];
#pragma unroll
        for (int t = 0; t < T / 2; ++t) { acc0[t] = 0.f; acc1[t] = 0.f; }
        const LAS f32x2* pwp = pw + (dir * (T + 1) + (T / 2) * th) * 64;
        for (int p = 0; p < 64; ++p) { const f32x2 C = cc[i * 64 + p]; const f32x4 Bb = *(const LAS f32x4*)(bbar + (dir * 64 + p) * 16 + 2 * jp);
            const float e0 = C.x * Bb[0] - C.y * Bb[1], f0 = C.x * Bb[1] + C.y * Bb[0], e1 = C.x * Bb[2] - C.y * Bb[3], f1 = C.x * Bb[3] + C.y * Bb[2];
#pragma unroll
            for (int t = 0; t < T / 2; ++t) { const f32x2 w = pwp[t * 64 + p]; acc0[t] += w.x * e0 - w.y * f0; acc1[t] += w.x * e1 - w.y * f1; } }
#pragma unroll
        for (int t = 0; t < T / 2; ++t) *(LAS f32x2*)(kf + ((dir * T + (T / 2) * th + t) * 16 + i) * 16 + 2 * jp) = (f32x2){acc0[t], acc1[t]};
    }
    __syncthreads();
    {
        bf16* BY = (bf16*)(a.ws + WS_S5BY) + (size_t)g * (S5_KS * S5_KY);
        const int i = F.tid >> 5, pcg = F.tid & 31; const float dsk_i = dsk[g * 16 + i];
        const int segc = pcg >> 3, p0c = (pcg & 7) * 8, dirc = segc >> 1;
        for (int t = 0; t < T; ++t) { bf16* rowp = BY + (size_t)(t * 16 + i) * S5_KY;
#pragma unroll
            for (int jq = 0; jq < 2; ++jq) { const int pc = pcg + 32 * jq, sidx = pc >> 1, j0 = (pc & 1) * 8, lag = t - sidx; f32x4 v0, v1;
                if (lag != 0) { const LAS float* kp = kf + (((lag > 0 ? 0 : 1) * T + (lag > 0 ? lag : -lag)) * 16 + i) * 16 + j0; v0 = *(const LAS f32x4*)kp; v1 = *(const LAS f32x4*)(kp + 4); }
                else { const LAS float* k0p = kf + (i * 16 + j0); const LAS float* k1p = kf + ((T * 16 + i) * 16 + j0);
                    v0 = *(const LAS f32x4*)k0p + *(const LAS f32x4*)k1p; v1 = *(const LAS f32x4*)(k0p + 4) + *(const LAS f32x4*)(k1p + 4);
#pragma unroll
                    for (int e = 0; e < 4; ++e) { if (j0 + e == i) v0[e] += dsk_i; if (j0 + 4 + e == i) v1[e] += dsk_i; } }
                *(GAS v4u*)(rowp + pc * 8) = (v4u){cvt_pk_bf16(v0[0], v0[1]), cvt_pk_bf16(v0[2], v0[3]), cvt_pk_bf16(v1[0], v1[1]), cvt_pk_bf16(v1[2], v1[3])}; }
            { const int tp = dirc ? (T - t) : (t + 1); const LAS f32x2* wp = pw + (dirc * (T + 1) + tp) * 64 + p0c; const LAS f32x2* cp = cc + i * 64 + p0c; float v[8];
#pragma unroll
              for (int e = 0; e < 8; ++e) { const f32x2 w = wp[e], C = cp[e]; v[e] = (segc & 1) ? -(C.x * w.y + C.y * w.x) : (C.x * w.x - C.y * w.y); }
              *(GAS v4u*)(rowp + S5_KS + pcg * 8) = (v4u){cvt_pk_bf16(v[0], v[1]), cvt_pk_bf16(v[2], v[3]), cvt_pk_bf16(v[4], v[5]), cvt_pk_bf16(v[6], v[7])}; }
        }
    }
    {
        bf16* BS = (bf16*)(a.ws + WS_S5BS) + (size_t)g * (256 * S5_KS);
        const int pc = F.tid & 63, sidx = pc >> 1, j0 = (pc & 1) * 8;
        for (int ps = 0; ps < 32; ++ps) { const int n = 8 * ps + (F.tid >> 6), seg = n >> 6, p = n & 63, dir = seg >> 1;
            const f32x2 w = pw[(dir * (T + 1) + (dir ? sidx : (T - 1 - sidx))) * 64 + p]; const LAS f32x2* bp = bbar + (dir * 64 + p) * 16 + j0; float v[8];
#pragma unroll
            for (int e = 0; e < 8; ++e) { const f32x2 Bb = bp[e]; v[e] = (seg & 1) ? (w.x * Bb.y + w.y * Bb.x) : (w.x * Bb.x - w.y * Bb.y); }
            *(GAS v4u*)(BS + (size_t)n * S5_KS + pc * 8) = (v4u){cvt_pk_bf16(v[0], v[1]), cvt_pk_bf16(v[2], v[3]), cvt_pk_bf16(v[4], v[5]), cvt_pk_bf16(v[6], v[7])};
        }
    }
    __syncthreads();
}
__device__ __forceinline__ void p0_prologue(Frame& F, const Args& a) {
    p0_mod(F, a);
    {
        LAS float* scr = (LAS float*)(F.lds + RING_OFF + F.wave * 16384);
        const int gw = F.vcu * NWAVES + F.wave, NGW = F.G * NWAVES;
        constexpr int I_NAIN = 64 * 512, I_SQ = 64 * 128, I_S5IN = 64 * 256, I_GLAIN = 64 * 384;
        constexpr int NITEMS = 2 * I_NAIN + 2 * I_SQ + I_S5IN + 2 * I_SQ + I_GLAIN + I_SQ;
        unsigned char* ws = a.ws;
        for (int it = gw; it < NITEMS; it += NGW) {
            int r = it;
            if (r < I_NAIN) { p0_transpose_item(a.in[5], 4096, 16384, (bf16*)(ws + WS_W_NAIN0), scr, r, F.lane); continue; } r -= I_NAIN;
            if (r < I_NAIN) { p0_transpose_item(a.in[5] + (size_t)4096 * 16384, 4096, 16384, (bf16*)(ws + WS_W_NAIN1), scr, r, F.lane); continue; } r -= I_NAIN;
            if (r < I_SQ) { p0_transpose_item(a.in[7], 4096, 4096, (bf16*)(ws + WS_W_NAOUT0), scr, r, F.lane); continue; } r -= I_SQ;
            if (r < I_SQ) { p0_transpose_item(a.in[7] + (size_t)4096 * 4096, 4096, 4096, (bf16*)(ws + WS_W_NAOUT1), scr, r, F.lane); continue; } r -= I_SQ;
            if (r < I_S5IN) { p0_transpose_item(a.in[8], 4096, 8192, (bf16*)(ws + WS_W_S5IN), scr, r, F.lane); continue; } r -= I_S5IN;
            if (r < I_SQ) { p0_transpose_item(a.in[20], 4096, 4096, (bf16*)(ws + WS_W_S5GLU), scr, r, F.lane); continue; } r -= I_SQ;
            if (r < I_SQ) { p0_transpose_item(a.in[22], 4096, 4096, (bf16*)(ws + WS_W_S5OUT), scr, r, F.lane); continue; } r -= I_SQ;
            if (r < I_GLAIN) { p0_transpose_item(a.in[23], 4096, 12288, (bf16*)(ws + WS_W_GLAIN), scr, r, F.lane); continue; } r -= I_GLAIN;
            p0_transpose_item(a.in[31], 4096, 4096, (bf16*)(ws + WS_W_GLAOUT), scr, r, F.lane);
        }
        bf16* G1T = (bf16*)(ws + WS_W_GLAG1);
        for (int e = (F.vcu * NWAVES * 64 + F.tid); e < 256 * 4096 / 2; e += F.G * NWAVES * 64) {
            const int n = e / 2048, k = (e % 2048) * 2; float v0 = 0.f, v1 = 0.f;
            if (n < 16) { v0 = a.in[24][(size_t)k * 16 + n]; v1 = a.in[24][(size_t)(k + 1) * 16 + n]; }
            else if (n < 32) { v0 = a.in[27][(size_t)k * 16 + (n - 16)]; v1 = a.in[27][(size_t)(k + 1) * 16 + (n - 16)]; }
            *(GAS unsigned*)(G1T + (size_t)n * 4096 + k) = pk2(v0, v1);
        }
    }
    __syncthreads();
    for (int g = F.vcu; g < S5_G; g += F.G) p0_s5_group(F, a, g);
}

template <bool FINAL>
__device__ __forceinline__ void norm_phase(Frame& F, const float* xin, const float* nw, const float* mod  , bf16* H, float* outf) {
    LAS f32x2* tab = (LAS f32x2*)(F.lds + RING_OFF);
    for (int i = F.tid; i < 2 * 4096; i += NWAVES * 64) { const int b = i >> 12, c = i & 4095;
        if (FINAL) tab[i] = (f32x2){nw[c], 0.f};
        else tab[i] = (f32x2){nw[c] * (1.0f + mod[b * 12288 + 4096 + c]), mod[b * 12288 + c]}; }
    __syncthreads();
    const int gw = F.vcu * NWAVES + F.wave, NGW = F.G * NWAVES;
    for (int m = gw; m < M; m += NGW) {
        const int b = m >> 13; const GAS f32x4* xr = (const GAS f32x4*)(xin + (size_t)m * D) + F.lane;
        f32x4 v[16]; float s = 0.f;
#pragma unroll
        for (int j = 0; j < 16; ++j) { v[j] = __builtin_nontemporal_load(xr + 64 * j); s += (v[j].x * v[j].x + v[j].y * v[j].y) + (v[j].z * v[j].z + v[j].w * v[j].w); }
        const float rstd = rsqrtf(wave_sum(s) * (1.f / D) + EPS);
#pragma unroll
        for (int j = 0; j < 16; ++j) { const int c = 4 * F.lane + 256 * j; const LAS f32x2* tp = tab + b * 4096 + c;
            const f32x2 t0 = tp[0], t1 = tp[1], t2 = tp[2], t3 = tp[3];
            const float o0 = v[j].x * rstd * t0.x + t0.y, o1 = v[j].y * rstd * t1.x + t1.y, o2 = v[j].z * rstd * t2.x + t2.y, o3 = v[j].w * rstd * t3.x + t3.y;
            if (FINAL) *((GAS f32x4*)(outf + (size_t)m * D) + F.lane + 64 * j) = (f32x4){o0, o1, o2, o3};
            else *(GAS v2u*)(H + (size_t)m * D + c) = (v2u){cvt_pk_bf16(o0, o1), cvt_pk_bf16(o2, o3)}; }
    }
    __syncthreads();
}

typedef short v4i16_t __attribute__((ext_vector_type(4)));
__device__ __forceinline__ s16x4 tr4(const LAS unsigned char* p) { return __builtin_bit_cast(s16x4, __builtin_amdgcn_ds_read_tr16_b64_v4i16((LAS v4i16_t*)p)); }
__device__ __forceinline__ bf16x8 cat8(s16x4 a, s16x4 b) { return (bf16x8){a[0], a[1], a[2], a[3], b[0], b[1], b[2], b[3]}; }
__device__ __forceinline__ bf16x8 pack8(f32x4 a, f32x4 b) { v4u w; w.x = cvt_pk_bf16(a[0], a[1]); w.y = cvt_pk_bf16(a[2], a[3]); w.z = cvt_pk_bf16(b[0], b[1]); w.w = cvt_pk_bf16(b[2], b[3]); return __builtin_bit_cast(bf16x8, w); }
#define MFMA16(a, b, c) __builtin_amdgcn_mfma_f32_16x16x32_bf16((a), (b), (c), 0, 0, 0)

constexpr int NA_PITCH = 288, NA_TILE = 64 * NA_PITCH;
__device__ __forceinline__ void na_attn_phase(Frame& F, const bf16* QKVG, bf16* Z, const float* rpb) {
    const int grp = F.wave >> 2, ct = F.wave & 3, lane = F.lane, li = lane & 15, g = lane >> 4, q4 = li >> 2, p4 = li & 3;
    const int c0 = ct * 16, kc0 = min(max(c0 - 8, 0), 32);
    const int ipw = (4096 + F.G - 1) / F.G;
    LAS unsigned char* const lbase = F.lds + RING_OFF;
    LAS float* const rp = (LAS float*)(lbase + 4 * NA_TILE + grp * 2048);
    for (int k = 0; k < ipw; ++k) {
        const int it = F.vcu * ipw + k; if (it >= 4096) break;
        const int b = it >> 11, hp = (it >> 7) & 15, r = ((it & 15) << 3) | ((it >> 4) & 7), h = hp * 2 + grp;
        const int rs = min(max(r - 4, 0), GROWS - 8);
        const size_t tok0 = (size_t)b * SEQ + (size_t)r * GRIDW;
        const bf16* qp = QKVG + (tok0 + c0 + li) * 16384 + h * 128 + 8 * g;
        bf16x8 qf[4];
#pragma unroll
        for (int ks = 0; ks < 4; ++ks) qf[ks] = *(const GAS bf16x8*)(qp + 32 * ks);
        for (int e = (F.tid & 255); e < 465; e += 256) rp[e] = rpb[h * 465 + e];
        v4u st[4];
        const bf16* kvbase = QKVG + ((size_t)b * SEQ + (size_t)rs * GRIDW + 16 * ct + g) * 16384 + h * 128 + li * 8;
#define NA_LOAD(t) do { _Pragma("unroll") for (int j = 0; j < 4; ++j) st[j] = *(const GAS v4u*)(kvbase + ((size_t)((t) & 7) * GRIDW + 4 * j) * 16384 + (((t) >> 3) ? 8192 : 4096)); } while (0)
#define NA_WRITE(buf) do { _Pragma("unroll") for (int j = 0; j < 4; ++j) *(LAS v4u*)(lbase + ((buf) * 2 + grp) * NA_TILE + (16 * ct + 4 * j + g) * NA_PITCH + li * 16) = st[j]; } while (0)
        NA_LOAD(0); NA_WRITE(0); __syncthreads();
        f32x4 S[8][2];
#pragma unroll
        for (int t = 0; t < 8; ++t) {
            NA_LOAD(t + 1);
            const LAS unsigned char* tb = lbase + ((t & 1) * 2 + grp) * NA_TILE;
            S[t][0] = (f32x4){0.f, 0.f, 0.f, 0.f}; S[t][1] = (f32x4){0.f, 0.f, 0.f, 0.f};
#pragma unroll
            for (int blk = 0; blk < 2; ++blk)
#pragma unroll
                for (int ks = 0; ks < 4; ++ks) { const bf16x8 A = *(const LAS bf16x8*)(tb + (kc0 + 16 * blk + li) * NA_PITCH + (32 * ks + 8 * g) * 2);
                    S[t][blk] = MFMA16(A, qf[ks], S[t][blk]); }
            NA_WRITE((t + 1) & 1);
            __syncthreads();
        }
        const int c = c0 + li, cs = min(max(c - 8, 0), GRIDW - 16);
        float mx = -1e30f;
#pragma unroll
        for (int t = 0; t < 8; ++t)
#pragma unroll
            for (int blk = 0; blk < 2; ++blk)
#pragma unroll
                for (int e = 0; e < 4; ++e) { const int kc = kc0 + 16 * blk + 4 * g + e; const bool valid = (kc >= cs) && (kc < cs + 16);
                    const int idx = valid ? ((rs + t - r + 7) * 31 + (kc - c + 15)) : 0;
                    const float s = valid ? (S[t][blk][e] * 0.08838834764831845f + rp[idx]) : -1e30f; S[t][blk][e] = s; mx = fmaxf(mx, s); }
        mx = fmaxf(mx, __shfl_xor(mx, 16)); mx = fmaxf(mx, __shfl_xor(mx, 32));
        float sum = 0.f;
#pragma unroll
        for (int t = 0; t < 8; ++t)
#pragma unroll
            for (int blk = 0; blk < 2; ++blk)
#pragma unroll
                for (int e = 0; e < 4; ++e) { const float p = __expf(S[t][blk][e] - mx); S[t][blk][e] = p; sum += p; }
        sum += __shfl_xor(sum, 16); sum += __shfl_xor(sum, 32);
        const float inv = 1.0f / sum;
        bf16x8 pb[8];
#pragma unroll
        for (int t = 0; t < 8; ++t) pb[t] = pack8(S[t][0], S[t][1]);
        f32x4 O[8];
#pragma unroll
        for (int db = 0; db < 8; ++db) O[db] = (f32x4){0.f, 0.f, 0.f, 0.f};
#pragma unroll
        for (int t = 8; t < 16; ++t) {
            if (t < 15) NA_LOAD(t + 1);
            const LAS unsigned char* tb = lbase + ((t & 1) * 2 + grp) * NA_TILE + (kc0 + 4 * g + q4) * NA_PITCH + 8 * p4;
#pragma unroll
            for (int db = 0; db < 8; ++db) { const s16x4 a0 = tr4(tb + 32 * db), a1 = tr4(tb + 16 * NA_PITCH + 32 * db);
                O[db] = MFMA16(cat8(a0, a1), pb[t - 8], O[db]); }
            if (t < 15) NA_WRITE((t + 1) & 1);
            __syncthreads();
        }
#undef NA_LOAD
#undef NA_WRITE
        bf16* zp = Z + (tok0 + c0 + li) * 4096 + h * 128 + 4 * g; const bf16* gp = QKVG + (tok0 + c0 + li) * 16384 + 12288 + h * 128 + 4 * g;
#pragma unroll
        for (int db = 0; db < 8; ++db) { const v2u gw = *(const GAS v2u*)(gp + 16 * db);
            const float z0 = O[db][0] * inv * siluf_(bf_lo(gw.x)), z1 = O[db][1] * inv * siluf_(bf_hi(gw.x)), z2 = O[db][2] * inv * siluf_(bf_lo(gw.y)), z3 = O[db][3] * inv * siluf_(bf_hi(gw.y));
            *(GAS v2u*)(zp + 16 * db) = (v2u){cvt_pk_bf16(z0, z1), cvt_pk_bf16(z2, z3)}; }
    }
    __syncthreads();
}

__device__ __forceinline__ void na_attn_phase2(Frame& F, const bf16* QKVG, bf16* Z, const float* rpb) {
    const int rq = F.wave >> 2, ct = F.wave & 3, lane = F.lane, li = lane & 15, g = lane >> 4, q4 = li >> 2, p4 = li & 3;
    const int c0 = ct * 16, kc0 = min(max(c0 - 8, 0), 32);
    LAS unsigned char* const lbase = F.lds + RING_OFF;
    LAS float* const rp = (LAS float*)(lbase + 6 * NA_TILE);
    const int ipw = (4096 + F.G - 1) / F.G, it0 = F.vcu * ipw;
    if (it0 >= 4096) return;
    const int nit = min(ipw, 4096 - it0);
    const bool xg = (F.G == 256);
#define NA2_ID(k_) (xg ? ((((F.vcu >> 5) * 8 + ((k_) >> 1)) << 6) | ((((k_) & 1) << 5) | (F.vcu & 31))) : (it0 + (k_)))
    const int id0 = NA2_ID(0);
    const int ptok = F.tid >> 4, pch = F.tid & 15;
    v4u R[1][3][2];
#define NA2_SEC (size_t)(2 * 32 * 8192) * 128
#define NA2_SRC(it_, ss_) (QKVG + (((ss_) >= 9) ? 2 : 1) * NA2_SEC + ((size_t)((it_) >> 6) * 8192 + (size_t)min(min(max(2 * ((it_) & 63) - 4, 0), GROWS - 8) + ((ss_) % 9), GROWS - 1) * GRIDW + ptok) * 128 + pch * 8)
#define NA2_LOADG(set_, it_, gq_) do { _Pragma("unroll") for (int jj_ = 0; jj_ < 3; ++jj_) { const bf16* s_ = NA2_SRC(it_, 3 * (gq_) + jj_); \
        R[set_][jj_][0] = *(const GAS v4u*)s_; R[set_][jj_][1] = *(const GAS v4u*)(s_ + 32 * 128); } } while (0)
#define NA2_WRITEG(set_, buf) do { _Pragma("unroll") for (int jj_ = 0; jj_ < 3; ++jj_) { LAS unsigned char* d_ = lbase + ((buf) * 3 + jj_) * NA_TILE + ptok * NA_PITCH + pch * 16; \
        *(LAS v4u*)d_ = R[set_][jj_][0]; *(LAS v4u*)(d_ + 32 * NA_PITCH) = R[set_][jj_][1]; } } while (0)
#define NA2_SCORE(kl, tb) do { S[kl][0] = (f32x4){0.f, 0.f, 0.f, 0.f}; S[kl][1] = (f32x4){0.f, 0.f, 0.f, 0.f}; \
        _Pragma("unroll") for (int blk = 0; blk < 2; ++blk) _Pragma("unroll") for (int ks = 0; ks < 4; ++ks) { \
            const bf16x8 A_ = *(const LAS bf16x8*)((tb) + (kc0 + 16 * blk + li) * NA_PITCH + (32 * ks + 8 * g) * 2); S[kl][blk] = MFMA16(A_, qf[ks], S[kl][blk]); } \
        _Pragma("unroll") for (int blk = 0; blk < 2; ++blk) _Pragma("unroll") for (int e = 0; e < 4; ++e) { const bool valid = ((blk ? vm1 : vm0) + (unsigned)e) < 16u; const float bias = bp[(kl) * 31 + blk * 16 + e]; \
            const float sv = valid ? (S[kl][blk][e] * 0.08838834764831845f + bias) : -1e30f; S[kl][blk][e] = sv; mx = fmaxf(mx, sv); } } while (0)
#define NA2_PV(kl, tb) do { const LAS unsigned char* t_ = (tb) + (kc0 + 4 * g + q4) * NA_PITCH + 8 * p4; \
        _Pragma("unroll") for (int blk = 0; blk < 2; ++blk) _Pragma("unroll") for (int e = 0; e < 4; ++e) { const float p_ = __expf(S[kl][blk][e] - mx); S[kl][blk][e] = p_; sum += p_; } \
        const bf16x8 pb_ = pack8(S[kl][0], S[kl][1]); \
        _Pragma("unroll") for (int db = 0; db < 8; ++db) O[db] = MFMA16(cat8(tr4(t_ + 32 * db), tr4(t_ + 16 * NA_PITCH + 32 * db)), pb_, O[db]); } while (0)
    NA2_LOADG(0, id0, 0);
    bf16x8 qf[4];
    { const int rp_ = id0 & 63, r_ = 2 * rp_ + rq;
      const bf16* qp = QKVG + ((size_t)(id0 >> 6) * 8192 + (size_t)r_ * GRIDW + c0 + li) * 128 + 8 * g;
#pragma unroll
      for (int ks = 0; ks < 4; ++ks) qf[ks] = *(const GAS bf16x8*)(qp + 32 * ks); }
    NA2_WRITEG(0, 0);
    for (int e = F.tid; e < 465; e += NWAVES * 64) rp[e] = rpb[((id0 >> 6) & 31) * 465 + e];
    __syncthreads();
    for (int k = 0; k < nit; ++k) {
        const int it = NA2_ID(k), itn = NA2_ID(k + 1), b = it >> 11, h = (it >> 6) & 31, rpi = it & 63;
        const int base = min(max(2 * rpi - 4, 0), GROWS - 8), r = 2 * rpi + rq, rsw = min(max(r - 4, 0), GROWS - 8), offw = rsw - base;
        const bool has_next = (k + 1 < nit);
        f32x4 S[8][2];
        int lz = F.lane; asm volatile("" : "+v"(lz)); const int liz = lz & 15, gz = lz >> 4, c = c0 + liz, cs = min(max(c - 8, 0), GRIDW - 16);
        const LAS float* bp = rp + (rsw - r + 7) * 31 + (kc0 + 4 * gz - c + 15);
        const unsigned vm0 = (unsigned)(kc0 + 4 * gz - cs), vm1 = vm0 + 16u;
        float mx = -1e30f, sum = 0.f;
#pragma unroll
        for (int gi = 0; gi < 3; ++gi) {
            NA2_LOADG(0, it, gi + 1);
#pragma unroll
            for (int jj = 0; jj < 3; ++jj) { const int j = 3 * gi + jj; const LAS unsigned char* tb = lbase + ((gi & 1) * 3 + jj) * NA_TILE;
                if (offw == 0) { if (j < 8) NA2_SCORE((j < 8 ? j : 0), tb); } else { if (j >= 1) NA2_SCORE((j >= 1 ? j - 1 : 0), tb); }
                asm volatile("" ::: "memory"); }
            NA2_WRITEG(0, (gi + 1) & 1);
            __syncthreads();
        }
        mx = fmaxf(mx, __shfl_xor(mx, 16)); mx = fmaxf(mx, __shfl_xor(mx, 32));
        f32x4 O[8];
#pragma unroll
        for (int db = 0; db < 8; ++db) O[db] = (f32x4){0.f, 0.f, 0.f, 0.f};
        v2u gw[8];
        bf16x8 qn[4];
#pragma unroll
        for (int gi = 0; gi < 3; ++gi) {
            const int sg = 3 + gi;
            if (sg + 1 < 6) NA2_LOADG(0, it, sg + 1); else if (has_next) NA2_LOADG(0, itn, 0);
            if (gi == 1 && has_next) { for (int e = F.tid; e < 465; e += NWAVES * 64) rp[e] = rpb[((itn >> 6) & 31) * 465 + e]; }
            if (gi == 2 && has_next) { const int rpn = itn & 63, rn = 2 * rpn + rq;
                const bf16* qp = QKVG + ((size_t)(itn >> 6) * 8192 + (size_t)rn * GRIDW + c0 + li) * 128 + 8 * g;
#pragma unroll
                for (int ks = 0; ks < 4; ++ks) qn[ks] = *(const GAS bf16x8*)(qp + 32 * ks); }
#pragma unroll
            for (int jj = 0; jj < 3; ++jj) { const int j = 3 * gi + jj; const LAS unsigned char* tb = lbase + ((sg & 1) * 3 + jj) * NA_TILE;
                if (offw == 0) { if (j < 8) NA2_PV((j < 8 ? j : 0), tb); } else { if (j >= 1) NA2_PV((j >= 1 ? j - 1 : 0), tb); }
                asm volatile("" ::: "memory"); }
            if (sg + 1 < 6 || has_next) NA2_WRITEG(0, (sg + 1) & 1);
            __syncthreads();
        }
        sum += __shfl_xor(sum, 16); sum += __shfl_xor(sum, 32);
        const float inv = __builtin_amdgcn_rcpf(sum);
        int lq = F.lane; asm volatile("" : "+v"(lq)); const int liq = lq & 15, gq = lq >> 4;
        const size_t mq = (size_t)b * SEQ + (size_t)r * GRIDW + c0 + liq;
        const bf16* gp = QKVG + 3 * NA2_SEC + ((size_t)(it >> 6) * 8192 + (size_t)r * GRIDW + c0 + liq) * 128 + 4 * gq;
        bf16* zp = Z + mq * 4096 + h * 128 + 4 * gq;
#pragma unroll
        for (int db = 0; db < 8; ++db) gw[db] = *(const GAS v2u*)(gp + 16 * db);
#pragma unroll
        for (int db = 0; db < 8; ++db) {
            const float z0 = O[db][0] * inv * siluf_(bf_lo(gw[db].x)), z1 = O[db][1] * inv * siluf_(bf_hi(gw[db].x)), z2 = O[db][2] * inv * siluf_(bf_lo(gw[db].y)), z3 = O[db][3] * inv * siluf_(bf_hi(gw[db].y));
            *(GAS v2u*)(zp + 16 * db) = (v2u){cvt_pk_bf16(z0, z1), cvt_pk_bf16(z2, z3)}; }
        if (has_next) {
#pragma unroll
            for (int ks = 0; ks < 4; ++ks) qf[ks] = qn[ks]; }
    }
#undef NA2_SRC
#undef NA2_SEC
#undef NA2_ID
#undef NA2_LOADG
#undef NA2_WRITEG
#undef NA2_SCORE
#undef NA2_PV
    __syncthreads();
}

__device__ __forceinline__ void s5_scan_phase(Frame& F, const Args& a) {
    const float* Sloc = (const float*)(a.ws + WS_S5_SLOC); bf16* Ug = (bf16*)(a.ws + WS_S5_UG); const float* LAMT = (const float*)(a.ws + WS_LAMT);
    const int t8 = F.tid & 255, b = t8 >> 7, dir = (t8 >> 6) & 1, p = t8 & 63;
    for (int gi = F.vcu * 2 + (F.tid >> 8); gi < S5_G; gi += F.G * 2) {
        const float lr = LAMT[((size_t)(gi * 2 + dir) * 64 + p) * 2 + 0], li = LAMT[((size_t)(gi * 2 + dir) * 64 + p) * 2 + 1];
        float xr = 0.f, xi = 0.f;
#pragma unroll 8
        for (int s = 0; s < S5_NCHB; ++s) { const int c = dir ? (S5_NCHB - 1 - s) : s; const size_t row = (size_t)gi * S5_NCH + b * S5_NCHB + c;
            bf16* up = Ug + row * S5_KY + S5_KS + dir * 128 + p;
            up[0] = (bf16)f2bf(xr); up[64] = (bf16)f2bf(xi);
            const float sr = Sloc[row * 256 + dir * 128 + p], si = Sloc[row * 256 + dir * 128 + 64 + p];
            const float nr = lr * xr - li * xi + sr, ni = lr * xi + li * xr + si; xr = nr; xi = ni; }
    }
}

__device__ __forceinline__ float log_sigmoidf_(float z) { return fminf(z, 0.f) - log1pf(expf(-fabsf(z))); }
__device__ __forceinline__ void gla_prep_phase(Frame& F, const Args& a) {
    const bf16* IN = (const bf16*)(a.ws + WS_GLA_IN); const float* G1P = (const float*)(a.ws + WS_GLA_G1P);
    bf16* PREP = (bf16*)(a.ws + WS_GLA_PREP); float* DECAY = (float*)(a.ws + WS_GLA_DECAY);
    LAS float* g1s = (LAS float*)(F.lds + RING_OFF);
    LAS float* Bc = g1s + 64 * 32;
    LAS float* bl = Bc + 2 * 64 * 256;
    static_assert((64 * 32 + 2 * 64 * 256 + 2 * 256) * 4 <= MISC_OFF, "gla prep LDS");
    const int ipw = (2048 + F.G - 1) / F.G; int cur_chunk = -1;
    for (int k = 0; k < ipw; ++k) {
        const int it = F.vcu * ipw + k; if (it >= 2048) break;
        const int cidx = it >> 3, h = it & 7, m0 = cidx * GLA_C, dbase = h * 256;
        if (cidx != cur_chunk) { cur_chunk = cidx;
            const int tok = F.tid >> 3, qd = F.tid & 7; f32x4 s4 = {0.f, 0.f, 0.f, 0.f};
#pragma unroll
            for (int ks = 0; ks < 4; ++ks) s4 += *(const GAS f32x4*)(G1P + ((size_t)ks * M + m0 + tok) * 32 + qd * 4);
            *(LAS f32x4*)(g1s + tok * 32 + qd * 4) = s4;
            __syncthreads(); }
        v4u q8[4], k8[4];
#pragma unroll
        for (int j = 0; j < 4; ++j) { const int e = F.tid + 512 * j, tok = e >> 5, c8 = (e & 31) * 8; const size_t m = (size_t)m0 + tok;
            q8[j] = __builtin_nontemporal_load((const GAS v4u*)(IN + m * GLA_NIN + dbase + c8)); k8[j] = __builtin_nontemporal_load((const GAS v4u*)(IN + m * GLA_NIN + GLA_KW + dbase + c8)); }
        {
            const int dir = F.tid >> 8, col = F.tid & 255, d = dbase + col;
            const float* w2 = dir ? a.in[28] : a.in[25]; const float bgd = (dir ? a.in[29] : a.in[26])[d];
            float w2r[16];
#pragma unroll
            for (int r = 0; r < 16; ++r) w2r[r] = w2[(size_t)r * GLA_KW + d];
            float run = 0.f;
#pragma unroll 4
            for (int s = 0; s < 64; ++s) { const int i = dir ? (63 - s) : s; const LAS f32x4* gp = (const LAS f32x4*)(g1s + i * 32 + dir * 16); float z = bgd;
                const f32x4 g0 = gp[0], g1 = gp[1], g2 = gp[2], g3 = gp[3];
                z += g0[0] * w2r[0] + g0[1] * w2r[1] + g0[2] * w2r[2] + g0[3] * w2r[3]; z += g1[0] * w2r[4] + g1[1] * w2r[5] + g1[2] * w2r[6] + g1[3] * w2r[7];
                z += g2[0] * w2r[8] + g2[1] * w2r[9] + g2[2] * w2r[10] + g2[3] * w2r[11]; z += g3[0] * w2r[12] + g3[1] * w2r[13] + g3[2] * w2r[14] + g3[3] * w2r[15];
                const float ls = fminf(z, 0.f) - __logf(1.0f + __expf(-fabsf(z)));
                run += ls * (1.0f / 16.0f); Bc[(dir * 64 + i) * 256 + col] = run; }
            bl[dir * 256 + col] = run;
        }
        __syncthreads();
#pragma unroll
        for (int j = 0; j < 4; ++j) { const int e = F.tid + 512 * j, tok = e >> 5, c8 = (e & 31) * 8; const size_t m = (size_t)m0 + tok;
            float qv[8], kv[8];
#pragma unroll
            for (int x = 0; x < 4; ++x) { qv[2 * x] = bf_lo(q8[j][x]) * 0.0625f; qv[2 * x + 1] = bf_hi(q8[j][x]) * 0.0625f; kv[2 * x] = bf_lo(k8[j][x]); kv[2 * x + 1] = bf_hi(k8[j][x]); }
#pragma unroll
            for (int dir = 0; dir < 2; ++dir) {
                f32x4 bbv[2], btv[2];
                bbv[0] = *(const LAS f32x4*)(Bc + (dir * 64 + tok) * 256 + c8); bbv[1] = *(const LAS f32x4*)(Bc + (dir * 64 + tok) * 256 + c8 + 4);
                btv[0] = *(const LAS f32x4*)(bl + dir * 256 + c8); btv[1] = *(const LAS f32x4*)(bl + dir * 256 + c8 + 4);
                float o0[8], o1[8];
#pragma unroll
                for (int x = 0; x < 8; ++x) { const float bx = bbv[x >> 2][x & 3]; o0[x] = qv[x] * __expf(bx); o1[x] = kv[x] * __expf(-bx); }
                v4u w0, w1;
#pragma unroll
                for (int x = 0; x < 4; ++x) { w0[x] = cvt_pk_bf16(o0[2 * x], o0[2 * x + 1]); w1[x] = cvt_pk_bf16(o1[2 * x], o1[2 * x + 1]); }
                bf16* pp = PREP + (size_t)(dir * 3) * M * GLA_KW + m * GLA_KW + dbase + c8;
                *(GAS v4u*)(pp) = w0; *(GAS v4u*)(pp + (size_t)M * GLA_KW) = w1;
                if (tok == 0) { float* dp = DECAY + ((size_t)dir * GLA_NCH + cidx) * GLA_KW + dbase + c8;
                    *(GAS f32x4*)(dp) = (f32x4){__expf(btv[0][0]), __expf(btv[0][1]), __expf(btv[0][2]), __expf(btv[0][3])}; *(GAS f32x4*)(dp + 4) = (f32x4){__expf(btv[1][0]), __expf(btv[1][1]), __expf(btv[1][2]), __expf(btv[1][3])}; }
            }
        }
        __syncthreads();
    }
}

constexpr int GLA_PQ = 528, GLA_PV = 272, GLA_PV2 = 144, GLA_PVI = 1040;
__device__ __forceinline__ void gla_chain_role(Frame& F, const Args& a, int ch) {
    const bf16* IN = (const bf16*)(a.ws + WS_GLA_IN); const bf16* PREP = (const bf16*)(a.ws + WS_GLA_PREP); const float* DECAY = (const float*)(a.ws + WS_GLA_DECAY);
    const int b = ch >> 7, h = (ch >> 4) & 7, dir = (ch >> 3) & 1, vo = ch & 7;
    bf16* OUT = (bf16*)(a.ws + WS_GLA_O) + (size_t)dir * M * 4096;
    const bf16* QS = PREP + (size_t)(dir * 3 + 0) * M * GLA_KW; const bf16* KE = PREP + (size_t)(dir * 3 + 1) * M * GLA_KW;
    LAS unsigned char* const qsT = F.lds + RING_OFF; LAS unsigned char* const keT = qsT + 64 * GLA_PQ; LAS unsigned char* const vT = keT + 64 * GLA_PQ; LAS float* const decT = (LAS float*)(vT + 64 * GLA_PV2);
    LAS unsigned char* const xbT = (LAS unsigned char*)(decT + 256);
    constexpr int GLA_PX = 272;
    static_assert(2 * 64 * GLA_PQ + 64 * GLA_PV2 + 1024 + 2 * 64 * GLA_PX <= MISC_OFF, "gla chain LDS");
    const int lane = F.lane, li = lane & 15, g = lane >> 4, q4 = li >> 2, p4 = li & 3, w = F.wave, wv = w & 3;
    f32x4 S[16];
#pragma unroll
    for (int dt = 0; dt < 16; ++dt) S[dt] = (f32x4){0.f, 0.f, 0.f, 0.f};
    f32x4 accp[4];
#pragma unroll
    for (int ib = 0; ib < 4; ++ib) accp[ib] = (f32x4){0.f, 0.f, 0.f, 0.f};
    size_t m0prev = 0;
    v4u rq[4], rk[4], rv[1]; f32x4 rd = {0.f, 0.f, 0.f, 0.f};
#define GC_LOAD(sidx) do { const int cn_ = dir ? (GLA_NCHB - 1 - (sidx)) : (sidx); const size_t m0_ = ((size_t)b * GLA_NCHB + cn_) * GLA_C; \
        _Pragma("unroll") for (int j = 0; j < 4; ++j) { const int e = F.tid + 512 * j, tok = e >> 5, pc = e & 31; \
            rq[j] = *(const GAS v4u*)(QS + (m0_ + tok) * GLA_KW + h * 256 + pc * 8); rk[j] = *(const GAS v4u*)(KE + (m0_ + tok) * GLA_KW + h * 256 + pc * 8); } \
        { const int tok = F.tid >> 3, pc = F.tid & 7; rv[0] = *(const GAS v4u*)(IN + (m0_ + tok) * GLA_NIN + 4096 + h * 512 + vo * 64 + pc * 8); } \
        if (F.tid < 64) rd = *(const GAS f32x4*)(DECAY + ((size_t)dir * GLA_NCH + b * GLA_NCHB + cn_) * GLA_KW + h * 256 + F.tid * 4); } while (0)
#define GC_FLUSH(m0p, pb) do { _Pragma("unroll") for (int vt = 0; vt < 4; ++vt) { \
        const f32x4 o_ = accp[vt] + *(const LAS f32x4*)(xbT + (pb) * (64 * GLA_PX) + (16 * wv + li) * GLA_PX + (16 * vt + 4 * g) * 4); \
        *(GAS v2u*)(OUT + ((m0p) + 16 * wv + li) * 4096 + h * 512 + vo * 64 + vt * 16 + 4 * g) = (v2u){cvt_pk_bf16(o_[0], o_[1]), cvt_pk_bf16(o_[2], o_[3])}; } } while (0)
    GC_LOAD(0);
    for (int sidx = 0; sidx < GLA_NCHB; ++sidx) {
#pragma unroll
        for (int j = 0; j < 4; ++j) { const int e = F.tid + 512 * j, tok = e >> 5, pc = e & 31; *(LAS v4u*)(qsT + tok * GLA_PQ + pc * 16) = rq[j]; *(LAS v4u*)(keT + tok * GLA_PQ + pc * 16) = rk[j]; }
        { const int tok = F.tid >> 3, pc = F.tid & 7; *(LAS v4u*)(vT + tok * GLA_PV2 + pc * 16) = rv[0]; }
        if (F.tid < 64) *(LAS f32x4*)(decT + F.tid * 4) = rd;
        __syncthreads();
        const int cn = dir ? (GLA_NCHB - 1 - sidx) : sidx; const size_t m0 = ((size_t)b * GLA_NCHB + cn) * GLA_C;
        if (sidx + 1 < GLA_NCHB) GC_LOAD(sidx + 1);
        if (w < 4) {
            __builtin_amdgcn_s_setprio(2);
            v2u Sb[16];
#pragma unroll
            for (int dt = 0; dt < 16; ++dt) Sb[dt] = (v2u){cvt_pk_bf16(S[dt][0], S[dt][1]), cvt_pk_bf16(S[dt][2], S[dt][3])};
            {
                f32x4 acc[4];
#pragma unroll
                for (int ib = 0; ib < 4; ++ib) acc[ib] = (f32x4){0.f, 0.f, 0.f, 0.f};
                const LAS unsigned char* qrow = qsT + li * GLA_PQ + 8 * g;
                v2u bq[2][8];
#pragma unroll
                for (int ib = 0; ib < 4; ++ib) { bq[0][2 * ib] = *(const LAS v2u*)(qrow + 16 * ib * GLA_PQ); bq[0][2 * ib + 1] = *(const LAS v2u*)(qrow + 16 * ib * GLA_PQ + 32); }
#pragma unroll
                for (int ks = 0; ks < 8; ++ks) {
                    if (ks < 7) {
#pragma unroll
                        for (int ib = 0; ib < 4; ++ib) { bq[(ks + 1) & 1][2 * ib] = *(const LAS v2u*)(qrow + 16 * ib * GLA_PQ + 64 * (ks + 1)); bq[(ks + 1) & 1][2 * ib + 1] = *(const LAS v2u*)(qrow + 16 * ib * GLA_PQ + 64 * (ks + 1) + 32); } }
                    __builtin_amdgcn_sched_barrier(0);
                    const bf16x8 A = __builtin_bit_cast(bf16x8, (v4u){Sb[2 * ks].x, Sb[2 * ks].y, Sb[2 * ks + 1].x, Sb[2 * ks + 1].y});
#pragma unroll
                    for (int ib = 0; ib < 4; ++ib) acc[ib] = MFMA16(A, __builtin_bit_cast(bf16x8, (v4u){bq[ks & 1][2 * ib].x, bq[ks & 1][2 * ib].y, bq[ks & 1][2 * ib + 1].x, bq[ks & 1][2 * ib + 1].y}), acc[ib]);
                    __builtin_amdgcn_sched_barrier(0);
                }
#pragma unroll
                for (int ib = 0; ib < 4; ++ib) *(LAS f32x4*)(xbT + (sidx & 1) * (64 * GLA_PX) + (16 * ib + li) * GLA_PX + (16 * wv + 4 * g) * 4) = acc[ib];
            }
            {
                const LAS unsigned char* vb0 = vT + (8 * g + q4) * GLA_PV2 + (wv * 16 + 4 * p4) * 2;
                const LAS unsigned char* kb0 = keT + (8 * g + q4) * GLA_PQ + 8 * p4;
                s16x4 Bv[4], ka[2][8];
#pragma unroll
                for (int k2 = 0; k2 < 2; ++k2) { Bv[2 * k2] = tr4(vb0 + 32 * k2 * GLA_PV2); Bv[2 * k2 + 1] = tr4(vb0 + (32 * k2 + 4) * GLA_PV2); }
#pragma unroll
                for (int j = 0; j < 4; ++j) { ka[0][2 * j] = tr4(kb0 + 32 * j); ka[0][2 * j + 1] = tr4(kb0 + 4 * GLA_PQ + 32 * j); }
#pragma unroll
                for (int gi = 0; gi < 8; ++gi) {
                    if (gi < 7) { const int k2n = (gi + 1) >> 2, dgn = (gi + 1) & 3;
#pragma unroll
                        for (int j = 0; j < 4; ++j) { ka[(gi + 1) & 1][2 * j] = tr4(kb0 + 32 * k2n * GLA_PQ + 32 * (4 * dgn + j)); ka[(gi + 1) & 1][2 * j + 1] = tr4(kb0 + (32 * k2n + 4) * GLA_PQ + 32 * (4 * dgn + j)); } }
                    __builtin_amdgcn_sched_barrier(0);
                    const int k2 = gi >> 2, dg = gi & 3;
                    const bf16x8 B = cat8(Bv[2 * k2], Bv[2 * k2 + 1]);
#pragma unroll
                    for (int j = 0; j < 4; ++j) S[4 * dg + j] = MFMA16(cat8(ka[gi & 1][2 * j], ka[gi & 1][2 * j + 1]), B, S[4 * dg + j]);
                    __builtin_amdgcn_sched_barrier(0);
                }
#pragma unroll
                for (int dh = 0; dh < 2; ++dh) { f32x4 dc[8];
#pragma unroll
                    for (int j = 0; j < 8; ++j) dc[j] = *(const LAS f32x4*)(decT + 16 * (8 * dh + j) + 4 * g);
                    __builtin_amdgcn_sched_barrier(0);
#pragma unroll
                    for (int j = 0; j < 8; ++j) S[8 * dh + j] *= dc[j]; }
            }
            __builtin_amdgcn_s_setprio(0);
        } else {
            const int ib = wv;
            bf16x8 qreg[8];
#pragma unroll
            for (int ks = 0; ks < 8; ++ks) qreg[ks] = *(const LAS bf16x8*)(qsT + (16 * ib + li) * GLA_PQ + (32 * ks + 8 * g) * 2);
            if (sidx > 0) GC_FLUSH(m0prev, (sidx - 1) & 1);
            m0prev = m0;
            __builtin_amdgcn_sched_barrier(0);
            f32x4 P[4];
#pragma unroll
            for (int jb = 0; jb < 4; ++jb) { f32x4 sc = {0.f, 0.f, 0.f, 0.f};
                if (dir ? (jb >= ib) : (jb <= ib)) {
                    bf16x8 kr[8];
#pragma unroll
                    for (int ks = 0; ks < 8; ++ks) kr[ks] = *(const LAS bf16x8*)(keT + (16 * jb + li) * GLA_PQ + (32 * ks + 8 * g) * 2);
                    __builtin_amdgcn_sched_barrier(0);
#pragma unroll
                    for (int ks = 0; ks < 8; ++ks) sc = MFMA16(kr[ks], qreg[ks], sc);
                    __builtin_amdgcn_sched_barrier(0); }
#pragma unroll
                for (int e = 0; e < 4; ++e) { const int ii = 16 * ib + li, jj = 16 * jb + 4 * g + e; const bool keep = dir ? (ii < jj) : (ii >= jj); P[jb][e] = keep ? sc[e] : 0.f; } }
            const bf16x8 Pb0 = pack8(P[0], P[1]), Pb1 = pack8(P[2], P[3]);
            const LAS unsigned char* vb = vT + (4 * g + q4) * GLA_PV2 + 8 * p4;
            s16x4 vr[16];
#pragma unroll
            for (int vt = 0; vt < 4; ++vt) { vr[4 * vt] = tr4(vb + 32 * vt); vr[4 * vt + 1] = tr4(vb + 16 * GLA_PV2 + 32 * vt); vr[4 * vt + 2] = tr4(vb + 32 * GLA_PV2 + 32 * vt); vr[4 * vt + 3] = tr4(vb + 48 * GLA_PV2 + 32 * vt); }
            __builtin_amdgcn_sched_barrier(0);
#pragma unroll
            for (int vt = 0; vt < 4; ++vt) { f32x4 acc = {0.f, 0.f, 0.f, 0.f};
                acc = MFMA16(cat8(vr[4 * vt], vr[4 * vt + 1]), Pb0, acc);
                acc = MFMA16(cat8(vr[4 * vt + 2], vr[4 * vt + 3]), Pb1, acc);
                accp[vt] = acc; }
        }
        __syncthreads();
    }
    if (w >= 4) GC_FLUSH(m0prev, (GLA_NCHB - 1) & 1);
    __syncthreads();
#undef GC_LOAD
#undef GC_FLUSH
}
__device__ __forceinline__ void gla_intra_role(Frame& F, const Args& a, int it) {
    const bf16* IN = (const bf16*)(a.ws + WS_GLA_IN); const bf16* PREP = (const bf16*)(a.ws + WS_GLA_PREP);
    bf16* OUT = (bf16*)(a.ws + WS_GLA_O);
    const int b = it >> 10, h = (it >> 7) & 7, cn = it & 127; const size_t m0 = ((size_t)b * GLA_NCHB + cn) * GLA_C;
    LAS unsigned char* const kfT = F.lds + RING_OFF; LAS unsigned char* const kbT = kfT + 64 * GLA_PQ; LAS unsigned char* const vT = kbT + 64 * GLA_PQ;
    const int lane = F.lane, li = lane & 15, g = lane >> 4, q4 = li >> 2, p4 = li & 3, ib = F.wave & 3, vh = F.wave >> 2;
    const bf16* KSF = PREP + (size_t)1 * M * GLA_KW; const bf16* KSB = PREP + (size_t)4 * M * GLA_KW;
    const bf16* QSF = PREP; const bf16* QSB = PREP + (size_t)3 * M * GLA_KW;
    {
        v4u r0[4], r1[4], r2[8];
#pragma unroll
        for (int j = 0; j < 4; ++j) { const int e = F.tid + 512 * j, tok = e >> 5, pc = e & 31; r0[j] = *(const GAS v4u*)(KSF + (m0 + tok) * GLA_KW + h * 256 + pc * 8); r1[j] = *(const GAS v4u*)(KSB + (m0 + tok) * GLA_KW + h * 256 + pc * 8); }
#pragma unroll
        for (int j = 0; j < 8; ++j) { const int e = F.tid + 512 * j, tok = e >> 6, pc = e & 63; r2[j] = *(const GAS v4u*)(IN + (m0 + tok) * GLA_NIN + 4096 + h * 512 + pc * 8); }
#pragma unroll
        for (int j = 0; j < 4; ++j) { const int e = F.tid + 512 * j, tok = e >> 5, pc = e & 31; *(LAS v4u*)(kfT + tok * GLA_PQ + pc * 16) = r0[j]; *(LAS v4u*)(kbT + tok * GLA_PQ + pc * 16) = r1[j]; }
#pragma unroll
        for (int j = 0; j < 8; ++j) { const int e = F.tid + 512 * j, tok = e >> 6, pc = e & 63; *(LAS v4u*)(vT + tok * GLA_PVI + pc * 16) = r2[j]; }
    }
    bf16x8 qf[8], qb[8];
#pragma unroll
    for (int ks = 0; ks < 8; ++ks) { qf[ks] = *(const GAS bf16x8*)(QSF + (m0 + 16 * ib + li) * GLA_KW + h * 256 + 32 * ks + 8 * g); qb[ks] = *(const GAS bf16x8*)(QSB + (m0 + 16 * ib + li) * GLA_KW + h * 256 + 32 * ks + 8 * g); }
    __syncthreads();
    f32x4 P[4];
#pragma unroll
    for (int jb = 0; jb < 4; ++jb) { f32x4 sf = {0.f, 0.f, 0.f, 0.f}, sb = {0.f, 0.f, 0.f, 0.f};
        if (jb <= ib) {
#pragma unroll
            for (int ks = 0; ks < 8; ++ks) sf = MFMA16(*(const LAS bf16x8*)(kfT + (16 * jb + li) * GLA_PQ + (32 * ks + 8 * g) * 2), qf[ks], sf); }
        if (jb >= ib) {
#pragma unroll
            for (int ks = 0; ks < 8; ++ks) sb = MFMA16(*(const LAS bf16x8*)(kbT + (16 * jb + li) * GLA_PQ + (32 * ks + 8 * g) * 2), qb[ks], sb); }
#pragma unroll
        for (int e = 0; e < 4; ++e) { const int ii = 16 * ib + li, jj = 16 * jb + 4 * g + e; P[jb][e] = (ii >= jj) ? sf[e] : sb[e]; } }
    if (MK_DIAG) { bool bad = false;
#pragma unroll
        for (int jb = 0; jb < 4; ++jb)
#pragma unroll
            for (int e = 0; e < 4; ++e) bad |= !(fabsf(P[jb][e]) < 1e30f);
        if (bad) atomicOr((unsigned*)(a.ws + WS_CTL) + 17, 1u << 4); }
    const bf16x8 Pb0 = pack8(P[0], P[1]), Pb1 = pack8(P[2], P[3]);
    bf16* op = OUT + (m0 + 16 * ib + li) * 4096 + h * 512 + vh * 256 + 4 * g;
    const LAS unsigned char* vb = vT + (4 * g + q4) * GLA_PVI + (vh * 256 + 4 * p4) * 2;
#pragma unroll
    for (int vt = 0; vt < 16; ++vt) { f32x4 acc = {0.f, 0.f, 0.f, 0.f};
        acc = MFMA16(cat8(tr4(vb + 32 * vt), tr4(vb + 16 * GLA_PVI + 32 * vt)), Pb0, acc);
        acc = MFMA16(cat8(tr4(vb + 32 * GLA_PVI + 32 * vt), tr4(vb + 48 * GLA_PVI + 32 * vt)), Pb1, acc);
        if (MK_DIAG && (!(fabsf(acc[0]) < 1e30f) || !(fabsf(acc[1]) < 1e30f) || !(fabsf(acc[2]) < 1e30f) || !(fabsf(acc[3]) < 1e30f))) atomicOr((unsigned*)(a.ws + WS_CTL) + 17, 1u << 5);
        *(GAS v2u*)(op + 16 * vt) = (v2u){cvt_pk_bf16(acc[0], acc[1]), cvt_pk_bf16(acc[2], acc[3])}; }
    __syncthreads();
}
__device__ __forceinline__ void gla_main_phase(Frame& F, const Args& a) {
    for (int ch = F.vcu; ch < 256; ch += F.G) gla_chain_role(F, a, ch);
}
__device__ __forceinline__ void gla_combine_phase(Frame& F, const Args& a) {
    const bf16* IN = (const bf16*)(a.ws + WS_GLA_IN); const bf16* O = (const bf16*)(a.ws + WS_GLA_O); bf16* Z = (bf16*)(a.ws + WS_GLA_Z);
    const float* nw = a.in[30];
    float nwr[8];
#pragma unroll
    for (int x = 0; x < 8; ++x) nwr[x] = nw[F.lane * 8 + x];
    const int gw = F.vcu * NWAVES + F.wave, NGW = F.G * NWAVES;
    for (int m = gw; m < M; m += NGW) {
#pragma unroll 2
        for (int h = 0; h < 8; ++h) { const size_t off = (size_t)m * 4096 + h * 512 + F.lane * 8;
            const v4u x0 = __builtin_nontemporal_load((const GAS v4u*)(O + off)), x1 = __builtin_nontemporal_load((const GAS v4u*)(O + (size_t)M * 4096 + off));
            const v4u gg = __builtin_nontemporal_load((const GAS v4u*)(IN + (size_t)m * GLA_NIN + 8192 + h * 512 + F.lane * 8));
            if (MK_DIAG) { bool b0 = false, b1 = false, b2 = false, b3 = false;
#pragma unroll
                for (int x = 0; x < 4; ++x) { b0 |= !(fabsf(bf_lo(x0[x])) < 1e30f) || !(fabsf(bf_hi(x0[x])) < 1e30f); b1 |= !(fabsf(bf_lo(x1[x])) < 1e30f) || !(fabsf(bf_hi(x1[x])) < 1e30f);
                    b3 |= !(fabsf(bf_lo(gg[x])) < 1e30f) || !(fabsf(bf_hi(gg[x])) < 1e30f); }
                const unsigned f = (b0 ? 1024u : 0u) | (b1 ? 2048u : 0u) | (b2 ? 4096u : 0u) | (b3 ? 8192u : 0u); if (f) atomicOr((unsigned*)(a.ws + WS_CTL) + 17, f); }
            float o[8]; float ss = 0.f;
#pragma unroll
            for (int x = 0; x < 4; ++x) { o[2 * x] = bf_lo(x0[x]) + bf_lo(x1[x]); o[2 * x + 1] = bf_hi(x0[x]) + bf_hi(x1[x]); ss += o[2 * x] * o[2 * x] + o[2 * x + 1] * o[2 * x + 1]; }
            const float rstd = rsqrtf(wave_sum(ss) * (1.0f / 512.0f) + EPS);
            v4u zw;
#pragma unroll
            for (int x = 0; x < 4; ++x) zw[x] = cvt_pk_bf16(o[2 * x] * rstd * nwr[2 * x] * siluf_(bf_lo(gg[x])), o[2 * x + 1] * rstd * nwr[2 * x + 1] * siluf_(bf_hi(gg[x])));
            *(GAS v4u*)(Z + off) = zw; }
    }
}

constexpr int NPH = 23;
__global__ void __launch_bounds__(NWAVES * 64, 2) fwd_kernel(Args args) {
    extern __shared__ __attribute__((aligned(16))) unsigned char lds[];
    Frame F;
    F.lds = (LAS unsigned char*)lds;
    F.tid = threadIdx.x; F.lane = F.tid & 63; F.wave = __builtin_amdgcn_readfirstlane(F.tid >> 6);
    F.G = gridDim.x; { const int bx = blockIdx.x; F.vcu = (F.G % 8 == 0) ? (bx % 8) * (F.G / 8) + bx / 8 : bx; }
    volatile LAS unsigned* MISC = (volatile LAS unsigned*)(F.lds + MISC_OFF);
    for (int u = F.tid; u < (LDS_BYTES - MISC_OFF) / 4; u += NWAVES * 64) MISC[u] = 0u;
    __syncthreads();
    unsigned char* ws = args.ws;
    const int lo = args.ph_lo, hi = args.ph_hi, rep = args.dup;
    XcdBarrier bar; bar.bar = (unsigned*)(ws + WS_CTL) + CW_BAR; bar.x = 0; bar.st = nullptr;
    if (hi - lo > 1) bar = xcd_barrier_post((unsigned*)(ws + WS_CTL) + CW_BAR, MISC + 8);
#define IN(k) (lo <= (k) && (k) < hi)
#define REP(k)
#if MK_PROF
    volatile LAS unsigned long long* PROF = (volatile LAS unsigned long long*)(F.lds + 135168);
    if (F.tid == 0) PROF[0] = __builtin_amdgcn_s_memrealtime();
#define SEAM(k) do { if (IN(k) && IN((k) + 1)) { if (F.tid == 0) PROF[32 + (k)] = __builtin_amdgcn_s_memrealtime(); xcd_barrier(bar); if (F.tid == 0) PROF[1 + (k)] = __builtin_amdgcn_s_memrealtime(); } } while (0)
#else
#define SEAM(k) do { if (IN(k) && IN((k) + 1)) xcd_barrier(bar); } while (0)
#endif
    const float* MOD = (const float*)(ws + WS_MOD);
    bf16* H = (bf16*)(ws + WS_H);
    float* XO = args.out;
    LAS unsigned char* ring = F.lds + RING_OFF;
    unsigned* const DFLAG = (unsigned*)(ws + WS_CTL) + 16;

    if (IN(0)) { REP(0) { p0_prologue(F, args); } } SEAM(0);

#if MK_NLAYERS >= 1
    if (IN(1)) { REP(1) { norm_phase<false>(F, args.in[0], args.in[4] + 0 * D, MOD + 0 * 2 * 12288, H, nullptr); } } SEAM(1);
    if (IN(2)) { REP(2) { pg8::Gemm g{H, (const bf16*)(ws + WS_W_NAIN0), 4096, 4096, 4096, DFLAG, 1u << 2}; pg8::StaticOrder S; S.init(M, 16384, F.G, (int)blockIdx.x);
        pg8::EpiNaIn E{(bf16*)(ws + WS_NA_QKVG)};
        pg8::gemm_phase<pg8::EpiNaIn, pg8::StaticOrder, false, true>(ring, g, S, E); } } SEAM(2);
    if (IN(3)) { REP(3) na_attn_phase2(F, (const bf16*)(ws + WS_NA_QKVG), (bf16*)(ws + WS_NA_Z), args.in[6] + 0 * 32 * 465); } SEAM(3);
    if (IN(4)) { REP(4) { pg8::Gemm g{(const bf16*)(ws + WS_NA_Z), (const bf16*)(ws + WS_W_NAOUT0), 4096, 4096, 4096, DFLAG, 1u << 4}; pg8::StaticOrder S; S.init(M, 4096, F.G, (int)blockIdx.x);
        pg8::EpiResid E{args.in[0], rep ? (float*)(ws + WS_SCR) : XO, D, MOD + 0 * 2 * 12288 + 8192, 12288, SEQ};
        pg8::gemm_phase<pg8::EpiResid, pg8::StaticOrder, true, true>(ring, g, S, E); } } SEAM(4);
#endif
#if MK_NLAYERS >= 2
    if (IN(5)) { REP(5) { norm_phase<false>(F, XO, args.in[4] + 1 * D, MOD + 1 * 2 * 12288, H, nullptr); } } SEAM(5);
    if (IN(6)) { REP(6) { pg8::Gemm g{H, (const bf16*)(ws + WS_W_S5IN), 4096, 4096, 4096, DFLAG, 1u << 6}; pg8::StaticOrder S; S.init(M, 8192, F.G, (int)blockIdx.x);
        pg8::EpiS5In<S5_T, S5_NCH, S5_KY> E{(bf16*)(ws + WS_S5_UG), (bf16*)(ws + WS_S5_GS)};
        pg8::gemm_phase<pg8::EpiS5In<S5_T, S5_NCH, S5_KY>, pg8::StaticOrder, true, true>(ring, g, S, E); } } SEAM(6);
    if (IN(7)) { REP(7) { pg8::Gemm g{(const bf16*)(ws + WS_S5_UG), (const bf16*)(ws + WS_S5BS), S5_KS, S5_KY, S5_KS, DFLAG, 1u << 7}; pg8::BatchedOrder S; S.init(S5_G, S5_NCH / 256, 1, F.G, (int)blockIdx.x);
        pg8::EpiF32 E{(float*)(ws + WS_S5_SLOC), 256};
        pg8::gemm_phase<pg8::EpiF32, pg8::BatchedOrder, true, true>(ring, g, S, E); } } SEAM(7);
    if (IN(8)) { REP(8) { s5_scan_phase(F, args); } } SEAM(8);
    if (IN(9)) { REP(9) { pg8::Gemm g{(const bf16*)(ws + WS_S5_UG), (const bf16*)(ws + WS_S5BY), S5_KY, S5_KY, S5_KY, DFLAG, 1u << 9}; pg8::BatchedOrder S; S.init(S5_G, S5_NCH / 256, S5_KS / 256, F.G, (int)blockIdx.x);
        pg8::EpiS5Y<S5_T, S5_NCH / 256> E{(bf16*)(ws + WS_S5_Y)};
        pg8::gemm_phase<pg8::EpiS5Y<S5_T, S5_NCH / 256>, pg8::BatchedOrder, true, true>(ring, g, S, E); } } SEAM(9);
    if (IN(10)) { REP(10) { pg8::Gemm g{(const bf16*)(ws + WS_S5_Y), (const bf16*)(ws + WS_W_S5GLU), 4096, 4096, 4096, DFLAG, 1u << 10}; pg8::StaticOrder S; S.init(M, 4096, F.G, (int)blockIdx.x);
        pg8::EpiGlu E{(const bf16*)(ws + WS_S5_Y), (const bf16*)(ws + WS_S5_GS), args.in[21], (bf16*)(ws + WS_S5_Z)};
        pg8::gemm_phase<pg8::EpiGlu, pg8::StaticOrder, true, true>(ring, g, S, E); } } SEAM(10);
    if (IN(11)) { REP(11) { pg8::Gemm g{(const bf16*)(ws + WS_S5_Z), (const bf16*)(ws + WS_W_S5OUT), 4096, 4096, 4096, DFLAG, 1u << 11}; pg8::StaticOrder S; S.init(M, 4096, F.G, (int)blockIdx.x);
        pg8::EpiResid E{XO, rep ? (float*)(ws + WS_SCR) : XO, D, MOD + 1 * 2 * 12288 + 8192, 12288, SEQ};
        pg8::gemm_phase<pg8::EpiResid, pg8::StaticOrder, true, true>(ring, g, S, E); } } SEAM(11);
#endif
#if MK_NLAYERS >= 3
    if (IN(12)) { REP(12) { norm_phase<false>(F, XO, args.in[4] + 2 * D, MOD + 2 * 2 * 12288, H, nullptr); } } SEAM(12);
    if (IN(13)) { REP(13) { { pg8::Gemm g{H, (const bf16*)(ws + WS_W_GLAIN), 4096, 4096, 4096, DFLAG, 1u << 13}; pg8::StaticOrder S; S.init(M, GLA_NIN, F.G, (int)blockIdx.x);
          pg8::EpiBf16 E{(bf16*)(ws + WS_GLA_IN), GLA_NIN};
          pg8::gemm_phase<pg8::EpiBf16, pg8::StaticOrder, true, true>(ring, g, S, E); }
        { pg8::Gemm g{H, (const bf16*)(ws + WS_W_GLAG1), 1024, 4096, 4096, DFLAG, 1u << 13}; pg8::SplitKOrder S; S.init(M, 4, 1024, F.G, (int)blockIdx.x);
          pg8::EpiGate E{(float*)(ws + WS_GLA_G1P), M};
          pg8::gemm_phase<pg8::EpiGate, pg8::SplitKOrder, true, true>(ring, g, S, E); } } } SEAM(13);
    if (IN(14)) { REP(14) { gla_prep_phase(F, args); } } SEAM(14);
    if (IN(15)) { REP(15) { gla_main_phase(F, args); } } SEAM(15);
    if (IN(16)) { REP(16) { gla_combine_phase(F, args); } } SEAM(16);
    if (IN(17)) { REP(17) { pg8::Gemm g{(const bf16*)(ws + WS_GLA_Z), (const bf16*)(ws + WS_W_GLAOUT), 4096, 4096, 4096, DFLAG, 1u << 17}; pg8::StaticOrder S; S.init(M, 4096, F.G, (int)blockIdx.x);
        pg8::EpiResid E{XO, rep ? (float*)(ws + WS_SCR) : XO, D, MOD + 2 * 2 * 12288 + 8192, 12288, SEQ};
        pg8::gemm_phase<pg8::EpiResid, pg8::StaticOrder, true, true>(ring, g, S, E); } } SEAM(17);
#endif
#if MK_NLAYERS >= 4
    if (IN(18)) { REP(18) { norm_phase<false>(F, XO, args.in[4] + 3 * D, MOD + 3 * 2 * 12288, H, nullptr); } } SEAM(18);
    if (IN(19)) { REP(19) { pg8::Gemm g{H, (const bf16*)(ws + WS_W_NAIN1), 4096, 4096, 4096, DFLAG, 1u << 19}; pg8::StaticOrder S; S.init(M, 16384, F.G, (int)blockIdx.x);
        pg8::EpiNaIn E{(bf16*)(ws + WS_NA_QKVG)};
        pg8::gemm_phase<pg8::EpiNaIn, pg8::StaticOrder, false, true>(ring, g, S, E); } } SEAM(19);
    if (IN(20)) { REP(20) na_attn_phase2(F, (const bf16*)(ws + WS_NA_QKVG), (bf16*)(ws + WS_NA_Z), args.in[6] + 1 * 32 * 465); } SEAM(20);
    if (IN(21)) { REP(21) { pg8::Gemm g{(const bf16*)(ws + WS_NA_Z), (const bf16*)(ws + WS_W_NAOUT1), 4096, 4096, 4096, DFLAG, 1u << 21}; pg8::StaticOrder S; S.init(M, 4096, F.G, (int)blockIdx.x);
        pg8::EpiResid E{XO, rep ? (float*)(ws + WS_SCR) : XO, D, MOD + 3 * 2 * 12288 + 8192, 12288, SEQ};
        pg8::gemm_phase<pg8::EpiResid, pg8::StaticOrder, true, true>(ring, g, S, E); } } SEAM(21);
#endif
    if (IN(22)) { REP(22) norm_phase<true>(F, (MK_NLAYERS >= 1) ? (const float*)XO : args.in[0], args.in[32], nullptr, nullptr, XO); }
#if MK_DIAG
    if (IN(22)) { __syncthreads(); const unsigned f = __hip_atomic_load(DFLAG, __ATOMIC_RELAXED, __HIP_MEMORY_SCOPE_AGENT);
        const unsigned f2 = __hip_atomic_load(DFLAG + 1, __ATOMIC_RELAXED, __HIP_MEMORY_SCOPE_AGENT);
        if (f != 0u || f2 != 0u) { const int k = f2 ? (24 + __builtin_ctz(f2)) : __builtin_ctz(f); float mk = 10.f; for (int i = 0; i < k; ++i) mk *= 10.f;
            const int gw = F.vcu * NWAVES + F.wave, NGW = F.G * NWAVES;
            for (int m = gw; m < M; m += NGW) for (int j = 0; j < 16; ++j) *((GAS f32x4*)(XO + (size_t)m * D) + F.lane + 64 * j) = (f32x4){mk, mk, mk, mk}; }
        else { const int gw = F.vcu * NWAVES + F.wave, NGW = F.G * NWAVES;
            for (int m = gw; m < M; m += NGW) for (int j = 0; j < 16; ++j) { GAS f32x4* p = (GAS f32x4*)(XO + (size_t)m * D) + F.lane + 64 * j; f32x4 v = *p; bool ch = false;
                for (int e = 0; e < 4; ++e) if (!(__builtin_fabsf(v[e]) < 3.0e38f)) { v[e] = 3.0e30f; ch = true; } if (ch) *p = v; } } }
#endif
#if MK_PROF
    if (F.tid == 0) PROF[32 + 22] = __builtin_amdgcn_s_memrealtime();
    xcd_barrier(bar);
    if (F.tid == 0) PROF[1 + 22] = __builtin_amdgcn_s_memrealtime();
    __syncthreads();
    if (blockIdx.x == 0) {
        float d[23], w[23];
        for (int k = 0; k < 23; ++k) { d[k] = (float)(PROF[1 + k] - PROF[k]) * 0.01f; w[k] = (float)(PROF[1 + k] - PROF[32 + k]) * 0.01f; }
        (void)w;
        const float A = (float)(MK_PROF_A) * 1.0e4f, B = (float)(MK_PROF_B) * 1.0e3f;
        for (size_t i = F.tid; i < (size_t)M * D; i += NWAVES * 64) XO[i] = (i == 0) ? A : B;
    }
#endif
#undef IN
#undef REP
#undef SEAM
}

extern "C" void kernel_launch(void* const* d_in, const int* in_sizes, int n_in, void* d_out, int out_size, void* d_ws, size_t ws_size, hipStream_t stream) {
    static int grid = 0;
    if (grid == 0) {
        if (n_in != 33 || in_sizes[0] != M * D || out_size != M * D || ws_size < WS_END) {
            fprintf(stderr, "kernel_launch: built for 33 inputs, x/out of %d floats, >= %zu bytes of workspace; got n_in %d, in0 %d, out %d, ws %zu; nothing launched\n", M * D, (size_t)WS_END, n_in, n_in > 0 ? in_sizes[0] : -1, out_size, ws_size);
            grid = -1; return; }
        int dev = 0, cus = 0, per_cu = 0;
        if (hipGetDevice(&dev) != hipSuccess || hipDeviceGetAttribute(&cus, hipDeviceAttributeMultiprocessorCount, dev) != hipSuccess) { fprintf(stderr, "kernel_launch: device query failed\n"); grid = -1; return; }
        if (hipFuncSetAttribute((const void*)fwd_kernel, hipFuncAttributeMaxDynamicSharedMemorySize, LDS_BYTES) != hipSuccess) { fprintf(stderr, "kernel_launch: hipFuncSetAttribute failed\n"); grid = -1; return; }
        if (hipOccupancyMaxActiveBlocksPerMultiprocessor(&per_cu, (const void*)fwd_kernel, NWAVES * 64, LDS_BYTES) != hipSuccess || per_cu < 1)
            fprintf(stderr, "kernel_launch: note: occupancy query reports %d workgroups per CU\n", per_cu);
        (void)hipGetLastError();
        grid = cus;
        if (grid != 256) fprintf(stderr, "kernel_launch: note: %d CUs (tuned for 256)\n", grid);
        if (grid < 136) { fprintf(stderr, "kernel_launch: needs >= 136 CUs\n"); grid = -1; return; }
    }
    if (grid < 0) return;
    if (hipMemsetAsync((char*)d_ws + WS_CTL, 0, CTL_ZERO_BYTES, stream) != hipSuccess) { fprintf(stderr, "kernel_launch: memset failed\n"); return; }
    Args a{};
    for (int i = 0; i < 33; ++i) a.in[i] = (const float*)d_in[i];
    a.out = (float*)d_out; a.ws = (unsigned char*)d_ws;
#if MK_ONE_LAUNCH
    a.ph_lo = 0; a.ph_hi = NPH;
    hipLaunchKernelGGL(fwd_kernel, dim3(grid), dim3(NWAVES * 64), LDS_BYTES, stream, a);
#else
    for (int ph = 0; ph < NPH; ++ph) { a.ph_lo = ph; a.ph_hi = ph + 1; a.dup = 0;
        hipLaunchKernelGGL(fwd_kernel, dim3(grid), dim3(NWAVES * 64), LDS_BYTES, stream, a);
        if ((MK_DUP >> ph) & 1u) { a.dup = 1; hipLaunchKernelGGL(fwd_kernel, dim3(grid), dim3(NWAVES * 64), LDS_BYTES, stream, a); } }
#endif
    const hipError_t le = hipPeekAtLastError();
    if (le != hipSuccess) fprintf(stderr, "kernel_launch: launch failed: %s\n", hipGetErrorName(le));
}
```
